# Optimizing an MI355X kernel written in HIP

```python
import math
import jax, jax.numpy as jnp
from jax import lax
import numpy as np

D_MODEL = 1024
BATCH = 2
SEQ = 8192
DEPTH = 1

GM_WIDTH = D_MODEL // 2
GM_GROUPS = 8
GM_GROUP_DIM = GM_WIDTH // GM_GROUPS
GM_CHUNK = 128

NSA_HEADS = 8
NSA_KV_GROUPS = 2
NSA_REP = NSA_HEADS // NSA_KV_GROUPS
HEAD_DIM = (D_MODEL - GM_WIDTH) // NSA_HEADS
Q_DIM = NSA_HEADS * HEAD_DIM
KV_DIM = NSA_KV_GROUPS * HEAD_DIM
MIX_WIDTH = GM_WIDTH + Q_DIM
CMP_BLOCK = 32
CMP_STRIDE = 16
CMP_HIDDEN = 256
SLC_BLOCK = 64
SLC_TOPN = 16
WINDOW = 512
Q_BLOCK = 128
FORCE_SCORE = 1e9
ATTN_SCALE = HEAD_DIM ** -0.5
IN_SIZES = (GM_WIDTH, GM_WIDTH, Q_DIM, KV_DIM, KV_DIM, KV_DIM, KV_DIM, KV_DIM, KV_DIM, 3 * NSA_HEADS)
IN_COLS = sum(IN_SIZES)

N_EXPERTS = 32
TOP_K = 4
D_FF = D_MODEL
SWIGLU_LIMIT = 7.0
SWIGLU_ALPHA = 1.702
MOE_BLOCK = 128

N_MOD = 6
EPS = 1e-6

kernel_name = "hybrid_gmlp_nsa_moe_adaln"


def rmsnorm(x, g):
    x32 = x.astype(jnp.float32)
    y = x32 * lax.rsqrt(jnp.mean(x32 * x32, axis=-1, keepdims=True) + EPS)
    return (y * g.astype(jnp.float32)).astype(x.dtype)


def masked_softmax(s, mask):
    s = jnp.where(mask, s, -jnp.inf)
    m = jnp.max(s, axis=-1, keepdims=True)
    m = jnp.where(jnp.isfinite(m), m, 0.0)
    p = jnp.where(mask, jnp.exp(s - m), 0.0)
    return p / jnp.maximum(jnp.sum(p, axis=-1, keepdims=True), 1e-30)


def alibi_slopes():
    h = jnp.arange(NSA_HEADS, dtype=jnp.float32)
    return jnp.exp2(-8.0 * (h + 1.0) / NSA_HEADS).reshape(NSA_KV_GROUPS, NSA_REP)


def gmlp_mixer(u, v, w_s, b_s, g_sgu):
    B_, S_, _ = v.shape
    u = jax.nn.gelu(u)
    v = jax.nn.gelu(v).reshape(B_, S_, GM_GROUPS, GM_GROUP_DIM)
    v = rmsnorm(v, g_sgu.reshape(GM_GROUPS, GM_GROUP_DIM))
    vc = v.reshape(B_, S_ // GM_CHUNK, GM_CHUNK, GM_GROUPS, GM_GROUP_DIM)
    causal = jnp.tril(jnp.ones((GM_CHUNK, GM_CHUNK), dtype=bool))
    ws = jnp.where(causal[None], w_s, 0.0)
    z = jnp.einsum('gij,bcjgd->bcigd', ws, vc) + b_s.T[:, :, None]
    return u * z.reshape(B_, S_, GM_WIDTH)


def compress(k, pe, w1, w2):
    B_, S_, G_, D_ = k.shape
    ratio = CMP_BLOCK // CMP_STRIDE
    n_chunk = S_ // CMP_STRIDE
    n_cmp = n_chunk - ratio + 1
    c = k.reshape(B_, n_chunk, CMP_STRIDE, G_, D_)
    blocks = jnp.concatenate([c[:, j:j + n_cmp] for j in range(ratio)], axis=2)
    blocks = blocks + pe[:, None, :]
    flat = blocks.transpose(0, 3, 1, 2, 4).reshape(B_, G_, n_cmp, CMP_BLOCK * D_)
    return jax.nn.gelu(flat @ w1) @ w2


def nsa_mixer(q, k_c, v_c, k_s, v_s, k_w, v_w, gates, pe_k, w1_k, w2_k, pe_v, w1_v, w2_v):
    B_, S_ = q.shape[0], q.shape[1]
    G, R, HD = NSA_KV_GROUPS, NSA_REP, HEAD_DIM
    slopes = alibi_slopes()
    qh = q.reshape(B_, S_, G, R, HD).transpose(0, 2, 3, 1, 4)
    gh = gates.reshape(B_, S_, G, R, 3).transpose(0, 2, 3, 1, 4)

    kc = compress(k_c, pe_k, w1_k, w2_k)
    vc = compress(v_c, pe_v, w1_v, w2_v)
    n_cmp = kc.shape[2]
    cend = jnp.arange(n_cmp) * CMP_STRIDE + CMP_BLOCK - 1

    n_blk = S_ // SLC_BLOCK
    n_sel = min(SLC_TOPN, n_blk)
    ksb = k_s.transpose(0, 2, 1, 3).reshape(B_, G, n_blk, SLC_BLOCK, HD)
    vsb = v_s.transpose(0, 2, 1, 3).reshape(B_, G, n_blk, SLC_BLOCK, HD)
    blk = jnp.arange(n_blk)
    cst = jnp.arange(n_cmp) * CMP_STRIDE
    overlap = ((cst[:, None] < blk[None] * SLC_BLOCK + SLC_BLOCK) &
               (blk[None] * SLC_BLOCK < cst[:, None] + CMP_BLOCK)).astype(jnp.float32)

    kw_pad = jnp.pad(k_w.transpose(0, 2, 1, 3), ((0, 0), (0, 0), (WINDOW, 0), (0, 0)))
    vw_pad = jnp.pad(v_w.transpose(0, 2, 1, 3), ((0, 0), (0, 0), (WINDOW, 0), (0, 0)))
    bi = jnp.arange(B_)[:, None, None, None]
    gi = jnp.arange(G)[None, :, None, None]

    def query_block(qb):
        q0 = qb * Q_BLOCK
        t = q0 + jnp.arange(Q_BLOCK)
        qblk = lax.dynamic_slice_in_dim(qh, q0, Q_BLOCK, axis=3)
        gblk = lax.dynamic_slice_in_dim(gh, q0, Q_BLOCK, axis=3)

        dist_c = (t[:, None] - cend[None]).astype(jnp.float32)
        s_c = jnp.einsum('bgrqd,bgcd->bgrqc', qblk, kc, preferred_element_type=jnp.float32) * ATTN_SCALE
        s_c = s_c - slopes[None, :, :, None, None] * dist_c
        p_c = masked_softmax(s_c, dist_c >= 0)
        o_c = jnp.einsum('bgrqc,bgcd->bgrqd', p_c.astype(vc.dtype), vc)

        imp = jnp.einsum('bgrqc,cj->bgqj', p_c, overlap)
        cur = t // SLC_BLOCK
        forced = (blk[None] == 0) | (blk[None] == cur[:, None]) | (blk[None] == cur[:, None] - 1)
        imp = jnp.where(forced, FORCE_SCORE, imp)
        imp = jnp.where(blk[None] * SLC_BLOCK <= t[:, None], imp, -jnp.inf)
        top_val, idx = lax.top_k(imp, n_sel)
        sel_ok = jnp.isfinite(top_val)
        ks = ksb[bi, gi, idx]
        vs = vsb[bi, gi, idx]
        pos = idx[..., None] * SLC_BLOCK + jnp.arange(SLC_BLOCK)
        dist_s = t[None, None, :, None, None] - pos
        mask_s = (dist_s >= 0) & sel_ok[..., None]
        s_s = jnp.einsum('bgrqd,bgqnld->bgrqnl', qblk, ks, preferred_element_type=jnp.float32) * ATTN_SCALE
        s_s = s_s - slopes[None, :, :, None, None, None] * dist_s[:, :, None].astype(jnp.float32)
        s_s = s_s.reshape(B_, G, R, Q_BLOCK, n_sel * SLC_BLOCK)
        mask_s = mask_s[:, :, None].reshape(B_, G, 1, Q_BLOCK, n_sel * SLC_BLOCK)
        p_s = masked_softmax(s_s, mask_s)
        o_s = jnp.einsum('bgrqm,bgqmd->bgrqd', p_s.astype(vs.dtype),
                         vs.reshape(B_, G, Q_BLOCK, n_sel * SLC_BLOCK, HD))

        kw = lax.dynamic_slice_in_dim(kw_pad, q0, Q_BLOCK + WINDOW, axis=2)
        vw = lax.dynamic_slice_in_dim(vw_pad, q0, Q_BLOCK + WINDOW, axis=2)
        spos = q0 - WINDOW + jnp.arange(Q_BLOCK + WINDOW)
        dist_w = t[:, None] - spos[None]
        mask_w = (spos[None] >= 0) & (dist_w >= 0) & (dist_w < WINDOW)
        s_w = jnp.einsum('bgrqd,bgkd->bgrqk', qblk, kw, preferred_element_type=jnp.float32) * ATTN_SCALE
        s_w = s_w - slopes[None, :, :, None, None] * dist_w.astype(jnp.float32)
        p_w = masked_softmax(s_w, mask_w)
        o_w = jnp.einsum('bgrqk,bgkd->bgrqd', p_w.astype(vw.dtype), vw)

        return gblk[..., 0:1] * o_c + gblk[..., 1:2] * o_s + gblk[..., 2:3] * o_w

    out = lax.map(query_block, jnp.arange(S_ // Q_BLOCK))
    return out.transpose(1, 0, 4, 2, 3, 5).reshape(B_, S_, Q_DIM)


def moe(h, w_router, b_router, w_gu, b_gu, w_dn, b_dn):
    B_, S_, D_ = h.shape
    T = B_ * S_
    TK = T * TOP_K
    hf = h.reshape(T, D_)
    logits = (hf @ w_router + b_router).astype(jnp.float32)
    top_logits, top_idx = lax.top_k(logits, TOP_K)
    wts = jax.nn.softmax(top_logits, axis=-1)
    e_flat = top_idx.reshape(-1)
    tok_flat = jnp.repeat(jnp.arange(T), TOP_K)
    order = jnp.argsort(e_flat)
    e_sorted = e_flat[order]
    tok_sorted = tok_flat[order]
    w_sorted = wts.reshape(-1)[order]
    counts = jnp.bincount(e_flat, length=N_EXPERTS)
    padded = (counts + MOE_BLOCK - 1) // MOE_BLOCK * MOE_BLOCK
    start = jnp.cumsum(counts) - counts
    pstart = jnp.cumsum(padded) - padded
    pend = pstart + padded
    dest = pstart[e_sorted] + (jnp.arange(TK) - start[e_sorted])
    P = (TK + MOE_BLOCK - 1) // MOE_BLOCK * MOE_BLOCK + N_EXPERTS * MOE_BLOCK
    n_rb = P // MOE_BLOCK
    xd = jnp.zeros((P, D_), h.dtype).at[dest].set(hf[tok_sorted])
    block_e = jnp.minimum(jnp.searchsorted(pend, jnp.arange(n_rb) * MOE_BLOCK, side='right'), N_EXPERTS - 1)

    def expert_block(args):
        xb, e = args
        gu = xb @ w_gu[e] + b_gu[e]
        x_glu = jnp.minimum(gu[:, 0::2], SWIGLU_LIMIT)
        x_lin = jnp.clip(gu[:, 1::2], -SWIGLU_LIMIT, SWIGLU_LIMIT)
        act = x_glu * jax.nn.sigmoid(SWIGLU_ALPHA * x_glu) * (x_lin + 1.0)
        return act @ w_dn[e] + b_dn[e]

    yd = lax.map(expert_block, (xd.reshape(n_rb, MOE_BLOCK, D_), block_e)).reshape(P, D_)
    y = yd[dest] * w_sorted[:, None].astype(h.dtype)
    out = jnp.zeros((T, D_), h.dtype).at[tok_sorted].add(y)
    return out.reshape(B_, S_, D_)


def setup_inputs(seed: int = 0) -> dict:
    key = jax.random.key(seed)
    ks = jax.random.split(key, 26)
    f32 = jnp.float32
    L, D = DEPTH, D_MODEL
    nrm = lambda k, shape, scale: jax.random.normal(k, shape, f32) * scale
    return {
        "x": nrm(ks[0], (BATCH, SEQ, D), 1.0),
        "c": nrm(ks[1], (BATCH, D), 1.0),
        "w_ada": nrm(ks[2], (L, D, N_MOD * D), 0.5 * D ** -0.5),
        "b_ada": nrm(ks[3], (L, N_MOD * D), 0.02),
        "g_mix_norm": 1.0 + nrm(ks[4], (L, D), 0.05),
        "w_in": nrm(ks[5], (L, D, IN_COLS), D ** -0.5),
        "gm_w_s": nrm(ks[6], (L, GM_GROUPS, GM_CHUNK, GM_CHUNK), GM_CHUNK ** -0.5),
        "gm_b_s": 1.0 + nrm(ks[7], (L, GM_GROUPS, GM_CHUNK), 0.1),
        "gm_norm_g": 1.0 + nrm(ks[8], (L, GM_WIDTH), 0.05),
        "cmp_pe_k": nrm(ks[9], (L, CMP_BLOCK, HEAD_DIM), 0.1),
        "cmp_w1_k": nrm(ks[10], (L, CMP_BLOCK * HEAD_DIM, CMP_HIDDEN), (CMP_BLOCK * HEAD_DIM) ** -0.5),
        "cmp_w2_k": nrm(ks[11], (L, CMP_HIDDEN, HEAD_DIM), CMP_HIDDEN ** -0.5),
        "cmp_pe_v": nrm(ks[12], (L, CMP_BLOCK, HEAD_DIM), 0.1),
        "cmp_w1_v": nrm(ks[13], (L, CMP_BLOCK * HEAD_DIM, CMP_HIDDEN), (CMP_BLOCK * HEAD_DIM) ** -0.5),
        "cmp_w2_v": nrm(ks[14], (L, CMP_HIDDEN, HEAD_DIM), CMP_HIDDEN ** -0.5),
        "w_out": nrm(ks[15], (L, MIX_WIDTH, D), MIX_WIDTH ** -0.5),
        "g_ffn_norm": 1.0 + nrm(ks[16], (L, D), 0.05),
        "w_router": nrm(ks[17], (L, D, N_EXPERTS), D ** -0.5),
        "b_router": nrm(ks[18], (L, N_EXPERTS), 0.01),
        "w_gate_up": nrm(ks[19], (L, N_EXPERTS, D, 2 * D_FF), D ** -0.5),
        "b_gate_up": nrm(ks[20], (L, N_EXPERTS, 2 * D_FF), 0.01),
        "w_down": nrm(ks[21], (L, N_EXPERTS, D_FF, D), D_FF ** -0.5),
        "b_down": nrm(ks[22], (L, N_EXPERTS, D), 0.01),
        "g_final": 1.0 + nrm(ks[23], (D,), 0.05),
    }


def reference(x, c, w_ada, b_ada, g_mix_norm, w_in, gm_w_s, gm_b_s, gm_norm_g,
              cmp_pe_k, cmp_w1_k, cmp_w2_k, cmp_pe_v, cmp_w1_v, cmp_w2_v, w_out,
              g_ffn_norm, w_router, b_router, w_gate_up, b_gate_up, w_down, b_down, g_final):
    B_, S_, D_ = x.shape
    split_at = [int(v) for v in np.cumsum(IN_SIZES)[:-1]]
    for l in range(DEPTH):
        mod = (c @ w_ada[l] + b_ada[l]).reshape(B_, N_MOD, D_)
        sh1, sc1, gt1, sh2, sc2, gt2 = [mod[:, i, None, :] for i in range(N_MOD)]

        h = rmsnorm(x, g_mix_norm[l]) * (1.0 + sc1) + sh1
        z = h @ w_in[l]
        u, v, q, kc, vc, ksl, vsl, kw, vw, gl = jnp.split(z, split_at, axis=-1)
        y_gm = gmlp_mixer(u, v, gm_w_s[l], gm_b_s[l], gm_norm_g[l])
        r4 = lambda a: a.reshape(B_, S_, NSA_KV_GROUPS, HEAD_DIM)
        gates = jax.nn.sigmoid(gl).reshape(B_, S_, NSA_HEADS, 3)
        y_nsa = nsa_mixer(q.reshape(B_, S_, NSA_HEADS, HEAD_DIM), r4(kc), r4(vc), r4(ksl), r4(vsl),
                          r4(kw), r4(vw), gates, cmp_pe_k[l], cmp_w1_k[l], cmp_w2_k[l],
                          cmp_pe_v[l], cmp_w1_v[l], cmp_w2_v[l])
        mix = jnp.concatenate([y_gm, y_nsa], axis=-1) @ w_out[l]
        x = x + gt1 * mix

        h2 = rmsnorm(x, g_ffn_norm[l]) * (1.0 + sc2) + sh2
        x = x + gt2 * moe(h2, w_router[l], b_router[l], w_gate_up[l], b_gate_up[l], w_down[l], b_down[l])
    return rmsnorm(x, g_final)
```

```cpp
#ifndef EMU
#include <hip/hip_runtime.h>
#endif
#include <cstdio>
#include <cstdint>

#ifndef CFG_BATCH
#define CFG_BATCH 2
#endif
#ifndef CFG_SEQ
#define CFG_SEQ 8192
#endif

#ifdef EMU
#define LAS
#define ASM_VMCNT(n) ((void)0)
#define ASM_LGKMCNT(n) ((void)0)
#define WAVE_SYNC() emu_wave_sync()
#define FENCE() ((void)0)
#else
#define LAS __attribute__((address_space(3)))
#define ASM_VMCNT(n) asm volatile("s_waitcnt vmcnt(" #n ")" ::: "memory")
#define ASM_LGKMCNT(n) asm volatile("s_waitcnt lgkmcnt(" #n ")" ::: "memory")
#define WAVE_SYNC() asm volatile("s_waitcnt lgkmcnt(0)" ::: "memory")
#define FENCE() asm volatile("" ::: "memory")
#endif

typedef unsigned short bf16_t;
typedef short bf16x8 __attribute__((ext_vector_type(8)));
typedef short s16x4 __attribute__((ext_vector_type(4)));
typedef float f32x4 __attribute__((ext_vector_type(4)));
typedef float f32x16 __attribute__((ext_vector_type(16)));
typedef unsigned u32x4 __attribute__((ext_vector_type(4)));
typedef unsigned u32x2 __attribute__((ext_vector_type(2)));

constexpr int NWAVES = 8, NTHREADS = 512;
constexpr int BATCH = CFG_BATCH, SEQ = CFG_SEQ, DM = 1024, T = BATCH * SEQ;
constexpr int GMW = 512, GMG = 8, GMC = 128;
constexpr int NH = 8, NG = 2, NR = 4, HD = 64;
constexpr int INC = 2328, ZP = 2560;
constexpr int ZC_U = 0, ZC_V = 512, ZC_Q = 1024, ZC_KC = 1536, ZC_VC = 1664, ZC_KS = 1792, ZC_VS = 1920, ZC_KW = 2048, ZC_VW = 2176, ZC_GL = 2304;
constexpr int NCMP = SEQ / 16 - 1, NCP = SEQ / 16;
constexpr int NBLK = SEQ / 64;
constexpr int NSEL = NBLK < 16 ? NBLK : 16;
constexpr int NE = 32, TOPK = 4, DFF = 1024;
constexpr int TK = T * TOPK;
constexpr int ACT_ROWS = TK + NE * 256;
constexpr float EPS = 1e-6f;
constexpr float LOG2E = 1.4426950408889634f;

constexpr size_t MiB = 1u << 20;
constexpr size_t WS_CTL = 0, CTL_ZERO_BYTES = 1 * MiB;
constexpr size_t WS_MOD = 1 * MiB;
constexpr size_t WS_BPE = 1 * MiB + 512 * 1024;
constexpr size_t WS_LISTS = 2 * MiB;
constexpr size_t WS_TOPE = 4 * MiB;
constexpr size_t WS_TOPW = 4 * MiB + 512 * 1024;
constexpr size_t WS_TOPP = 5 * MiB;
constexpr size_t WS_WSBF = 6 * MiB;
constexpr size_t WS_W2KT = 6 * MiB + 512 * 1024;
constexpr size_t WS_W2VT = WS_W2KT + 64 * 1024;
constexpr size_t WS_W1KT = 7 * MiB;
constexpr size_t WS_W1VT = 8 * MiB;
constexpr size_t WS_WOUTT = 9 * MiB;
constexpr size_t WS_WINT = 11 * MiB;
constexpr size_t WS_KC = 16 * MiB;
constexpr size_t WS_VC = 16 * MiB + 512 * 1024;
constexpr size_t WS_WGUT = 32 * MiB;
constexpr size_t WS_WDNT = 160 * MiB;
constexpr size_t WS_HB = 224 * MiB;
constexpr size_t WS_H2 = 256 * MiB;
constexpr size_t WS_ZB = 288 * MiB;
constexpr size_t WS_YMIX = 368 * MiB;
constexpr size_t WS_X1 = 400 * MiB;
constexpr size_t WS_ACT = 464 * MiB;
constexpr size_t WS_YD = 608 * MiB;
constexpr size_t WS_END = 752 * MiB;
constexpr int CW_BAR = 4096;
constexpr int CW_CNT = 16384;

constexpr int RING_BYTES = 131072;
constexpr int MISC_OFF = 139264;
constexpr int LDS_BYTES = 147456;
constexpr int MW_CNT = 16, MW_TPFX = 64, MW_ROFF = 128;

__device__ __forceinline__ unsigned f2bf(float f) { unsigned u = __builtin_bit_cast(unsigned, f); return (u + 0x7fffu + ((u >> 16) & 1u)) >> 16; }
__device__ __forceinline__ unsigned pk2(float lo, float hi) { return f2bf(lo) | (f2bf(hi) << 16); }
__device__ __forceinline__ float bf2f(unsigned short h) { return __builtin_bit_cast(float, (unsigned)h << 16); }
__device__ __forceinline__ float bflo(unsigned w) { return __builtin_bit_cast(float, w << 16); }
__device__ __forceinline__ float bfhi(unsigned w) { return __builtin_bit_cast(float, w & 0xffff0000u); }
__device__ __forceinline__ float fexp2(float x) { return __builtin_amdgcn_exp2f(x); }
__device__ __forceinline__ float gelu_tanh(float x) {
    const float y2 = 1.5957691216057308f * (x + 0.044715f * x * x * x);
    return x / (1.0f + fexp2(-y2 * LOG2E));
}
__device__ __forceinline__ float sigmoidf_(float x) { return 1.0f / (1.0f + fexp2(-x * LOG2E)); }
__device__ __forceinline__ float wave_sum(float v) {
#pragma unroll
    for (int o = 1; o < 64; o <<= 1) v += __shfl_xor(v, o);
    return v;
}
__device__ __forceinline__ int crow(int r, int hi) { return (r & 3) + 8 * (r >> 2) + 4 * hi; }

#define XB_TMO      128
#define XB_XCNT(j)  (256  + 64 * (j))
#define XB_XSUB(j)  (1280 + 64 * (j))
#define XB_XGEN(j)  (2304 + 64 * (j))
#define XB_TOP      3328
#define XB_TOPGEN   3392
#define XCD_BAR_WORDS 3456
#define XB_SPIN_CAP (1u << 18)
struct XcdBarrier { unsigned* bar; unsigned x; volatile LAS unsigned* st; };
#ifndef EMU
__device__ __forceinline__ unsigned xb_ld(unsigned* p)              { return __hip_atomic_load(p, __ATOMIC_RELAXED, __HIP_MEMORY_SCOPE_AGENT); }
__device__ __forceinline__ unsigned xb_add(unsigned* p, unsigned v) { return __hip_atomic_fetch_add(p, v, __ATOMIC_RELAXED, __HIP_MEMORY_SCOPE_AGENT); }
__device__ __forceinline__ unsigned xb_xcc_id() { return (unsigned)__builtin_amdgcn_s_getreg((3 << 11) | 20) & 0xFu; }
#define XB_SPIN(cond, bar) do { unsigned _sp = 0; while (cond) { __builtin_amdgcn_s_sleep(1); \
    if ((++_sp & 255u) == 0u) { if (xb_ld(&(bar)[XB_TMO])) break; if (_sp > XB_SPIN_CAP) { atomicAdd(&(bar)[XB_TMO], 1u); break; } } } } while (0)
__device__ __forceinline__ XcdBarrier xcd_barrier_post(unsigned* bar, volatile LAS unsigned* st) {
    XcdBarrier b; b.bar = bar; b.x = xb_xcc_id(); b.st = st;
    if (threadIdx.x == 0) (void)xb_add(&bar[XB_XCNT(b.x)], 1u);
    return b;
}
__device__ __forceinline__ void xcd_barrier_complete(unsigned* bar, unsigned x, unsigned& nloc, unsigned& nx) {
    const unsigned G = gridDim.x * gridDim.y * gridDim.z;
    unsigned sum, cnt, mine, sp = 0u;
    for (;;) {
        sum = 0u; cnt = 0u; mine = 0u;
#pragma unroll
        for (unsigned j = 0; j < 16; ++j) { const unsigned c = xb_ld(&bar[XB_XCNT(j)]); sum += c; cnt += (c > 0u) ? 1u : 0u; mine = (j == x) ? c : mine; }
        if (sum == G) break;
        __builtin_amdgcn_s_sleep(1);
        if ((++sp & 255u) == 0u) { if (xb_ld(&bar[XB_TMO])) break; if (sp > XB_SPIN_CAP) { atomicAdd(&bar[XB_TMO], 1u); break; } }
    }
    nloc = mine > 0u ? mine : 1u; nx = cnt > 0u ? cnt : 1u;
}
__device__ __forceinline__ void xcd_barrier(const XcdBarrier& b) {
    asm volatile("s_waitcnt vmcnt(0)" ::: "memory");
    __syncthreads();
    if (threadIdx.x == 0) {
        unsigned* bar = b.bar;
        __builtin_amdgcn_s_waitcnt(0);
        unsigned nloc = b.st[0], nx = b.st[1];
        if (nloc == 0u) { xcd_barrier_complete(bar, b.x, nloc, nx); b.st[0] = nloc; b.st[1] = nx; }
        const unsigned old = xb_add(&bar[XB_XSUB(b.x)], 1u);
        const unsigned gen = old / nloc;
        if (old + 1u == (gen + 1u) * nloc) {
            __builtin_amdgcn_fence(__ATOMIC_RELEASE, "agent");
            asm volatile("s_waitcnt vmcnt(0)" ::: "memory");
            const unsigned og = xb_add(&bar[XB_TOP], 1u);
            const unsigned tg = og / nx;
            if (og + 1u == (tg + 1u) * nx) xb_add(&bar[XB_TOPGEN], 1u);
            else XB_SPIN(xb_ld(&bar[XB_TOPGEN]) == tg, bar);
            __builtin_amdgcn_fence(__ATOMIC_ACQUIRE, "agent");
            xb_add(&bar[XB_XGEN(b.x)], 1u);
            asm volatile("s_waitcnt vmcnt(0)" ::: "memory");
        } else {
            XB_SPIN(xb_ld(&bar[XB_XGEN(b.x)]) == gen, bar);
            __builtin_amdgcn_fence(__ATOMIC_ACQUIRE, "agent");
            asm volatile("s_waitcnt vmcnt(0)" ::: "memory");
        }
    }
    __syncthreads();
}
#else
__device__ __forceinline__ XcdBarrier xcd_barrier_post(unsigned* bar, volatile unsigned* st) { XcdBarrier b; b.bar = bar; b.x = 0; b.st = st; return b; }
__device__ __forceinline__ void xcd_barrier(const XcdBarrier&) { fprintf(stderr, "EMU: grid barrier inside a launch\n"); abort(); }
#endif

struct Args { const float* in[24]; float* out; unsigned char* ws; int ph_lo, ph_hi; };
enum { I_X = 0, I_C, I_WADA, I_BADA, I_GMIX, I_WIN, I_GMWS, I_GMBS, I_GMNG, I_PEK, I_W1K, I_W2K, I_PEV, I_W1V, I_W2V, I_WOUT, I_GFFN, I_WR, I_BR, I_WGU, I_BGU, I_WDN, I_BDN, I_GFIN };

struct Frame {
    LAS unsigned char* lds;
    volatile LAS unsigned* MISC;
    unsigned* ctl;
    unsigned char* ws;
    const float* in[24];
    float* out;
    int tid, lane, wave, vcu, G;
};

namespace pg8 {
constexpr int BM = 256, BK = 64, HALF = 128, HTB = HALF * BK * 2, STAGE_BYTES = 8 * HTB;
__device__ __forceinline__ int lds_byte(int r, int c) { const int st = (r >> 4) * 2 + (c >> 5), rr = r & 15, cc = c & 31, ob = rr * 64 + cc * 2; return st * 1024 + (ob ^ (((ob >> 9) & 1) << 5)); }
__device__ __forceinline__ void stage_rc(int b, int& R, int& C) { const int st = b / 1024, sb = b % 1024, swz = sb ^ (((sb >> 9) & 1) << 5); R = (st >> 1) * 16 + swz / 64; C = (st & 1) * 32 + (swz % 64) / 2; }
__device__ __forceinline__ int perm32(int rho) { const int n = rho >> 4, i = rho & 15; return 8 * (i >> 2) + 4 * n + (i & 3); }
struct Unit { int pm, pn, e; };

template <class Prob, class Sched, class Epi>
__device__ __forceinline__ void gemm_phase(LAS unsigned char* lds, const Prob& P, const Sched& S, const Epi& E) {
    const int tid = threadIdx.x, wid = __builtin_amdgcn_readfirstlane(tid >> 6), lane = tid & 63, wr = wid >> 2, wc = wid & 3, fr = lane & 15, fq = lane >> 4;
    const int K = P.K, nt = K / BK;
    int Rr[2], Cc[2]; unsigned voffB[2];
#pragma unroll
    for (int i = 0; i < 2; ++i) { int R, C; stage_rc(tid * 16 + i * 8192, R, C); Rr[i] = R; Cc[i] = C; const int Rb = Epi::PERM ? ((R & ~31) + perm32(R & 31)) : R; voffB[i] = (unsigned)(Rb * K + C) * 2u; }
    const size_t kstep = (size_t)(BK * 2);
    const size_t hstepB = (size_t)HALF * K * 2;
    const unsigned ldsw = (unsigned)wid * 1024u;
    const int aoff = lds_byte(wr * 64 + fr, fq * 8), boff = lds_byte(wc * 32 + fr, fq * 8);
#define PG8_SA(b, h) (((b) * 2 + (h)) * HTB)
#define PG8_SB(b, h) ((4 + (b) * 2 + (h)) * HTB)
#define PG8_STAGE(bufoff, gbase, voff) do { _Pragma("unroll") for (int _i = 0; _i < 2; ++_i) \
        __builtin_amdgcn_global_load_lds((const unsigned*)((const char*)(gbase) + (voff)[_i]), (LAS unsigned*)(lds + (bufoff) + ldsw + _i * 8192), 16, 0, 0); } while (0)
#define PG8_LDA(dst, b, h) do { _Pragma("unroll") for (int m = 0; m < 4; ++m) _Pragma("unroll") for (int k = 0; k < 2; ++k) dst[m][k] = *(const LAS bf16x8*)(lds + PG8_SA(b, h) + aoff + m * 2048 + k * 1024); } while (0)
#define PG8_LDB(dst, b, h) do { _Pragma("unroll") for (int n = 0; n < 2; ++n) _Pragma("unroll") for (int k = 0; k < 2; ++k) dst[n][k] = *(const LAS bf16x8*)(lds + PG8_SB(b, h) + boff + n * 2048 + k * 1024); } while (0)
#define PG8_MMA(ai, bj, At, Bt) do { __builtin_amdgcn_s_setprio(1); _Pragma("unroll") for (int m = 0; m < 4; ++m) _Pragma("unroll") for (int n = 0; n < 2; ++n) _Pragma("unroll") for (int k = 0; k < 2; ++k) \
        acc[ai][bj][m][n] = __builtin_amdgcn_mfma_f32_16x16x32_bf16(Bt[n][k], At[m][k], acc[ai][bj][m][n], 0, 0, 0); __builtin_amdgcn_s_setprio(0); } while (0)
#define PG8_WAIT_V(n) ASM_VMCNT(n)
#define PG8_WAIT_L(n) ASM_LGKMCNT(n)
#define PG8_BAR __builtin_amdgcn_s_barrier()
#define PG8_SCHED __builtin_amdgcn_sched_barrier(0)
    Unit cur, nxt; int ui = 0;
    if (!S.next(0, cur)) return;
    f32x4 acc[2][2][4][2];
#pragma unroll
    for (int a = 0; a < 2; ++a)
#pragma unroll
        for (int b = 0; b < 2; ++b)
#pragma unroll
            for (int m = 0; m < 4; ++m)
#pragma unroll
                for (int n = 0; n < 2; ++n) acc[a][b][m][n] = (f32x4){0.f, 0.f, 0.f, 0.f};
    bf16x8 At[4][2], B0[2][2], B1[2][2];
    unsigned vA0[2], vA1[2], nA0[2], nA1[2];
#pragma unroll
    for (int i = 0; i < 2; ++i) { vA0[i] = P.a_rowoff(cur, Rr[i]) + (unsigned)Cc[i] * 2u; vA1[i] = P.a_rowoff(cur, HALF + Rr[i]) + (unsigned)Cc[i] * 2u; }
    const char* cA = P.a_base(cur); const char* cB = P.b_base(cur);
    PG8_STAGE(PG8_SB(0, 0), cB, voffB); PG8_STAGE(PG8_SB(0, 1), cB + hstepB, voffB); PG8_STAGE(PG8_SA(0, 0), cA, vA0); PG8_STAGE(PG8_SA(0, 1), cA, vA1);
    if (wr == 1) PG8_BAR;
    PG8_WAIT_V(2); PG8_BAR;
    PG8_STAGE(PG8_SB(1, 0), cB + kstep, voffB); PG8_STAGE(PG8_SA(1, 0), cA + kstep, vA0); PG8_STAGE(PG8_SB(1, 1), cB + hstepB + kstep, voffB);
    PG8_WAIT_V(6); PG8_BAR;
    for (;;) {
        const bool has_next = S.next(ui + 1, nxt);
        const char* nA = has_next ? P.a_base(nxt) : cA; const char* nB = has_next ? P.b_base(nxt) : cB;
#pragma unroll
        for (int i = 0; i < 2; ++i) {
            nA0[i] = has_next ? P.a_rowoff(nxt, Rr[i]) + (unsigned)Cc[i] * 2u : vA0[i];
            nA1[i] = has_next ? P.a_rowoff(nxt, HALF + Rr[i]) + (unsigned)Cc[i] * 2u : vA1[i];
        }
        for (int t = 0; t < nt; t += 2) {
            const bool last = (t == nt - 2);
            const char* a1 = cA + (size_t)(t + 1) * kstep;
            const char* a2 = last ? nA : cA + (size_t)(t + 2) * kstep; const char* b2 = last ? nB : cB + (size_t)(t + 2) * kstep;
            const char* a3 = a2 + kstep; const char* b3 = b2 + kstep;
            unsigned s0[2], s1[2];
#pragma unroll
            for (int i = 0; i < 2; ++i) { s0[i] = last ? nA0[i] : vA0[i]; s1[i] = last ? nA1[i] : vA1[i]; }
            PG8_LDB(B0, 0, 0); PG8_LDB(B1, 0, 1); PG8_SCHED; PG8_LDA(At, 0, 0); PG8_STAGE(PG8_SA(1, 1), a1, vA1);
            PG8_WAIT_V(8); PG8_WAIT_L(0); PG8_BAR; PG8_MMA(0, 0, At, B0); PG8_MMA(0, 1, At, B1); PG8_BAR; PG8_SCHED;
            PG8_LDA(At, 0, 1); PG8_STAGE(PG8_SB(0, 0), b2, voffB); PG8_STAGE(PG8_SB(0, 1), b2 + hstepB, voffB); PG8_STAGE(PG8_SA(0, 0), a2, s0);
            PG8_WAIT_V(8); PG8_WAIT_L(0); PG8_BAR; PG8_MMA(1, 0, At, B0); PG8_MMA(1, 1, At, B1); PG8_BAR; PG8_SCHED;
            PG8_LDB(B0, 1, 0); PG8_LDB(B1, 1, 1); PG8_SCHED; PG8_LDA(At, 1, 0); PG8_STAGE(PG8_SA(0, 1), a2, s1);
            PG8_WAIT_V(8); PG8_WAIT_L(0); PG8_BAR; PG8_MMA(0, 0, At, B0); PG8_MMA(0, 1, At, B1); PG8_BAR; PG8_SCHED;
            PG8_LDA(At, 1, 1); PG8_STAGE(PG8_SB(1, 0), b3, voffB); PG8_STAGE(PG8_SB(1, 1), b3 + hstepB, voffB); PG8_STAGE(PG8_SA(1, 0), a3, s0);
            PG8_WAIT_V(8); PG8_WAIT_L(0); PG8_BAR; PG8_MMA(1, 0, At, B0); PG8_MMA(1, 1, At, B1); PG8_BAR; PG8_SCHED;
        }
        if (wr == 0) PG8_BAR;
        E(acc, cur, wr, wc, fr, fq);
        if (!has_next) break;
#pragma unroll
        for (int a = 0; a < 2; ++a)
#pragma unroll
            for (int b = 0; b < 2; ++b)
#pragma unroll
                for (int m = 0; m < 4; ++m)
#pragma unroll
                    for (int n = 0; n < 2; ++n) acc[a][b][m][n] = (f32x4){0.f, 0.f, 0.f, 0.f};
        cur = nxt; cA = nA; cB = nB; ++ui;
#pragma unroll
        for (int i = 0; i < 2; ++i) { vA0[i] = nA0[i]; vA1[i] = nA1[i]; }
        if (wr == 1) PG8_BAR;
    }
    PG8_WAIT_V(0);
    PG8_BAR;
#undef PG8_SA
#undef PG8_SB
#undef PG8_STAGE
#undef PG8_LDA
#undef PG8_LDB
#undef PG8_MMA
#undef PG8_WAIT_V
#undef PG8_WAIT_L
#undef PG8_BAR
#undef PG8_SCHED
}

struct DenseOrder {
    int nM, nN, nwg, G, c;
    __device__ __forceinline__ void init(int M, int N, int G_, int c_) { nM = M / BM; nN = N / BM; nwg = nM * nN; G = G_; c = c_; }
    __device__ __forceinline__ bool next(int i, Unit& u) const {
        const long L = (long)i * G + c; if (L >= nwg) return false;
        int wgid = (int)L; { const int q = nwg / 8, r = nwg % 8, xcd = wgid % 8, off = wgid / 8; wgid = (xcd < r ? xcd * (q + 1) : r * (q + 1) + (xcd - r) * q) + off; }
        const int nig = 8 * nN, gid = wgid / nig, fm = gid * 8, gsz = (nM - fm) < 8 ? (nM - fm) : 8;
        u.pm = fm + ((wgid % nig) % gsz); u.pn = (wgid % nig) / gsz; u.e = 0; return true;
    }
};
struct DenseProb {
    const char* A; const char* Bt; int K;
    __device__ __forceinline__ const char* a_base(const Unit& u) const { return A + (size_t)u.pm * BM * K * 2; }
    __device__ __forceinline__ unsigned a_rowoff(const Unit&, int r) const { return (unsigned)(r * K * 2); }
    __device__ __forceinline__ const char* b_base(const Unit& u) const { return Bt + (size_t)u.pn * BM * K * 2; }
};
struct MoeOrder {
    volatile LAS unsigned* tpfx; int nN, G, c;
    __device__ __forceinline__ bool next(int i, Unit& u) const {
        const int L = i * G + c; const int total = (int)tpfx[NE] * nN; if (L >= total) return false;
        const int tl = L / nN;  (void)tl;
        int e = 0;
        for (int k = 0; k < NE; ++k) { if (L >= (int)tpfx[k + 1] * nN) e = k + 1; }
        const int rem = L - (int)tpfx[e] * nN, tm = (int)tpfx[e + 1] - (int)tpfx[e];
        u.e = e; u.pm = rem % tm; u.pn = rem / tm; return true;
    }
};
}

struct EpiZ {
    static constexpr bool PERM = true;
    bf16_t* O;
    __device__ __forceinline__ void operator()(const f32x4 (&acc)[2][2][4][2], const pg8::Unit& u, int wr, int wc, int fr, int fq) const {
        const int row0 = u.pm * 256 + wr * 64 + fr, col0 = u.pn * 256 + wc * 32 + 8 * fq;
#pragma unroll
        for (int ai = 0; ai < 2; ++ai)
#pragma unroll
            for (int m = 0; m < 4; ++m) { bf16_t* rowp = O + (size_t)(row0 + ai * 128 + m * 16) * ZP + col0;
#pragma unroll
                for (int bj = 0; bj < 2; ++bj) { const f32x4 v0 = acc[ai][bj][m][0], v1 = acc[ai][bj][m][1];
                    u32x4 w; w.x = pk2(v0[0], v0[1]); w.y = pk2(v0[2], v0[3]); w.z = pk2(v1[0], v1[1]); w.w = pk2(v1[2], v1[3]);
                    *(u32x4*)(rowp + bj * 128) = w; } }
    }
};
struct EpiX1 {
    static constexpr bool PERM = false;
    const float* x; const float* mod; float* O;
    __device__ __forceinline__ void operator()(const f32x4 (&acc)[2][2][4][2], const pg8::Unit& u, int wr, int wc, int fr, int fq) const {
        const int col0 = u.pn * 256 + wc * 32 + 4 * fq;
        const int b = (u.pm * 256) / SEQ;
        const float* gt = mod + (size_t)b * 6144 + 2 * 1024;
#pragma unroll
        for (int bj = 0; bj < 2; ++bj)
#pragma unroll
            for (int n = 0; n < 2; ++n) { const int c = col0 + bj * 128 + n * 16; const f32x4 g = *(const f32x4*)(gt + c);
#pragma unroll
                for (int ai = 0; ai < 2; ++ai)
#pragma unroll
                    for (int m = 0; m < 4; ++m) { const size_t off = (size_t)(u.pm * 256 + ai * 128 + wr * 64 + m * 16 + fr) * DM + c;
                        const f32x4 xv = *(const f32x4*)(x + off); *(f32x4*)(O + off) = xv + g * acc[ai][bj][m][n]; } }
    }
};
struct EpiAct {
    static constexpr bool PERM = true;
    bf16_t* O; const float* bgu; volatile LAS unsigned* roff;
    __device__ __forceinline__ void operator()(const f32x4 (&acc)[2][2][4][2], const pg8::Unit& u, int wr, int wc, int fr, int fq) const {
        const int row0 = (int)roff[u.e] + u.pm * 256 + wr * 64 + fr, col0 = u.pn * 128 + wc * 32 + 8 * fq;
        const float* bp = bgu + (size_t)u.e * 2048 + 2 * col0;
        f32x4 bb[4];
#pragma unroll
        for (int j = 0; j < 4; ++j) bb[j] = *(const f32x4*)(bp + 4 * j);
#pragma unroll
        for (int ai = 0; ai < 2; ++ai)
#pragma unroll
            for (int m = 0; m < 4; ++m) { float a8[8];
#pragma unroll
                for (int n = 0; n < 2; ++n)
#pragma unroll
                    for (int j = 0; j < 4; ++j) { const int cc = 4 * n + j;
                        float g = acc[ai][0][m][n][j] + bb[cc >> 1][(cc & 1) * 2], l = acc[ai][1][m][n][j] + bb[cc >> 1][(cc & 1) * 2 + 1];
                        g = fminf(g, 7.0f); l = fminf(fmaxf(l, -7.0f), 7.0f);
                        a8[cc] = g * sigmoidf_(1.702f * g) * (l + 1.0f); }
                u32x4 w; w.x = pk2(a8[0], a8[1]); w.y = pk2(a8[2], a8[3]); w.z = pk2(a8[4], a8[5]); w.w = pk2(a8[6], a8[7]);
                *(u32x4*)(O + (size_t)(row0 + ai * 128 + m * 16) * DFF + col0) = w; }
    }
};
struct EpiYd {
    static constexpr bool PERM = true;
    bf16_t* O; const float* bdn; volatile LAS unsigned* roff;
    __device__ __forceinline__ void operator()(const f32x4 (&acc)[2][2][4][2], const pg8::Unit& u, int wr, int wc, int fr, int fq) const {
        const int row0 = (int)roff[u.e] + u.pm * 256 + wr * 64 + fr, col0 = u.pn * 256 + wc * 32 + 8 * fq;
        f32x4 bv[2][2];
#pragma unroll
        for (int bj = 0; bj < 2; ++bj)
#pragma unroll
            for (int n = 0; n < 2; ++n) bv[bj][n] = *(const f32x4*)(bdn + (size_t)u.e * 1024 + col0 + bj * 128 + 4 * n);
#pragma unroll
        for (int ai = 0; ai < 2; ++ai)
#pragma unroll
            for (int m = 0; m < 4; ++m) { bf16_t* rowp = O + (size_t)(row0 + ai * 128 + m * 16) * DM + col0;
#pragma unroll
                for (int bj = 0; bj < 2; ++bj) { const f32x4 v0 = acc[ai][bj][m][0] + bv[bj][0], v1 = acc[ai][bj][m][1] + bv[bj][1];
                    u32x4 w; w.x = pk2(v0[0], v0[1]); w.y = pk2(v0[2], v0[3]); w.z = pk2(v1[0], v1[1]); w.w = pk2(v1[2], v1[3]);
                    *(u32x4*)(rowp + bj * 128) = w; } }
    }
};
struct MoeProb1 {
    const char* H2; const char* Bt; const int* lists; volatile LAS unsigned* cnt; int K;
    __device__ __forceinline__ const char* a_base(const pg8::Unit&) const { return H2; }
    __device__ __forceinline__ unsigned a_rowoff(const pg8::Unit& u, int r) const { const int i = u.pm * 256 + r; const int tok = (i < (int)cnt[u.e]) ? lists[(size_t)u.e * T + i] : 0; return (unsigned)tok * 2048u; }
    __device__ __forceinline__ const char* b_base(const pg8::Unit& u) const { return Bt + ((size_t)u.e * 2048 + (size_t)u.pn * 256) * 2048; }
};
struct MoeProb2 {
    const char* A; const char* Bt; volatile LAS unsigned* roff; int K;
    __device__ __forceinline__ const char* a_base(const pg8::Unit& u) const { return A + ((size_t)roff[u.e] + (size_t)u.pm * 256) * 2048; }
    __device__ __forceinline__ unsigned a_rowoff(const pg8::Unit&, int r) const { return (unsigned)r * 2048u; }
    __device__ __forceinline__ const char* b_base(const pg8::Unit& u) const { return Bt + ((size_t)u.e * 1024 + (size_t)u.pn * 256) * 2048; }
};

template <int NB>
__device__ __forceinline__ void gemv_item(Frame& F, const float* vec, int vstride, const float* W, int K, int N, int n0, const float* bias, float* out, int ostride) {
    LAS float* red = (LAS float*)F.lds;
    const int col = n0 + F.lane, ks = K / NWAVES;
    float acc[NB];
#pragma unroll
    for (int b = 0; b < NB; ++b) acc[b] = 0.f;
    for (int k = F.wave * ks; k < (F.wave + 1) * ks; ++k) { const float w = W[(size_t)k * N + col];
#pragma unroll
        for (int b = 0; b < NB; ++b) acc[b] += vec[b * vstride + k] * w; }
#pragma unroll
    for (int b = 0; b < NB; ++b) red[(F.wave * NB + b) * 64 + F.lane] = acc[b];
    __syncthreads();
    if (F.wave == 0) {
#pragma unroll
        for (int b = 0; b < NB; ++b) { float s = bias ? bias[col] : 0.f;
            for (int w = 0; w < NWAVES; ++w) s += red[(w * NB + b) * 64 + F.lane];
            out[b * ostride + col] = s; }
    }
    __syncthreads();
}
template <int MAP>
__device__ __forceinline__ int t_rowmap(int n) {
    if (MAP == 0) return n;
    const int ac = n >> 1, bj = n & 1; return (ac >> 7) * 256 + bj * 128 + (ac & 127);
}
template <int MAP>
__device__ __forceinline__ void transpose_item(const float* W, int K, int Nsrc, int nblk, bf16_t* WT, LAS float* scr, int item, int lane) {
    const int kb = item / nblk, nb = item % nblk, k0 = 64 * kb, n0 = 32 * nb;
    const int nc = n0 + (lane & 31);
#pragma unroll 8
    for (int i = 0; i < 32; ++i) { const int kk = 2 * i + (lane >> 5); scr[kk * 33 + (lane & 31)] = (nc < Nsrc) ? W[(size_t)(k0 + kk) * Nsrc + nc] : 0.f; }
    WAVE_SYNC(); FENCE();
    const int c = lane & 7;
#pragma unroll
    for (int j = 0; j < 4; ++j) { const int n = (lane >> 3) + 8 * j; const LAS float* s = scr + (8 * c) * 33 + n;
        u32x4 o; o.x = pk2(s[0 * 33], s[1 * 33]); o.y = pk2(s[2 * 33], s[3 * 33]); o.z = pk2(s[4 * 33], s[5 * 33]); o.w = pk2(s[6 * 33], s[7 * 33]);
        *(u32x4*)(WT + (size_t)t_rowmap<MAP>(n0 + n) * K + k0 + 8 * c) = o; }
    WAVE_SYNC(); FENCE();
}
__device__ __forceinline__ void p0_prologue(Frame& F) {
    for (int it = F.vcu; it < 96 + 8; it += F.G) {
        if (it < 96) gemv_item<BATCH>(F, F.in[I_C], DM, F.in[I_WADA], DM, 6 * DM, 64 * it, F.in[I_BADA], (float*)(F.ws + WS_MOD), 6 * DM);
        else { const int j = it - 96, kv = j >> 2, n0 = (j & 3) * 64;
            gemv_item<1>(F, F.in[kv ? I_PEV : I_PEK], 0, F.in[kv ? I_W1V : I_W1K], 2048, 256, n0, nullptr, (float*)(F.ws + WS_BPE) + kv * 256, 0); }
    }
    { const float* src = F.in[I_GMWS]; bf16_t* dst = (bf16_t*)(F.ws + WS_WSBF);
      for (int idx = F.vcu * NTHREADS + F.tid; idx < GMG * GMC * GMC; idx += F.G * NTHREADS) { const int i = (idx >> 7) & 127, j = idx & 127; dst[idx] = (bf16_t)f2bf(j <= i ? src[idx] : 0.f); } }
    LAS float* scr = (LAS float*)(F.lds + 8192 + F.wave * 16384);
    const int gw = F.vcu * NWAVES + F.wave, NGW = F.G * NWAVES;
    constexpr int I_IN = (DM / 64) * (ZP / 32), I_OUT = (DM / 64) * (DM / 32), I_W1 = (2048 / 64) * (256 / 32), I_W2 = (256 / 64) * (64 / 32);
    constexpr int I_GU1 = (DM / 64) * (2048 / 32), I_DN1 = (DFF / 64) * (DM / 32);
    constexpr int NITEMS = I_IN + I_OUT + 2 * I_W1 + 2 * I_W2 + NE * I_GU1 + NE * I_DN1;
    for (int it = gw; it < NITEMS; it += NGW) {
        int r = it;
        if (r < I_IN) { transpose_item<0>(F.in[I_WIN], DM, INC, ZP / 32, (bf16_t*)(F.ws + WS_WINT), scr, r, F.lane); continue; } r -= I_IN;
        if (r < I_OUT) { transpose_item<0>(F.in[I_WOUT], DM, DM, DM / 32, (bf16_t*)(F.ws + WS_WOUTT), scr, r, F.lane); continue; } r -= I_OUT;
        if (r < I_W1) { transpose_item<0>(F.in[I_W1K], 2048, 256, 8, (bf16_t*)(F.ws + WS_W1KT), scr, r, F.lane); continue; } r -= I_W1;
        if (r < I_W1) { transpose_item<0>(F.in[I_W1V], 2048, 256, 8, (bf16_t*)(F.ws + WS_W1VT), scr, r, F.lane); continue; } r -= I_W1;
        if (r < I_W2) { transpose_item<0>(F.in[I_W2K], 256, 64, 2, (bf16_t*)(F.ws + WS_W2KT), scr, r, F.lane); continue; } r -= I_W2;
        if (r < I_W2) { transpose_item<0>(F.in[I_W2V], 256, 64, 2, (bf16_t*)(F.ws + WS_W2VT), scr, r, F.lane); continue; } r -= I_W2;
        if (r < NE * I_GU1) { const int e = r / I_GU1; transpose_item<1>(F.in[I_WGU] + (size_t)e * DM * 2048, DM, 2048, 64, (bf16_t*)(F.ws + WS_WGUT) + (size_t)e * 2048 * DM, scr, r % I_GU1, F.lane); continue; } r -= NE * I_GU1;
        { const int e = r / I_DN1; transpose_item<0>(F.in[I_WDN] + (size_t)e * DFF * DM, DFF, DM, 32, (bf16_t*)(F.ws + WS_WDNT) + (size_t)e * DM * DFF, scr, r % I_DN1, F.lane); }
    }
}

__device__ __forceinline__ void norm_rows(Frame& F, const float* xin, const float* g, int mod_shift, int mod_scale, bf16_t* outb) {
    const int gw = F.vcu * NWAVES + F.wave, NGW = F.G * NWAVES;
    const float* mod = (const float*)(F.ws + WS_MOD);
    for (int m = gw; m < T; m += NGW) {
        const int b = m / SEQ;
        const f32x4* xr = (const f32x4*)(xin + (size_t)m * DM) + F.lane;
        f32x4 v[4]; float s = 0.f;
#pragma unroll
        for (int j = 0; j < 4; ++j) { v[j] = xr[64 * j]; s += (v[j][0] * v[j][0] + v[j][1] * v[j][1]) + (v[j][2] * v[j][2] + v[j][3] * v[j][3]); }
        const float rinv = 1.0f / sqrtf(wave_sum(s) * (1.0f / DM) + EPS);
        u32x2* o8 = (u32x2*)(outb + (size_t)m * DM) + F.lane;
#pragma unroll
        for (int j = 0; j < 4; ++j) { const int c = 4 * F.lane + 256 * j;
            const f32x4 gg = *(const f32x4*)(g + c), sc = *(const f32x4*)(mod + (size_t)b * 6144 + mod_scale * 1024 + c), sh = *(const f32x4*)(mod + (size_t)b * 6144 + mod_shift * 1024 + c);
            const f32x4 h = v[j] * rinv * gg * (sc + 1.0f) + sh;
            u32x2 w; w.x = pk2(h[0], h[1]); w.y = pk2(h[2], h[3]); o8[64 * j] = w; }
    }
}

__device__ __forceinline__ void gmlp_tile(Frame& F, int tile) {
    const int g = tile % GMG, ch = (tile / GMG) % (SEQ / GMC), b = tile / (GMG * (SEQ / GMC));
    const size_t row0 = (size_t)b * SEQ + (size_t)ch * GMC;
    const bf16_t* ZB = (const bf16_t*)(F.ws + WS_ZB);
    LAS bf16_t* Vt = (LAS bf16_t*)F.lds;
    constexpr int VP = 136;
    const float* gn = F.in[I_GMNG] + g * 64;
#pragma unroll
    for (int it = 0; it < 2; ++it) {
        const int idx = F.tid + it * NTHREADS, row = idx >> 3, c8 = idx & 7;
        const u32x4 raw = *(const u32x4*)(ZB + (row0 + row) * ZP + ZC_V + g * 64 + c8 * 8);
        float v[8]; v[0] = bflo(raw.x); v[1] = bfhi(raw.x); v[2] = bflo(raw.y); v[3] = bfhi(raw.y); v[4] = bflo(raw.z); v[5] = bfhi(raw.z); v[6] = bflo(raw.w); v[7] = bfhi(raw.w);
        float ss = 0.f;
#pragma unroll
        for (int e = 0; e < 8; ++e) { v[e] = gelu_tanh(v[e]); ss += v[e] * v[e]; }
        ss += __shfl_xor(ss, 1); ss += __shfl_xor(ss, 2); ss += __shfl_xor(ss, 4);
        const float rinv = 1.0f / sqrtf(ss * (1.0f / 64.0f) + EPS);
#pragma unroll
        for (int e = 0; e < 8; ++e) Vt[(c8 * 8 + e) * VP + row] = (bf16_t)f2bf(v[e] * rinv * gn[c8 * 8 + e]);
    }
    __syncthreads();
    const int fr = F.lane & 15, fq = F.lane >> 4, w = F.wave;
    const bf16_t* Wg = (const bf16_t*)(F.ws + WS_WSBF) + (size_t)g * GMC * GMC;
    f32x4 acc[4];
#pragma unroll
    for (int n = 0; n < 4; ++n) acc[n] = (f32x4){0.f, 0.f, 0.f, 0.f};
    for (int ks = 0; ks < 4; ++ks) {
        if (32 * ks > 16 * w + 15) break;
        const bf16x8 a = *(const bf16x8*)(Wg + (size_t)(16 * w + fr) * GMC + 32 * ks + 8 * fq);
#pragma unroll
        for (int n = 0; n < 4; ++n) { const bf16x8 bb = *(const LAS bf16x8*)(Vt + (16 * n + fr) * VP + 32 * ks + 8 * fq);
            acc[n] = __builtin_amdgcn_mfma_f32_16x16x32_bf16(a, bb, acc[n], 0, 0, 0); }
    }
    bf16_t* Y = (bf16_t*)(F.ws + WS_YMIX);
    const float* bs = F.in[I_GMBS] + g * GMC;
#pragma unroll
    for (int n = 0; n < 4; ++n)
#pragma unroll
        for (int r = 0; r < 4; ++r) { const int i = 16 * w + 4 * fq + r, d = 16 * n + fr;
            const float u = gelu_tanh(bf2f(ZB[(row0 + i) * ZP + ZC_U + g * 64 + d]));
            Y[(row0 + i) * DM + g * 64 + d] = (bf16_t)f2bf(u * (acc[n][r] + bs[i])); }
    __syncthreads();
}

__device__ __forceinline__ void cmp_tile(Frame& F, int tile) {
    constexpr int NT = NCP / 32;
    const int nt = tile % NT, g = (tile / NT) % NG, b = (tile / (NT * NG)) % BATCH, kv = tile / (NT * NG * BATCH);
    const int n0 = 32 * nt, p0 = 16 * n0;
    const bf16_t* ZB = (const bf16_t*)(F.ws + WS_ZB);
    constexpr int RP = 72;
    LAS bf16_t* Rs = (LAS bf16_t*)F.lds;
    LAS bf16_t* Hs = (LAS bf16_t*)(F.lds + 528 * RP * 2);
    constexpr int HP = 264;
    const int zc = (kv ? ZC_VC : ZC_KC) + g * 64;
    for (int idx = F.tid; idx < 528 * 8; idx += NTHREADS) { const int row = idx >> 3, c8 = idx & 7; const int p = p0 + row;
        u32x4 v = (u32x4){0u, 0u, 0u, 0u};
        if (p < SEQ) v = *(const u32x4*)(ZB + ((size_t)b * SEQ + p) * ZP + zc + c8 * 8);
        *(LAS u32x4*)(Rs + row * RP + c8 * 8) = v; }
    __syncthreads();
    const int i = F.lane & 31, hi = F.lane >> 5, w = F.wave;
    const bf16_t* W1T = (const bf16_t*)(F.ws + (kv ? WS_W1VT : WS_W1KT)) + (size_t)(32 * w + i) * 2048;
    f32x16 acc;
#pragma unroll
    for (int r = 0; r < 16; ++r) acc[r] = 0.f;
    for (int kk = 0; kk < 128; ++kk) {
        const int l = kk >> 2, d = (16 * kk + 8 * hi) & 63;
        const bf16x8 a = *(const LAS bf16x8*)(Rs + (16 * i + l) * RP + d);
        const bf16x8 bb = *(const bf16x8*)(W1T + 16 * kk + 8 * hi);
        acc = __builtin_amdgcn_mfma_f32_32x32x16_bf16(a, bb, acc, 0, 0, 0);
    }
    const float bpe = ((const float*)(F.ws + WS_BPE))[kv * 256 + 32 * w + i];
#pragma unroll
    for (int r = 0; r < 16; ++r) Hs[crow(r, hi) * HP + 32 * w + i] = (bf16_t)f2bf(gelu_tanh(acc[r] + bpe));
    __syncthreads();
    if (w < 2) {
        const bf16_t* W2T = (const bf16_t*)(F.ws + (kv ? WS_W2VT : WS_W2KT)) + (size_t)(32 * w + i) * 256;
        f32x16 o;
#pragma unroll
        for (int r = 0; r < 16; ++r) o[r] = 0.f;
        for (int kk = 0; kk < 16; ++kk) {
            const bf16x8 a = *(const LAS bf16x8*)(Hs + i * HP + 16 * kk + 8 * hi);
            const bf16x8 bb = *(const bf16x8*)(W2T + 16 * kk + 8 * hi);
            o = __builtin_amdgcn_mfma_f32_32x32x16_bf16(a, bb, o, 0, 0, 0);
        }
        bf16_t* KC = (bf16_t*)(F.ws + (kv ? WS_VC : WS_KC)) + ((size_t)(b * NG + g) * NCP) * 64;
#pragma unroll
        for (int r = 0; r < 16; ++r) { const int n = n0 + crow(r, hi); KC[(size_t)n * 64 + 32 * w + i] = (n < NCMP) ? (bf16_t)f2bf(o[r]) : (bf16_t)0; }
    }
    __syncthreads();
}

constexpr int KP = 72;
constexpr int A_KS = 0, A_VT = 64 * KP * 2, A_IMP = 2 * 64 * KP * 2, A_SEL = A_IMP + 64 * 128 * 4, A_UNI = A_SEL + 64 * 4 * 4, A_Y = A_UNI + 256, A_END = A_Y + 8 * 32 * 64 * 4;

struct AttnState { float m, l; f32x16 o0, o1; };

__device__ __forceinline__ void stage_kv(Frame& F, const bf16_t* Kg, const bf16_t* Vg, size_t pitch, long rbase, long nvalid, bool doV) {
    LAS bf16_t* Ks = (LAS bf16_t*)(F.lds + A_KS); LAS bf16_t* Vt = (LAS bf16_t*)(F.lds + A_VT);
    const int row = F.tid >> 3, c8 = F.tid & 7; const long rr = rbase + row;
    u32x4 kk = (u32x4){0u, 0u, 0u, 0u}, vv = (u32x4){0u, 0u, 0u, 0u};
    if (rr >= 0 && rr < nvalid) { kk = *(const u32x4*)(Kg + (size_t)rr * pitch + c8 * 8); if (doV) vv = *(const u32x4*)(Vg + (size_t)rr * pitch + c8 * 8); }
    *(LAS u32x4*)(Ks + row * KP + c8 * 8) = kk;
    if (doV) {
        const unsigned w4[4] = {vv.x, vv.y, vv.z, vv.w};
#pragma unroll
        for (int e = 0; e < 4; ++e) { Vt[(c8 * 8 + 2 * e) * KP + row] = (bf16_t)(w4[e] & 0xffffu); Vt[(c8 * 8 + 2 * e + 1) * KP + row] = (bf16_t)(w4[e] >> 16); }
    }
}
__device__ __forceinline__ void qk_tile(Frame& F, const bf16x8 (&qr)[4], f32x16& p0, f32x16& p1) {
    const LAS bf16_t* Ks = (const LAS bf16_t*)(F.lds + A_KS);
    const int i = F.lane & 31, hi = F.lane >> 5;
#pragma unroll
    for (int r = 0; r < 16; ++r) { p0[r] = 0.f; p1[r] = 0.f; }
#pragma unroll
    for (int d0 = 0; d0 < 4; ++d0) {
        const bf16x8 k0 = *(const LAS bf16x8*)(Ks + i * KP + 16 * d0 + 8 * hi);
        const bf16x8 k1 = *(const LAS bf16x8*)(Ks + (32 + i) * KP + 16 * d0 + 8 * hi);
        p0 = __builtin_amdgcn_mfma_f32_32x32x16_bf16(k0, qr[d0], p0, 0, 0, 0);
        p1 = __builtin_amdgcn_mfma_f32_32x32x16_bf16(k1, qr[d0], p1, 0, 0, 0);
    }
}
__device__ __forceinline__ void pv_tile(Frame& F, const f32x16& p0, const f32x16& p1, f32x16& o0, f32x16& o1) {
    const LAS bf16_t* Vt = (const LAS bf16_t*)(F.lds + A_VT);
    const int dcol = F.lane & 31, hi = F.lane >> 5;
#pragma unroll
    for (int ks = 0; ks < 4; ++ks) {
        const f32x16& p = (ks < 2) ? p0 : p1; const int s = ks & 1;
        u32x4 pw; pw.x = pk2(p[8 * s + 0], p[8 * s + 1]); pw.y = pk2(p[8 * s + 2], p[8 * s + 3]); pw.z = pk2(p[8 * s + 4], p[8 * s + 5]); pw.w = pk2(p[8 * s + 6], p[8 * s + 7]);
        const bf16x8 pa = __builtin_bit_cast(bf16x8, pw);
#pragma unroll
        for (int d0 = 0; d0 < 2; ++d0) {
            const LAS bf16_t* vp = Vt + (32 * d0 + dcol) * KP + 16 * ks + 4 * hi;
            const u32x2 lo = *(const LAS u32x2*)(vp), hi2 = *(const LAS u32x2*)(vp + 8);
            u32x4 vw; vw.x = lo.x; vw.y = lo.y; vw.z = hi2.x; vw.w = hi2.y;
            const bf16x8 vb = __builtin_bit_cast(bf16x8, vw);
            if (d0 == 0) o0 = __builtin_amdgcn_mfma_f32_32x32x16_bf16(pa, vb, o0, 0, 0, 0);
            else         o1 = __builtin_amdgcn_mfma_f32_32x32x16_bf16(pa, vb, o1, 0, 0, 0);
        }
    }
}
__device__ __forceinline__ void online_update(Frame& F, AttnState& st, f32x16& p0, f32x16& p1, bool withO) {
    const int hi = F.lane >> 5;
    float mt = -INFINITY;
#pragma unroll
    for (int r = 0; r < 16; ++r) mt = fmaxf(mt, fmaxf(p0[r], p1[r]));
    mt = fmaxf(mt, __shfl_xor(mt, 32));
    const float mn = fmaxf(st.m, mt);
    const float mref = (mn == -INFINITY) ? 0.f : mn;
    const float alpha = (st.m == -INFINITY) ? 0.f : fexp2(st.m - mref);
    float rs = 0.f;
#pragma unroll
    for (int r = 0; r < 16; ++r) { p0[r] = fexp2(p0[r] - mref); p1[r] = fexp2(p1[r] - mref); rs += p0[r] + p1[r]; }
    st.l = st.l * alpha + rs; st.m = mn;
    if (withO) {
#pragma unroll
        for (int r = 0; r < 16; ++r) { const float a = __shfl(alpha, crow(r, hi)); st.o0[r] *= a; st.o1[r] *= a; }
    }
}

__device__ __forceinline__ void nsa_task(Frame& F, int task) {
    constexpr int NQT = SEQ / 64;
    const int qt = task % NQT, g = (task / NQT) % NG, b = task / (NQT * NG);
    const int t0 = 64 * qt, w = F.wave, i = F.lane & 31, hi = F.lane >> 5;
    const int r_head = i >> 3, ql = i & 7, qloc = 8 * w + ql, t = t0 + qloc, head = 4 * g + r_head;
    const bf16_t* ZB = (const bf16_t*)(F.ws + WS_ZB);
    const bf16_t* Zb = ZB + (size_t)b * SEQ * ZP;
    const float slope2 = fexp2(-(float)(head + 1)) * LOG2E;
    const float sc2 = 0.125f * LOG2E;
    bf16x8 qr[4];
#pragma unroll
    for (int d0 = 0; d0 < 4; ++d0) qr[d0] = *(const bf16x8*)(Zb + (size_t)t * ZP + ZC_Q + head * 64 + 16 * d0 + 8 * hi);
    float gate[3];
#pragma unroll
    for (int k = 0; k < 3; ++k) gate[k] = sigmoidf_(bf2f(Zb[(size_t)t * ZP + ZC_GL + head * 3 + k]));
    LAS float* yl = (LAS float*)(F.lds + A_Y) + w * 2048;
    for (int k = F.lane; k < 2048; k += 64) yl[k] = 0.f;
    LAS float* imp = (LAS float*)(F.lds + A_IMP);
    LAS unsigned* selm = (LAS unsigned*)(F.lds + A_SEL);
    LAS unsigned* uni = (LAS unsigned*)(F.lds + A_UNI);
    for (int idx = F.tid; idx < 64 * 128; idx += NTHREADS) imp[idx] = 0.f;
    if (F.tid < 48) uni[F.tid] = 0u;

#define ACC_BRANCH(st, gidx) do { float f_ = st.l + __shfl_xor(st.l, 32); f_ = (f_ > 0.f) ? gate[gidx] / f_ : 0.f; \
        _Pragma("unroll") for (int r = 0; r < 16; ++r) { const float a_ = __shfl(f_, crow(r, hi)); yl[crow(r, hi) * 64 + i] += a_ * st.o0[r]; yl[crow(r, hi) * 64 + 32 + i] += a_ * st.o1[r]; } } while (0)
#define INIT_ST(st) do { st.m = -INFINITY; st.l = 0.f; _Pragma("unroll") for (int r = 0; r < 16; ++r) { st.o0[r] = 0.f; st.o1[r] = 0.f; } } while (0)

    {
        AttnState st; INIT_ST(st);
        const bf16_t* Kg = Zb + ZC_KW + g * 64; const bf16_t* Vg = Zb + ZC_VW + g * 64;
        for (int kt = qt - 8; kt <= qt; ++kt) {
            if (kt < 0) continue;
            __syncthreads();
            stage_kv(F, Kg, Vg, ZP, 64L * kt, SEQ, true);
            __syncthreads();
            f32x16 p0, p1; qk_tile(F, qr, p0, p1);
#pragma unroll
            for (int r = 0; r < 16; ++r) {
                const int kp0 = 64 * kt + crow(r, hi), kp1 = kp0 + 32; const int d0 = t - kp0, d1 = t - kp1;
                p0[r] = (d0 >= 0 && d0 < 512) ? p0[r] * sc2 - slope2 * (float)d0 : -INFINITY;
                p1[r] = (d1 >= 0 && d1 < 512) ? p1[r] * sc2 - slope2 * (float)d1 : -INFINITY;
            }
            online_update(F, st, p0, p1, true);
            pv_tile(F, p0, p1, st.o0, st.o1);
        }
        ACC_BRANCH(st, 2);
    }
    {
        const bf16_t* Kg = (const bf16_t*)(F.ws + WS_KC) + (size_t)(b * NG + g) * NCP * 64;
        const bf16_t* Vg = (const bf16_t*)(F.ws + WS_VC) + (size_t)(b * NG + g) * NCP * 64;
        const int cmax = (t0 + 63 - 31) >> 4;
        const int nct = (t0 + 63 >= 31) ? (cmax / 64 + 1) : 0;
        AttnState st; INIT_ST(st);
        for (int ct = 0; ct < nct; ++ct) {
            __syncthreads();
            stage_kv(F, Kg, Vg, 64, 64L * ct, NCMP, false);
            __syncthreads();
            f32x16 p0, p1; qk_tile(F, qr, p0, p1);
#pragma unroll
            for (int r = 0; r < 16; ++r) {
                const int c0 = 64 * ct + crow(r, hi), c1 = c0 + 32; const int d0 = t - (16 * c0 + 31), d1 = t - (16 * c1 + 31);
                p0[r] = (d0 >= 0 && c0 < NCMP) ? p0[r] * sc2 - slope2 * (float)d0 : -INFINITY;
                p1[r] = (d1 >= 0 && c1 < NCMP) ? p1[r] * sc2 - slope2 * (float)d1 : -INFINITY;
            }
            online_update(F, st, p0, p1, false);
        }
        float ltot = st.l + __shfl_xor(st.l, 32);
        const float linv = (ltot > 0.f) ? 1.0f / ltot : 0.f;
        const float mfin = (st.m == -INFINITY) ? 0.f : st.m;
        f32x16 o0, o1;
#pragma unroll
        for (int r = 0; r < 16; ++r) { o0[r] = 0.f; o1[r] = 0.f; }
        float carry = 0.f;
        for (int ct = 0; ct < nct; ++ct) {
            __syncthreads();
            stage_kv(F, Kg, Vg, 64, 64L * ct, NCMP, true);
            __syncthreads();
            f32x16 p0, p1; qk_tile(F, qr, p0, p1);
#pragma unroll
            for (int r = 0; r < 16; ++r) {
                const int c0 = 64 * ct + crow(r, hi), c1 = c0 + 32; const int d0 = t - (16 * c0 + 31), d1 = t - (16 * c1 + 31);
                p0[r] = (d0 >= 0 && c0 < NCMP) ? fexp2(p0[r] * sc2 - slope2 * (float)d0 - mfin) * linv : 0.f;
                p1[r] = (d1 >= 0 && c1 < NCMP) ? fexp2(p1[r] * sc2 - slope2 * (float)d1 - mfin) * linv : 0.f;
            }
            pv_tile(F, p0, p1, o0, o1);
            float G0[4], G1[4], S0[4], S1[4];
#pragma unroll
            for (int k = 0; k < 4; ++k) { G0[k] = (p0[4 * k] + p0[4 * k + 1]) + (p0[4 * k + 2] + p0[4 * k + 3]); S0[k] = p0[4 * k + 3];
                                          G1[k] = (p1[4 * k] + p1[4 * k + 1]) + (p1[4 * k + 2] + p1[4 * k + 3]); S1[k] = p1[4 * k + 3]; }
#pragma unroll
            for (int k = 0; k < 4; ++k) {
                G0[k] += __shfl_xor(G0[k], 8); G0[k] += __shfl_xor(G0[k], 16); G1[k] += __shfl_xor(G1[k], 8); G1[k] += __shfl_xor(G1[k], 16);
                S0[k] += __shfl_xor(S0[k], 8); S0[k] += __shfl_xor(S0[k], 16); S1[k] += __shfl_xor(S1[k], 8); S1[k] += __shfl_xor(S1[k], 16);
            }
            float P0[4], P1[4];
#pragma unroll
            for (int k = 0; k < 4; ++k) { P0[k] = __shfl_xor(S0[k], 32); P1[k] = __shfl_xor(S1[k], 32); }
            if (i < 8) {
                LAS float* row = imp + qloc * 128 + 16 * ct;
#pragma unroll
                for (int k = 0; k < 4; ++k) {
                    const float prev0 = hi ? P0[k] : (k == 0 ? carry : P0[k - 1]);
                    const float prev1 = hi ? P1[k] : (k == 0 ? P0[3] : P1[k - 1]);
                    row[2 * k + hi] = G0[k] + prev0;
                    row[8 + 2 * k + hi] = G1[k] + prev1;
                }
            }
            carry = hi ? S1[3] : P1[3];
        }
        AttnState s2; s2.l = 0.5f; s2.m = 0.f; s2.o0 = o0; s2.o1 = o1;
        ACC_BRANCH(s2, 0);
    }
    __syncthreads();
    for (int q8 = 0; q8 < 8; ++q8) {
        const int qq = 8 * w + q8, tq = t0 + qq, cur = tq >> 6;
        float v[2]; int id[2];
#pragma unroll
        for (int k = 0; k < 2; ++k) { const int j = F.lane + 64 * k; id[k] = j;
            float x = (j < NBLK) ? imp[qq * 128 + j] : -INFINITY;
            if (j == 0 || j == cur || j == cur - 1) x = 1e9f;
            if (j > cur || j >= NBLK) x = -INFINITY;
            v[k] = x; }
        unsigned m0 = 0u, m1 = 0u, m2 = 0u, m3 = 0u;
        for (int it = 0; it < NSEL; ++it) {
            float bv; int bi;
            if (v[0] >= v[1]) { bv = v[0]; bi = id[0]; } else { bv = v[1]; bi = id[1]; }
#pragma unroll
            for (int o = 1; o < 64; o <<= 1) { const float ov = __shfl_xor(bv, o); const int oi = __shfl_xor(bi, o);
                if (ov > bv || (ov == bv && oi < bi)) { bv = ov; bi = oi; } }
            if (bv > -INFINITY) { if (bi < 32) m0 |= 1u << bi; else if (bi < 64) m1 |= 1u << (bi - 32); else if (bi < 96) m2 |= 1u << (bi - 64); else m3 |= 1u << (bi - 96); }
            if (id[0] == bi) v[0] = -INFINITY;
            if (id[1] == bi) v[1] = -INFINITY;
        }
        if (F.lane == 0) { selm[qq * 4 + 0] = m0; selm[qq * 4 + 1] = m1; selm[qq * 4 + 2] = m2; selm[qq * 4 + 3] = m3;
            atomicOr((unsigned*)&uni[0], m0); atomicOr((unsigned*)&uni[1], m1); atomicOr((unsigned*)&uni[2], m2); atomicOr((unsigned*)&uni[3], m3);
            atomicOr((unsigned*)&uni[8 + 4 * w + 0], m0); atomicOr((unsigned*)&uni[8 + 4 * w + 1], m1); atomicOr((unsigned*)&uni[8 + 4 * w + 2], m2); atomicOr((unsigned*)&uni[8 + 4 * w + 3], m3); }
    }
    __syncthreads();
    {
        AttnState st; INIT_ST(st);
        const bf16_t* Kg = Zb + ZC_KS + g * 64; const bf16_t* Vg = Zb + ZC_VS + g * 64;
        unsigned um[4], wm[4], qm[4];
#pragma unroll
        for (int k = 0; k < 4; ++k) { um[k] = uni[k]; wm[k] = uni[8 + 4 * w + k]; qm[k] = selm[qloc * 4 + k]; }
        for (int j = 0; j <= qt; ++j) {
            const unsigned ub = (j < 32 ? um[0] >> j : j < 64 ? um[1] >> (j - 32) : j < 96 ? um[2] >> (j - 64) : um[3] >> (j - 96)) & 1u;
            if (!ub) continue;
            __syncthreads();
            stage_kv(F, Kg, Vg, ZP, 64L * j, SEQ, true);
            __syncthreads();
            const unsigned wb = (j < 32 ? wm[0] >> j : j < 64 ? wm[1] >> (j - 32) : j < 96 ? wm[2] >> (j - 64) : wm[3] >> (j - 96)) & 1u;
            if (!wb) continue;
            const unsigned qb = (j < 32 ? qm[0] >> j : j < 64 ? qm[1] >> (j - 32) : j < 96 ? qm[2] >> (j - 64) : qm[3] >> (j - 96)) & 1u;
            f32x16 p0, p1; qk_tile(F, qr, p0, p1);
#pragma unroll
            for (int r = 0; r < 16; ++r) {
                const int kp0 = 64 * j + crow(r, hi), kp1 = kp0 + 32; const int d0 = t - kp0, d1 = t - kp1;
                p0[r] = (qb && d0 >= 0) ? p0[r] * sc2 - slope2 * (float)d0 : -INFINITY;
                p1[r] = (qb && d1 >= 0) ? p1[r] * sc2 - slope2 * (float)d1 : -INFINITY;
            }
            online_update(F, st, p0, p1, true);
            pv_tile(F, p0, p1, st.o0, st.o1);
        }
        ACC_BRANCH(st, 1);
    }
    {
        WAVE_SYNC(); FENCE();
        bf16_t* Y = (bf16_t*)(F.ws + WS_YMIX) + (size_t)b * SEQ * DM;
#pragma unroll
        for (int c = 0; c < 4; ++c) { const int idx = F.lane + 64 * c, ii = idx >> 3, c8 = idx & 7; const int tt = t0 + 8 * w + (ii & 7), hh = 4 * g + (ii >> 3);
            const f32x4 a = *(const LAS f32x4*)(yl + ii * 64 + c8 * 8), bq = *(const LAS f32x4*)(yl + ii * 64 + c8 * 8 + 4);
            u32x4 o; o.x = pk2(a[0], a[1]); o.y = pk2(a[2], a[3]); o.z = pk2(bq[0], bq[1]); o.w = pk2(bq[2], bq[3]);
            *(u32x4*)(Y + (size_t)tt * DM + 512 + hh * 64 + c8 * 8) = o; }
    }
    __syncthreads();
#undef ACC_BRANCH
#undef INIT_ST
}

__device__ __forceinline__ void router_task(Frame& F, int task) {
    const int row0 = 32 * task;
    LAS float* Hs = (LAS float*)F.lds;
    const float* mod = (const float*)(F.ws + WS_MOD);
    const float* X1 = (const float*)(F.ws + WS_X1);
    bf16_t* H2 = (bf16_t*)(F.ws + WS_H2);
    const float* g = F.in[I_GFFN];
    for (int rr = 0; rr < 4; ++rr) {
        const int lr = 4 * F.wave + rr, m = row0 + lr, b = m / SEQ;
        const f32x4* xr = (const f32x4*)(X1 + (size_t)m * DM) + F.lane;
        f32x4 v[4]; float s = 0.f;
#pragma unroll
        for (int j = 0; j < 4; ++j) { v[j] = xr[64 * j]; s += (v[j][0] * v[j][0] + v[j][1] * v[j][1]) + (v[j][2] * v[j][2] + v[j][3] * v[j][3]); }
        const float rinv = 1.0f / sqrtf(wave_sum(s) * (1.0f / DM) + EPS);
        u32x2* o8 = (u32x2*)(H2 + (size_t)m * DM) + F.lane;
#pragma unroll
        for (int j = 0; j < 4; ++j) { const int c = 4 * F.lane + 256 * j;
            const f32x4 gg = *(const f32x4*)(g + c), sc = *(const f32x4*)(mod + (size_t)b * 6144 + 4 * 1024 + c), sh = *(const f32x4*)(mod + (size_t)b * 6144 + 3 * 1024 + c);
            const f32x4 h = v[j] * rinv * gg * (sc + 1.0f) + sh;
            u32x2 wv; wv.x = pk2(h[0], h[1]); wv.y = pk2(h[2], h[3]); o8[64 * j] = wv;
#pragma unroll
            for (int e = 0; e < 4; ++e) Hs[(c + e) * 33 + lr] = h[e]; }
    }
    __syncthreads();
    const int i = F.lane & 31, hi = F.lane >> 5;
    f32x16 acc;
#pragma unroll
    for (int r = 0; r < 16; ++r) acc[r] = 0.f;
    const float* WR = F.in[I_WR];
    for (int ks = 0; ks < 64; ++ks) { const int k = 128 * F.wave + 2 * ks + hi;
        acc = __builtin_amdgcn_mfma_f32_32x32x2f32(Hs[k * 33 + i], WR[k * 32 + i], acc, 0, 0, 0); }
    __syncthreads();
    LAS float* Ls = (LAS float*)F.lds;
    LAS float* Lg = Ls + 8 * 1024;
    LAS unsigned* hist = (LAS unsigned*)(Lg + 32 * 33);
#pragma unroll
    for (int r = 0; r < 16; ++r) Ls[F.wave * 1024 + crow(r, hi) * 32 + i] = acc[r];
    if (F.tid < 64) hist[F.tid] = 0u;
    __syncthreads();
    for (int idx = F.tid; idx < 1024; idx += NTHREADS) { float s = F.in[I_BR][idx & 31];
#pragma unroll
        for (int w = 0; w < 8; ++w) s += Ls[w * 1024 + idx];
        Lg[(idx >> 5) * 33 + (idx & 31)] = s; }
    __syncthreads();
    if (F.wave == 0) {
        const int tok = row0 + i;
        int be[4]; float bv[4]; unsigned rank[4];
        if (F.lane < 32) {
            unsigned used = 0u;
#pragma unroll
            for (int k = 0; k < 4; ++k) { float best = -INFINITY; int bi = 0;
                for (int e = 0; e < 32; ++e) { const float x = Lg[i * 33 + e]; if (!((used >> e) & 1u) && x > best) { best = x; bi = e; } }
                used |= 1u << bi; be[k] = bi; bv[k] = best; }
            float sum = 0.f; const float mx0 = bv[0];
#pragma unroll
            for (int k = 0; k < 4; ++k) { bv[k] = fexp2((bv[k] - mx0) * LOG2E); sum += bv[k]; }
#pragma unroll
            for (int k = 0; k < 4; ++k) { bv[k] /= sum; rank[k] = atomicAdd((unsigned*)&hist[be[k]], 1u); }
        }
        WAVE_SYNC(); FENCE();
        if (F.lane < 32) { const unsigned c = hist[F.lane]; hist[32 + F.lane] = c ? atomicAdd(F.ctl + CW_CNT + 64 * F.lane, c) : 0u; }
        WAVE_SYNC(); FENCE();
        if (F.lane < 32) {
            int* lists = (int*)(F.ws + WS_LISTS); int* tope = (int*)(F.ws + WS_TOPE); float* topw = (float*)(F.ws + WS_TOPW); int* topp = (int*)(F.ws + WS_TOPP);
#pragma unroll
            for (int k = 0; k < 4; ++k) { const int pos = (int)(hist[32 + be[k]] + rank[k]);
                lists[(size_t)be[k] * T + pos] = tok; tope[tok * 4 + k] = be[k]; topw[tok * 4 + k] = bv[k]; topp[tok * 4 + k] = pos; }
        }
    }
    __syncthreads();
}

__device__ __forceinline__ void moe_tables(Frame& F) {
    if (F.tid == 0) {
        unsigned tp = 0, ro = 0;
        for (int e = 0; e < NE; ++e) { const unsigned c = __hip_atomic_load(F.ctl + CW_CNT + 64 * e, __ATOMIC_RELAXED, __HIP_MEMORY_SCOPE_AGENT);
            F.MISC[MW_CNT + e] = c; F.MISC[MW_TPFX + e] = tp; F.MISC[MW_ROFF + e] = ro; const unsigned tl = (c + 255u) / 256u; tp += tl; ro += tl * 256u; }
        F.MISC[MW_TPFX + NE] = tp; F.MISC[MW_ROFF + NE] = ro;
    }
    __syncthreads();
}

__device__ __forceinline__ void final_rows(Frame& F) {
    const int gw = F.vcu * NWAVES + F.wave, NGW = F.G * NWAVES;
    const float* mod = (const float*)(F.ws + WS_MOD);
    const float* X1 = (const float*)(F.ws + WS_X1);
    const bf16_t* YD = (const bf16_t*)(F.ws + WS_YD);
    const int* tope = (const int*)(F.ws + WS_TOPE); const float* topw = (const float*)(F.ws + WS_TOPW); const int* topp = (const int*)(F.ws + WS_TOPP);
    const float* gf = F.in[I_GFIN];
    for (int m = gw; m < T; m += NGW) {
        const int b = m / SEQ;
        size_t yrow[4]; float wk[4];
#pragma unroll
        for (int k = 0; k < 4; ++k) { const int e = tope[m * 4 + k]; yrow[k] = (size_t)(F.MISC[MW_ROFF + e] + (unsigned)topp[m * 4 + k]) * DM; wk[k] = topw[m * 4 + k]; }
        const f32x4* xr = (const f32x4*)(X1 + (size_t)m * DM) + F.lane;
        f32x4 v[4]; float s = 0.f;
#pragma unroll
        for (int j = 0; j < 4; ++j) { const int c = 4 * F.lane + 256 * j;
            f32x4 mo = (f32x4){0.f, 0.f, 0.f, 0.f};
#pragma unroll
            for (int k = 0; k < 4; ++k) { const u32x2 yw = *(const u32x2*)(YD + yrow[k] + c); mo += wk[k] * (f32x4){bflo(yw.x), bfhi(yw.x), bflo(yw.y), bfhi(yw.y)}; }
            const f32x4 gt = *(const f32x4*)(mod + (size_t)b * 6144 + 5 * 1024 + c);
            v[j] = xr[64 * j] + gt * mo;
            s += (v[j][0] * v[j][0] + v[j][1] * v[j][1]) + (v[j][2] * v[j][2] + v[j][3] * v[j][3]); }
        const float rinv = 1.0f / sqrtf(wave_sum(s) * (1.0f / DM) + EPS);
        f32x4* orow = (f32x4*)(F.out + (size_t)m * DM) + F.lane;
#pragma unroll
        for (int j = 0; j < 4; ++j) orow[64 * j] = v[j] * rinv * *(const f32x4*)(gf + 4 * F.lane + 256 * j);
    }
}

constexpr int N_PHASES = 10;
__global__ void __launch_bounds__(NTHREADS, 2) mk_fwd(Args args) {
#ifdef EMU
    unsigned char* lds = emu_blk->lds;
#else
    extern __shared__ __attribute__((aligned(16))) unsigned char lds[];
#endif
    Frame F;
    F.lds = (LAS unsigned char*)lds;
    F.MISC = (volatile LAS unsigned*)(F.lds + MISC_OFF);
    F.tid = threadIdx.x; F.lane = F.tid & 63; F.wave = __builtin_amdgcn_readfirstlane(F.tid >> 6);
    F.G = gridDim.x; { const int bx = blockIdx.x; F.vcu = (F.G % 8 == 0) ? (bx % 8) * (F.G / 8) + bx / 8 : bx; }
    F.ws = args.ws; F.ctl = (unsigned*)(args.ws + WS_CTL); F.out = args.out;
#pragma unroll
    for (int k = 0; k < 24; ++k) F.in[k] = args.in[k];
    for (int u = F.tid; u < (LDS_BYTES - MISC_OFF) / 4; u += NTHREADS) F.MISC[u] = 0u;
    __syncthreads();
    XcdBarrier bar = xcd_barrier_post(F.ctl + CW_BAR, F.MISC + 8);
    const int lo = args.ph_lo, hi = args.ph_hi;
#ifndef PH_MASK
#define PH_MASK 0xffff
#endif
#define IN(k) (((PH_MASK >> (k)) & 1) && lo <= (k) && (k) < hi)
#define SEAM(k) do { if (IN(k) && IN((k) + 1)) xcd_barrier(bar); } while (0)

    if (IN(0)) { p0_prologue(F); }
    SEAM(0);
    if (IN(1)) { norm_rows(F, F.in[I_X], F.in[I_GMIX], 0, 1, (bf16_t*)(F.ws + WS_HB)); }
    SEAM(1);
    if (IN(2)) {
        pg8::DenseProb P{(const char*)(F.ws + WS_HB), (const char*)(F.ws + WS_WINT), DM};
        pg8::DenseOrder S; S.init(T, ZP, F.G, (int)blockIdx.x);
        EpiZ E{(bf16_t*)(F.ws + WS_ZB)};
        pg8::gemm_phase(F.lds, P, S, E);
    }
    SEAM(2);
    if (IN(3)) {
        constexpr int NGM = BATCH * (SEQ / GMC) * GMG, NCT = 2 * BATCH * NG * (NCP / 32);
        for (int it = F.vcu; it < NCT + NGM; it += F.G) { if (it < NCT) cmp_tile(F, it); else gmlp_tile(F, it - NCT); }
    }
    SEAM(3);
    if (IN(4)) {
        constexpr int NTASK = BATCH * NG * (SEQ / 64);
        for (int it = F.vcu; it < NTASK; it += F.G) nsa_task(F, NTASK - 1 - it);
    }
    SEAM(4);
    if (IN(5)) {
        pg8::DenseProb P{(const char*)(F.ws + WS_YMIX), (const char*)(F.ws + WS_WOUTT), DM};
        pg8::DenseOrder S; S.init(T, DM, F.G, (int)blockIdx.x);
        EpiX1 E{F.in[I_X], (const float*)(F.ws + WS_MOD), (float*)(F.ws + WS_X1)};
        pg8::gemm_phase(F.lds, P, S, E);
    }
    SEAM(5);
    if (IN(6)) { for (int it = F.vcu; it < T / 32; it += F.G) router_task(F, it); }
    SEAM(6);
    if (IN(7)) {
        moe_tables(F);
        MoeProb1 P{(const char*)(F.ws + WS_H2), (const char*)(F.ws + WS_WGUT), (const int*)(F.ws + WS_LISTS), F.MISC + MW_CNT, DM};
        pg8::MoeOrder S{F.MISC + MW_TPFX, 8, F.G, F.vcu};
        EpiAct E{(bf16_t*)(F.ws + WS_ACT), F.in[I_BGU], F.MISC + MW_ROFF};
        pg8::gemm_phase(F.lds, P, S, E);
    }
    SEAM(7);
    if (IN(8)) {
        moe_tables(F);
        MoeProb2 P{(const char*)(F.ws + WS_ACT), (const char*)(F.ws + WS_WDNT), F.MISC + MW_ROFF, DFF};
        pg8::MoeOrder S{F.MISC + MW_TPFX, 4, F.G, F.vcu};
        EpiYd E{(bf16_t*)(F.ws + WS_YD), F.in[I_BDN], F.MISC + MW_ROFF};
        pg8::gemm_phase(F.lds, P, S, E);
    }
    SEAM(8);
    if (IN(9)) { moe_tables(F); final_rows(F); }
#undef IN
#undef SEAM
}

#ifdef EMU
struct EmuDump { const char* name; size_t off; size_t bytes; };
EmuDump emu_dumps[] = {
    {"mod", WS_MOD, (size_t)BATCH * 6144 * 4}, {"bpe", WS_BPE, 512 * 4}, {"wint", WS_WINT, (size_t)ZP * DM * 2}, {"hb", WS_HB, (size_t)T * DM * 2},
    {"zb", WS_ZB, (size_t)T * ZP * 2}, {"kc", WS_KC, (size_t)BATCH * NG * NCP * 64 * 2}, {"vc", WS_VC, (size_t)BATCH * NG * NCP * 64 * 2},
    {"ymix", WS_YMIX, (size_t)T * DM * 2}, {"x1", WS_X1, (size_t)T * DM * 4}, {"h2", WS_H2, (size_t)T * DM * 2},
    {"tope", WS_TOPE, (size_t)T * 16}, {"topw", WS_TOPW, (size_t)T * 16}, {"topp", WS_TOPP, (size_t)T * 16}, {"ctl", WS_CTL, CTL_ZERO_BYTES},
};
int emu_ndumps = sizeof(emu_dumps) / sizeof(emu_dumps[0]);
size_t emu_ws_bytes = WS_END;
int emu_out_elems = T * DM;
#endif

extern "C" void kernel_launch(void* const* d_in, const int* in_sizes, int n_in, void* d_out, int out_size, void* d_ws, size_t ws_size, hipStream_t stream) {
    (void)in_sizes; (void)out_size; (void)ws_size;
    Args a{};
    for (int i = 0; i < 24 && i < n_in; ++i) a.in[i] = (const float*)d_in[i];
    a.out = (float*)d_out; a.ws = (unsigned char*)d_ws;
#ifndef EMU
    (void)hipMemsetAsync((char*)d_ws + WS_CTL, 0, CTL_ZERO_BYTES, stream);
#endif
#ifdef EMU
    int plo = 0, phi = N_PHASES;
    if (const char* e = getenv("EMU_PH_LO")) plo = atoi(e);
    if (const char* e = getenv("EMU_PH_HI")) phi = atoi(e);
    if (plo == 0) (void)hipMemsetAsync((char*)d_ws + WS_CTL, 0, CTL_ZERO_BYTES, stream);
    const int grid = emu_num_cus();
    for (int ph = plo; ph < phi; ++ph) { a.ph_lo = ph; a.ph_hi = ph + 1; Args ac = a; fprintf(stderr, "EMU phase %d\n", ph);
        emu_launch(grid, NTHREADS, LDS_BYTES, [ac]() { mk_fwd(ac); }); }
#else
    static int grid = 0;
    if (grid == 0) {
        int dev = 0, cus = 0, per_cu = 0;
        (void)hipGetDevice(&dev);
        (void)hipDeviceGetAttribute(&cus, hipDeviceAttributeMultiprocessorCount, dev);
        (void)hipFuncSetAttribute((const void*)mk_fwd, hipFuncAttributeMaxDynamicSharedMemorySize, LDS_BYTES);
        (void)hipOccupancyMaxActiveBlocksPerMultiprocessor(&per_cu, (const void*)mk_fwd, NTHREADS, LDS_BYTES);
        if (per_cu < 1) fprintf(stderr, "kernel_launch: occupancy query reports %d blocks/CU\n", per_cu);
        grid = cus;
        (void)hipGetLastError();
    }
    a.ph_lo = 0; a.ph_hi = N_PHASES;
    void* kargs[] = {&a};
    hipError_t e = hipLaunchCooperativeKernel((const void*)mk_fwd, dim3(grid), dim3(NTHREADS), kargs, LDS_BYTES, stream);
    if (e != hipSuccess) fprintf(stderr, "cooperative launch failed: %s (grid %d)\n", hipGetErrorString(e), grid);
#endif
}
```

```cpp
#ifndef EMU
#include <hip/hip_runtime.h>
#endif
#include <cstdio>
#include <cstdint>

#ifndef CFG_BATCH
#define CFG_BATCH 2
#endif
#ifndef CFG_SEQ
#define CFG_SEQ 8192
#endif

#ifdef EMU
#define LAS
#define ASM_VMCNT(n) ((void)0)
#define ASM_LGKMCNT(n) ((void)0)
#define WAVE_SYNC() emu_wave_sync()
#define FENCE() ((void)0)
#else
#define LAS __attribute__((address_space(3)))
#define ASM_VMCNT(n) asm volatile("s_waitcnt vmcnt(" #n ")" ::: "memory")
#define ASM_LGKMCNT(n) asm volatile("s_waitcnt lgkmcnt(" #n ")" ::: "memory")
#define WAVE_SYNC() asm volatile("s_waitcnt lgkmcnt(0)" ::: "memory")
#define FENCE() asm volatile("" ::: "memory")
#endif

typedef unsigned short bf16_t;
typedef short bf16x8 __attribute__((ext_vector_type(8)));
typedef short s16x4 __attribute__((ext_vector_type(4)));
typedef float f32x4 __attribute__((ext_vector_type(4)));
typedef float f32x16 __attribute__((ext_vector_type(16)));
typedef unsigned u32x4 __attribute__((ext_vector_type(4)));
typedef unsigned u32x2 __attribute__((ext_vector_type(2)));

constexpr int NWAVES = 8, NTHREADS = 512;
constexpr int BATCH = CFG_BATCH, SEQ = CFG_SEQ, DM = 1024, T = BATCH * SEQ;
constexpr int GMW = 512, GMG = 8, GMC = 128;
constexpr int NH = 8, NG = 2, NR = 4, HD = 64;
constexpr int INC = 2328, ZP = 2560;
constexpr int ZC_U = 0, ZC_V = 512, ZC_Q = 1024, ZC_KC = 1536, ZC_VC = 1664, ZC_KS = 1792, ZC_VS = 1920, ZC_KW = 2048, ZC_VW = 2176, ZC_GL = 2304;
constexpr int NCMP = SEQ / 16 - 1, NCP = SEQ / 16;
constexpr int NBLK = SEQ / 64;
constexpr int NSEL = NBLK < 16 ? NBLK : 16;
constexpr int NE = 32, TOPK = 4, DFF = 1024;
constexpr int TK = T * TOPK;
constexpr int ACT_ROWS = TK + NE * 256;
constexpr float EPS = 1e-6f;
constexpr float LOG2E = 1.4426950408889634f;

constexpr size_t MiB = 1u << 20;
constexpr size_t WS_CTL = 0, CTL_ZERO_BYTES = 1 * MiB;
constexpr size_t WS_MOD = 1 * MiB;
constexpr size_t WS_BPE = 1 * MiB + 512 * 1024;
constexpr size_t WS_LISTS = 2 * MiB;
constexpr size_t WS_TOPE = 4 * MiB;
constexpr size_t WS_TOPW = 4 * MiB + 512 * 1024;
constexpr size_t WS_TOPP = 5 * MiB;
constexpr size_t WS_WSBF = 6 * MiB;
constexpr size_t WS_W2KT = 6 * MiB + 512 * 1024;
constexpr size_t WS_W2VT = WS_W2KT + 64 * 1024;
constexpr size_t WS_W1KT = 7 * MiB;
constexpr size_t WS_W1VT = 8 * MiB;
constexpr size_t WS_WOUTT = 9 * MiB;
constexpr size_t WS_WINT = 11 * MiB;
constexpr size_t WS_KC = 16 * MiB;
constexpr size_t WS_VC = 16 * MiB + 512 * 1024;
constexpr size_t WS_WGUT = 32 * MiB;
constexpr size_t WS_WDNT = 160 * MiB;
constexpr size_t WS_HB = 224 * MiB;
constexpr size_t WS_H2 = 256 * MiB;
constexpr size_t WS_ZB = 288 * MiB;
constexpr size_t WS_YMIX = 368 * MiB;
constexpr size_t WS_X1 = 400 * MiB;
constexpr size_t WS_ACT = 464 * MiB;
constexpr size_t WS_YD = 608 * MiB;
constexpr size_t WS_END = 752 * MiB;
constexpr int CW_BAR = 4096;
constexpr int CW_CNT = 16384;

constexpr int RING_BYTES = 131072;
constexpr int MISC_OFF = 139264;
constexpr int LDS_BYTES = 147456;
constexpr int MW_CNT = 16, MW_TPFX = 64, MW_ROFF = 128;

__device__ __forceinline__ unsigned f2bf(float f) { unsigned u = __builtin_bit_cast(unsigned, f); return (u + 0x7fffu + ((u >> 16) & 1u)) >> 16; }
#ifdef EMU
__device__ __forceinline__ unsigned pk2(float lo, float hi) { return f2bf(lo) | (f2bf(hi) << 16); }
#else
typedef float f32x2_t __attribute__((ext_vector_type(2))); typedef __bf16 bf16x2_t __attribute__((ext_vector_type(2)));
__device__ __forceinline__ unsigned pk2(float lo, float hi) { f32x2_t v = {lo, hi}; bf16x2_t bb = __builtin_convertvector(v, bf16x2_t); return __builtin_bit_cast(unsigned, bb); }
#endif
__device__ __forceinline__ float bf2f(unsigned short h) { return __builtin_bit_cast(float, (unsigned)h << 16); }
__device__ __forceinline__ float bflo(unsigned w) { return __builtin_bit_cast(float, w << 16); }
__device__ __forceinline__ float bfhi(unsigned w) { return __builtin_bit_cast(float, w & 0xffff0000u); }
__device__ __forceinline__ float fexp2(float x) { return __builtin_amdgcn_exp2f(x); }
__device__ __forceinline__ float gelu_tanh(float x) {
    const float y2 = 1.5957691216057308f * (x + 0.044715f * x * x * x);
    return x / (1.0f + fexp2(-y2 * LOG2E));
}
__device__ __forceinline__ float sigmoidf_(float x) { return 1.0f / (1.0f + fexp2(-x * LOG2E)); }
__device__ __forceinline__ float wave_sum(float v) {
#pragma unroll
    for (int o = 1; o < 64; o <<= 1) v += __shfl_xor(v, o);
    return v;
}
__device__ __forceinline__ int crow(int r, int hi) { return (r & 3) + 8 * (r >> 2) + 4 * hi; }

#define XB_TMO      128
#define XB_XCNT(j)  (256  + 64 * (j))
#define XB_XSUB(j)  (1280 + 64 * (j))
#define XB_XGEN(j)  (2304 + 64 * (j))
#define XB_TOP      3328
#define XB_TOPGEN   3392
#define XCD_BAR_WORDS 3456
#define XB_SPIN_CAP (1u << 18)
struct XcdBarrier { unsigned* bar; unsigned x; volatile LAS unsigned* st; };
#ifndef EMU
__device__ __forceinline__ unsigned xb_ld(unsigned* p)              { return __hip_atomic_load(p, __ATOMIC_RELAXED, __HIP_MEMORY_SCOPE_AGENT); }
__device__ __forceinline__ unsigned xb_add(unsigned* p, unsigned v) { return __hip_atomic_fetch_add(p, v, __ATOMIC_RELAXED, __HIP_MEMORY_SCOPE_AGENT); }
__device__ __forceinline__ unsigned xb_xcc_id() { return (unsigned)__builtin_amdgcn_s_getreg((3 << 11) | 20) & 0xFu; }
#define XB_SPIN(cond, bar) do { unsigned _sp = 0; while (cond) { __builtin_amdgcn_s_sleep(1); \
    if ((++_sp & 255u) == 0u) { if (xb_ld(&(bar)[XB_TMO])) break; if (_sp > XB_SPIN_CAP) { atomicAdd(&(bar)[XB_TMO], 1u); break; } } } } while (0)
__device__ __forceinline__ XcdBarrier xcd_barrier_post(unsigned* bar, volatile LAS unsigned* st) {
    XcdBarrier b; b.bar = bar; b.x = xb_xcc_id(); b.st = st;
    if (threadIdx.x == 0) (void)xb_add(&bar[XB_XCNT(b.x)], 1u);
    return b;
}
__device__ __forceinline__ void xcd_barrier_complete(unsigned* bar, unsigned x, unsigned& nloc, unsigned& nx) {
    const unsigned G = gridDim.x * gridDim.y * gridDim.z;
    unsigned sum, cnt, mine, sp = 0u;
    for (;;) {
        sum = 0u; cnt = 0u; mine = 0u;
#pragma unroll
        for (unsigned j = 0; j < 16; ++j) { const unsigned c = xb_ld(&bar[XB_XCNT(j)]); sum += c; cnt += (c > 0u) ? 1u : 0u; mine = (j == x) ? c : mine; }
        if (sum == G) break;
        __builtin_amdgcn_s_sleep(1);
        if ((++sp & 255u) == 0u) { if (xb_ld(&bar[XB_TMO])) break; if (sp > XB_SPIN_CAP) { atomicAdd(&bar[XB_TMO], 1u); break; } }
    }
    nloc = mine > 0u ? mine : 1u; nx = cnt > 0u ? cnt : 1u;
}
__device__ __forceinline__ void xcd_barrier(const XcdBarrier& b) {
    asm volatile("s_waitcnt vmcnt(0)" ::: "memory");
    __syncthreads();
    if (threadIdx.x == 0) {
        unsigned* bar = b.bar;
        __builtin_amdgcn_s_waitcnt(0);
        unsigned nloc = b.st[0], nx = b.st[1];
        if (nloc == 0u) { xcd_barrier_complete(bar, b.x, nloc, nx); b.st[0] = nloc; b.st[1] = nx; }
        const unsigned old = xb_add(&bar[XB_XSUB(b.x)], 1u);
        const unsigned gen = old / nloc;
        if (old + 1u == (gen + 1u) * nloc) {
            __builtin_amdgcn_fence(__ATOMIC_RELEASE, "agent");
            asm volatile("s_waitcnt vmcnt(0)" ::: "memory");
            const unsigned og = xb_add(&bar[XB_TOP], 1u);
            const unsigned tg = og / nx;
            if (og + 1u == (tg + 1u) * nx) xb_add(&bar[XB_TOPGEN], 1u);
            else XB_SPIN(xb_ld(&bar[XB_TOPGEN]) == tg, bar);
            __builtin_amdgcn_fence(__ATOMIC_ACQUIRE, "agent");
            xb_add(&bar[XB_XGEN(b.x)], 1u);
            asm volatile("s_waitcnt vmcnt(0)" ::: "memory");
        } else {
            XB_SPIN(xb_ld(&bar[XB_XGEN(b.x)]) == gen, bar);
            __builtin_amdgcn_fence(__ATOMIC_ACQUIRE, "agent");
            asm volatile("s_waitcnt vmcnt(0)" ::: "memory");
        }
    }
    __syncthreads();
}
#else
__device__ __forceinline__ XcdBarrier xcd_barrier_post(unsigned* bar, volatile unsigned* st) { XcdBarrier b; b.bar = bar; b.x = 0; b.st = st; return b; }
__device__ __forceinline__ void xcd_barrier(const XcdBarrier&) { fprintf(stderr, "EMU: grid barrier inside a launch\n"); abort(); }
#endif

struct Args { const float* in[24]; float* out; unsigned char* ws; int ph_lo, ph_hi; };
enum { I_X = 0, I_C, I_WADA, I_BADA, I_GMIX, I_WIN, I_GMWS, I_GMBS, I_GMNG, I_PEK, I_W1K, I_W2K, I_PEV, I_W1V, I_W2V, I_WOUT, I_GFFN, I_WR, I_BR, I_WGU, I_BGU, I_WDN, I_BDN, I_GFIN };

struct Frame {
    LAS unsigned char* lds;
    volatile LAS unsigned* MISC;
    unsigned* ctl;
    unsigned char* ws;
    const float* in[24];
    float* out;
    int tid, lane, wave, vcu, G;
};

namespace pg8 {
constexpr int BM = 256, BK = 64, HALF = 128, HTB = HALF * BK * 2, STAGE_BYTES = 8 * HTB;
__device__ __forceinline__ int lds_byte(int r, int c) { const int st = (r >> 4) * 2 + (c >> 5), rr = r & 15, cc = c & 31, ob = rr * 64 + cc * 2; return st * 1024 + (ob ^ (((ob >> 9) & 1) << 5)); }
__device__ __forceinline__ void stage_rc(int b, int& R, int& C) { const int st = b / 1024, sb = b % 1024, swz = sb ^ (((sb >> 9) & 1) << 5); R = (st >> 1) * 16 + swz / 64; C = (st & 1) * 32 + (swz % 64) / 2; }
__device__ __forceinline__ int perm32(int rho) { const int n = rho >> 4, i = rho & 15; return 8 * (i >> 2) + 4 * n + (i & 3); }
struct Unit { int pm, pn, e; };

template <class Prob, class Sched, class Epi>
__device__ __forceinline__ void gemm_phase(LAS unsigned char* lds, const Prob& P, const Sched& S, const Epi& E) {
    const int tid = threadIdx.x, wid = __builtin_amdgcn_readfirstlane(tid >> 6), lane = tid & 63, wr = wid >> 2, wc = wid & 3, fr = lane & 15, fq = lane >> 4;
    const int K = P.K, nt = K / BK;
    int Rr[2], Cc[2]; unsigned voffB[2];
#pragma unroll
    for (int i = 0; i < 2; ++i) { int R, C; stage_rc(tid * 16 + i * 8192, R, C); Rr[i] = R; Cc[i] = C; const int Rb = Epi::PERM ? ((R & ~31) + perm32(R & 31)) : R; voffB[i] = (unsigned)(Rb * K + C) * 2u; }
    const size_t kstep = (size_t)(BK * 2);
    const size_t hstepB = (size_t)HALF * K * 2;
    const unsigned ldsw = (unsigned)wid * 1024u;
    const int aoff = lds_byte(wr * 64 + fr, fq * 8), boff = lds_byte(wc * 32 + fr, fq * 8);
#define PG8_SA(b, h) (((b) * 2 + (h)) * HTB)
#define PG8_SB(b, h) ((4 + (b) * 2 + (h)) * HTB)
#define PG8_STAGE(bufoff, gbase, voff) do { _Pragma("unroll") for (int _i = 0; _i < 2; ++_i) \
        __builtin_amdgcn_global_load_lds((const unsigned*)((const char*)(gbase) + (voff)[_i]), (LAS unsigned*)(lds + (bufoff) + ldsw + _i * 8192), 16, 0, 0); } while (0)
#define PG8_LDA(dst, b, h) do { _Pragma("unroll") for (int m = 0; m < 4; ++m) _Pragma("unroll") for (int k = 0; k < 2; ++k) dst[m][k] = *(const LAS bf16x8*)(lds + PG8_SA(b, h) + aoff + m * 2048 + k * 1024); } while (0)
#define PG8_LDB(dst, b, h) do { _Pragma("unroll") for (int n = 0; n < 2; ++n) _Pragma("unroll") for (int k = 0; k < 2; ++k) dst[n][k] = *(const LAS bf16x8*)(lds + PG8_SB(b, h) + boff + n * 2048 + k * 1024); } while (0)
#define PG8_MMA(ai, bj, At, Bt) do { __builtin_amdgcn_s_setprio(1); _Pragma("unroll") for (int m = 0; m < 4; ++m) _Pragma("unroll") for (int n = 0; n < 2; ++n) _Pragma("unroll") for (int k = 0; k < 2; ++k) \
        acc[ai][bj][m][n] = __builtin_amdgcn_mfma_f32_16x16x32_bf16(Bt[n][k], At[m][k], acc[ai][bj][m][n], 0, 0, 0); __builtin_amdgcn_s_setprio(0); } while (0)
#define PG8_WAIT_V(n) ASM_VMCNT(n)
#define PG8_WAIT_L(n) ASM_LGKMCNT(n)
#define PG8_BAR __builtin_amdgcn_s_barrier()
#define PG8_SCHED __builtin_amdgcn_sched_barrier(0)
    Unit cur, nxt; int ui = 0;
    if (!S.next(0, cur)) return;
    f32x4 acc[2][2][4][2];
#pragma unroll
    for (int a = 0; a < 2; ++a)
#pragma unroll
        for (int b = 0; b < 2; ++b)
#pragma unroll
            for (int m = 0; m < 4; ++m)
#pragma unroll
                for (int n = 0; n < 2; ++n) acc[a][b][m][n] = (f32x4){0.f, 0.f, 0.f, 0.f};
    bf16x8 At[4][2], B0[2][2], B1[2][2];
    unsigned vA0[2], vA1[2], nA0[2], nA1[2];
#pragma unroll
    for (int i = 0; i < 2; ++i) { vA0[i] = P.a_rowoff(cur, Rr[i]) + (unsigned)Cc[i] * 2u; vA1[i] = P.a_rowoff(cur, HALF + Rr[i]) + (unsigned)Cc[i] * 2u; }
    const char* cA = P.a_base(cur); const char* cB = P.b_base(cur);
    PG8_STAGE(PG8_SB(0, 0), cB, voffB); PG8_STAGE(PG8_SB(0, 1), cB + hstepB, voffB); PG8_STAGE(PG8_SA(0, 0), cA, vA0); PG8_STAGE(PG8_SA(0, 1), cA, vA1);
    if (wr == 1) PG8_BAR;
    PG8_WAIT_V(2); PG8_BAR;
    PG8_STAGE(PG8_SB(1, 0), cB + kstep, voffB); PG8_STAGE(PG8_SA(1, 0), cA + kstep, vA0); PG8_STAGE(PG8_SB(1, 1), cB + hstepB + kstep, voffB);
    PG8_WAIT_V(6); PG8_BAR;
    for (;;) {
        const bool has_next = S.next(ui + 1, nxt);
        const char* nA = has_next ? P.a_base(nxt) : cA; const char* nB = has_next ? P.b_base(nxt) : cB;
#pragma unroll
        for (int i = 0; i < 2; ++i) {
            nA0[i] = has_next ? P.a_rowoff(nxt, Rr[i]) + (unsigned)Cc[i] * 2u : vA0[i];
            nA1[i] = has_next ? P.a_rowoff(nxt, HALF + Rr[i]) + (unsigned)Cc[i] * 2u : vA1[i];
        }
        for (int t = 0; t < nt; t += 2) {
            const bool last = (t == nt - 2);
            const char* a1 = cA + (size_t)(t + 1) * kstep;
            const char* a2 = last ? nA : cA + (size_t)(t + 2) * kstep; const char* b2 = last ? nB : cB + (size_t)(t + 2) * kstep;
            const char* a3 = a2 + kstep; const char* b3 = b2 + kstep;
            unsigned s0[2], s1[2];
#pragma unroll
            for (int i = 0; i < 2; ++i) { s0[i] = last ? nA0[i] : vA0[i]; s1[i] = last ? nA1[i] : vA1[i]; }
            PG8_LDB(B0, 0, 0); PG8_LDB(B1, 0, 1); PG8_SCHED; PG8_LDA(At, 0, 0); PG8_STAGE(PG8_SA(1, 1), a1, vA1);
            PG8_WAIT_V(8); PG8_WAIT_L(0); PG8_BAR; PG8_MMA(0, 0, At, B0); PG8_MMA(0, 1, At, B1); PG8_BAR; PG8_SCHED;
            PG8_LDA(At, 0, 1); PG8_STAGE(PG8_SB(0, 0), b2, voffB); PG8_STAGE(PG8_SB(0, 1), b2 + hstepB, voffB); PG8_STAGE(PG8_SA(0, 0), a2, s0);
            PG8_WAIT_V(8); PG8_WAIT_L(0); PG8_BAR; PG8_MMA(1, 0, At, B0); PG8_MMA(1, 1, At, B1); PG8_BAR; PG8_SCHED;
            PG8_LDB(B0, 1, 0); PG8_LDB(B1, 1, 1); PG8_SCHED; PG8_LDA(At, 1, 0); PG8_STAGE(PG8_SA(0, 1), a2, s1);
            PG8_WAIT_V(8); PG8_WAIT_L(0); PG8_BAR; PG8_MMA(0, 0, At, B0); PG8_MMA(0, 1, At, B1); PG8_BAR; PG8_SCHED;
            PG8_LDA(At, 1, 1); PG8_STAGE(PG8_SB(1, 0), b3, voffB); PG8_STAGE(PG8_SB(1, 1), b3 + hstepB, voffB); PG8_STAGE(PG8_SA(1, 0), a3, s0);
            PG8_WAIT_V(8); PG8_WAIT_L(0); PG8_BAR; PG8_MMA(1, 0, At, B0); PG8_MMA(1, 1, At, B1); PG8_BAR; PG8_SCHED;
        }
        if (wr == 0) PG8_BAR;
        E(acc, cur, wr, wc, fr, fq);
        if (!has_next) break;
#pragma unroll
        for (int a = 0; a < 2; ++a)
#pragma unroll
            for (int b = 0; b < 2; ++b)
#pragma unroll
                for (int m = 0; m < 4; ++m)
#pragma unroll
                    for (int n = 0; n < 2; ++n) acc[a][b][m][n] = (f32x4){0.f, 0.f, 0.f, 0.f};
        cur = nxt; cA = nA; cB = nB; ++ui;
#pragma unroll
        for (int i = 0; i < 2; ++i) { vA0[i] = nA0[i]; vA1[i] = nA1[i]; }
        if (wr == 1) PG8_BAR;
    }
    PG8_WAIT_V(0);
    PG8_BAR;
#undef PG8_SA
#undef PG8_SB
#undef PG8_STAGE
#undef PG8_LDA
#undef PG8_LDB
#undef PG8_MMA
#undef PG8_WAIT_V
#undef PG8_WAIT_L
#undef PG8_BAR
#undef PG8_SCHED
}

struct DenseOrder {
    int nM, nN, nwg, G, c;
    __device__ __forceinline__ void init(int M, int N, int G_, int c_) { nM = M / BM; nN = N / BM; nwg = nM * nN; G = G_; c = c_; }
    __device__ __forceinline__ bool next(int i, Unit& u) const {
        const long L = (long)i * G + c; if (L >= nwg) return false;
        int wgid = (int)L; { const int q = nwg / 8, r = nwg % 8, xcd = wgid % 8, off = wgid / 8; wgid = (xcd < r ? xcd * (q + 1) : r * (q + 1) + (xcd - r) * q) + off; }
        const int nig = 8 * nN, gid = wgid / nig, fm = gid * 8, gsz = (nM - fm) < 8 ? (nM - fm) : 8;
        u.pm = fm + ((wgid % nig) % gsz); u.pn = (wgid % nig) / gsz; u.e = 0; return true;
    }
};
struct DenseProb {
    const char* A; const char* Bt; int K;
    __device__ __forceinline__ const char* a_base(const Unit& u) const { return A + (size_t)u.pm * BM * K * 2; }
    __device__ __forceinline__ unsigned a_rowoff(const Unit&, int r) const { return (unsigned)(r * K * 2); }
    __device__ __forceinline__ const char* b_base(const Unit& u) const { return Bt + (size_t)u.pn * BM * K * 2; }
};
struct MoeOrder {
    volatile LAS unsigned* tpfx; int nN, G, c;
    __device__ __forceinline__ bool next(int i, Unit& u) const {
        const int L = i * G + c; const int total = (int)tpfx[NE] * nN; if (L >= total) return false;
        const int tl = L / nN;  (void)tl;
        int e = 0;
        for (int k = 0; k < NE; ++k) { if (L >= (int)tpfx[k + 1] * nN) e = k + 1; }
        const int rem = L - (int)tpfx[e] * nN, tm = (int)tpfx[e + 1] - (int)tpfx[e];
        u.e = e; u.pm = rem % tm; u.pn = rem / tm; return true;
    }
};
}

struct EpiZ {
    static constexpr bool PERM = true;
    bf16_t* O;
    __device__ __forceinline__ void operator()(const f32x4 (&acc)[2][2][4][2], const pg8::Unit& u, int wr, int wc, int fr, int fq) const {
        const int row0 = u.pm * 256 + wr * 64 + fr, col0 = u.pn * 256 + wc * 32 + 8 * fq;
#pragma unroll
        for (int ai = 0; ai < 2; ++ai)
#pragma unroll
            for (int m = 0; m < 4; ++m) { bf16_t* rowp = O + (size_t)(row0 + ai * 128 + m * 16) * ZP + col0;
#pragma unroll
                for (int bj = 0; bj < 2; ++bj) { const f32x4 v0 = acc[ai][bj][m][0], v1 = acc[ai][bj][m][1];
                    u32x4 w; w.x = pk2(v0[0], v0[1]); w.y = pk2(v0[2], v0[3]); w.z = pk2(v1[0], v1[1]); w.w = pk2(v1[2], v1[3]);
                    *(u32x4*)(rowp + bj * 128) = w; } }
    }
};
struct EpiX1 {
    static constexpr bool PERM = false;
    const float* x; const float* mod; float* O;
    __device__ __forceinline__ void operator()(const f32x4 (&acc)[2][2][4][2], const pg8::Unit& u, int wr, int wc, int fr, int fq) const {
        const int col0 = u.pn * 256 + wc * 32 + 4 * fq;
        const int b = (u.pm * 256) / SEQ;
        const float* gt = mod + (size_t)b * 6144 + 2 * 1024;
#pragma unroll
        for (int bj = 0; bj < 2; ++bj)
#pragma unroll
            for (int n = 0; n < 2; ++n) { const int c = col0 + bj * 128 + n * 16; const f32x4 g = *(const f32x4*)(gt + c);
#pragma unroll
                for (int ai = 0; ai < 2; ++ai)
#pragma unroll
                    for (int m = 0; m < 4; ++m) { const size_t off = (size_t)(u.pm * 256 + ai * 128 + wr * 64 + m * 16 + fr) * DM + c;
                        const f32x4 xv = *(const f32x4*)(x + off); *(f32x4*)(O + off) = xv + g * acc[ai][bj][m][n]; } }
    }
};
struct EpiAct {
    static constexpr bool PERM = true;
    bf16_t* O; const float* bgu; volatile LAS unsigned* roff;
    __device__ __forceinline__ void operator()(const f32x4 (&acc)[2][2][4][2], const pg8::Unit& u, int wr, int wc, int fr, int fq) const {
        const int row0 = (int)roff[u.e] + u.pm * 256 + wr * 64 + fr, col0 = u.pn * 128 + wc * 32 + 8 * fq;
        const float* bp = bgu + (size_t)u.e * 2048 + 2 * col0;
        f32x4 bb[4];
#pragma unroll
        for (int j = 0; j < 4; ++j) bb[j] = *(const f32x4*)(bp + 4 * j);
#pragma unroll
        for (int ai = 0; ai < 2; ++ai)
#pragma unroll
            for (int m = 0; m < 4; ++m) { float a8[8];
#pragma unroll
                for (int n = 0; n < 2; ++n)
#pragma unroll
                    for (int j = 0; j < 4; ++j) { const int cc = 4 * n + j;
                        float g = acc[ai][0][m][n][j] + bb[cc >> 1][(cc & 1) * 2], l = acc[ai][1][m][n][j] + bb[cc >> 1][(cc & 1) * 2 + 1];
                        g = fminf(g, 7.0f); l = fminf(fmaxf(l, -7.0f), 7.0f);
                        a8[cc] = g * sigmoidf_(1.702f * g) * (l + 1.0f); }
                u32x4 w; w.x = pk2(a8[0], a8[1]); w.y = pk2(a8[2], a8[3]); w.z = pk2(a8[4], a8[5]); w.w = pk2(a8[6], a8[7]);
                *(u32x4*)(O + (size_t)(row0 + ai * 128 + m * 16) * DFF + col0) = w; }
    }
};
struct EpiYd {
    static constexpr bool PERM = true;
    bf16_t* O; const float* bdn; volatile LAS unsigned* roff;
    __device__ __forceinline__ void operator()(const f32x4 (&acc)[2][2][4][2], const pg8::Unit& u, int wr, int wc, int fr, int fq) const {
        const int row0 = (int)roff[u.e] + u.pm * 256 + wr * 64 + fr, col0 = u.pn * 256 + wc * 32 + 8 * fq;
        f32x4 bv[2][2];
#pragma unroll
        for (int bj = 0; bj < 2; ++bj)
#pragma unroll
            for (int n = 0; n < 2; ++n) bv[bj][n] = *(const f32x4*)(bdn + (size_t)u.e * 1024 + col0 + bj * 128 + 4 * n);
#pragma unroll
        for (int ai = 0; ai < 2; ++ai)
#pragma unroll
            for (int m = 0; m < 4; ++m) { bf16_t* rowp = O + (size_t)(row0 + ai * 128 + m * 16) * DM + col0;
#pragma unroll
                for (int bj = 0; bj < 2; ++bj) { const f32x4 v0 = acc[ai][bj][m][0] + bv[bj][0], v1 = acc[ai][bj][m][1] + bv[bj][1];
                    u32x4 w; w.x = pk2(v0[0], v0[1]); w.y = pk2(v0[2], v0[3]); w.z = pk2(v1[0], v1[1]); w.w = pk2(v1[2], v1[3]);
                    *(u32x4*)(rowp + bj * 128) = w; } }
    }
};
struct MoeProb1 {
    const char* H2; const char* Bt; const int* lists; volatile LAS unsigned* cnt; int K;
    __device__ __forceinline__ const char* a_base(const pg8::Unit&) const { return H2; }
    __device__ __forceinline__ unsigned a_rowoff(const pg8::Unit& u, int r) const { const int i = u.pm * 256 + r; const int tok = (i < (int)cnt[u.e]) ? lists[(size_t)u.e * T + i] : 0; return (unsigned)tok * 2048u; }
    __device__ __forceinline__ const char* b_base(const pg8::Unit& u) const { return Bt + ((size_t)u.e * 2048 + (size_t)u.pn * 256) * 2048; }
};
struct MoeProb2 {
    const char* A; const char* Bt; volatile LAS unsigned* roff; int K;
    __device__ __forceinline__ const char* a_base(const pg8::Unit& u) const { return A + ((size_t)roff[u.e] + (size_t)u.pm * 256) * 2048; }
    __device__ __forceinline__ unsigned a_rowoff(const pg8::Unit&, int r) const { return (unsigned)r * 2048u; }
    __device__ __forceinline__ const char* b_base(const pg8::Unit& u) const { return Bt + ((size_t)u.e * 1024 + (size_t)u.pn * 256) * 2048; }
};

template <int NB>
__device__ __forceinline__ void gemv_item(Frame& F, const float* vec, int vstride, const float* W, int K, int N, int n0, const float* bias, float* out, int ostride) {
    LAS float* red = (LAS float*)F.lds;
    const int col = n0 + F.lane, ks = K / NWAVES;
    float acc[NB];
#pragma unroll
    for (int b = 0; b < NB; ++b) acc[b] = 0.f;
    for (int k0 = F.wave * ks; k0 < (F.wave + 1) * ks; k0 += 32) {
        float wv[32];
#pragma unroll
        for (int j = 0; j < 32; ++j) wv[j] = __builtin_nontemporal_load(W + (size_t)(k0 + j) * N + col);
#pragma unroll
        for (int j = 0; j < 32; ++j)
#pragma unroll
            for (int b = 0; b < NB; ++b) acc[b] += vec[b * vstride + k0 + j] * wv[j]; }
#pragma unroll
    for (int b = 0; b < NB; ++b) red[(F.wave * NB + b) * 64 + F.lane] = acc[b];
    __syncthreads();
    if (F.wave == 0) {
#pragma unroll
        for (int b = 0; b < NB; ++b) { float s = bias ? bias[col] : 0.f;
            for (int w = 0; w < NWAVES; ++w) s += red[(w * NB + b) * 64 + F.lane];
            out[b * ostride + col] = s; }
    }
    __syncthreads();
}
template <int MAP>
__device__ __forceinline__ int t_rowmap(int n) {
    if (MAP == 0) return n;
    const int ac = n >> 1, bj = n & 1; return (ac >> 7) * 256 + bj * 128 + (ac & 127);
}
template <int MAP>
__device__ __forceinline__ void transpose_item(const float* W, int K, int Nsrc, int nblk, bf16_t* WT, LAS float* scr, int item, int lane) {
    const int kb = item / nblk, nb = item % nblk, k0 = 64 * kb, n0 = 32 * nb;
    const int nc = n0 + (lane & 31);
    float tv[32];
    if (nc < Nsrc) {
#pragma unroll
        for (int i = 0; i < 32; ++i) tv[i] = __builtin_nontemporal_load(W + (size_t)(k0 + 2 * i + (lane >> 5)) * Nsrc + nc);
    } else {
#pragma unroll
        for (int i = 0; i < 32; ++i) tv[i] = 0.f;
    }
#pragma unroll
    for (int i = 0; i < 32; ++i) scr[(2 * i + (lane >> 5)) * 33 + (lane & 31)] = tv[i];
    WAVE_SYNC(); FENCE();
    const int c = lane & 7;
#pragma unroll
    for (int j = 0; j < 4; ++j) { const int n = (lane >> 3) + 8 * j; const LAS float* s = scr + (8 * c) * 33 + n;
        u32x4 o; o.x = pk2(s[0 * 33], s[1 * 33]); o.y = pk2(s[2 * 33], s[3 * 33]); o.z = pk2(s[4 * 33], s[5 * 33]); o.w = pk2(s[6 * 33], s[7 * 33]);
        *(u32x4*)(WT + (size_t)t_rowmap<MAP>(n0 + n) * K + k0 + 8 * c) = o; }
    WAVE_SYNC(); FENCE();
}
__device__ __forceinline__ void p0_prologue(Frame& F) {
    for (int it = F.vcu; it < 96 + 8; it += F.G) {
        if (it < 96) gemv_item<BATCH>(F, F.in[I_C], DM, F.in[I_WADA], DM, 6 * DM, 64 * it, F.in[I_BADA], (float*)(F.ws + WS_MOD), 6 * DM);
        else { const int j = it - 96, kv = j >> 2, n0 = (j & 3) * 64;
            gemv_item<1>(F, F.in[kv ? I_PEV : I_PEK], 0, F.in[kv ? I_W1V : I_W1K], 2048, 256, n0, nullptr, (float*)(F.ws + WS_BPE) + kv * 256, 0); }
    }
    { const float* src = F.in[I_GMWS]; bf16_t* dst = (bf16_t*)(F.ws + WS_WSBF);
      for (int idx = F.vcu * NTHREADS + F.tid; idx < GMG * GMC * GMC; idx += F.G * NTHREADS) { const int i = (idx >> 7) & 127, j = idx & 127; dst[idx] = (bf16_t)f2bf(j <= i ? src[idx] : 0.f); } }
    LAS float* scr = (LAS float*)(F.lds + 8192 + F.wave * 16384);
    const int gw = F.vcu * NWAVES + F.wave, NGW = F.G * NWAVES;
    constexpr int I_IN = (DM / 64) * (ZP / 32), I_OUT = (DM / 64) * (DM / 32), I_W1 = (2048 / 64) * (256 / 32), I_W2 = (256 / 64) * (64 / 32);
    constexpr int I_GU1 = (DM / 64) * (2048 / 32), I_DN1 = (DFF / 64) * (DM / 32);
    constexpr int NITEMS = I_IN + I_OUT + 2 * I_W1 + 2 * I_W2 + NE * I_GU1 + NE * I_DN1;
    for (int it = gw; it < NITEMS; it += NGW) {
        int r = it;
        if (r < I_IN) { transpose_item<0>(F.in[I_WIN], DM, INC, ZP / 32, (bf16_t*)(F.ws + WS_WINT), scr, r, F.lane); continue; } r -= I_IN;
        if (r < I_OUT) { transpose_item<0>(F.in[I_WOUT], DM, DM, DM / 32, (bf16_t*)(F.ws + WS_WOUTT), scr, r, F.lane); continue; } r -= I_OUT;
        if (r < I_W1) { transpose_item<0>(F.in[I_W1K], 2048, 256, 8, (bf16_t*)(F.ws + WS_W1KT), scr, r, F.lane); continue; } r -= I_W1;
        if (r < I_W1) { transpose_item<0>(F.in[I_W1V], 2048, 256, 8, (bf16_t*)(F.ws + WS_W1VT), scr, r, F.lane); continue; } r -= I_W1;
        if (r < I_W2) { transpose_item<0>(F.in[I_W2K], 256, 64, 2, (bf16_t*)(F.ws + WS_W2KT), scr, r, F.lane); continue; } r -= I_W2;
        if (r < I_W2) { transpose_item<0>(F.in[I_W2V], 256, 64, 2, (bf16_t*)(F.ws + WS_W2VT), scr, r, F.lane); continue; } r -= I_W2;
        if (r < NE * I_GU1) { const int e = r / I_GU1; transpose_item<1>(F.in[I_WGU] + (size_t)e * DM * 2048, DM, 2048, 64, (bf16_t*)(F.ws + WS_WGUT) + (size_t)e * 2048 * DM, scr, r % I_GU1, F.lane); continue; } r -= NE * I_GU1;
        { const int e = r / I_DN1; transpose_item<0>(F.in[I_WDN] + (size_t)e * DFF * DM, DFF, DM, 32, (bf16_t*)(F.ws + WS_WDNT) + (size_t)e * DM * DFF, scr, r % I_DN1, F.lane); }
    }
}

__device__ __forceinline__ void norm_rows(Frame& F, const float* xin, const float* g, int mod_shift, int mod_scale, bf16_t* outb) {
    const int gw = F.vcu * NWAVES + F.wave, NGW = F.G * NWAVES;
    const float* mod = (const float*)(F.ws + WS_MOD);
    for (int m = gw; m < T; m += NGW) {
        const int b = m / SEQ;
        const f32x4* xr = (const f32x4*)(xin + (size_t)m * DM) + F.lane;
        f32x4 v[4]; float s = 0.f;
#pragma unroll
        for (int j = 0; j < 4; ++j) { v[j] = xr[64 * j]; s += (v[j][0] * v[j][0] + v[j][1] * v[j][1]) + (v[j][2] * v[j][2] + v[j][3] * v[j][3]); }
        const float rinv = 1.0f / sqrtf(wave_sum(s) * (1.0f / DM) + EPS);
        u32x2* o8 = (u32x2*)(outb + (size_t)m * DM) + F.lane;
#pragma unroll
        for (int j = 0; j < 4; ++j) { const int c = 4 * F.lane + 256 * j;
            const f32x4 gg = *(const f32x4*)(g + c), sc = *(const f32x4*)(mod + (size_t)b * 6144 + mod_scale * 1024 + c), sh = *(const f32x4*)(mod + (size_t)b * 6144 + mod_shift * 1024 + c);
            const f32x4 h = v[j] * rinv * gg * (sc + 1.0f) + sh;
            u32x2 w; w.x = pk2(h[0], h[1]); w.y = pk2(h[2], h[3]); o8[64 * j] = w; }
    }
}

__device__ __forceinline__ void gmlp_tile(Frame& F, int tile) {
    const int g = tile % GMG, ch = (tile / GMG) % (SEQ / GMC), b = tile / (GMG * (SEQ / GMC));
    const size_t row0 = (size_t)b * SEQ + (size_t)ch * GMC;
    const bf16_t* ZB = (const bf16_t*)(F.ws + WS_ZB);
    LAS bf16_t* Vt = (LAS bf16_t*)F.lds;
    constexpr int VP = 136;
    const float* gn = F.in[I_GMNG] + g * 64;
#pragma unroll
    for (int it = 0; it < 2; ++it) {
        const int idx = F.tid + it * NTHREADS, row = idx >> 3, c8 = idx & 7;
        const u32x4 raw = *(const u32x4*)(ZB + (row0 + row) * ZP + ZC_V + g * 64 + c8 * 8);
        float v[8]; v[0] = bflo(raw.x); v[1] = bfhi(raw.x); v[2] = bflo(raw.y); v[3] = bfhi(raw.y); v[4] = bflo(raw.z); v[5] = bfhi(raw.z); v[6] = bflo(raw.w); v[7] = bfhi(raw.w);
        float ss = 0.f;
#pragma unroll
        for (int e = 0; e < 8; ++e) { v[e] = gelu_tanh(v[e]); ss += v[e] * v[e]; }
        ss += __shfl_xor(ss, 1); ss += __shfl_xor(ss, 2); ss += __shfl_xor(ss, 4);
        const float rinv = 1.0f / sqrtf(ss * (1.0f / 64.0f) + EPS);
#pragma unroll
        for (int e = 0; e < 8; ++e) Vt[(c8 * 8 + e) * VP + row] = (bf16_t)f2bf(v[e] * rinv * gn[c8 * 8 + e]);
    }
    __syncthreads();
    const int fr = F.lane & 15, fq = F.lane >> 4, w = F.wave;
    const bf16_t* Wg = (const bf16_t*)(F.ws + WS_WSBF) + (size_t)g * GMC * GMC;
    f32x4 acc[4];
#pragma unroll
    for (int n = 0; n < 4; ++n) acc[n] = (f32x4){0.f, 0.f, 0.f, 0.f};
    for (int ks = 0; ks < 4; ++ks) {
        if (32 * ks > 16 * w + 15) break;
        const bf16x8 a = *(const bf16x8*)(Wg + (size_t)(16 * w + fr) * GMC + 32 * ks + 8 * fq);
#pragma unroll
        for (int n = 0; n < 4; ++n) { const bf16x8 bb = *(const LAS bf16x8*)(Vt + (16 * n + fr) * VP + 32 * ks + 8 * fq);
            acc[n] = __builtin_amdgcn_mfma_f32_16x16x32_bf16(a, bb, acc[n], 0, 0, 0); }
    }
    bf16_t* Y = (bf16_t*)(F.ws + WS_YMIX);
    const float* bs = F.in[I_GMBS] + g * GMC;
#pragma unroll
    for (int n = 0; n < 4; ++n)
#pragma unroll
        for (int r = 0; r < 4; ++r) { const int i = 16 * w + 4 * fq + r, d = 16 * n + fr;
            const float u = gelu_tanh(bf2f(ZB[(row0 + i) * ZP + ZC_U + g * 64 + d]));
            Y[(row0 + i) * DM + g * 64 + d] = (bf16_t)f2bf(u * (acc[n][r] + bs[i])); }
    __syncthreads();
}

__device__ __forceinline__ void cmp_tile(Frame& F, int tile) {
    constexpr int NT = NCP / 32;
    const int nt = tile % NT, g = (tile / NT) % NG, b = (tile / (NT * NG)) % BATCH, kv = tile / (NT * NG * BATCH);
    const int n0 = 32 * nt, p0 = 16 * n0;
    const bf16_t* ZB = (const bf16_t*)(F.ws + WS_ZB);
    constexpr int RP = 72;
    LAS bf16_t* Rs = (LAS bf16_t*)F.lds;
    LAS bf16_t* Hs = (LAS bf16_t*)(F.lds + 528 * RP * 2);
    constexpr int HP = 264;
    const int zc = (kv ? ZC_VC : ZC_KC) + g * 64;
    for (int idx = F.tid; idx < 528 * 8; idx += NTHREADS) { const int row = idx >> 3, c8 = idx & 7; const int p = p0 + row;
        u32x4 v = (u32x4){0u, 0u, 0u, 0u};
        if (p < SEQ) v = *(const u32x4*)(ZB + ((size_t)b * SEQ + p) * ZP + zc + c8 * 8);
        *(LAS u32x4*)(Rs + row * RP + c8 * 8) = v; }
    __syncthreads();
    const int i = F.lane & 31, hi = F.lane >> 5, w = F.wave;
    const bf16_t* W1T = (const bf16_t*)(F.ws + (kv ? WS_W1VT : WS_W1KT)) + (size_t)(32 * w + i) * 2048;
    f32x16 acc;
#pragma unroll
    for (int r = 0; r < 16; ++r) acc[r] = 0.f;
    for (int kk = 0; kk < 128; ++kk) {
        const int l = kk >> 2, d = (16 * kk + 8 * hi) & 63;
        const bf16x8 a = *(const LAS bf16x8*)(Rs + (16 * i + l) * RP + d);
        const bf16x8 bb = *(const bf16x8*)(W1T + 16 * kk + 8 * hi);
        acc = __builtin_amdgcn_mfma_f32_32x32x16_bf16(a, bb, acc, 0, 0, 0);
    }
    const float bpe = ((const float*)(F.ws + WS_BPE))[kv * 256 + 32 * w + i];
#pragma unroll
    for (int r = 0; r < 16; ++r) Hs[crow(r, hi) * HP + 32 * w + i] = (bf16_t)f2bf(gelu_tanh(acc[r] + bpe));
    __syncthreads();
    if (w < 2) {
        const bf16_t* W2T = (const bf16_t*)(F.ws + (kv ? WS_W2VT : WS_W2KT)) + (size_t)(32 * w + i) * 256;
        f32x16 o;
#pragma unroll
        for (int r = 0; r < 16; ++r) o[r] = 0.f;
        for (int kk = 0; kk < 16; ++kk) {
            const bf16x8 a = *(const LAS bf16x8*)(Hs + i * HP + 16 * kk + 8 * hi);
            const bf16x8 bb = *(const bf16x8*)(W2T + 16 * kk + 8 * hi);
            o = __builtin_amdgcn_mfma_f32_32x32x16_bf16(a, bb, o, 0, 0, 0);
        }
        bf16_t* KC = (bf16_t*)(F.ws + (kv ? WS_VC : WS_KC)) + ((size_t)(b * NG + g) * NCP) * 64;
#pragma unroll
        for (int r = 0; r < 16; ++r) { const int n = n0 + crow(r, hi); KC[(size_t)n * 64 + 32 * w + i] = (n < NCMP) ? (bf16_t)f2bf(o[r]) : (bf16_t)0; }
    }
    __syncthreads();
}

constexpr int KPB = 144;
constexpr int NB_K = 64 * KPB;
constexpr int V_H1 = 4096 + 64;
constexpr int NB_BUF = NB_K + 8192 + 64;
constexpr int A_IMP = 2 * NB_BUF, A_SEL = A_IMP + 64 * 128 * 4, A_UNI = A_SEL + 64 * 8 * 2, A_Y = A_UNI + 256, A_WSF = A_Y + 8 * 32 * 64 * 4, A_END = A_WSF + 8 * 32 * 4;
static_assert(A_END <= MISC_OFF, "NSA LDS map");
#ifndef NSA_THR_VAL
#define NSA_THR_VAL 20.0f
#endif
constexpr float NSA_THR = NSA_THR_VAL, NEG_BIG = -1e30f;

#ifdef EMU
__device__ __forceinline__ int opaque_lane(int l) { return l; }
#else
__device__ __forceinline__ int opaque_lane(int) { int x; asm volatile("v_mbcnt_lo_u32_b32 %0, -1, 0\n\tv_mbcnt_hi_u32_b32 %0, -1, %0" : "=v"(x)); return x; }
#endif
struct StageRegs { u32x4 k, v; };
template <bool WITHV>
__device__ __forceinline__ void stage_issue(StageRegs& sr, const bf16_t* Kg, const bf16_t* Vg, size_t pitch, long rbase, long nvalid, int tid) {
    const int row = tid >> 3, c8 = tid & 7; const long rr = rbase + row;
    sr.k = (u32x4){0u, 0u, 0u, 0u}; sr.v = (u32x4){0u, 0u, 0u, 0u};
    if (rr >= 0 && rr < nvalid) { sr.k = *(const u32x4*)(Kg + (size_t)rr * pitch + c8 * 8); if (WITHV) sr.v = *(const u32x4*)(Vg + (size_t)rr * pitch + c8 * 8); }
}
template <bool WITHV>
__device__ __forceinline__ void stage_commit(const StageRegs& sr, LAS unsigned char* buf, int tid) {
    const int row = tid >> 3, c8 = tid & 7;
    *(LAS u32x4*)(buf + row * KPB + c8 * 16) = sr.k;
    if (WITHV) *(LAS u32x4*)(buf + NB_K + (c8 >> 2) * V_H1 + row * 64 + (c8 & 3) * 16) = sr.v;
}
struct BrState { float mref, l; int has; unsigned qxm; f32x16 o0, o1; };
__device__ __forceinline__ unsigned ref_words(float m, float& meff) { const unsigned mh = f2bf(m); const float fh = bf2f((unsigned short)mh); const unsigned ml = f2bf(m - fh); meff = fh + bf2f((unsigned short)ml); return mh | (ml << 16); }

#ifdef EMU
#define VTR(p) __builtin_amdgcn_ds_read_tr16_b64_v4i16(p)
#else
typedef short v4i16_t __attribute__((ext_vector_type(4)));
#define VTR(p) __builtin_bit_cast(s16x4, __builtin_amdgcn_ds_read_tr16_b64_v4i16((LAS v4i16_t*)(p)))
#endif

template <bool PV, bool TRACK>
__device__ __forceinline__ void nsa_tile(LAS unsigned char* buf, const bf16x8 (&qf)[4], unsigned qxs, unsigned qxm_t, unsigned klw0, unsigned klw1, unsigned tbw, unsigned neg1w,
                                         int mode, int lim, BrState& st, f32x16& p0, f32x16& p1, int lane, LAS float* wsf) {
#ifndef EMU
    asm volatile("" : "+v"(lim));
#endif
    const int i = lane & 31, hi = lane >> 5;
    const bf16x8 qx = __builtin_bit_cast(bf16x8, ((u32x4){qxs, qxs, qxm_t, 0u}));
    const bf16x8 kx0 = __builtin_bit_cast(bf16x8, ((u32x4){klw0, tbw, neg1w, 0u})), kx1 = __builtin_bit_cast(bf16x8, ((u32x4){klw1, tbw, neg1w, 0u}));
    const LAS unsigned char* kp = buf + i * KPB + 16 * hi;
#pragma unroll
    for (int r = 0; r < 16; ++r) { p0[r] = 0.f; p1[r] = 0.f; }
#pragma unroll
    for (int d0 = 0; d0 < 4; ++d0) {
        const bf16x8 k0 = *(const LAS bf16x8*)(kp + 32 * d0), k1 = *(const LAS bf16x8*)(kp + 32 * KPB + 32 * d0);
        p0 = __builtin_amdgcn_mfma_f32_32x32x16_bf16(k0, qf[d0], p0, 0, 0, 0);
        p1 = __builtin_amdgcn_mfma_f32_32x32x16_bf16(k1, qf[d0], p1, 0, 0, 0);
    }
    p0 = __builtin_amdgcn_mfma_f32_32x32x16_bf16(kx0, qx, p0, 0, 0, 0);
    p1 = __builtin_amdgcn_mfma_f32_32x32x16_bf16(kx1, qx, p1, 0, 0, 0);
    if (mode) {
        const int lim2 = lim - 4 * hi; const bool inv = (mode == 2);
#pragma unroll
        for (int r = 0; r < 16; ++r) { const int c0 = (r & 3) + 8 * (r >> 2);
            const bool v0 = (c0 <= lim2) != inv, v1 = (c0 + 32 <= lim2) != inv;
            p0[r] = v0 ? p0[r] : -INFINITY; p1[r] = v1 ? p1[r] : -INFINITY; }
    }
    if (TRACK) {
        float mx = fmaxf(p0[0], p1[0]);
#pragma unroll
        for (int r = 1; r < 16; ++r) mx = fmaxf(mx, fmaxf(p0[r], p1[r]));
        mx = fmaxf(mx, __shfl_xor(mx, 32));
        const bool upd = (mx > (st.has ? NSA_THR : NEG_BIG)) && (mx > NEG_BIG);
        if (__any(upd)) {
            float meff; const unsigned w = ref_words(st.mref + mx, meff);
            const float de = upd ? (meff - st.mref) : 0.f;
            const float f = (upd && st.has) ? fexp2(-de) : 1.0f;
#pragma unroll
            for (int r = 0; r < 16; ++r) { p0[r] -= de; p1[r] -= de; }
            st.l *= f;
            if (PV) {
                wsf[i] = f; WAVE_SYNC(); FENCE();
                const LAS float* wr_ = wsf + 4 * hi;
#pragma unroll
                for (int r = 0; r < 16; ++r) { const float a = wr_[(r & 3) + 8 * (r >> 2)]; st.o0[r] *= a; st.o1[r] *= a; }
                WAVE_SYNC(); FENCE();
            }
            if (upd) { st.mref = meff; st.qxm = hi ? 0u : w; st.has = 1; }
        }
    }
    float rs = 0.f;
#pragma unroll
    for (int r = 0; r < 16; ++r) { p0[r] = fexp2(p0[r]); p1[r] = fexp2(p1[r]); rs += p0[r] + p1[r]; }
    st.l += rs;
    if (PV) {
        const LAS unsigned char* vb = buf + NB_K + (4 * hi + ((lane & 15) >> 2)) * 64 + 32 * ((lane >> 4) & 1) + 8 * (lane & 3);
#pragma unroll
        for (int ks = 0; ks < 4; ++ks) {
            const f32x16& p = (ks < 2) ? p0 : p1; const int s = ks & 1;
            u32x4 pw; pw.x = pk2(p[8 * s + 0], p[8 * s + 1]); pw.y = pk2(p[8 * s + 2], p[8 * s + 3]); pw.z = pk2(p[8 * s + 4], p[8 * s + 5]); pw.w = pk2(p[8 * s + 6], p[8 * s + 7]);
            const bf16x8 pa = __builtin_bit_cast(bf16x8, pw);
#pragma unroll
            for (int d0 = 0; d0 < 2; ++d0) {
                const s16x4 lo = VTR(vb + d0 * V_H1 + ks * 1024), hh = VTR(vb + d0 * V_H1 + ks * 1024 + 512);
                const bf16x8 vf = (bf16x8){lo[0], lo[1], lo[2], lo[3], hh[0], hh[1], hh[2], hh[3]};
                if (d0 == 0) st.o0 = __builtin_amdgcn_mfma_f32_32x32x16_bf16(pa, vf, st.o0, 0, 0, 0);
                else         st.o1 = __builtin_amdgcn_mfma_f32_32x32x16_bf16(pa, vf, st.o1, 0, 0, 0);
            }
            __builtin_amdgcn_sched_barrier(0);
        }
    }
}

__device__ __forceinline__ int bit128(const unsigned (&m)[4], int j) { return (int)((m[j >> 5] >> (j & 31)) & 1u); }
__device__ __forceinline__ int next_below(const unsigned (&m)[4], int j) { for (int k = j - 1; k >= 0; --k) if ((m[k >> 5] >> (k & 31)) & 1u) return k; return -1; }

__device__ __forceinline__ void nsa_task(Frame& F, int task) {
    constexpr int NQT = SEQ / 64;
    const int qt = task % NQT, g = (task / NQT) % NG, b = task / (NQT * NG);
    const int t0 = 64 * qt, w = F.wave, lane = F.lane, i = lane & 31, hi = lane >> 5;
    const int r_head = i >> 3, ql = i & 7, qloc = 8 * w + ql, t = t0 + qloc, tloc = qloc, head = 4 * g + r_head;
    const bf16_t* Zb = (const bf16_t*)(F.ws + WS_ZB) + (size_t)b * SEQ * ZP;
    bf16x8 qf[4];
#pragma unroll
    for (int d0 = 0; d0 < 4; ++d0) { const u32x4 raw = *(const u32x4*)(Zb + (size_t)t * ZP + ZC_Q + head * 64 + 16 * d0 + 8 * hi);
        const float sc = 0.125f * LOG2E; u32x4 o;
        o.x = pk2(bflo(raw.x) * sc, bfhi(raw.x) * sc); o.y = pk2(bflo(raw.y) * sc, bfhi(raw.y) * sc); o.z = pk2(bflo(raw.z) * sc, bfhi(raw.z) * sc); o.w = pk2(bflo(raw.w) * sc, bfhi(raw.w) * sc);
        qf[d0] = __builtin_bit_cast(bf16x8, o); }
    LAS unsigned char* buf0 = F.lds; LAS unsigned char* buf1 = F.lds + NB_BUF;
    LAS float* imp = (LAS float*)(F.lds + A_IMP);
    LAS unsigned short* selm = (LAS unsigned short*)(F.lds + A_SEL);
    LAS unsigned* uniw = (LAS unsigned*)(F.lds + A_UNI);
    LAS float* yl = (LAS float*)(F.lds + A_Y) + w * 2048;
    LAS float* wsf = (LAS float*)(F.lds + A_WSF) + w * 32;
    for (int idx = F.tid; idx < 64 * 128; idx += NTHREADS) imp[idx] = 0.f;
    for (int k = lane; k < 2048; k += 64) yl[k] = 0.f;
    StageRegs sr;
    f32x16 p0, p1;

#define LANE_CONSTS(CMP) \
        const int ln_ = opaque_lane(lane), hi_ = ln_ >> 5, i_ = ln_ & 31; \
        unsigned qxs; { const float s2_ = fexp2(-(float)(4 * g + (i_ >> 3) + 1)) * LOG2E; const unsigned sh_ = f2bf(s2_); const unsigned sl_ = f2bf(s2_ - bf2f((unsigned short)sh_)); qxs = hi_ ? 0u : (sh_ | (sl_ << 16)); } \
        const unsigned neg1w = hi_ ? 0u : 0xBF80BF80u; const unsigned maskw = hi_ ? 0u : 0x00007E96u; (void)maskw; \
        const unsigned klw0 = hi_ ? 0u : (f2bf((float)((CMP) ? 16 * i_ : i_)) * 0x10001u), klw1 = hi_ ? 0u : (f2bf((float)((CMP) ? 16 * (i_ + 32) : (i_ + 32))) * 0x10001u);
#define INIT_ST(st) do { st.mref = 0.f; st.l = 0.f; st.has = 0; st.qxm = 0u; _Pragma("unroll") for (int r = 0; r < 16; ++r) { st.o0[r] = 0.f; st.o1[r] = 0.f; } } while (0)
#define ACC_BRANCH(st, gidx) do { float f_ = st.l + __shfl_xor(st.l, 32); const float gate_ = sigmoidf_(bf2f(Zb[(size_t)t * ZP + ZC_GL + head * 3 + gidx])); f_ = (f_ > 0.f) ? gate_ / f_ : 0.f; \
        wsf[i] = f_; WAVE_SYNC(); FENCE(); const LAS float* wr_ = wsf + 4 * hi; LAS float* yb_ = yl + hi * 256 + i; \
        _Pragma("unroll") for (int r = 0; r < 16; ++r) { const int c_ = (r & 3) + 8 * (r >> 2); const float a_ = wr_[c_]; yb_[c_ * 64] += a_ * st.o0[r]; yb_[c_ * 64 + 32] += a_ * st.o1[r]; } \
        WAVE_SYNC(); FENCE(); } while (0)

    {
        BrState st; INIT_ST(st);
        LANE_CONSTS(0)
        const bf16_t* Kg = Zb + ZC_KW + g * 64; const bf16_t* Vg = Zb + ZC_VW + g * 64;
        const int klast = (qt - 8 > 0) ? qt - 8 : 0;
        int cur = qt, bsel = 0;
        __syncthreads();
        stage_issue<true>(sr, Kg, Vg, ZP, 64L * cur, SEQ, F.tid); stage_commit<true>(sr, buf0, F.tid);
        __syncthreads();
        while (cur >= klast) {
            const int nxt = cur - 1;
            if (nxt >= klast) stage_issue<true>(sr, Kg, Vg, ZP, 64L * nxt, SEQ, F.tid);
            const int mode = (cur == qt) ? 1 : ((cur == qt - 8) ? 2 : 0);
            const unsigned tbw = hi ? 0u : (f2bf((float)(64 * cur)) * 0x10001u);
            nsa_tile<true, true>(bsel ? buf1 : buf0, qf, qxs, st.qxm, klw0, klw1, tbw, neg1w, mode, tloc, st, p0, p1, lane, wsf);
            if (nxt >= klast) stage_commit<true>(sr, bsel ? buf0 : buf1, F.tid);
            __syncthreads();
            cur = nxt; bsel ^= 1;
        }
        ACC_BRANCH(st, 2);
    }
    {
        const bf16_t* Kg = (const bf16_t*)(F.ws + WS_KC) + (size_t)(b * NG + g) * NCP * 64;
        const bf16_t* Vg = (const bf16_t*)(F.ws + WS_VC) + (size_t)(b * NG + g) * NCP * 64;
        const int nct = (t0 + 63 >= 31) ? (((t0 + 63 - 31) >> 4) / 64 + 1) : 0;
        const int cfull = (t0 >= 31) ? ((t0 - 31) >> 4) : -1;
        const int climit = (t >= 31) ? ((t - 31) >> 4) : -1;
        BrState st; INIT_ST(st);
        LANE_CONSTS(1)
        if (nct > 0) {
            int cur = nct - 1, bsel = 0;
            stage_issue<false>(sr, Kg, Vg, 64, 64L * cur, NCP, F.tid); stage_commit<false>(sr, buf0, F.tid);
            __syncthreads();
            while (cur >= 0) {
                const int nxt = cur - 1;
                if (nxt >= 0) stage_issue<false>(sr, Kg, Vg, 64, 64L * nxt, NCP, F.tid);
                const int mode = (64 * cur + 63 <= cfull) ? 0 : 1;
                const unsigned tbw = hi ? 0u : (f2bf((float)(1024 * cur)) * 0x10001u);
                nsa_tile<false, true>(bsel ? buf1 : buf0, qf, qxs, st.qxm, klw0, klw1, tbw, neg1w, mode, climit - 64 * cur, st, p0, p1, lane, wsf);
                if (nxt >= 0) stage_commit<false>(sr, bsel ? buf0 : buf1, F.tid);
                __syncthreads();
                cur = nxt; bsel ^= 1;
            }
            const float ltot = st.l + __shfl_xor(st.l, 32);
            float meff; const unsigned wfin = ref_words(st.mref + ((ltot > 0.f) ? __builtin_log2f(ltot) : 0.f), meff);
            BrState s2; INIT_ST(s2); s2.qxm = hi ? 0u : wfin;
            float carry = 0.f;
            cur = nct - 1; bsel = 0;
            stage_issue<true>(sr, Kg, Vg, 64, 64L * cur, NCP, F.tid); stage_commit<true>(sr, buf0, F.tid);
            __syncthreads();
            while (cur >= 0) {
                const int nxt = cur - 1;
                if (nxt >= 0) stage_issue<true>(sr, Kg, Vg, 64, 64L * nxt, NCP, F.tid);
                const int mode = (64 * cur + 63 <= cfull) ? 0 : 1;
                const unsigned tbw = hi ? 0u : (f2bf((float)(1024 * cur)) * 0x10001u);
                nsa_tile<true, false>(bsel ? buf1 : buf0, qf, qxs, s2.qxm, klw0, klw1, tbw, neg1w, mode, climit - 64 * cur, s2, p0, p1, lane, wsf);
                float G0[4], G1[4], S0[4], S1[4];
#pragma unroll
                for (int k = 0; k < 4; ++k) { G0[k] = (p0[4 * k] + p0[4 * k + 1]) + (p0[4 * k + 2] + p0[4 * k + 3]); S0[k] = p0[4 * k + 3];
                                              G1[k] = (p1[4 * k] + p1[4 * k + 1]) + (p1[4 * k + 2] + p1[4 * k + 3]); S1[k] = p1[4 * k + 3]; }
#pragma unroll
                for (int k = 0; k < 4; ++k) {
                    G0[k] += __shfl_xor(G0[k], 8); G0[k] += __shfl_xor(G0[k], 16); G1[k] += __shfl_xor(G1[k], 8); G1[k] += __shfl_xor(G1[k], 16);
                    S0[k] += __shfl_xor(S0[k], 8); S0[k] += __shfl_xor(S0[k], 16); S1[k] += __shfl_xor(S1[k], 8); S1[k] += __shfl_xor(S1[k], 16);
                }
                float P0[4], P1[4];
#pragma unroll
                for (int k = 0; k < 4; ++k) { P0[k] = __shfl_xor(S0[k], 32); P1[k] = __shfl_xor(S1[k], 32); }
                if (i < 8) {
                    LAS float* row = imp + qloc * 128 + 16 * cur + hi;
#pragma unroll
                    for (int k = 0; k < 4; ++k) {
                        const float prev0 = hi ? P0[k] : (k == 0 ? 0.f : P0[k - 1]);
                        const float prev1 = hi ? P1[k] : (k == 0 ? P0[3] : P1[k - 1]);
                        row[2 * k] = G0[k] + prev0;
                        row[8 + 2 * k] = G1[k] + prev1;
                    }
                    if (hi == 1 && 16 * (cur + 1) < 128) row[15] += S1[3];
                }
                if (nxt >= 0) stage_commit<true>(sr, bsel ? buf0 : buf1, F.tid);
                __syncthreads();
                cur = nxt; bsel ^= 1;
            }
            (void)carry;
            s2.l = 0.5f;
            ACC_BRANCH(s2, 0);
        }
    }
    __syncthreads();
    {
        const int q8 = lane >> 3, sub = lane & 7, qq = 8 * w + q8;
        unsigned key[16];
#pragma unroll
        for (int e = 0; e < 16; ++e) { const int j = 16 * sub + e; const bool valid = (j <= qt) && (j < NBLK);
            unsigned kk = valid ? (__builtin_bit_cast(unsigned, imp[qq * 128 + j]) + 1u) : 0u;
            if (valid && (j == 0 || j == qt || j == qt - 1)) kk = 0x7F000000u;
            key[e] = kk; }
        unsigned thr = 0u;
        for (int bit = 30; bit >= 0; --bit) { const unsigned cand = thr | (1u << bit); int c = 0;
#pragma unroll
            for (int e = 0; e < 16; ++e) c += (key[e] >= cand) ? 1 : 0;
            c += __shfl_xor(c, 1); c += __shfl_xor(c, 2); c += __shfl_xor(c, 4);
            if (c >= NSEL) thr = cand; }
        int ngt = 0, tl = 0;
#pragma unroll
        for (int e = 0; e < 16; ++e) { ngt += (key[e] > thr) ? 1 : 0; tl += (key[e] == thr) ? 1 : 0; }
        ngt += __shfl_xor(ngt, 1); ngt += __shfl_xor(ngt, 2); ngt += __shfl_xor(ngt, 4);
        int sc = tl;
#pragma unroll
        for (int d = 1; d < 8; d <<= 1) { const int o = __shfl(sc, (lane - d) & 63); if (sub >= d) sc += o; }
        int before = sc - tl; const int need = (thr == 0u) ? 0 : (NSEL - ngt);
        unsigned m16 = 0u;
#pragma unroll
        for (int e = 0; e < 16; ++e) { if (key[e] > thr) m16 |= 1u << e; else if (key[e] == thr) { if (before < need) m16 |= 1u << e; ++before; } }
        selm[qq * 8 + sub] = (unsigned short)m16;
        unsigned um = m16; um |= __shfl_xor(um, 8); um |= __shfl_xor(um, 16); um |= __shfl_xor(um, 32);
        if (q8 == 0) ((LAS unsigned short*)uniw)[w * 8 + sub] = (unsigned short)um;
    }
    __syncthreads();
    {
        BrState st; INIT_ST(st);
        LANE_CONSTS(0)
        const bf16_t* Kg = Zb + ZC_KS + g * 64; const bf16_t* Vg = Zb + ZC_VS + g * 64;
        unsigned um[4], wm[4], qm[4];
#pragma unroll
        for (int k = 0; k < 4; ++k) { unsigned u = 0u;
#pragma unroll
            for (int ww = 0; ww < 8; ++ww) u |= uniw[ww * 4 + k];
            um[k] = u; wm[k] = uniw[w * 4 + k]; qm[k] = ((const LAS unsigned*)selm)[qloc * 4 + k]; }
        int cur = qt, bsel = 0;
        stage_issue<true>(sr, Kg, Vg, ZP, 64L * cur, SEQ, F.tid); stage_commit<true>(sr, buf0, F.tid);
        __syncthreads();
        while (cur >= 0) {
            const int nxt = next_below(um, cur);
            if (nxt >= 0) stage_issue<true>(sr, Kg, Vg, ZP, 64L * nxt, SEQ, F.tid);
            if (bit128(wm, cur)) {
                const unsigned tbw = hi ? 0u : (f2bf((float)(64 * cur)) * 0x10001u);
                const unsigned qxm_t = bit128(qm, cur) ? st.qxm : maskw;
                nsa_tile<true, true>(bsel ? buf1 : buf0, qf, qxs, qxm_t, klw0, klw1, tbw, neg1w, (cur == qt) ? 1 : 0, tloc, st, p0, p1, lane, wsf);
            }
            if (nxt >= 0) stage_commit<true>(sr, bsel ? buf0 : buf1, F.tid);
            __syncthreads();
            cur = nxt; bsel ^= 1;
        }
        ACC_BRANCH(st, 1);
    }
    {
        WAVE_SYNC(); FENCE();
        bf16_t* Y = (bf16_t*)(F.ws + WS_YMIX) + (size_t)b * SEQ * DM;
#pragma unroll
        for (int c = 0; c < 4; ++c) { const int idx = lane + 64 * c, ii = idx >> 3, c8 = idx & 7; const int tt = t0 + 8 * w + (ii & 7), hh = 4 * g + (ii >> 3);
            const f32x4 a = *(const LAS f32x4*)(yl + ii * 64 + c8 * 8), bq = *(const LAS f32x4*)(yl + ii * 64 + c8 * 8 + 4);
            u32x4 o; o.x = pk2(a[0], a[1]); o.y = pk2(a[2], a[3]); o.z = pk2(bq[0], bq[1]); o.w = pk2(bq[2], bq[3]);
            *(u32x4*)(Y + (size_t)tt * DM + 512 + hh * 64 + c8 * 8) = o; }
    }
    __syncthreads();
#undef ACC_BRANCH
#undef INIT_ST
#undef LANE_CONSTS
}

__device__ __forceinline__ void router_task(Frame& F, int task) {
    const int row0 = 32 * task;
    LAS float* Hs = (LAS float*)F.lds;
    const float* mod = (const float*)(F.ws + WS_MOD);
    const float* X1 = (const float*)(F.ws + WS_X1);
    bf16_t* H2 = (bf16_t*)(F.ws + WS_H2);
    const float* g = F.in[I_GFFN];
    for (int rr = 0; rr < 4; ++rr) {
        const int lr = 4 * F.wave + rr, m = row0 + lr, b = m / SEQ;
        const f32x4* xr = (const f32x4*)(X1 + (size_t)m * DM) + F.lane;
        f32x4 v[4]; float s = 0.f;
#pragma unroll
        for (int j = 0; j < 4; ++j) { v[j] = xr[64 * j]; s += (v[j][0] * v[j][0] + v[j][1] * v[j][1]) + (v[j][2] * v[j][2] + v[j][3] * v[j][3]); }
        const float rinv = 1.0f / sqrtf(wave_sum(s) * (1.0f / DM) + EPS);
        u32x2* o8 = (u32x2*)(H2 + (size_t)m * DM) + F.lane;
#pragma unroll
        for (int j = 0; j < 4; ++j) { const int c = 4 * F.lane + 256 * j;
            const f32x4 gg = *(const f32x4*)(g + c), sc = *(const f32x4*)(mod + (size_t)b * 6144 + 4 * 1024 + c), sh = *(const f32x4*)(mod + (size_t)b * 6144 + 3 * 1024 + c);
            const f32x4 h = v[j] * rinv * gg * (sc + 1.0f) + sh;
            u32x2 wv; wv.x = pk2(h[0], h[1]); wv.y = pk2(h[2], h[3]); o8[64 * j] = wv;
#pragma unroll
            for (int e = 0; e < 4; ++e) Hs[(c + e) * 33 + lr] = h[e]; }
    }
    __syncthreads();
    const int i = F.lane & 31, hi = F.lane >> 5;
    f32x16 acc;
#pragma unroll
    for (int r = 0; r < 16; ++r) acc[r] = 0.f;
    const float* WR = F.in[I_WR];
    for (int ks = 0; ks < 64; ++ks) { const int k = 128 * F.wave + 2 * ks + hi;
        acc = __builtin_amdgcn_mfma_f32_32x32x2f32(Hs[k * 33 + i], WR[k * 32 + i], acc, 0, 0, 0); }
    __syncthreads();
    LAS float* Ls = (LAS float*)F.lds;
    LAS float* Lg = Ls + 8 * 1024;
    LAS unsigned* hist = (LAS unsigned*)(Lg + 32 * 33);
#pragma unroll
    for (int r = 0; r < 16; ++r) Ls[F.wave * 1024 + crow(r, hi) * 32 + i] = acc[r];
    if (F.tid < 64) hist[F.tid] = 0u;
    __syncthreads();
    for (int idx = F.tid; idx < 1024; idx += NTHREADS) { float s = F.in[I_BR][idx & 31];
#pragma unroll
        for (int w = 0; w < 8; ++w) s += Ls[w * 1024 + idx];
        Lg[(idx >> 5) * 33 + (idx & 31)] = s; }
    __syncthreads();
    if (F.wave == 0) {
        const int tok = row0 + i;
        int be[4]; float bv[4]; unsigned rank[4];
        if (F.lane < 32) {
            unsigned used = 0u;
#pragma unroll
            for (int k = 0; k < 4; ++k) { float best = -INFINITY; int bi = 0;
                for (int e = 0; e < 32; ++e) { const float x = Lg[i * 33 + e]; if (!((used >> e) & 1u) && x > best) { best = x; bi = e; } }
                used |= 1u << bi; be[k] = bi; bv[k] = best; }
            float sum = 0.f; const float mx0 = bv[0];
#pragma unroll
            for (int k = 0; k < 4; ++k) { bv[k] = fexp2((bv[k] - mx0) * LOG2E); sum += bv[k]; }
#pragma unroll
            for (int k = 0; k < 4; ++k) { bv[k] /= sum; rank[k] = atomicAdd((unsigned*)&hist[be[k]], 1u); }
        }
        WAVE_SYNC(); FENCE();
        if (F.lane < 32) { const unsigned c = hist[F.lane]; hist[32 + F.lane] = c ? atomicAdd(F.ctl + CW_CNT + 64 * F.lane, c) : 0u; }
        WAVE_SYNC(); FENCE();
        if (F.lane < 32) {
            int* lists = (int*)(F.ws + WS_LISTS); int* tope = (int*)(F.ws + WS_TOPE); float* topw = (float*)(F.ws + WS_TOPW); int* topp = (int*)(F.ws + WS_TOPP);
#pragma unroll
            for (int k = 0; k < 4; ++k) { const int pos = (int)(hist[32 + be[k]] + rank[k]);
                lists[(size_t)be[k] * T + pos] = tok; tope[tok * 4 + k] = be[k]; topw[tok * 4 + k] = bv[k]; topp[tok * 4 + k] = pos; }
        }
    }
    __syncthreads();
}

__device__ __forceinline__ void moe_tables(Frame& F) {
    if (F.tid == 0) {
        unsigned tp = 0, ro = 0;
        for (int e = 0; e < NE; ++e) { const unsigned c = __hip_atomic_load(F.ctl + CW_CNT + 64 * e, __ATOMIC_RELAXED, __HIP_MEMORY_SCOPE_AGENT);
            F.MISC[MW_CNT + e] = c; F.MISC[MW_TPFX + e] = tp; F.MISC[MW_ROFF + e] = ro; const unsigned tl = (c + 255u) / 256u; tp += tl; ro += tl * 256u; }
        F.MISC[MW_TPFX + NE] = tp; F.MISC[MW_ROFF + NE] = ro;
    }
    __syncthreads();
}

__device__ __forceinline__ void final_rows(Frame& F) {
    const int gw = F.vcu * NWAVES + F.wave, NGW = F.G * NWAVES;
    const float* mod = (const float*)(F.ws + WS_MOD);
    const float* X1 = (const float*)(F.ws + WS_X1);
    const bf16_t* YD = (const bf16_t*)(F.ws + WS_YD);
    const int* tope = (const int*)(F.ws + WS_TOPE); const float* topw = (const float*)(F.ws + WS_TOPW); const int* topp = (const int*)(F.ws + WS_TOPP);
    const float* gf = F.in[I_GFIN];
    for (int m = gw; m < T; m += NGW) {
        const int b = m / SEQ;
        size_t yrow[4]; float wk[4];
#pragma unroll
        for (int k = 0; k < 4; ++k) { const int e = tope[m * 4 + k]; yrow[k] = (size_t)(F.MISC[MW_ROFF + e] + (unsigned)topp[m * 4 + k]) * DM; wk[k] = topw[m * 4 + k]; }
        const f32x4* xr = (const f32x4*)(X1 + (size_t)m * DM) + F.lane;
        f32x4 v[4]; float s = 0.f;
#pragma unroll
        for (int j = 0; j < 4; ++j) { const int c = 4 * F.lane + 256 * j;
            f32x4 mo = (f32x4){0.f, 0.f, 0.f, 0.f};
#pragma unroll
            for (int k = 0; k < 4; ++k) { const u32x2 yw = *(const u32x2*)(YD + yrow[k] + c); mo += wk[k] * (f32x4){bflo(yw.x), bfhi(yw.x), bflo(yw.y), bfhi(yw.y)}; }
            const f32x4 gt = *(const f32x4*)(mod + (size_t)b * 6144 + 5 * 1024 + c);
            v[j] = xr[64 * j] + gt * mo;
            s += (v[j][0] * v[j][0] + v[j][1] * v[j][1]) + (v[j][2] * v[j][2] + v[j][3] * v[j][3]); }
        const float rinv = 1.0f / sqrtf(wave_sum(s) * (1.0f / DM) + EPS);
        f32x4* orow = (f32x4*)(F.out + (size_t)m * DM) + F.lane;
#pragma unroll
        for (int j = 0; j < 4; ++j) orow[64 * j] = v[j] * rinv * *(const f32x4*)(gf + 4 * F.lane + 256 * j);
    }
}

constexpr int N_PHASES = 10;
#define REP0 1
#define REP2 1
#define REP3 1
#define REP4 1
#define REP5 1
#define REP7 1
#define REP8 1
#define REP9 1
__global__ void __launch_bounds__(NTHREADS, 2) mk_fwd(Args args) {
#ifdef EMU
    unsigned char* lds = emu_blk->lds;
#else
    extern __shared__ __attribute__((aligned(16))) unsigned char lds[];
#endif
    Frame F;
    F.lds = (LAS unsigned char*)lds;
    F.MISC = (volatile LAS unsigned*)(F.lds + MISC_OFF);
    F.tid = threadIdx.x; F.lane = F.tid & 63; F.wave = __builtin_amdgcn_readfirstlane(F.tid >> 6);
    F.G = gridDim.x; { const int bx = blockIdx.x; F.vcu = (F.G % 8 == 0) ? (bx % 8) * (F.G / 8) + bx / 8 : bx; }
    F.ws = args.ws; F.ctl = (unsigned*)(args.ws + WS_CTL); F.out = args.out;
#pragma unroll
    for (int k = 0; k < 24; ++k) F.in[k] = args.in[k];
    for (int u = F.tid; u < (LDS_BYTES - MISC_OFF) / 4; u += NTHREADS) F.MISC[u] = 0u;
    __syncthreads();
    XcdBarrier bar = xcd_barrier_post(F.ctl + CW_BAR, F.MISC + 8);
    const int lo = args.ph_lo, hi = args.ph_hi;
#ifndef PH_MASK
#define PH_MASK 0xffff
#endif
#define IN(k) (((PH_MASK >> (k)) & 1) && lo <= (k) && (k) < hi)
#define SEAM(k) do { if (IN(k) && IN((k) + 1)) xcd_barrier(bar); } while (0)

    if (IN(0)) { p0_prologue(F); if (REP0 > 1) p0_prologue(F); }
    SEAM(0);
    if (IN(1)) { norm_rows(F, F.in[I_X], F.in[I_GMIX], 0, 1, (bf16_t*)(F.ws + WS_HB)); }
    SEAM(1);
    if (IN(2)) {
        {
        pg8::DenseProb P{(const char*)(F.ws + WS_HB), (const char*)(F.ws + WS_WINT), DM};
        pg8::DenseOrder S; S.init(T, ZP, F.G, (int)blockIdx.x);
        EpiZ E{(bf16_t*)(F.ws + WS_ZB)};
        pg8::gemm_phase(F.lds, P, S, E);
        }
        if (REP2 > 1) {
        pg8::DenseProb P{(const char*)(F.ws + WS_HB), (const char*)(F.ws + WS_WINT), DM};
        pg8::DenseOrder S; S.init(T, ZP, F.G, (int)blockIdx.x);
        EpiZ E{(bf16_t*)(F.ws + WS_ZB)};
        pg8::gemm_phase(F.lds, P, S, E);
        }
    }
    SEAM(2);
    if (IN(3)) {
        constexpr int NGM = BATCH * (SEQ / GMC) * GMG, NCT = 2 * BATCH * NG * (NCP / 32);
        for (int it = F.vcu; it < NCT + NGM; it += F.G) { if (it < NCT) cmp_tile(F, it); else gmlp_tile(F, it - NCT); }
        if (REP3 > 1) for (int it = F.vcu; it < NCT + NGM; it += F.G) { if (it < NCT) cmp_tile(F, it); else gmlp_tile(F, it - NCT); }
    }
    SEAM(3);
    if (IN(4)) {
        constexpr int NTASK = BATCH * NG * (SEQ / 64);
        for (int it = F.vcu; it < NTASK; it += F.G) nsa_task(F, NTASK - 1 - it);
    }
    SEAM(4);
    if (IN(5)) {
        {
        pg8::DenseProb P{(const char*)(F.ws + WS_YMIX), (const char*)(F.ws + WS_WOUTT), DM};
        pg8::DenseOrder S; S.init(T, DM, F.G, (int)blockIdx.x);
        EpiX1 E{F.in[I_X], (const float*)(F.ws + WS_MOD), (float*)(F.ws + WS_X1)};
        pg8::gemm_phase(F.lds, P, S, E);
        }
        if (REP5 > 1) {
        pg8::DenseProb P{(const char*)(F.ws + WS_YMIX), (const char*)(F.ws + WS_WOUTT), DM};
        pg8::DenseOrder S; S.init(T, DM, F.G, (int)blockIdx.x);
        EpiX1 E{F.in[I_X], (const float*)(F.ws + WS_MOD), (float*)(F.ws + WS_X1)};
        pg8::gemm_phase(F.lds, P, S, E);
        }
    }
    SEAM(5);
    if (IN(6)) { for (int it = F.vcu; it < T / 32; it += F.G) router_task(F, it); }
    SEAM(6);
    if (IN(7)) {
        {
        moe_tables(F);
        MoeProb1 P{(const char*)(F.ws + WS_H2), (const char*)(F.ws + WS_WGUT), (const int*)(F.ws + WS_LISTS), F.MISC + MW_CNT, DM};
        pg8::MoeOrder S{F.MISC + MW_TPFX, 8, F.G, F.vcu};
        EpiAct E{(bf16_t*)(F.ws + WS_ACT), F.in[I_BGU], F.MISC + MW_ROFF};
        pg8::gemm_phase(F.lds, P, S, E);
        }
        if (REP7 > 1) {
        moe_tables(F);
        MoeProb1 P{(const char*)(F.ws + WS_H2), (const char*)(F.ws + WS_WGUT), (const int*)(F.ws + WS_LISTS), F.MISC + MW_CNT, DM};
        pg8::MoeOrder S{F.MISC + MW_TPFX, 8, F.G, F.vcu};
        EpiAct E{(bf16_t*)(F.ws + WS_ACT), F.in[I_BGU], F.MISC + MW_ROFF};
        pg8::gemm_phase(F.lds, P, S, E);
        }
    }
    SEAM(7);
    if (IN(8)) {
        {
        moe_tables(F);
        MoeProb2 P{(const char*)(F.ws + WS_ACT), (const char*)(F.ws + WS_WDNT), F.MISC + MW_ROFF, DFF};
        pg8::MoeOrder S{F.MISC + MW_TPFX, 4, F.G, F.vcu};
        EpiYd E{(bf16_t*)(F.ws + WS_YD), F.in[I_BDN], F.MISC + MW_ROFF};
        pg8::gemm_phase(F.lds, P, S, E);
        }
        if (REP8 > 1) {
        moe_tables(F);
        MoeProb2 P{(const char*)(F.ws + WS_ACT), (const char*)(F.ws + WS_WDNT), F.MISC + MW_ROFF, DFF};
        pg8::MoeOrder S{F.MISC + MW_TPFX, 4, F.G, F.vcu};
        EpiYd E{(bf16_t*)(F.ws + WS_YD), F.in[I_BDN], F.MISC + MW_ROFF};
        pg8::gemm_phase(F.lds, P, S, E);
        }
    }
    SEAM(8);
    if (IN(9)) { moe_tables(F); final_rows(F); if (REP9 > 1) final_rows(F); }
#undef IN
#undef SEAM
}

#ifdef EMU
struct EmuDump { const char* name; size_t off; size_t bytes; };
EmuDump emu_dumps[] = {
    {"mod", WS_MOD, (size_t)BATCH * 6144 * 4}, {"bpe", WS_BPE, 512 * 4}, {"wint", WS_WINT, (size_t)ZP * DM * 2}, {"hb", WS_HB, (size_t)T * DM * 2},
    {"zb", WS_ZB, (size_t)T * ZP * 2}, {"kc", WS_KC, (size_t)BATCH * NG * NCP * 64 * 2}, {"vc", WS_VC, (size_t)BATCH * NG * NCP * 64 * 2},
    {"ymix", WS_YMIX, (size_t)T * DM * 2}, {"x1", WS_X1, (size_t)T * DM * 4}, {"h2", WS_H2, (size_t)T * DM * 2},
    {"tope", WS_TOPE, (size_t)T * 16}, {"topw", WS_TOPW, (size_t)T * 16}, {"topp", WS_TOPP, (size_t)T * 16}, {"ctl", WS_CTL, CTL_ZERO_BYTES},
};
int emu_ndumps = sizeof(emu_dumps) / sizeof(emu_dumps[0]);
size_t emu_ws_bytes = WS_END;
int emu_out_elems = T * DM;
#endif

extern "C" void kernel_launch(void* const* d_in, const int* in_sizes, int n_in, void* d_out, int out_size, void* d_ws, size_t ws_size, hipStream_t stream) {
    (void)in_sizes; (void)out_size; (void)ws_size;
    Args a{};
    for (int i = 0; i < 24 && i < n_in; ++i) a.in[i] = (const float*)d_in[i];
    a.out = (float*)d_out; a.ws = (unsigned char*)d_ws;
#ifndef EMU
    (void)hipMemsetAsync((char*)d_ws + WS_CTL, 0, CTL_ZERO_BYTES, stream);
#endif
#ifdef EMU
    int plo = 0, phi = N_PHASES;
    if (const char* e = getenv("EMU_PH_LO")) plo = atoi(e);
    if (const char* e = getenv("EMU_PH_HI")) phi = atoi(e);
    if (plo == 0) (void)hipMemsetAsync((char*)d_ws + WS_CTL, 0, CTL_ZERO_BYTES, stream);
    const int grid = emu_num_cus();
    for (int ph = plo; ph < phi; ++ph) { a.ph_lo = ph; a.ph_hi = ph + 1; Args ac = a; fprintf(stderr, "EMU phase %d\n", ph);
        emu_launch(grid, NTHREADS, LDS_BYTES, [ac]() { mk_fwd(ac); }); }
#else
    static int grid = 0;
    if (grid == 0) {
        int dev = 0, cus = 0, per_cu = 0;
        (void)hipGetDevice(&dev);
        (void)hipDeviceGetAttribute(&cus, hipDeviceAttributeMultiprocessorCount, dev);
        (void)hipFuncSetAttribute((const void*)mk_fwd, hipFuncAttributeMaxDynamicSharedMemorySize, LDS_BYTES);
        (void)hipOccupancyMaxActiveBlocksPerMultiprocessor(&per_cu, (const void*)mk_fwd, NTHREADS, LDS_BYTES);
        if (per_cu < 1) fprintf(stderr, "kernel_launch: occupancy query reports %d blocks/CU\n", per_cu);
        grid = cus;
        (void)hipGetLastError();
    }
    a.ph_lo = 0; a.ph_hi = N_PHASES;
    void* kargs[] = {&a};
    hipError_t e = hipLaunchCooperativeKernel((const void*)mk_fwd, dim3(grid), dim3(NTHREADS), kargs, LDS_BYTES, stream);
    if (e != hipSuccess) fprintf(stderr, "cooperative launch failed: %s (grid %d)\n", hipGetErrorString(e), grid);
#endif
}
```

```cpp
#ifndef EMU
#include <hip/hip_runtime.h>
#endif
#include <cstdio>
#include <cstdint>

#ifndef CFG_BATCH
#define CFG_BATCH 2
#endif
#ifndef CFG_SEQ
#define CFG_SEQ 8192
#endif

#define PROBE_K -1
#ifdef EMU
#define NOSPEC() ((void)0)
#define LAS
#define ASM_VMCNT(n) ((void)0)
#define ASM_LGKMCNT(n) ((void)0)
#define WAVE_SYNC() emu_wave_sync()
#define FENCE() ((void)0)
#else
#define NOSPEC() asm volatile("; rare path" ::: "memory")
#define LAS __attribute__((address_space(3)))
#define ASM_VMCNT(n) asm volatile("s_waitcnt vmcnt(" #n ")" ::: "memory")
#define ASM_LGKMCNT(n) asm volatile("s_waitcnt lgkmcnt(" #n ")" ::: "memory")
#define WAVE_SYNC() asm volatile("s_waitcnt lgkmcnt(0)" ::: "memory")
#define FENCE() asm volatile("" ::: "memory")
#endif

typedef unsigned short bf16_t;
typedef short bf16x8 __attribute__((ext_vector_type(8)));
typedef short s16x4 __attribute__((ext_vector_type(4)));
typedef float f32x4 __attribute__((ext_vector_type(4)));
typedef float f32x16 __attribute__((ext_vector_type(16)));
typedef unsigned u32x4 __attribute__((ext_vector_type(4)));
typedef unsigned u32x2 __attribute__((ext_vector_type(2)));

constexpr int NWAVES = 8, NTHREADS = 512;
constexpr int BATCH = CFG_BATCH, SEQ = CFG_SEQ, DM = 1024, T = BATCH * SEQ;
constexpr int GMW = 512, GMG = 8, GMC = 128;
constexpr int NH = 8, NG = 2, NR = 4, HD = 64;
constexpr int INC = 2328, ZP = 2560;
constexpr int ZC_U = 0, ZC_V = 512, ZC_Q = 1024, ZC_KC = 1536, ZC_VC = 1664, ZC_KS = 1792, ZC_VS = 1920, ZC_KW = 2048, ZC_VW = 2176, ZC_GL = 2304;
constexpr int NCMP = SEQ / 16 - 1, NCP = SEQ / 16;
constexpr int NBLK = SEQ / 64;
constexpr int NSEL = NBLK < 16 ? NBLK : 16;
constexpr int NE = 32, TOPK = 4, DFF = 1024;
constexpr int TK = T * TOPK;
constexpr int ACT_ROWS = TK + NE * 256;
constexpr float EPS = 1e-6f;
constexpr float LOG2E = 1.4426950408889634f;
constexpr float F8_ACT_SCALE = 8.0f, F8_W_SCALE = 64.0f, F8_ACC_SCALE = 1.0f / 512.0f;

constexpr size_t MiB = 1u << 20;
constexpr size_t WS_CTL = 0, CTL_ZERO_BYTES = 1 * MiB;
constexpr size_t WS_MOD = 1 * MiB;
constexpr size_t WS_BPE = 1 * MiB + 512 * 1024;
constexpr size_t WS_LISTS = 2 * MiB;
constexpr size_t WS_TOPE = 4 * MiB;
constexpr size_t WS_TOPW = 4 * MiB + 512 * 1024;
constexpr size_t WS_TOPP = 5 * MiB;
constexpr size_t WS_WSBF = 6 * MiB;
constexpr size_t WS_W2KT = 6 * MiB + 512 * 1024;
constexpr size_t WS_W2VT = WS_W2KT + 64 * 1024;
constexpr size_t WS_W1KT = 7 * MiB;
constexpr size_t WS_W1VT = 8 * MiB;
constexpr size_t WS_WOUTT = 9 * MiB;
constexpr size_t WS_WINT = 11 * MiB;
constexpr size_t WS_KC = 16 * MiB;
constexpr size_t WS_VC = 16 * MiB + 512 * 1024;
constexpr size_t WS_WGUT = 32 * MiB;
constexpr size_t WS_WDNT = 160 * MiB;
constexpr size_t WS_HB = 224 * MiB;
constexpr size_t WS_H2 = 256 * MiB;
constexpr size_t WS_ZB = 288 * MiB;
constexpr size_t WS_YMIX = 368 * MiB;
constexpr size_t WS_MIX = 400 * MiB;
constexpr size_t WS_ACT = 464 * MiB;
constexpr size_t WS_YD = 608 * MiB;
constexpr size_t WS_YACC = 768 * MiB;
constexpr size_t WS_END = 804 * MiB;
constexpr int CW_BAR = 4096;
constexpr int CW_CNT = 16384;
constexpr int CW_CNT2 = 32768;
constexpr size_t WS_SHADOW = 752 * MiB;

constexpr int RING_BYTES = 131072;
constexpr int MISC_OFF = 155648;
constexpr int LDS_BYTES = 159744;
constexpr int MW_CNT = 16, MW_TPFX = 64, MW_ROFF = 128;

__device__ __forceinline__ unsigned f2bf(float f) { unsigned u = __builtin_bit_cast(unsigned, f); return (u + 0x7fffu + ((u >> 16) & 1u)) >> 16; }
#ifdef EMU
__device__ __forceinline__ unsigned pk2(float lo, float hi) { return f2bf(lo) | (f2bf(hi) << 16); }
#else
typedef float f32x2_t __attribute__((ext_vector_type(2))); typedef __bf16 bf16x2_t __attribute__((ext_vector_type(2)));
__device__ __forceinline__ unsigned pk2(float lo, float hi) { f32x2_t v = {lo, hi}; bf16x2_t bb = __builtin_convertvector(v, bf16x2_t); return __builtin_bit_cast(unsigned, bb); }
#endif
__device__ __forceinline__ unsigned pk4_fp8(float a, float b, float c, float d) {
    a = fminf(fmaxf(a, -448.f), 448.f); b = fminf(fmaxf(b, -448.f), 448.f); c = fminf(fmaxf(c, -448.f), 448.f); d = fminf(fmaxf(d, -448.f), 448.f);
    int w = 0; w = __builtin_amdgcn_cvt_pk_fp8_f32(a, b, w, false); w = __builtin_amdgcn_cvt_pk_fp8_f32(c, d, w, true); return (unsigned)w;
}
__device__ __forceinline__ unsigned pk4_fp8_nc(float a, float b, float c, float d) {
    int w = 0; w = __builtin_amdgcn_cvt_pk_fp8_f32(a, b, w, false); w = __builtin_amdgcn_cvt_pk_fp8_f32(c, d, w, true); return (unsigned)w;
}
typedef int v8i_t __attribute__((ext_vector_type(8)));
typedef int v4i_t __attribute__((ext_vector_type(4)));
__device__ __forceinline__ float bf2f(unsigned short h) { return __builtin_bit_cast(float, (unsigned)h << 16); }
__device__ __forceinline__ float bflo(unsigned w) { return __builtin_bit_cast(float, w << 16); }
__device__ __forceinline__ float bfhi(unsigned w) { return __builtin_bit_cast(float, w & 0xffff0000u); }
__device__ __forceinline__ float fexp2(float x) { return __builtin_amdgcn_exp2f(x); }
__device__ __forceinline__ float gelu_tanh(float x) {
    const float y2 = 1.5957691216057308f * (x + 0.044715f * x * x * x);
    return x * __builtin_amdgcn_rcpf(1.0f + fexp2(-y2 * LOG2E));
}
__device__ __forceinline__ float sigmoidf_(float x) { return __builtin_amdgcn_rcpf(1.0f + fexp2(-x * LOG2E)); }
__device__ __forceinline__ float wave_sum(float v) {
#pragma unroll
    for (int o = 1; o < 64; o <<= 1) v += __shfl_xor(v, o);
    return v;
}
__device__ __forceinline__ int crow(int r, int hi) { return (r & 3) + 8 * (r >> 2) + 4 * hi; }

#define XB_TMO      128
#define XB_XCNT(j)  (256  + 64 * (j))
#define XB_XSUB(j)  (1280 + 64 * (j))
#define XB_XGEN(j)  (2304 + 64 * (j))
#define XB_TOP      3328
#define XB_TOPGEN   3392
#define XCD_BAR_WORDS 3456
#define XB_SPIN_CAP (1u << 18)
struct XcdBarrier { unsigned* bar; unsigned x; volatile LAS unsigned* st; };
#ifndef EMU
__device__ __forceinline__ unsigned xb_ld(unsigned* p)              { return __hip_atomic_load(p, __ATOMIC_RELAXED, __HIP_MEMORY_SCOPE_AGENT); }
__device__ __forceinline__ unsigned xb_add(unsigned* p, unsigned v) { return __hip_atomic_fetch_add(p, v, __ATOMIC_RELAXED, __HIP_MEMORY_SCOPE_AGENT); }
__device__ __forceinline__ unsigned xb_xcc_id() { return (unsigned)__builtin_amdgcn_s_getreg((3 << 11) | 20) & 0xFu; }
#define XB_SPIN(cond, bar) do { unsigned _sp = 0; while (cond) { __builtin_amdgcn_s_sleep(1); \
    if ((++_sp & 255u) == 0u) { if (xb_ld(&(bar)[XB_TMO])) break; if (_sp > XB_SPIN_CAP) { atomicAdd(&(bar)[XB_TMO], 1u); break; } } } } while (0)
__device__ __forceinline__ XcdBarrier xcd_barrier_post(unsigned* bar, volatile LAS unsigned* st) {
    XcdBarrier b; b.bar = bar; b.x = xb_xcc_id(); b.st = st;
    if (threadIdx.x == 0) st[2] = xb_add(&bar[XB_XCNT(b.x)], 1u);
    return b;
}
__device__ __forceinline__ void xcd_barrier_complete(unsigned* bar, unsigned x, unsigned& nloc, unsigned& nx) {
    const unsigned G = gridDim.x * gridDim.y * gridDim.z;
    unsigned sum, cnt, mine, sp = 0u;
    for (;;) {
        sum = 0u; cnt = 0u; mine = 0u;
#pragma unroll
        for (unsigned j = 0; j < 16; ++j) { const unsigned c = xb_ld(&bar[XB_XCNT(j)]); sum += c; cnt += (c > 0u) ? 1u : 0u; mine = (j == x) ? c : mine; }
        if (sum == G) break;
        __builtin_amdgcn_s_sleep(1);
        if ((++sp & 255u) == 0u) { if (xb_ld(&bar[XB_TMO])) break; if (sp > XB_SPIN_CAP) { atomicAdd(&bar[XB_TMO], 1u); break; } }
    }
    nloc = mine > 0u ? mine : 1u; nx = cnt > 0u ? cnt : 1u;
}
__device__ __forceinline__ void xcd_barrier(const XcdBarrier& b) {
    asm volatile("s_waitcnt vmcnt(0)" ::: "memory");
    __syncthreads();
    if (threadIdx.x == 0) {
        unsigned* bar = b.bar;
        __builtin_amdgcn_s_waitcnt(0);
        unsigned nloc = b.st[0], nx = b.st[1];
        if (nloc == 0u) { xcd_barrier_complete(bar, b.x, nloc, nx); b.st[0] = nloc; b.st[1] = nx; }
        const unsigned old = xb_add(&bar[XB_XSUB(b.x)], 1u);
        const unsigned gen = old / nloc;
        if (old + 1u == (gen + 1u) * nloc) {
            __builtin_amdgcn_fence(__ATOMIC_RELEASE, "agent");
            asm volatile("s_waitcnt vmcnt(0)" ::: "memory");
            const unsigned og = xb_add(&bar[XB_TOP], 1u);
            const unsigned tg = og / nx;
            if (og + 1u == (tg + 1u) * nx) xb_add(&bar[XB_TOPGEN], 1u);
            else XB_SPIN(xb_ld(&bar[XB_TOPGEN]) == tg, bar);
            __builtin_amdgcn_fence(__ATOMIC_ACQUIRE, "agent");
            xb_add(&bar[XB_XGEN(b.x)], 1u);
            asm volatile("s_waitcnt vmcnt(0)" ::: "memory");
        } else {
            XB_SPIN(xb_ld(&bar[XB_XGEN(b.x)]) == gen, bar);
            __builtin_amdgcn_fence(__ATOMIC_ACQUIRE, "agent");
            asm volatile("s_waitcnt vmcnt(0)" ::: "memory");
        }
    }
    __syncthreads();
}
#else
__device__ __forceinline__ XcdBarrier xcd_barrier_post(unsigned* bar, volatile unsigned* st) { XcdBarrier b; b.bar = bar; b.x = 0; b.st = st; return b; }
__device__ __forceinline__ void xcd_barrier(const XcdBarrier&) { fprintf(stderr, "EMU: grid barrier inside a launch\n"); abort(); }
#endif

struct Args { const float* in[24]; float* out; unsigned char* ws; int ph_lo, ph_hi; };
enum { I_X = 0, I_C, I_WADA, I_BADA, I_GMIX, I_WIN, I_GMWS, I_GMBS, I_GMNG, I_PEK, I_W1K, I_W2K, I_PEV, I_W1V, I_W2V, I_WOUT, I_GFFN, I_WR, I_BR, I_WGU, I_BGU, I_WDN, I_BDN, I_GFIN };

struct Frame {
    LAS unsigned char* lds;
    volatile LAS unsigned* MISC;
    unsigned* ctl;
    unsigned char* ws;
    const float* in[24];
    float* out;
    int tid, lane, wave, vcu, G;
};

namespace pg8 {
constexpr int BM = 256, BK = 64, HALF = 128, HTB = HALF * BK * 2, STAGE_BYTES = 8 * HTB;
__device__ __forceinline__ int lds_byte(int r, int c) { const int st = (r >> 4) * 2 + (c >> 5), rr = r & 15, cc = c & 31, ob = rr * 64 + cc * 2; return st * 1024 + (ob ^ (((ob >> 9) & 1) << 5)); }
__device__ __forceinline__ void stage_rc(int b, int& R, int& C) { const int st = b / 1024, sb = b % 1024, swz = sb ^ (((sb >> 9) & 1) << 5); R = (st >> 1) * 16 + swz / 64; C = (st & 1) * 32 + (swz % 64) / 2; }
__device__ __forceinline__ int perm32(int rho) { const int n = rho >> 4, i = rho & 15; return 8 * (i >> 2) + 4 * n + (i & 3); }
struct Unit { int pm, pn, e; };

template <bool FP8, class Prob, class Sched, class Epi>
__device__ __forceinline__ void gemm_phase(LAS unsigned char* lds, const Prob& P, const Sched& S, const Epi& E) {
    const int tid = threadIdx.x, wid = __builtin_amdgcn_readfirstlane(tid >> 6), lane = tid & 63, wr = wid >> 2, wc = wid & 3, fr = lane & 15, fq = lane >> 4;
    const int KB = P.KB, nt = KB / 128;
    int Rr[2], Cc[2]; unsigned voffB[2];
#pragma unroll
    for (int i = 0; i < 2; ++i) { int R, C; stage_rc(tid * 16 + i * 8192, R, C); Rr[i] = R; Cc[i] = C; const int Rb = Epi::PERM ? ((R & ~31) + perm32(R & 31)) : R; voffB[i] = (unsigned)(Rb * KB + C * 2); }
    const size_t kstep = (size_t)(BK * 2);
    const size_t hstepB = (size_t)HALF * KB;
    const unsigned ldsw = (unsigned)wid * 1024u;
    const int aoff = lds_byte(wr * 64 + fr, fq * 8), boff = lds_byte(wc * 32 + fr, fq * 8);
#define PG8_SA(b, h) (((b) * 2 + (h)) * HTB)
#define PG8_SB(b, h) ((4 + (b) * 2 + (h)) * HTB)
#define PG8_STAGE(bufoff, gbase, voff) do { _Pragma("unroll") for (int _i = 0; _i < 2; ++_i) \
        __builtin_amdgcn_global_load_lds((const unsigned*)((const char*)(gbase) + (voff)[_i]), (LAS unsigned*)(lds + (bufoff) + ldsw + _i * 8192), 16, 0, 0); } while (0)
#define PG8_LD8(p) __builtin_shufflevector(*(const LAS v4i_t*)(p), *(const LAS v4i_t*)((p) + 1024), 0, 1, 2, 3, 4, 5, 6, 7)
#define PG8_LDA(dst, b, h) do { _Pragma("unroll") for (int m = 0; m < 4; ++m) dst[m] = PG8_LD8(lds + PG8_SA(b, h) + aoff + m * 2048); } while (0)
#define PG8_LDB(dst, b, h) do { _Pragma("unroll") for (int n = 0; n < 2; ++n) dst[n] = PG8_LD8(lds + PG8_SB(b, h) + boff + n * 2048); } while (0)
#define PG8_LO(x) __builtin_bit_cast(bf16x8, __builtin_shufflevector(x, x, 0, 1, 2, 3))
#define PG8_HI(x) __builtin_bit_cast(bf16x8, __builtin_shufflevector(x, x, 4, 5, 6, 7))
#ifdef EMU
#define PG8_MFMA_F8(c_, b_, a_) c_ = __builtin_amdgcn_mfma_scale_f32_16x16x128_f8f6f4(b_, a_, c_, 0, 0, 0, 0x7F7F7F7F, 0, 0x7F7F7F7F)
#else
#define PG8_MFMA_F8(c_, b_, a_) asm volatile("v_mfma_scale_f32_16x16x128_f8f6f4 %0, %1, %2, %0, %3, %3 op_sel_hi:[0,0,0]" : "+v"(c_) : "v"(b_), "v"(a_), "v"(f8one))
#endif
#define PG8_MMA(ai, bj, At, Bt) do { __builtin_amdgcn_s_setprio(1); \
        if (FP8) { _Pragma("unroll") for (int m = 0; m < 4; ++m) _Pragma("unroll") for (int n = 0; n < 2; ++n) PG8_MFMA_F8(acc[ai][bj][m][n], Bt[n], At[m]); } \
        else { _Pragma("unroll") for (int m = 0; m < 4; ++m) _Pragma("unroll") for (int n = 0; n < 2; ++n) { \
            acc[ai][bj][m][n] = __builtin_amdgcn_mfma_f32_16x16x32_bf16(PG8_LO(Bt[n]), PG8_LO(At[m]), acc[ai][bj][m][n], 0, 0, 0); \
            acc[ai][bj][m][n] = __builtin_amdgcn_mfma_f32_16x16x32_bf16(PG8_HI(Bt[n]), PG8_HI(At[m]), acc[ai][bj][m][n], 0, 0, 0); } } \
        __builtin_amdgcn_s_setprio(0); } while (0)
#define PG8_WAIT_V(n) ASM_VMCNT(n)
#define PG8_WAIT_L(n) ASM_LGKMCNT(n)
#define PG8_BAR __builtin_amdgcn_s_barrier()
#define PG8_SCHED __builtin_amdgcn_sched_barrier(0)
#ifndef EMU
    unsigned long long ge0_ = 0; const bool gprobe0_ = (PROBE_K / 10 == Epi::PID) && blockIdx.x == 0 && tid == 0;
    if (gprobe0_) ge0_ = __builtin_amdgcn_s_memrealtime();
#endif
    Unit cur, nxt; int ui = 0;
    if (!S.next(0, cur)) return;
    f32x4 acc[2][2][4][2];
#pragma unroll
    for (int a = 0; a < 2; ++a)
#pragma unroll
        for (int b = 0; b < 2; ++b)
#pragma unroll
            for (int m = 0; m < 4; ++m)
#pragma unroll
                for (int n = 0; n < 2; ++n) acc[a][b][m][n] = (f32x4){0.f, 0.f, 0.f, 0.f};
    v8i_t At[4], B0[2], B1[2];
    int f8one = 0x7F7F7F7F;
#ifndef EMU
    asm volatile("" : "+v"(f8one));
#endif
    (void)f8one;
    unsigned vA0[2], vA1[2], nA0[2], nA1[2];
#define PG8_SIDE(k) (lds + STAGE_BYTES + ((k) % 3) * 2048)
    if (Prob::SIDE) { P.side_issue(cur, PG8_SIDE(0), wid, lane); PG8_WAIT_V(0); PG8_BAR; }
#pragma unroll
    for (int i = 0; i < 2; ++i) { vA0[i] = P.a_rowoff(cur, Rr[i], PG8_SIDE(0)) + (unsigned)Cc[i] * 2u; vA1[i] = P.a_rowoff(cur, HALF + Rr[i], PG8_SIDE(0)) + (unsigned)Cc[i] * 2u; }
    const char* cA = P.a_base(cur); const char* cB = P.b_base(cur);
    PG8_STAGE(PG8_SB(0, 0), cB, voffB); PG8_STAGE(PG8_SB(0, 1), cB + hstepB, voffB); PG8_STAGE(PG8_SA(0, 0), cA, vA0); PG8_STAGE(PG8_SA(0, 1), cA, vA1);
    if (wr == 1) PG8_BAR;
    PG8_WAIT_V(2); PG8_BAR;
    PG8_STAGE(PG8_SB(1, 0), cB + kstep, voffB); PG8_STAGE(PG8_SA(1, 0), cA + kstep, vA0); PG8_STAGE(PG8_SB(1, 1), cB + hstepB + kstep, voffB);
    PG8_WAIT_V(6); PG8_BAR;
    for (;;) {
        const bool has_next = S.next(ui + 1, nxt);
        const char* nA = has_next ? P.a_base(nxt) : cA; const char* nB = has_next ? P.b_base(nxt) : cB;
        if (Prob::SIDE && has_next) P.side_issue(nxt, PG8_SIDE(ui + 1), wid, lane);
#pragma unroll
        for (int i = 0; i < 2; ++i) { nA0[i] = vA0[i]; nA1[i] = vA1[i]; }
        if (!Prob::SIDE && has_next) {
#pragma unroll
            for (int i = 0; i < 2; ++i) { nA0[i] = P.a_rowoff(nxt, Rr[i], PG8_SIDE(0)) + (unsigned)Cc[i] * 2u; nA1[i] = P.a_rowoff(nxt, HALF + Rr[i], PG8_SIDE(0)) + (unsigned)Cc[i] * 2u; }
        }
#ifndef EMU
        unsigned long long gt0_ = 0; const bool gprobe_ = (PROBE_K / 10 == Epi::PID) && blockIdx.x == 0 && tid == 0;
        if (gprobe_) { gt0_ = __builtin_amdgcn_s_memrealtime(); if (ui == 0) ((volatile LAS unsigned*)(lds + MISC_OFF))[300 + 8] += (unsigned)(gt0_ - ge0_); }
#endif
        for (int t = 0; t < nt; t += 2) {
            const bool last = (t == nt - 2);
            if (Prob::SIDE && has_next && t == nt - 4) {
#pragma unroll
                for (int i = 0; i < 2; ++i) { nA0[i] = P.a_rowoff(nxt, Rr[i], PG8_SIDE(ui + 1)) + (unsigned)Cc[i] * 2u; nA1[i] = P.a_rowoff(nxt, HALF + Rr[i], PG8_SIDE(ui + 1)) + (unsigned)Cc[i] * 2u; }
            }
            const char* a1 = cA + (size_t)(t + 1) * kstep;
            const char* a2 = last ? nA : cA + (size_t)(t + 2) * kstep; const char* b2 = last ? nB : cB + (size_t)(t + 2) * kstep;
            const char* a3 = a2 + kstep; const char* b3 = b2 + kstep;
            unsigned s0[2], s1[2];
#pragma unroll
            for (int i = 0; i < 2; ++i) { s0[i] = last ? nA0[i] : vA0[i]; s1[i] = last ? nA1[i] : vA1[i]; }
            PG8_LDB(B0, 0, 0); PG8_LDB(B1, 0, 1); PG8_SCHED; PG8_LDA(At, 0, 0); PG8_STAGE(PG8_SA(1, 1), a1, vA1);
            PG8_WAIT_V(8); PG8_WAIT_L(0); PG8_BAR; PG8_MMA(0, 0, At, B0); PG8_MMA(0, 1, At, B1); PG8_BAR; PG8_SCHED;
            PG8_LDA(At, 0, 1); PG8_STAGE(PG8_SB(0, 0), b2, voffB); PG8_STAGE(PG8_SB(0, 1), b2 + hstepB, voffB); PG8_STAGE(PG8_SA(0, 0), a2, s0);
            PG8_WAIT_V(8); PG8_WAIT_L(0); PG8_BAR; PG8_MMA(1, 0, At, B0); PG8_MMA(1, 1, At, B1); PG8_BAR; PG8_SCHED;
            PG8_LDB(B0, 1, 0); PG8_LDB(B1, 1, 1); PG8_SCHED; PG8_LDA(At, 1, 0); PG8_STAGE(PG8_SA(0, 1), a2, s1);
            PG8_WAIT_V(8); PG8_WAIT_L(0); PG8_BAR; PG8_MMA(0, 0, At, B0); PG8_MMA(0, 1, At, B1); PG8_BAR; PG8_SCHED;
            PG8_LDA(At, 1, 1); PG8_STAGE(PG8_SB(1, 0), b3, voffB); PG8_STAGE(PG8_SB(1, 1), b3 + hstepB, voffB); PG8_STAGE(PG8_SA(1, 0), a3, s0);
            PG8_WAIT_V(8); PG8_WAIT_L(0); PG8_BAR; PG8_MMA(1, 0, At, B0); PG8_MMA(1, 1, At, B1); PG8_BAR; PG8_SCHED;
        }
#ifndef EMU
        if (gprobe_) { const unsigned long long t1_ = __builtin_amdgcn_s_memrealtime(); ((volatile LAS unsigned*)(lds + MISC_OFF))[300 + 6] += (unsigned)(t1_ - gt0_); gt0_ = t1_; }
#endif
        if (wr == 0) PG8_BAR;
#ifndef EMU
        if (FP8) asm volatile("s_nop 15\n\ts_nop 15" ::: "memory");
#endif
        E(acc, cur, wr, wc, fr, fq, (const LAS float*)(PG8_SIDE(ui) + 1024));
        if (!has_next) break;
#pragma unroll
        for (int a = 0; a < 2; ++a)
#pragma unroll
            for (int b = 0; b < 2; ++b)
#pragma unroll
                for (int m = 0; m < 4; ++m)
#pragma unroll
                    for (int n = 0; n < 2; ++n) acc[a][b][m][n] = (f32x4){0.f, 0.f, 0.f, 0.f};
#ifndef EMU
        if (gprobe_) { const unsigned long long t1_ = __builtin_amdgcn_s_memrealtime(); ((volatile LAS unsigned*)(lds + MISC_OFF))[300 + 7] += (unsigned)(t1_ - gt0_); }
#endif
        cur = nxt; cA = nA; cB = nB; ++ui;
#pragma unroll
        for (int i = 0; i < 2; ++i) { vA0[i] = nA0[i]; vA1[i] = nA1[i]; }
        if (wr == 1) PG8_BAR;
    }
#ifndef EMU
    if (gprobe0_) ge0_ = __builtin_amdgcn_s_memrealtime();
#endif
    PG8_WAIT_V(0);
    PG8_BAR;
#ifndef EMU
    if (gprobe0_) ((volatile LAS unsigned*)(lds + MISC_OFF))[300 + 9] += (unsigned)(__builtin_amdgcn_s_memrealtime() - ge0_);
#endif
#undef PG8_SIDE
#undef PG8_SA
#undef PG8_SB
#undef PG8_STAGE
#undef PG8_LDA
#undef PG8_LDB
#undef PG8_MMA
#undef PG8_MFMA_F8
#undef PG8_LD8
#undef PG8_LO
#undef PG8_HI
#undef PG8_WAIT_V
#undef PG8_WAIT_L
#undef PG8_BAR
#undef PG8_SCHED
}

struct DenseOrder {
    int nM, nN, nwg, G, c;
    __device__ __forceinline__ void init(int M, int N, int G_, int c_) { nM = M / BM; nN = N / BM; nwg = nM * nN; G = G_; c = c_; }
    __device__ __forceinline__ bool next(int i, Unit& u) const {
        const long L = (long)i * G + c; if (L >= nwg) return false;
        int wgid = (int)L; { const int q = nwg / 8, r = nwg % 8, xcd = wgid % 8, off = wgid / 8; wgid = (xcd < r ? xcd * (q + 1) : r * (q + 1) + (xcd - r) * q) + off; }
        const int nig = 8 * nN, gid = wgid / nig, fm = gid * 8, gsz = (nM - fm) < 8 ? (nM - fm) : 8;
        u.pm = fm + ((wgid % nig) % gsz); u.pn = (wgid % nig) / gsz; u.e = 0; return true;
    }
};
struct DenseProb {
    static constexpr bool SIDE = false;
    const char* A; const char* Bt; int KB;
    __device__ __forceinline__ const char* a_base(const Unit& u) const { return A + (size_t)u.pm * BM * KB; }
    __device__ __forceinline__ unsigned a_rowoff(const Unit&, int r, const LAS unsigned char*) const { return (unsigned)(r * KB); }
    __device__ __forceinline__ const char* b_base(const Unit& u) const { return Bt + (size_t)u.pn * BM * KB; }
    __device__ __forceinline__ void side_issue(const Unit&, LAS unsigned char*, int, int) const {}
};
struct MoeOrder {
    volatile LAS unsigned* tpfx; int nN, G, c;
    mutable int ecur;
    __device__ __forceinline__ bool next(int i, Unit& u) const {
        const int L = i * G + c; const int total = (int)tpfx[NE] * nN; if (L >= total) return false;
        int e = ecur;
        if (L < (int)tpfx[e] * nN) e = 0;
        while (L >= (int)tpfx[e + 1] * nN) ++e;
        ecur = e;
        const int rem = L - (int)tpfx[e] * nN, tm = (int)tpfx[e + 1] - (int)tpfx[e];
        u.e = e; u.pm = rem % tm; u.pn = rem / tm; return true;
    }
};
}

struct EpiZ {
    static constexpr bool PERM = true; static constexpr int PID = 2;
    bf16_t* O;
    __device__ __forceinline__ void operator()(const f32x4 (&acc)[2][2][4][2], const pg8::Unit& u, int wr, int wc, int fr, int fq, const LAS float*) const {
        const int row0 = u.pm * 256 + wr * 64 + fr, col0 = u.pn * 256 + wc * 32 + 8 * fq;
#pragma unroll
        for (int ai = 0; ai < 2; ++ai)
#pragma unroll
            for (int m = 0; m < 4; ++m) { bf16_t* rowp = O + (size_t)(row0 + ai * 128 + m * 16) * ZP + col0;
#pragma unroll
                for (int bj = 0; bj < 2; ++bj) { const f32x4 v0 = acc[ai][bj][m][0], v1 = acc[ai][bj][m][1];
                    u32x4 w; w.x = pk2(v0[0], v0[1]); w.y = pk2(v0[2], v0[3]); w.z = pk2(v1[0], v1[1]); w.w = pk2(v1[2], v1[3]);
                    *(u32x4*)(rowp + bj * 128) = w; } }
    }
};
struct EpiMix {
    static constexpr bool PERM = true; static constexpr int PID = 5;
    bf16_t* O;
    __device__ __forceinline__ void operator()(const f32x4 (&acc)[2][2][4][2], const pg8::Unit& u, int wr, int wc, int fr, int fq, const LAS float*) const {
        const int row0 = u.pm * 256 + wr * 64 + fr, col0 = u.pn * 256 + wc * 32 + 8 * fq;
#pragma unroll
        for (int ai = 0; ai < 2; ++ai)
#pragma unroll
            for (int m = 0; m < 4; ++m) { bf16_t* rowp = O + (size_t)(row0 + ai * 128 + m * 16) * DM + col0;
#pragma unroll
                for (int bj = 0; bj < 2; ++bj) { const f32x4 v0 = acc[ai][bj][m][0], v1 = acc[ai][bj][m][1];
                    u32x4 w; w.x = pk2(v0[0], v0[1]); w.y = pk2(v0[2], v0[3]); w.z = pk2(v1[0], v1[1]); w.w = pk2(v1[2], v1[3]);
                    *(u32x4*)(rowp + bj * 128) = w; } }
    }
};
struct EpiAct {
    static constexpr bool PERM = true; static constexpr int PID = 7;
    unsigned char* O; const float* bgu; volatile LAS unsigned* roff;
    __device__ __forceinline__ void operator()(const f32x4 (&acc)[2][2][4][2], const pg8::Unit& u, int wr, int wc, int fr, int fq, const LAS float* sb) const {
        const int row0 = (int)roff[u.e] + u.pm * 256 + wr * 64 + fr, col0 = u.pn * 128 + wc * 32 + 8 * fq;
        const LAS float* bp = sb + 2 * (wc * 32 + 8 * fq);
        f32x4 bb[4];
#pragma unroll
        for (int j = 0; j < 4; ++j) bb[j] = *(const LAS f32x4*)(bp + 4 * j);
#pragma unroll
        for (int ai = 0; ai < 2; ++ai)
#pragma unroll
            for (int m = 0; m < 4; ++m) { float a8[8];
#pragma unroll
                for (int n = 0; n < 2; ++n)
#pragma unroll
                    for (int j = 0; j < 4; ++j) { const int cc = 4 * n + j;
                        float g = acc[ai][0][m][n][j] * F8_ACC_SCALE + bb[cc >> 1][(cc & 1) * 2], l = acc[ai][1][m][n][j] * F8_ACC_SCALE + bb[cc >> 1][(cc & 1) * 2 + 1];
                        g = fminf(g, 7.0f); l = fminf(fmaxf(l, -7.0f), 7.0f);
                        a8[cc] = (g * F8_ACT_SCALE) * __builtin_amdgcn_rcpf(1.0f + fexp2(g * (-1.702f * LOG2E))) * (l + 1.0f); }
                u32x2 w; w.x = pk4_fp8_nc(a8[0], a8[1], a8[2], a8[3]); w.y = pk4_fp8_nc(a8[4], a8[5], a8[6], a8[7]);
                *(u32x2*)(O + (size_t)(row0 + ai * 128 + m * 16) * DFF + col0) = w; }
    }
};
struct EpiYd {
    static constexpr bool PERM = true; static constexpr int PID = 8;
    bf16_t* O; const float* bdn; volatile LAS unsigned* roff;
    __device__ __forceinline__ void operator()(const f32x4 (&acc)[2][2][4][2], const pg8::Unit& u, int wr, int wc, int fr, int fq, const LAS float* sb) const {
        const int row0 = (int)roff[u.e] + u.pm * 256 + wr * 64 + fr, col0 = u.pn * 256 + wc * 32 + 8 * fq;
        f32x4 bv[2][2];
#pragma unroll
        for (int bj = 0; bj < 2; ++bj)
#pragma unroll
            for (int n = 0; n < 2; ++n) bv[bj][n] = *(const LAS f32x4*)(sb + wc * 32 + 8 * fq + bj * 128 + 4 * n);
#pragma unroll
        for (int ai = 0; ai < 2; ++ai)
#pragma unroll
            for (int m = 0; m < 4; ++m) { bf16_t* rowp = O + (size_t)(row0 + ai * 128 + m * 16) * DM + col0;
#pragma unroll
                for (int bj = 0; bj < 2; ++bj) { const f32x4 v0 = acc[ai][bj][m][0] * F8_ACC_SCALE + bv[bj][0], v1 = acc[ai][bj][m][1] * F8_ACC_SCALE + bv[bj][1];
                    u32x4 w; w.x = pk2(v0[0], v0[1]); w.y = pk2(v0[2], v0[3]); w.z = pk2(v1[0], v1[1]); w.w = pk2(v1[2], v1[3]);
                    *(u32x4*)(rowp + bj * 128) = w; } }
    }
};
struct MoeProb1 {
    static constexpr bool SIDE = true;
    const char* H2; const char* Bt; const int* lists; const float* bias; volatile LAS unsigned* cnt; int KB;
    __device__ __forceinline__ const char* a_base(const pg8::Unit&) const { return H2; }
    __device__ __forceinline__ unsigned a_rowoff(const pg8::Unit& u, int r, const LAS unsigned char* side) const { const int i = u.pm * 256 + r; const int tok = (i < (int)cnt[u.e]) ? ((const LAS int*)side)[r] : 0; return (unsigned)tok * 1024u; }
    __device__ __forceinline__ const char* b_base(const pg8::Unit& u) const { return Bt + ((size_t)u.e * 2048 + (size_t)u.pn * 256) * 1024; }
    __device__ __forceinline__ void side_issue(const pg8::Unit& u, LAS unsigned char* side, int wid, int lane) const {
        if (wid == 0) __builtin_amdgcn_global_load_lds((const unsigned*)(lists + (size_t)u.e * T + u.pm * 256 + lane * 4), (LAS unsigned*)side, 16, 0, 0);
        if (wid == 1) __builtin_amdgcn_global_load_lds((const unsigned*)(bias + (size_t)u.e * 2048 + u.pn * 256 + lane * 4), (LAS unsigned*)(side + 1024), 16, 0, 0);
    }
};
struct MoeProb2 {
    static constexpr bool SIDE = true;
    const char* A; const char* Bt; const float* bias; volatile LAS unsigned* roff; int KB;
    __device__ __forceinline__ const char* a_base(const pg8::Unit& u) const { return A + ((size_t)roff[u.e] + (size_t)u.pm * 256) * 1024; }
    __device__ __forceinline__ unsigned a_rowoff(const pg8::Unit&, int r, const LAS unsigned char*) const { return (unsigned)r * 1024u; }
    __device__ __forceinline__ const char* b_base(const pg8::Unit& u) const { return Bt + ((size_t)u.e * 1024 + (size_t)u.pn * 256) * 1024; }
    __device__ __forceinline__ void side_issue(const pg8::Unit& u, LAS unsigned char* side, int wid, int lane) const {
        if (wid == 1) __builtin_amdgcn_global_load_lds((const unsigned*)(bias + (size_t)u.e * 1024 + u.pn * 256 + lane * 4), (LAS unsigned*)(side + 1024), 16, 0, 0);
    }
};

template <int NB>
__device__ __forceinline__ void gemv_item(Frame& F, const float* vec, int vstride, const float* W, int K, int N, int n0, const float* bias, float* out, int ostride) {
    LAS float* red = (LAS float*)F.lds;
    const int col = n0 + F.lane, ks = K / NWAVES;
    float acc[NB];
#pragma unroll
    for (int b = 0; b < NB; ++b) acc[b] = 0.f;
    for (int k0 = F.wave * ks; k0 < (F.wave + 1) * ks; k0 += 32) {
        float wv[32];
#pragma unroll
        for (int j = 0; j < 32; ++j) wv[j] = __builtin_nontemporal_load(W + (size_t)(k0 + j) * N + col);
#pragma unroll
        for (int j = 0; j < 32; ++j)
#pragma unroll
            for (int b = 0; b < NB; ++b) acc[b] += vec[b * vstride + k0 + j] * wv[j]; }
#pragma unroll
    for (int b = 0; b < NB; ++b) red[(F.wave * NB + b) * 64 + F.lane] = acc[b];
    __syncthreads();
    if (F.wave == 0) {
#pragma unroll
        for (int b = 0; b < NB; ++b) { float s = bias ? bias[col] : 0.f;
            for (int w = 0; w < NWAVES; ++w) s += red[(w * NB + b) * 64 + F.lane];
            out[b * ostride + col] = s; }
    }
    __syncthreads();
}
template <int MAP>
__device__ __forceinline__ int t_rowmap(int n) {
    if (MAP == 0) return n;
    const int ac = n >> 1, bj = n & 1; return (ac >> 7) * 256 + bj * 128 + (ac & 127);
}
template <int MAP>
__device__ __forceinline__ void transpose_item(const float* W, int K, int Nsrc, int nblk, bf16_t* WT, LAS float* scr, int item, int lane) {
    const int kb = item / nblk, nb = item % nblk, k0 = 64 * kb, n0 = 32 * nb;
    const int nc = n0 + (lane & 31);
    float tv[32];
    if (nc < Nsrc) {
#pragma unroll
        for (int i = 0; i < 32; ++i) tv[i] = __builtin_nontemporal_load(W + (size_t)(k0 + 2 * i + (lane >> 5)) * Nsrc + nc);
    } else {
#pragma unroll
        for (int i = 0; i < 32; ++i) tv[i] = 0.f;
    }
#pragma unroll
    for (int i = 0; i < 32; ++i) scr[(2 * i + (lane >> 5)) * 33 + (lane & 31)] = tv[i];
    WAVE_SYNC(); FENCE();
    const int c = lane & 7;
#pragma unroll
    for (int j = 0; j < 4; ++j) { const int n = (lane >> 3) + 8 * j; const LAS float* s = scr + (8 * c) * 33 + n;
        u32x4 o; o.x = pk2(s[0 * 33], s[1 * 33]); o.y = pk2(s[2 * 33], s[3 * 33]); o.z = pk2(s[4 * 33], s[5 * 33]); o.w = pk2(s[6 * 33], s[7 * 33]);
        *(u32x4*)(WT + (size_t)t_rowmap<MAP>(n0 + n) * K + k0 + 8 * c) = o; }
    WAVE_SYNC(); FENCE();
}
template <int MAP>
__device__ __forceinline__ void transpose_item_f8(const float* W, int K, int Nsrc, int nblk, unsigned char* WT, LAS float* scr, int item, int lane, float scale) {
    const int kb = item / nblk, nb = item % nblk, k0 = 64 * kb, n0 = 32 * nb;
    const int nc = n0 + (lane & 31);
    (void)nc;
    f32x4 tv[8];
#pragma unroll
    for (int i = 0; i < 8; ++i) tv[i] = __builtin_nontemporal_load((const f32x4*)(W + (size_t)(k0 + 8 * i + (lane >> 3)) * Nsrc + n0 + 4 * (lane & 7)));
#pragma unroll
    for (int i = 0; i < 8; ++i) { LAS float* d = scr + (8 * i + (lane >> 3)) * 33 + 4 * (lane & 7);
        d[0] = tv[i][0] * scale; d[1] = tv[i][1] * scale; d[2] = tv[i][2] * scale; d[3] = tv[i][3] * scale; }
    WAVE_SYNC(); FENCE();
    const int c = lane & 7;
#pragma unroll
    for (int j = 0; j < 4; ++j) { const int n = (lane >> 3) + 8 * j; const LAS float* sp = scr + (8 * c) * 33 + n;
        u32x2 o; o.x = pk4_fp8(sp[0 * 33], sp[1 * 33], sp[2 * 33], sp[3 * 33]); o.y = pk4_fp8(sp[4 * 33], sp[5 * 33], sp[6 * 33], sp[7 * 33]);
        *(u32x2*)(WT + (size_t)t_rowmap<MAP>(n0 + n) * K + k0 + 8 * c) = o; }
    WAVE_SYNC(); FENCE();
}
constexpr int P0_I_IN = (DM / 64) * (ZP / 32), P0_I_OUT = (DM / 64) * (DM / 32), P0_I_W1 = (2048 / 64) * (256 / 32), P0_I_W2 = (256 / 64) * (64 / 32);
constexpr int P0_I_GU1 = (DM / 64) * (2048 / 32), P0_I_DN1 = (DFF / 64) * (DM / 32);
constexpr int P0_NITEMS = P0_I_IN + P0_I_OUT + 2 * P0_I_W1 + 2 * P0_I_W2 + NE * P0_I_GU1 + NE * P0_I_DN1;
constexpr int P2_FILL_PER_CU = 44;
__device__ __forceinline__ int p2_fill_items(const Frame& F) { return (F.G == 256 && (T / 256) * (ZP / 256) == 640) ? 128 * P2_FILL_PER_CU : 0; }
__device__ __forceinline__ void p0_item(Frame& F, LAS float* scr, int it) {
    int r = it;
    if (r < P0_I_IN) { transpose_item<0>(F.in[I_WIN], DM, INC, ZP / 32, (bf16_t*)(F.ws + WS_WINT), scr, r, F.lane); return; } r -= P0_I_IN;
    if (r < P0_I_OUT) { transpose_item<0>(F.in[I_WOUT], DM, DM, DM / 32, (bf16_t*)(F.ws + WS_WOUTT), scr, r, F.lane); return; } r -= P0_I_OUT;
    if (r < P0_I_W1) { transpose_item<0>(F.in[I_W1K], 2048, 256, 8, (bf16_t*)(F.ws + WS_W1KT), scr, r, F.lane); return; } r -= P0_I_W1;
    if (r < P0_I_W1) { transpose_item<0>(F.in[I_W1V], 2048, 256, 8, (bf16_t*)(F.ws + WS_W1VT), scr, r, F.lane); return; } r -= P0_I_W1;
    if (r < P0_I_W2) { transpose_item<0>(F.in[I_W2K], 256, 64, 2, (bf16_t*)(F.ws + WS_W2KT), scr, r, F.lane); return; } r -= P0_I_W2;
    if (r < P0_I_W2) { transpose_item<0>(F.in[I_W2V], 256, 64, 2, (bf16_t*)(F.ws + WS_W2VT), scr, r, F.lane); return; } r -= P0_I_W2;
    if (r < NE * P0_I_GU1) { const int e = r / P0_I_GU1; transpose_item_f8<1>(F.in[I_WGU] + (size_t)e * DM * 2048, DM, 2048, 64, (unsigned char*)(F.ws + WS_WGUT) + (size_t)e * 2048 * DM, scr, r % P0_I_GU1, F.lane, F8_W_SCALE); return; } r -= NE * P0_I_GU1;
    { const int e = r / P0_I_DN1; transpose_item_f8<0>(F.in[I_WDN] + (size_t)e * DFF * DM, DFF, DM, 32, (unsigned char*)(F.ws + WS_WDNT) + (size_t)e * DM * DFF, scr, r % P0_I_DN1, F.lane, F8_W_SCALE); }
}
__device__ __forceinline__ void p0_prologue(Frame& F) {
    for (int it = F.vcu; it < 96 + 8; it += F.G) {
        if (it < 96) gemv_item<BATCH>(F, F.in[I_C], DM, F.in[I_WADA], DM, 6 * DM, 64 * it, F.in[I_BADA], (float*)(F.ws + WS_MOD), 6 * DM);
        else { const int j = it - 96, kv = j >> 2, n0 = (j & 3) * 64;
            gemv_item<1>(F, F.in[kv ? I_PEV : I_PEK], 0, F.in[kv ? I_W1V : I_W1K], 2048, 256, n0, nullptr, (float*)(F.ws + WS_BPE) + kv * 256, 0); }
    }
    { const float* src = F.in[I_GMWS]; bf16_t* dst = (bf16_t*)(F.ws + WS_WSBF);
      for (int idx = F.vcu * NTHREADS + F.tid; idx < GMG * GMC * GMC; idx += F.G * NTHREADS) { const int i = (idx >> 7) & 127, j = idx & 127; dst[idx] = (bf16_t)f2bf(j <= i ? src[idx] : 0.f); } }
    LAS float* scr = (LAS float*)(F.lds + 8192 + F.wave * 16384);
    const int gw = F.vcu * NWAVES + F.wave, NGW = F.G * NWAVES;
    const int nit = P0_NITEMS - p2_fill_items(F);
    constexpr int NGEMV = 96 + 8;
    const int shift = (F.G > 2 * NGEMV) ? 2 * NGEMV * NWAVES : 0, n1 = nit - shift;
    for (int it = gw; it < n1; it += NGW) p0_item(F, scr, it);
    if (shift && F.vcu >= NGEMV) for (int it = n1 + (F.vcu - NGEMV) * NWAVES + F.wave; it < nit; it += (F.G - NGEMV) * NWAVES) p0_item(F, scr, it);
}

__device__ __forceinline__ void norm_rows(Frame& F, const float* xin, const float* g, int mod_shift, int mod_scale, bf16_t* outb) {
    const int gw = F.vcu * NWAVES + F.wave, NGW = F.G * NWAVES;
    const float* mod = (const float*)(F.ws + WS_MOD);
    for (int m0 = gw; m0 < T / 2; m0 += NGW) {
        f32x4 v[2][4]; float s[2] = {0.f, 0.f};
#pragma unroll
        for (int q = 0; q < 2; ++q) { const f32x4* xr = (const f32x4*)(xin + (size_t)(m0 + q * (T / 2)) * DM) + F.lane;
#pragma unroll
            for (int j = 0; j < 4; ++j) v[q][j] = __builtin_nontemporal_load(xr + 64 * j); }
#pragma unroll
        for (int q = 0; q < 2; ++q)
#pragma unroll
            for (int j = 0; j < 4; ++j) s[q] += (v[q][j][0] * v[q][j][0] + v[q][j][1] * v[q][j][1]) + (v[q][j][2] * v[q][j][2] + v[q][j][3] * v[q][j][3]);
#pragma unroll
        for (int o = 1; o < 64; o <<= 1) { s[0] += __shfl_xor(s[0], o); s[1] += __shfl_xor(s[1], o); }
#pragma unroll
        for (int q = 0; q < 2; ++q) { const int m = m0 + q * (T / 2), b = m / SEQ;
            const float rinv = __builtin_amdgcn_rsqf(s[q] * (1.0f / DM) + EPS);
            u32x2* o8 = (u32x2*)(outb + (size_t)m * DM) + F.lane;
#pragma unroll
            for (int j = 0; j < 4; ++j) { const int c = 4 * F.lane + 256 * j;
                const f32x4 gg = *(const f32x4*)(g + c), sc = *(const f32x4*)(mod + (size_t)b * 6144 + mod_scale * 1024 + c), sh = *(const f32x4*)(mod + (size_t)b * 6144 + mod_shift * 1024 + c);
                const f32x4 h = v[q][j] * rinv * gg * (sc + 1.0f) + sh;
                u32x2 w; w.x = pk2(h[0], h[1]); w.y = pk2(h[2], h[3]); o8[64 * j] = w; } }
    }
}

struct GmRegs { u32x4 v[2], u[2]; };
__device__ __forceinline__ void gmlp_load(Frame& F, int tile, GmRegs& R) {
    const int g = tile % GMG, ch = (tile / GMG) % (SEQ / GMC), b = tile / (GMG * (SEQ / GMC));
    const size_t row0 = (size_t)b * SEQ + (size_t)ch * GMC;
    const bf16_t* ZB = (const bf16_t*)(F.ws + WS_ZB);
#pragma unroll
    for (int it = 0; it < 2; ++it) { const int idx = F.tid + it * NTHREADS, row = idx >> 3, c8 = idx & 7;
        R.v[it] = *(const u32x4*)(ZB + (row0 + row) * ZP + ZC_V + g * 64 + c8 * 8);
        R.u[it] = *(const u32x4*)(ZB + (row0 + row) * ZP + ZC_U + g * 64 + c8 * 8); }
}
__device__ __forceinline__ void gmlp_compute(Frame& F, int tile, const GmRegs& R) {
    const int g = tile % GMG, ch = (tile / GMG) % (SEQ / GMC), b = tile / (GMG * (SEQ / GMC));
    const size_t row0 = (size_t)b * SEQ + (size_t)ch * GMC;
    LAS bf16_t* Vt = (LAS bf16_t*)F.lds;
    constexpr int VP = 136, UP = 68;
    LAS float* Us = (LAS float*)(F.lds + 64 * VP * 2);
    const float* gn = F.in[I_GMNG] + g * 64;
    const int fr = F.lane & 15, fq = F.lane >> 4, w = F.wave;
    const bf16_t* Wg = (const bf16_t*)(F.ws + WS_WSBF) + (size_t)g * GMC * GMC;
    bf16x8 af[4];
#pragma unroll
    for (int ks = 0; ks < 4; ++ks) af[ks] = *(const bf16x8*)(Wg + (size_t)(16 * w + fr) * GMC + 32 * ks + 8 * fq);
#pragma unroll
    for (int it = 0; it < 2; ++it) {
        const int idx = F.tid + it * NTHREADS, row = idx >> 3, c8 = idx & 7;
        const u32x4 raw = R.v[it];
        float v[8]; v[0] = bflo(raw.x); v[1] = bfhi(raw.x); v[2] = bflo(raw.y); v[3] = bfhi(raw.y); v[4] = bflo(raw.z); v[5] = bfhi(raw.z); v[6] = bflo(raw.w); v[7] = bfhi(raw.w);
        float ss = 0.f;
#pragma unroll
        for (int e = 0; e < 8; ++e) { v[e] = gelu_tanh(v[e]); ss += v[e] * v[e]; }
        ss += __shfl_xor(ss, 1); ss += __shfl_xor(ss, 2); ss += __shfl_xor(ss, 4);
        const float rinv = __builtin_amdgcn_rsqf(ss * (1.0f / 64.0f) + EPS);
#pragma unroll
        for (int e = 0; e < 8; ++e) Vt[(c8 * 8 + e) * VP + row] = (bf16_t)f2bf(v[e] * rinv * gn[c8 * 8 + e]);
        const u32x4 ur = R.u[it];
        f32x4 u0 = {gelu_tanh(bflo(ur.x)), gelu_tanh(bfhi(ur.x)), gelu_tanh(bflo(ur.y)), gelu_tanh(bfhi(ur.y))}, u1 = {gelu_tanh(bflo(ur.z)), gelu_tanh(bfhi(ur.z)), gelu_tanh(bflo(ur.w)), gelu_tanh(bfhi(ur.w))};
        *(LAS f32x4*)(Us + row * UP + c8 * 8) = u0; *(LAS f32x4*)(Us + row * UP + c8 * 8 + 4) = u1;
    }
    __syncthreads();
    f32x4 acc[4];
#pragma unroll
    for (int n = 0; n < 4; ++n) acc[n] = (f32x4){0.f, 0.f, 0.f, 0.f};
#pragma unroll
    for (int ks = 0; ks < 4; ++ks) {
        if (32 * ks <= 16 * w + 15) {
#pragma unroll
            for (int n = 0; n < 4; ++n) { const bf16x8 bb = *(const LAS bf16x8*)(Vt + (16 * n + fr) * VP + 32 * ks + 8 * fq);
                acc[n] = __builtin_amdgcn_mfma_f32_16x16x32_bf16(af[ks], bb, acc[n], 0, 0, 0); }
        }
    }
    bf16_t* Y = (bf16_t*)(F.ws + WS_YMIX);
    const float* bs = F.in[I_GMBS] + g * GMC;
#pragma unroll
    for (int n = 0; n < 4; ++n)
#pragma unroll
        for (int r = 0; r < 4; ++r) { const int i = 16 * w + 4 * fq + r, d = 16 * n + fr;
            Y[(row0 + i) * DM + g * 64 + d] = (bf16_t)f2bf(Us[i * UP + d] * (acc[n][r] + bs[i])); }
    __syncthreads();
}
__device__ __forceinline__ void gmlp_run(Frame& F, int base, int stride, int n) {
    if (n <= 0) return;
    GmRegs A, B;
    gmlp_load(F, base, A);
    for (int k = 0; k < n; k += 2) {
        if (k + 1 < n) gmlp_load(F, base + (k + 1) * stride, B);
        gmlp_compute(F, base + k * stride, A);
        if (k + 1 < n) { if (k + 2 < n) gmlp_load(F, base + (k + 2) * stride, A); gmlp_compute(F, base + (k + 1) * stride, B); }
    }
}

__device__ __forceinline__ void cmp_tile(Frame& F, int tile) {
    constexpr int NT = NCP / 32;
    const int nt = tile % NT, g = (tile / NT) % NG, b = (tile / (NT * NG)) % BATCH, kv = tile / (NT * NG * BATCH);
    const int n0 = 32 * nt, p0 = 16 * n0;
    const bf16_t* ZB = (const bf16_t*)(F.ws + WS_ZB);
    constexpr int RP = 72;
    LAS bf16_t* Rs = (LAS bf16_t*)F.lds;
    LAS bf16_t* Hs = (LAS bf16_t*)(F.lds + 528 * RP * 2);
    constexpr int HP = 264;
    const int zc = (kv ? ZC_VC : ZC_KC) + g * 64;
    {
        u32x4 sv[9];
#pragma unroll
        for (int it = 0; it < 9; ++it) { const int idx = F.tid + it * NTHREADS, row = idx >> 3, c8 = idx & 7; const int p = p0 + row;
            sv[it] = (u32x4){0u, 0u, 0u, 0u};
            if (idx < 528 * 8 && p < SEQ) sv[it] = *(const u32x4*)(ZB + ((size_t)b * SEQ + p) * ZP + zc + c8 * 8); }
#pragma unroll
        for (int it = 0; it < 9; ++it) { const int idx = F.tid + it * NTHREADS, row = idx >> 3, c8 = idx & 7;
            if (idx < 528 * 8) *(LAS u32x4*)(Rs + row * RP + c8 * 8) = sv[it]; }
    }
    __syncthreads();
    const int i = F.lane & 31, hi = F.lane >> 5, w = F.wave;
    const bf16_t* W1T = (const bf16_t*)(F.ws + (kv ? WS_W1VT : WS_W1KT)) + (size_t)(32 * w + i) * 2048;
    f32x16 acc;
#pragma unroll
    for (int r = 0; r < 16; ++r) acc[r] = 0.f;
    bf16x8 bq[16];
#pragma unroll
    for (int j = 0; j < 16; ++j) bq[j] = *(const bf16x8*)(W1T + 16 * j + 8 * hi);
    for (int kb = 0; kb < 8; ++kb) {
        bf16x8 bn[16];
        const int kn = (kb < 7) ? (kb + 1) * 16 : kb * 16;
#pragma unroll
        for (int j = 0; j < 16; ++j) bn[j] = *(const bf16x8*)(W1T + 16 * (kn + j) + 8 * hi);
#pragma unroll
        for (int j = 0; j < 16; ++j) { const int kk = kb * 16 + j; const int l = kk >> 2, d = (16 * j + 8 * hi) & 63;
            const bf16x8 a = *(const LAS bf16x8*)(Rs + (16 * i + l) * RP + d);
            acc = __builtin_amdgcn_mfma_f32_32x32x16_bf16(a, bq[j], acc, 0, 0, 0); }
#pragma unroll
        for (int j = 0; j < 16; ++j) bq[j] = bn[j];
    }
    const float bpe = ((const float*)(F.ws + WS_BPE))[kv * 256 + 32 * w + i];
#pragma unroll
    for (int r = 0; r < 16; ++r) Hs[crow(r, hi) * HP + 32 * w + i] = (bf16_t)f2bf(gelu_tanh(acc[r] + bpe));
    __syncthreads();
    if (w < 2) {
        const bf16_t* W2T = (const bf16_t*)(F.ws + (kv ? WS_W2VT : WS_W2KT)) + (size_t)(32 * w + i) * 256;
        f32x16 o;
#pragma unroll
        for (int r = 0; r < 16; ++r) o[r] = 0.f;
        for (int kk = 0; kk < 16; ++kk) {
            const bf16x8 a = *(const LAS bf16x8*)(Hs + i * HP + 16 * kk + 8 * hi);
            const bf16x8 bb = *(const bf16x8*)(W2T + 16 * kk + 8 * hi);
            o = __builtin_amdgcn_mfma_f32_32x32x16_bf16(a, bb, o, 0, 0, 0);
        }
        bf16_t* KC = (bf16_t*)(F.ws + (kv ? WS_VC : WS_KC)) + ((size_t)(b * NG + g) * NCP) * 64;
#pragma unroll
        for (int r = 0; r < 16; ++r) { const int n = n0 + crow(r, hi); KC[(size_t)n * 64 + 32 * w + i] = (n < NCMP) ? (bf16_t)f2bf(o[r]) : (bf16_t)0; }
    }
    __syncthreads();
}

constexpr int KPB = 128;
constexpr int NB_K = 64 * KPB;
constexpr int V_H1 = 4096;
constexpr int NB_BUF = NB_K + 8192;
constexpr int A_IMP = 3 * NB_BUF, A_SEL = A_IMP + 64 * 128 * 4, A_UNI = A_SEL + 64 * 8 * 2, A_WSF = A_UNI + 256, A_QF = A_WSF + 8 * 32 * 4, A_Y = A_QF + 8 * 4096, A_GATE = A_Y + 8 * 4096, A_END = A_GATE + 8 * 32 * 3 * 4;
static_assert(A_END <= MISC_OFF, "NSA LDS map");
#ifndef NSA_THR_VAL
#define NSA_THR_VAL 20.0f
#endif
constexpr float NSA_THR = NSA_THR_VAL, NEG_BIG = -1e30f;

#ifdef EMU
__device__ __forceinline__ int opaque_lane(int l) { return l; }
#else
__device__ __forceinline__ int opaque_lane(int) { int x; asm volatile("v_mbcnt_lo_u32_b32 %0, -1, 0\n\tv_mbcnt_hi_u32_b32 %0, -1, %0" : "=v"(x)); return x; }
#endif
#ifdef EMU
__device__ __forceinline__ int red8_add(int v) { v += __shfl_xor(v, 1); v += __shfl_xor(v, 2); v += __shfl_xor(v, 4); return v; }
__device__ __forceinline__ float quad_sum(float v) { v += __shfl_xor(v, 1); v += __shfl_xor(v, 2); return v; }
__device__ __forceinline__ float xor32f(float v) { return __shfl_xor(v, 32); }
#else
__device__ __forceinline__ int red8_add(int v) {
    v += __builtin_amdgcn_update_dpp(0, v, 0xB1, 0xF, 0xF, true);
    v += __builtin_amdgcn_update_dpp(0, v, 0x4E, 0xF, 0xF, true);
    v += __builtin_amdgcn_update_dpp(0, v, 0x141, 0xF, 0xF, true);
    return v;
}
__device__ __forceinline__ float quad_sum(float v) {
    v += __builtin_bit_cast(float, __builtin_amdgcn_update_dpp(0, __builtin_bit_cast(int, v), 0xB1, 0xF, 0xF, true));
    v += __builtin_bit_cast(float, __builtin_amdgcn_update_dpp(0, __builtin_bit_cast(int, v), 0x4E, 0xF, 0xF, true));
    return v;
}
__device__ __forceinline__ float xor32f(float v) {
    const unsigned u = __builtin_bit_cast(unsigned, v); auto rr = __builtin_amdgcn_permlane32_swap(u, u, false, false);
    return __builtin_bit_cast(float, (threadIdx.x & 32) ? rr[0] : rr[1]);
}
#endif

template <bool WITHV>
__device__ __forceinline__ void stage_dma(LAS unsigned char* buf, const bf16_t* Kg, const bf16_t* Vg, size_t pitch, long rbase, int wave, int lane) {
    const int krow = 8 * wave + (lane >> 3), kc = (lane & 7) ^ ((lane >> 3) & 7);
    __builtin_amdgcn_global_load_lds((const unsigned*)(Kg + (size_t)(rbase + krow) * pitch + kc * 8), (LAS unsigned*)(buf + wave * 1024), 16, 0, 0);
    if (WITHV) { const int vrow = 16 * (wave & 3) + (lane >> 2), vc = (wave >> 2) * 4 + (lane & 3);
        __builtin_amdgcn_global_load_lds((const unsigned*)(Vg + (size_t)(rbase + vrow) * pitch + vc * 8), (LAS unsigned*)(buf + NB_K + wave * 1024), 16, 0, 0); }
}
struct BrState { float mref, l; int has; unsigned qxm; f32x16 o0, o1; };
__device__ __forceinline__ unsigned ref_words(float m, float& meff) { const unsigned mh = f2bf(m); const float fh = bf2f((unsigned short)mh); const unsigned ml = f2bf(m - fh); meff = fh + bf2f((unsigned short)ml); return mh | (ml << 16); }

#ifdef EMU
#define VTR(p) __builtin_amdgcn_ds_read_tr16_b64_v4i16(p)
#else
typedef short v4i16_t __attribute__((ext_vector_type(4)));
#define VTR(p) __builtin_bit_cast(s16x4, __builtin_amdgcn_ds_read_tr16_b64_v4i16((LAS v4i16_t*)(p)))
#endif

__device__ __forceinline__ void nsa_qk(const LAS unsigned char* buf, const LAS unsigned char* qfl, unsigned qxs, unsigned qxm_t, unsigned klw0, unsigned klw1, unsigned tbw, unsigned neg1w,
                                       f32x16& p0, f32x16& p1, int lane) {
    const int i = lane & 31, hi = lane >> 5;
    const bf16x8 qx = __builtin_bit_cast(bf16x8, ((u32x4){qxs, qxs, qxm_t, 0u}));
    const bf16x8 kx0 = __builtin_bit_cast(bf16x8, ((u32x4){klw0, tbw, neg1w, 0u})), kx1 = __builtin_bit_cast(bf16x8, ((u32x4){klw1, tbw, neg1w, 0u}));
    const LAS unsigned char* kp = buf + i * KPB;
    {
        const f32x16 zero16 = {0.f, 0.f, 0.f, 0.f, 0.f, 0.f, 0.f, 0.f, 0.f, 0.f, 0.f, 0.f, 0.f, 0.f, 0.f, 0.f};
        p0 = __builtin_amdgcn_mfma_f32_32x32x16_bf16(kx0, qx, zero16, 0, 0, 0);
        p1 = __builtin_amdgcn_mfma_f32_32x32x16_bf16(kx1, qx, zero16, 0, 0, 0);
    }
#pragma unroll
    for (int d0 = 0; d0 < 4; ++d0) {
        const int ko = ((2 * d0 + hi) ^ (i & 7)) << 4;
        const bf16x8 k0 = *(const LAS bf16x8*)(kp + ko), k1 = *(const LAS bf16x8*)(kp + 32 * KPB + ko);
        const bf16x8 qd = *(const LAS bf16x8*)(qfl + d0 * 1024);
        p0 = __builtin_amdgcn_mfma_f32_32x32x16_bf16(k0, qd, p0, 0, 0, 0);
        p1 = __builtin_amdgcn_mfma_f32_32x32x16_bf16(k1, qd, p1, 0, 0, 0);
    }
}
template <bool PV, bool TRACK>
__device__ __forceinline__ void nsa_prep(int mode, int lim, BrState& st, f32x16& p0, f32x16& p1, int lane, LAS float* wsf) {
#ifndef EMU
    asm volatile("" : "+v"(lim));
#endif
    const int i = lane & 31, hi = lane >> 5;
    if (__builtin_amdgcn_readfirstlane(mode) != 0) {
        NOSPEC();
        const int lim2 = lim - 4 * hi; const bool inv = (mode == 2);
#pragma unroll
        for (int r = 0; r < 16; ++r) { const int c0 = (r & 3) + 8 * (r >> 2);
            const bool v0 = (c0 <= lim2) != inv, v1 = (c0 + 32 <= lim2) != inv;
            p0[r] = v0 ? p0[r] : -INFINITY; p1[r] = v1 ? p1[r] : -INFINITY; }
    }
    if (TRACK) {
        float mxa = fmaxf(p0[0], p1[0]), mxb = fmaxf(p0[1], p1[1]);
#pragma unroll
        for (int r = 2; r < 16; r += 2) { mxa = fmaxf(fmaxf(mxa, p0[r]), p1[r]); mxb = fmaxf(fmaxf(mxb, p0[r + 1]), p1[r + 1]); }
        float mx = fmaxf(mxa, mxb);
        mx = fmaxf(mx, xor32f(mx));
        const bool upd = (mx > (st.has ? NSA_THR : NEG_BIG)) && (mx > NEG_BIG);
        if (__any(upd)) {
            NOSPEC();
            float meff; const unsigned w = ref_words(st.mref + mx, meff);
            const float de = upd ? (meff - st.mref) : 0.f;
            const float f = (upd && st.has) ? fexp2(-de) : 1.0f;
#pragma unroll
            for (int r = 0; r < 16; ++r) { p0[r] -= de; p1[r] -= de; }
            st.l *= f;
            if (PV) {
                wsf[i] = f; WAVE_SYNC(); FENCE();
                const LAS float* wr_ = wsf + 4 * hi;
#pragma unroll
                for (int r = 0; r < 16; ++r) { const float a = wr_[(r & 3) + 8 * (r >> 2)]; st.o0[r] *= a; st.o1[r] *= a; }
                WAVE_SYNC(); FENCE();
            }
            if (upd) { st.mref = meff; st.qxm = hi ? 0u : w; st.has = 1; }
        }
    }
}
template <bool PV>
__device__ __forceinline__ void nsa_softmax_pv(const LAS unsigned char* buf, BrState& st, f32x16& p0, f32x16& p1, int lane) {
    const int hi = lane >> 5;
    float rs = 0.f;
#pragma unroll
    for (int r = 0; r < 16; ++r) { p0[r] = fexp2(p0[r]); p1[r] = fexp2(p1[r]); rs += p0[r] + p1[r]; }
    st.l += rs;
    if (PV) {
        const LAS unsigned char* vb = buf + NB_K + (4 * hi + ((lane & 15) >> 2)) * 64 + 32 * ((lane >> 4) & 1) + 8 * (lane & 3);
#pragma unroll
        for (int ks = 0; ks < 4; ++ks) {
            const f32x16& p = (ks < 2) ? p0 : p1; const int s = ks & 1;
            u32x4 pw; pw.x = pk2(p[8 * s + 0], p[8 * s + 1]); pw.y = pk2(p[8 * s + 2], p[8 * s + 3]); pw.z = pk2(p[8 * s + 4], p[8 * s + 5]); pw.w = pk2(p[8 * s + 6], p[8 * s + 7]);
            const bf16x8 pa = __builtin_bit_cast(bf16x8, pw);
#pragma unroll
            for (int d0 = 0; d0 < 2; ++d0) {
                const s16x4 lo = VTR(vb + d0 * V_H1 + ks * 1024), hh = VTR(vb + d0 * V_H1 + ks * 1024 + 512);
                const bf16x8 vf = (bf16x8){lo[0], lo[1], lo[2], lo[3], hh[0], hh[1], hh[2], hh[3]};
                if (d0 == 0) st.o0 = __builtin_amdgcn_mfma_f32_32x32x16_bf16(pa, vf, st.o0, 0, 0, 0);
                else         st.o1 = __builtin_amdgcn_mfma_f32_32x32x16_bf16(pa, vf, st.o1, 0, 0, 0);
            }
        }
    }
}

struct ImpSums { float G0[4], S0[4], G1[4], S1[4]; };
template <bool PRODUCE, bool IMP>
__device__ __forceinline__ void nsa_exp_qk(const LAS unsigned char* nbuf, const LAS unsigned char* qfl, unsigned qxs, unsigned qxm_t, unsigned klw0, unsigned klw1, unsigned tbw, unsigned neg1w,
                                           f32x16& n0, f32x16& n1, BrState& st, f32x16& p0, f32x16& p1, u32x4 (&pw)[4], ImpSums& im, int lane) {
    const int i = lane & 31, hi = lane >> 5;
    const LAS unsigned char* kp = nbuf + i * KPB;
    if (PRODUCE) {
        const bf16x8 qx = __builtin_bit_cast(bf16x8, ((u32x4){qxs, qxs, qxm_t, 0u}));
        const bf16x8 kx0 = __builtin_bit_cast(bf16x8, ((u32x4){klw0, tbw, neg1w, 0u})), kx1 = __builtin_bit_cast(bf16x8, ((u32x4){klw1, tbw, neg1w, 0u}));
        const f32x16 zero16 = {0.f, 0.f, 0.f, 0.f, 0.f, 0.f, 0.f, 0.f, 0.f, 0.f, 0.f, 0.f, 0.f, 0.f, 0.f, 0.f};
        n0 = __builtin_amdgcn_mfma_f32_32x32x16_bf16(kx0, qx, zero16, 0, 0, 0);
        n1 = __builtin_amdgcn_mfma_f32_32x32x16_bf16(kx1, qx, zero16, 0, 0, 0);
    }
    float rs = 0.f;
#pragma unroll
    for (int d0 = 0; d0 < 4; ++d0) {
        if (PRODUCE) {
            const int ko = ((2 * d0 + hi) ^ (i & 7)) << 4;
            const bf16x8 k0 = *(const LAS bf16x8*)(kp + ko), k1 = *(const LAS bf16x8*)(kp + 32 * KPB + ko);
            const bf16x8 qd = *(const LAS bf16x8*)(qfl + d0 * 1024);
            n0 = __builtin_amdgcn_mfma_f32_32x32x16_bf16(k0, qd, n0, 0, 0, 0);
            n1 = __builtin_amdgcn_mfma_f32_32x32x16_bf16(k1, qd, n1, 0, 0, 0);
        }
        const float a0 = fexp2(p0[4 * d0]), a1 = fexp2(p0[4 * d0 + 1]), a2 = fexp2(p0[4 * d0 + 2]), a3 = fexp2(p0[4 * d0 + 3]);
        const float b0 = fexp2(p1[4 * d0]), b1 = fexp2(p1[4 * d0 + 1]), b2 = fexp2(p1[4 * d0 + 2]), b3 = fexp2(p1[4 * d0 + 3]);
        const float ga = (a0 + a1) + (a2 + a3), gb = (b0 + b1) + (b2 + b3);
        rs += ga + gb;
        if (IMP) { im.G0[d0] = ga; im.S0[d0] = a3; im.G1[d0] = gb; im.S1[d0] = b3; }
        const unsigned w0 = pk2(a0, a1), w1 = pk2(a2, a3), v0 = pk2(b0, b1), v1 = pk2(b2, b3);
        if ((d0 & 1) == 0) { pw[d0 >> 1].x = w0; pw[d0 >> 1].y = w1; pw[2 + (d0 >> 1)].x = v0; pw[2 + (d0 >> 1)].y = v1; }
        else               { pw[d0 >> 1].z = w0; pw[d0 >> 1].w = w1; pw[2 + (d0 >> 1)].z = v0; pw[2 + (d0 >> 1)].w = v1; }
        __builtin_amdgcn_sched_barrier(0);
    }
    st.l += rs;
}
template <bool PV>
__device__ __forceinline__ void nsa_pv(const LAS unsigned char* buf, BrState& st, const u32x4 (&pw)[4], int lane) {
    if (!PV) return;
    const int hi = lane >> 5;
    const LAS unsigned char* vb = buf + NB_K + (4 * hi + ((lane & 15) >> 2)) * 64 + 32 * ((lane >> 4) & 1) + 8 * (lane & 3);
#pragma unroll
    for (int ks = 0; ks < 4; ++ks) {
        const bf16x8 pa = __builtin_bit_cast(bf16x8, pw[ks]);
#pragma unroll
        for (int d0 = 0; d0 < 2; ++d0) {
            const s16x4 lo = VTR(vb + d0 * V_H1 + ks * 1024), hh = VTR(vb + d0 * V_H1 + ks * 1024 + 512);
            const bf16x8 vf = (bf16x8){lo[0], lo[1], lo[2], lo[3], hh[0], hh[1], hh[2], hh[3]};
            if (d0 == 0) st.o0 = __builtin_amdgcn_mfma_f32_32x32x16_bf16(pa, vf, st.o0, 0, 0, 0);
            else         st.o1 = __builtin_amdgcn_mfma_f32_32x32x16_bf16(pa, vf, st.o1, 0, 0, 0);
        }
        __builtin_amdgcn_sched_barrier(0);
    }
}

__device__ __forceinline__ int bit128(const LAS unsigned* m, int j) { return (int)((m[j >> 5] >> (j & 31)) & 1u); }
__device__ __forceinline__ int next_below(const LAS unsigned* m, int j) { for (int k = j - 1; k >= 0; --k) if ((m[k >> 5] >> (k & 31)) & 1u) return k; return -1; }

struct NsaCtx {
    int qt, g, t, tloc, qloc, head, w, lane; const bf16_t* Zb;
    LAS unsigned char* lds; LAS float* imp; LAS float* wsf;
};
__device__ __forceinline__ void nsa_importance(const NsaCtx& C, const ImpSums& im, int cur) {
    const int i = C.lane & 31, hi = C.lane >> 5;
    float G0[4], G1[4], S0[4], S1[4];
#pragma unroll
    for (int k = 0; k < 4; ++k) { G0[k] = quad_sum(im.G0[k]); G1[k] = quad_sum(im.G1[k]); S0[k] = quad_sum(im.S0[k]); S1[k] = quad_sum(im.S1[k]); }
    float P0[4], P1[4];
#pragma unroll
    for (int k = 0; k < 4; ++k) { P0[k] = xor32f(S0[k]); P1[k] = xor32f(S1[k]); }
    if ((i & 3) == 0) {
        LAS float* row = C.imp + C.qloc * 128 + 16 * cur + hi;
#pragma unroll
        for (int k = 0; k < 4; ++k) {
            const float prev0 = hi ? P0[k] : (k == 0 ? 0.f : P0[k - 1]);
            const float prev1 = hi ? P1[k] : (k == 0 ? P0[3] : P1[k - 1]);
            row[2 * k] = G0[k] + prev0;
            row[8 + 2 * k] = G1[k] + prev1;
        }
        if (hi == 1 && 16 * (cur + 1) < 128) row[15] += S1[3];
    }
}
template <int KIND, int PRE>
__device__ __forceinline__ void nsa_branch(Frame& F, const NsaCtx& C, const LAS unsigned char* qf, const bf16_t* Kg, const bf16_t* Vg, size_t pitch,
                                           int first, int lo, const LAS unsigned* um, const LAS unsigned* wm, const LAS unsigned* qm, int cfull, int climit, BrState& st) {
    constexpr bool PV = (KIND != 1), TRACK = (KIND != 2), CMP = (KIND == 1 || KIND == 2);
    const int lane = C.lane, w = C.w, qt = C.qt;
    const int ln_ = opaque_lane(lane), hi_ = ln_ >> 5, i_ = ln_ & 31;
    unsigned qxs; { const float s2_ = fexp2(-(float)(4 * C.g + (i_ & 3) + 1)) * LOG2E; const unsigned sh_ = f2bf(s2_); const unsigned sl_ = f2bf(s2_ - bf2f((unsigned short)sh_)); qxs = hi_ ? 0u : (sh_ | (sl_ << 16)); }
    const unsigned neg1w = hi_ ? 0u : 0xBF80BF80u; const unsigned maskw = hi_ ? 0u : 0x00007E96u;
    const unsigned klw0 = hi_ ? 0u : (f2bf((float)(CMP ? 16 * i_ : i_)) * 0x10001u), klw1 = hi_ ? 0u : (f2bf((float)(CMP ? 16 * (i_ + 32) : (i_ + 32))) * 0x10001u);
#define SEQ_NEXT(c) ((c) < 0 ? -1 : (KIND == 3 ? next_below(um, (c)) : (((c) - 1 >= lo) ? (c) - 1 : -1)))
#define TILE_NEED(c) (KIND == 3 ? bit128(wm, (c)) : 1)
#define TILE_MODE(c) (KIND == 0 ? (((c) == qt) ? 1 : (((c) == qt - 8) ? 2 : 0)) : (CMP ? ((64 * (c) + 63 <= cfull) ? 0 : 1) : (((c) == qt) ? 1 : 0)))
#define TILE_LIM(c) (CMP ? (climit - 64 * (c)) : C.tloc)
#define TILE_TBW(c) (hi_ ? 0u : (f2bf((float)((CMP ? 1024 : 64) * (c))) * 0x10001u))
#define TILE_QXM(c) ((KIND == 3) ? (bit128(qm, (c)) ? st.qxm : maskw) : st.qxm)
#define SLOT(s) (C.lds + (s) * NB_BUF)
    f32x16 pA0, pA1, pB0, pB1;
    int c0 = first, c1 = SEQ_NEXT(c0), c2 = SEQ_NEXT(c1), s0 = 0;
    if (PRE == 0) { __syncthreads();
        stage_dma<PV>(SLOT(0), Kg, Vg, pitch, 64L * c0, w, lane); }
    if (PRE < 2 && c1 >= 0) stage_dma<PV>(SLOT(1), Kg, Vg, pitch, 64L * c1, w, lane);
    __syncthreads();
    if (TILE_NEED(c0)) nsa_qk(SLOT(0), qf, qxs, TILE_QXM(c0), klw0, klw1, TILE_TBW(c0), neg1w, pA0, pA1, lane);
#define NSA_STEP(P0, P1, N0, N1) do { \
        const int s1_ = (s0 == 2) ? 0 : s0 + 1, s2_ = (s1_ == 2) ? 0 : s1_ + 1; \
        if (c2 >= 0) stage_dma<PV>(SLOT(s2_), Kg, Vg, pitch, 64L * c2, w, lane); \
        const bool need0_ = TILE_NEED(c0) != 0; const int cn_ = (c1 >= 0) ? c1 : c0;     \
        if (need0_) { \
            u32x4 pw_[4]; ImpSums im_; \
            nsa_prep<PV, TRACK>(TILE_MODE(c0), TILE_LIM(c0), st, P0, P1, lane, C.wsf); \
            __builtin_amdgcn_sched_barrier(0); \
            nsa_exp_qk<true, KIND == 2>(SLOT(s1_), qf, qxs, TILE_QXM(cn_), klw0, klw1, TILE_TBW(cn_), neg1w, N0, N1, st, P0, P1, pw_, im_, lane); \
            nsa_pv<PV>(SLOT(s0), st, pw_, lane); \
            if (KIND == 2) nsa_importance(C, im_, c0); \
        } else nsa_qk(SLOT(s1_), qf, qxs, TILE_QXM(cn_), klw0, klw1, TILE_TBW(cn_), neg1w, N0, N1, lane); \
        __syncthreads(); \
        c0 = c1; c1 = c2; c2 = SEQ_NEXT(c2); s0 = s1_; } while (0)
    for (;;) {
        NSA_STEP(pA0, pA1, pB0, pB1); if (c0 < 0) break;
        NSA_STEP(pB0, pB1, pA0, pA1); if (c0 < 0) break;
    }
#undef NSA_STEP
#undef SEQ_NEXT
#undef TILE_NEED
#undef TILE_MODE
#undef TILE_LIM
#undef TILE_TBW
#undef TILE_QXM
#undef SLOT
}
#if !defined(EMU)
#define SUBT_BEGIN() unsigned long long st_t0_ = 0; if (PROBE_K >= 20 && blockIdx.x == 0 && F.tid == 0) st_t0_ = __builtin_amdgcn_s_memrealtime()
#define SUBT_END(i) do { if (PROBE_K >= 20 && blockIdx.x == 0 && F.tid == 0) { const unsigned long long t1_ = __builtin_amdgcn_s_memrealtime(); F.MISC[300 + (i)] += (unsigned)(t1_ - st_t0_); st_t0_ = t1_; } } while (0)
#else
#define SUBT_BEGIN() ((void)0)
#define SUBT_END(i) ((void)0)
#endif
__device__ __forceinline__ void nsa_task(Frame& F, int task) {
    constexpr int NQT = SEQ / 64;
    const int qt = task % NQT, g = (task / NQT) % NG, b = task / (NQT * NG);
    const int t0 = 64 * qt, w = F.wave;
    const bf16_t* Zb = (const bf16_t*)(F.ws + WS_ZB) + (size_t)b * SEQ * ZP;
    LAS float* imp = (LAS float*)(F.lds + A_IMP);
    LAS unsigned short* selm = (LAS unsigned short*)(F.lds + A_SEL);
    LAS unsigned* uniw = (LAS unsigned*)(F.lds + A_UNI);
#define SECTION_LANE() const int lane = opaque_lane(F.lane), i = lane & 31, hi = lane >> 5, ql = i >> 2, qloc = 8 * w + ql, t = t0 + qloc, head = 4 * g + (i & 3); \
        LAS float* wsf = (LAS float*)(F.lds + A_WSF) + w * 32; LAS unsigned char* qf = F.lds + A_QF + w * 4096 + lane * 16; \
        NsaCtx C; C.qt = qt; C.g = g; C.t = t; C.tloc = qloc; C.qloc = qloc; C.head = head; C.w = w; C.lane = lane; C.Zb = Zb; C.lds = F.lds; C.imp = imp; C.wsf = wsf; \
        LAS unsigned* ya = (LAS unsigned*)(F.lds + A_Y) + w * 1024 + hi * 128 + i; (void)ya; (void)head; (void)t
    const LAS unsigned* zz = (const LAS unsigned*)(F.lds + A_UNI);
#define INIT_ST(st) do { st.mref = 0.f; st.l = 0.f; st.has = 0; st.qxm = 0u; _Pragma("unroll") for (int r = 0; r < 16; ++r) { st.o0[r] = 0.f; st.o1[r] = 0.f; } } while (0)
#define ACC_PREP(st, gidx) float f_ = st.l + xor32f(st.l); { const float gate_ = ((const LAS float*)(F.lds + A_GATE))[w * 96 + i * 3 + gidx]; f_ = (f_ > 0.f) ? gate_ * __builtin_amdgcn_rcpf(f_) : 0.f; }     \
        wsf[i] = f_; WAVE_SYNC(); FENCE(); const LAS float* wr_ = wsf + 4 * hi;
    const bf16_t* KCg = (const bf16_t*)(F.ws + WS_KC) + (size_t)(b * NG + g) * NCP * 64;
    const bf16_t* VCg = (const bf16_t*)(F.ws + WS_VC) + (size_t)(b * NG + g) * NCP * 64;
    const int nct = (t0 + 63 >= 31) ? (((t0 + 63 - 31) >> 4) / 64 + 1) : 0;
#define NSA_PRELOAD_CMP(WV) do { if (nct > 0) { stage_dma<WV>(F.lds, KCg, VCg, 64, 64L * (nct - 1), w, lane); if (nct > 1) stage_dma<WV>(F.lds + NB_BUF, KCg, VCg, 64, 64L * (nct - 2), w, lane); } } while (0)
    bool sel_pre = false;
    SUBT_BEGIN();
    {
        SECTION_LANE();
        __syncthreads();
        stage_dma<true>(F.lds, Zb + ZC_KW + g * 64, Zb + ZC_VW + g * 64, ZP, 64L * qt, w, lane);
        if (qt - 1 >= ((qt - 8 > 0) ? qt - 8 : 0)) stage_dma<true>(F.lds + NB_BUF, Zb + ZC_KW + g * 64, Zb + ZC_VW + g * 64, ZP, 64L * (qt - 1), w, lane);
        for (int idx = F.tid; idx < 64 * 128; idx += NTHREADS) imp[idx] = 0.f;
#pragma unroll
        for (int d0 = 0; d0 < 4; ++d0) { const u32x4 raw = *(const u32x4*)(Zb + (size_t)t * ZP + ZC_Q + head * 64 + 16 * d0 + 8 * hi);
            const float sc = 0.125f * LOG2E; u32x4 o;
            o.x = pk2(bflo(raw.x) * sc, bfhi(raw.x) * sc); o.y = pk2(bflo(raw.y) * sc, bfhi(raw.y) * sc); o.z = pk2(bflo(raw.z) * sc, bfhi(raw.z) * sc); o.w = pk2(bflo(raw.w) * sc, bfhi(raw.w) * sc);
            *(LAS u32x4*)(qf + d0 * 1024) = o; }
        if (hi == 0) {
#pragma unroll
            for (int k = 0; k < 3; ++k) ((LAS float*)(F.lds + A_GATE))[w * 96 + i * 3 + k] = sigmoidf_(bf2f(Zb[(size_t)t * ZP + ZC_GL + head * 3 + k]));
        }
    }
    {
        SECTION_LANE();
        BrState st; INIT_ST(st);
        nsa_branch<0, 2>(F, C, qf, Zb + ZC_KW + g * 64, Zb + ZC_VW + g * 64, ZP, qt, (qt - 8 > 0) ? qt - 8 : 0, zz, zz, zz, 0, 0, st);
        NSA_PRELOAD_CMP(false);
        ACC_PREP(st, 2)
#pragma unroll
        for (int r = 0; r < 16; ++r) { const int c_ = (r & 3) + 8 * (r >> 2); const float a_ = wr_[c_]; ya[c_ * 32] = pk2(a_ * st.o0[r], a_ * st.o1[r]); }
        WAVE_SYNC(); FENCE();
    }
    SUBT_END(1);
    {
        SECTION_LANE();
        const bf16_t* Kg = KCg; const bf16_t* Vg = VCg;
        const int cfull = (t0 >= 31) ? ((t0 - 31) >> 4) : -1;
        const int climit = (t >= 31) ? ((t - 31) >> 4) : -1;
        if (nct > 0) {
            BrState st; INIT_ST(st);
            nsa_branch<1, 2>(F, C, qf, Kg, Vg, 64, nct - 1, 0, zz, zz, zz, cfull, climit, st);
            NSA_PRELOAD_CMP(true);
            SUBT_END(2);
            const float ltot = st.l + xor32f(st.l);
            float meff; const unsigned wfin = ref_words(st.mref + ((ltot > 0.f) ? __builtin_log2f(ltot) : 0.f), meff);
            BrState s2; INIT_ST(s2); s2.qxm = hi ? 0u : wfin;
            nsa_branch<2, 2>(F, C, qf, Kg, Vg, 64, nct - 1, 0, zz, zz, zz, cfull, climit, s2);
            stage_dma<true>(F.lds, Zb + ZC_KS + g * 64, Zb + ZC_VS + g * 64, ZP, 64L * qt, w, lane);
            sel_pre = true;
            s2.l = 0.5f;
            ACC_PREP(s2, 0)
#pragma unroll
            for (int r = 0; r < 16; ++r) { const int c_ = (r & 3) + 8 * (r >> 2); const float a_ = wr_[c_]; const unsigned y_ = ya[c_ * 32]; ya[c_ * 32] = pk2(bflo(y_) + a_ * s2.o0[r], bfhi(y_) + a_ * s2.o1[r]); }
            WAVE_SYNC(); FENCE();
        }
    }
    if (!sel_pre) stage_dma<true>(F.lds, Zb + ZC_KS + g * 64, Zb + ZC_VS + g * 64, ZP, 64L * qt, w, F.lane);
    __syncthreads();
    SUBT_END(3);
    {
        const int lane = opaque_lane(F.lane);
        const int q8 = lane >> 3, sub = lane & 7, qq = 8 * w + q8;
        unsigned key[16];
#pragma unroll
        for (int e = 0; e < 16; ++e) { const int j = 16 * sub + e; const bool valid = (j <= qt) && (j < NBLK);
            unsigned kk = valid ? (__builtin_bit_cast(unsigned, imp[qq * 128 + j]) + 1u) : 0u;
            if (valid && (j == 0 || j == qt || j == qt - 1)) kk = 0x7F000000u;
            key[e] = kk; }
        unsigned thr = 0u;
        for (int bit = 30; bit >= 0; --bit) { const unsigned cand = thr | (1u << bit); int c = 0;
#pragma unroll
            for (int e = 0; e < 16; ++e) c += (key[e] >= cand) ? 1 : 0;
            c = red8_add(c);
            if (c >= NSEL) thr = cand; }
        int ngt = 0, tl = 0;
#pragma unroll
        for (int e = 0; e < 16; ++e) { ngt += (key[e] > thr) ? 1 : 0; tl += (key[e] == thr) ? 1 : 0; }
        ngt = red8_add(ngt);
        int sc = tl;
#pragma unroll
        for (int d = 1; d < 8; d <<= 1) { const int o = __shfl(sc, (lane - d) & 63); if (sub >= d) sc += o; }
        int before = sc - tl; const int need = (thr == 0u) ? 0 : (NSEL - ngt);
        unsigned m16 = 0u;
#pragma unroll
        for (int e = 0; e < 16; ++e) { if (key[e] > thr) m16 |= 1u << e; else if (key[e] == thr) { if (before < need) m16 |= 1u << e; ++before; } }
        selm[qq * 8 + sub] = (unsigned short)m16;
        unsigned um = m16; um |= __shfl_xor(um, 8); um |= __shfl_xor(um, 16); um |= __shfl_xor(um, 32);
        if (q8 == 0) ((LAS unsigned short*)uniw)[w * 8 + sub] = (unsigned short)um;
    }
    __syncthreads();
    SUBT_END(4);
    {
        SECTION_LANE();
        BrState st; INIT_ST(st);
        if (F.tid < 4) { unsigned u = 0u; for (int ww = 0; ww < 8; ++ww) u |= uniw[ww * 4 + F.tid]; uniw[32 + F.tid] = u; }
        __syncthreads();
        const LAS unsigned* um = uniw + 32; const LAS unsigned* wm = uniw + w * 4; const LAS unsigned* qm = (const LAS unsigned*)selm + qloc * 4;
        nsa_branch<3, 1>(F, C, qf, Zb + ZC_KS + g * 64, Zb + ZC_VS + g * 64, ZP, qt, 0, um, wm, qm, 0, 0, st);
        ACC_PREP(st, 1)
        bf16_t* ym = (bf16_t*)(F.ws + WS_YMIX) + ((size_t)b * SEQ + t0 + 8 * w + hi) * DM + 512 + 4 * g * 64 + i;
#pragma unroll
        for (int r = 0; r < 16; ++r) { const int c_ = (r & 3) + 8 * (r >> 2); const float a_ = wr_[c_]; const unsigned y_ = ya[c_ * 32]; bf16_t* op = ym + (c_ >> 2) * DM + (c_ & 3) * 64;
            const unsigned o_ = pk2(bflo(y_) + a_ * st.o0[r], bfhi(y_) + a_ * st.o1[r]); op[0] = (bf16_t)(o_ & 0xffffu); op[32] = (bf16_t)(o_ >> 16); }
        WAVE_SYNC(); FENCE();
    }
    SUBT_END(5);
#undef ACC_PREP
#undef INIT_ST
#undef SECTION_LANE
#undef NSA_PRELOAD_CMP
}

__device__ __forceinline__ void argmax16(float& v, int& idx) {
#ifdef EMU
    for (int o = 1; o < 16; o <<= 1) { const float ov = __shfl_xor(v, o); const int oi = __shfl_xor(idx, o); if (ov > v || (ov == v && oi < idx)) { v = ov; idx = oi; } }
#else
#define AM_STEP(ctrl) do { const float ov = __builtin_bit_cast(float, __builtin_amdgcn_update_dpp(0, __builtin_bit_cast(int, v), ctrl, 0xF, 0xF, true)); \
        const int oi = __builtin_amdgcn_update_dpp(0, idx, ctrl, 0xF, 0xF, true); if (ov > v || (ov == v && oi < idx)) { v = ov; idx = oi; } } while (0)
    AM_STEP(0xB1); AM_STEP(0x4E); AM_STEP(0x141); AM_STEP(0x140);
#undef AM_STEP
#endif
}
template <bool SHADOW>
__device__ __forceinline__ void router_task(Frame& F, int task) {
    const int row0 = 32 * task;
    LAS float* Hs = (LAS float*)F.lds;
    const float* mod = (const float*)(F.ws + WS_MOD);
    const float* X0 = F.in[I_X]; const bf16_t* MIX = (const bf16_t*)(F.ws + WS_MIX);
    unsigned char* H2 = (unsigned char*)(F.ws + WS_H2);
    const float* g = F.in[I_GFFN];
    {
        const int b = row0 / SEQ;
        const float* mb = mod + (size_t)b * 6144;
#pragma unroll
        for (int rb = 0; rb < 2; ++rb) {
            f32x4 v[2][4]; u32x2 mw[2][4];
#pragma unroll
            for (int rr = 0; rr < 2; ++rr) { const size_t ro = (size_t)(row0 + 4 * F.wave + 2 * rb + rr) * DM; const f32x4* xr = (const f32x4*)(X0 + ro) + F.lane; const u32x2* mr = (const u32x2*)(MIX + ro) + F.lane;
#pragma unroll
                for (int j = 0; j < 4; ++j) { v[rr][j] = xr[64 * j]; mw[rr][j] = mr[64 * j]; } }
#pragma unroll
            for (int rr = 0; rr < 2; ++rr)
#pragma unroll
                for (int j = 0; j < 4; ++j) v[rr][j] += *(const f32x4*)(mb + 2 * 1024 + 4 * F.lane + 256 * j) * (f32x4){bflo(mw[rr][j].x), bfhi(mw[rr][j].x), bflo(mw[rr][j].y), bfhi(mw[rr][j].y)};
#pragma unroll
            for (int rr = 0; rr < 2; ++rr) {
                const int lr = 4 * F.wave + 2 * rb + rr, m = row0 + lr;
                float s = 0.f;
#pragma unroll
                for (int j = 0; j < 4; ++j) s += (v[rr][j][0] * v[rr][j][0] + v[rr][j][1] * v[rr][j][1]) + (v[rr][j][2] * v[rr][j][2] + v[rr][j][3] * v[rr][j][3]);
                const float rinv = __builtin_amdgcn_rsqf(wave_sum(s) * (1.0f / DM) + EPS);
                unsigned* o4 = (unsigned*)(H2 + (size_t)m * DM) + F.lane;
#pragma unroll
                for (int j = 0; j < 4; ++j) { const int c = 4 * F.lane + 256 * j;
                    const f32x4 h = v[rr][j] * rinv * (*(const f32x4*)(g + c) * (*(const f32x4*)(mb + 4 * 1024 + c) + 1.0f)) + *(const f32x4*)(mb + 3 * 1024 + c);
                    o4[64 * j] = pk4_fp8(h[0] * F8_ACT_SCALE, h[1] * F8_ACT_SCALE, h[2] * F8_ACT_SCALE, h[3] * F8_ACT_SCALE);
#pragma unroll
                    for (int e = 0; e < 4; ++e) Hs[(c + e) * 33 + lr] = h[e]; }
                __builtin_amdgcn_sched_barrier(0);
            }
        }
    }
    const int i = F.lane & 31, hi = F.lane >> 5;
    const float* WR = F.in[I_WR];
    __builtin_amdgcn_sched_barrier(0);
    float wr[32];
#pragma unroll
    for (int ks = 0; ks < 32; ++ks) wr[ks] = WR[(128 * F.wave + 2 * ks + hi) * 32 + i];
    __syncthreads();
    f32x16 acc;
#pragma unroll
    for (int r = 0; r < 16; ++r) acc[r] = 0.f;
    float wr2[32];
#pragma unroll
    for (int ks = 0; ks < 32; ++ks) wr2[ks] = WR[(128 * F.wave + 2 * (ks + 32) + hi) * 32 + i];
    __builtin_amdgcn_sched_barrier(0);
#pragma unroll
    for (int q4 = 0; q4 < 4; ++q4) {
#pragma unroll
        for (int ks = 8 * q4; ks < 8 * q4 + 8; ++ks) acc = __builtin_amdgcn_mfma_f32_32x32x2f32(Hs[(128 * F.wave + 2 * ks + hi) * 33 + i], wr[ks], acc, 0, 0, 0);
        __builtin_amdgcn_sched_barrier(0);
    }
#pragma unroll
    for (int q4 = 0; q4 < 4; ++q4) {
#pragma unroll
        for (int ks = 8 * q4; ks < 8 * q4 + 8; ++ks) acc = __builtin_amdgcn_mfma_f32_32x32x2f32(Hs[(128 * F.wave + 2 * (ks + 32) + hi) * 33 + i], wr2[ks], acc, 0, 0, 0);
        __builtin_amdgcn_sched_barrier(0);
    }
    __syncthreads();
    LAS float* Ls = (LAS float*)F.lds;
    LAS float* Lg = Ls + 8 * 1024;
    LAS unsigned* hist = (LAS unsigned*)(Lg + 32 * 33);
#pragma unroll
    for (int r = 0; r < 16; ++r) Ls[F.wave * 1024 + crow(r, hi) * 32 + i] = acc[r];
    if (F.tid < 64) hist[F.tid] = 0u;
    __syncthreads();
    const int tk = F.tid >> 4, sub = F.tid & 15;
    float l0 = F.in[I_BR][sub], l1 = F.in[I_BR][sub + 16];
#pragma unroll
    for (int w = 0; w < 8; ++w) { l0 += Ls[w * 1024 + tk * 32 + sub]; l1 += Ls[w * 1024 + tk * 32 + sub + 16]; }
    int be[4]; float bv[4];
#pragma unroll
    for (int k = 0; k < 4; ++k) { float v; int id;
        if (l0 >= l1) { v = l0; id = sub; } else { v = l1; id = sub + 16; }
        argmax16(v, id);
        be[k] = id; bv[k] = v;
        if (id == sub) l0 = -INFINITY;
        if (id == sub + 16) l1 = -INFINITY; }
    unsigned rank[4] = {0u, 0u, 0u, 0u};
    {
        float sum = 0.f; const float mx0 = bv[0];
#pragma unroll
        for (int k = 0; k < 4; ++k) { bv[k] = fexp2((bv[k] - mx0) * LOG2E); sum += bv[k]; }
        const float rs = 1.0f / sum;
#pragma unroll
        for (int k = 0; k < 4; ++k) bv[k] *= rs;
    }
    if (sub == 0) {
#pragma unroll
        for (int k = 0; k < 4; ++k) rank[k] = atomicAdd((unsigned*)&hist[be[k]], 1u);
    }
    __syncthreads();
    if (F.tid < 32) { const unsigned c = hist[F.tid]; hist[32 + F.tid] = c ? atomicAdd(F.ctl + (SHADOW ? CW_CNT2 : CW_CNT) + 64 * F.tid, c) : 0u; }
    __syncthreads();
    if (sub == 0) {
        const int tok = row0 + tk;
        const size_t sh_ = SHADOW ? WS_SHADOW : 0;
        int* lists = (int*)(F.ws + sh_ + WS_LISTS); int* tope = (int*)(F.ws + sh_ + WS_TOPE); float* topw = (float*)(F.ws + sh_ + WS_TOPW); int* topp = (int*)(F.ws + sh_ + WS_TOPP);
#pragma unroll
        for (int k = 0; k < 4; ++k) { const int pos = (int)(hist[32 + be[k]] + rank[k]);
            lists[(size_t)be[k] * T + pos] = tok; tope[tok * 4 + k] = be[k]; topw[tok * 4 + k] = bv[k]; topp[tok * 4 + k] = pos; }
    }
    __syncthreads();
}

__device__ __forceinline__ void moe_tables(Frame& F) {
    if (F.tid < 64) {
        const int e = F.lane & 31;
        const unsigned c = __hip_atomic_load(F.ctl + CW_CNT + 64 * e, __ATOMIC_RELAXED, __HIP_MEMORY_SCOPE_AGENT);
        const unsigned tl = (c + 255u) / 256u;
        unsigned incl = tl;
#pragma unroll
        for (int d = 1; d < 32; d <<= 1) { const unsigned o = __shfl(incl, (F.lane - d) & 63); if (e >= d) incl += o; }
        if (F.lane < 32) { F.MISC[MW_CNT + e] = c; F.MISC[MW_TPFX + e] = incl - tl; F.MISC[MW_ROFF + e] = (incl - tl) * 256u;
            if (e == 31) { F.MISC[MW_TPFX + NE] = incl; F.MISC[MW_ROFF + NE] = incl * 256u; } }
    }
    __syncthreads();
}

__device__ __forceinline__ void final_rows(Frame& F) {
    const int gw = F.vcu * NWAVES + F.wave, NGW = F.G * NWAVES;
    const float* mod = (const float*)(F.ws + WS_MOD);
    const float* X0 = F.in[I_X]; const bf16_t* MIX = (const bf16_t*)(F.ws + WS_MIX);
    const bf16_t* YD = (const bf16_t*)(F.ws + WS_YD);
    const int* tope = (const int*)(F.ws + WS_TOPE); const float* topw = (const float*)(F.ws + WS_TOPW); const int* topp = (const int*)(F.ws + WS_TOPP);
    const float* gf = F.in[I_GFIN];
    int m = gw;
    u32x4 ne = (u32x4){0u, 0u, 0u, 0u}, np = ne; f32x4 nw = (f32x4){0.f, 0.f, 0.f, 0.f}; f32x4 nx[4]; u32x2 nm[4];
    if (m < T) { ne = *(const u32x4*)(tope + m * 4); np = *(const u32x4*)(topp + m * 4); nw = *(const f32x4*)(topw + m * 4);
#pragma unroll
        for (int j = 0; j < 4; ++j) { nx[j] = ((const f32x4*)(X0 + (size_t)m * DM) + F.lane)[64 * j]; nm[j] = ((const u32x2*)(MIX + (size_t)m * DM) + F.lane)[64 * j]; } }
    for (; m < T; m += NGW) {
        const int b = m / SEQ;
        const u32x4 ce = ne, cp = np; const f32x4 cw = nw; f32x4 cx[4];
#pragma unroll
        for (int j = 0; j < 4; ++j) { const f32x4 g1 = *(const f32x4*)(mod + (size_t)b * 6144 + 2 * 1024 + 4 * F.lane + 256 * j);
            cx[j] = nx[j] + g1 * (f32x4){bflo(nm[j].x), bfhi(nm[j].x), bflo(nm[j].y), bfhi(nm[j].y)}; }
        size_t yrow[4];
#pragma unroll
        for (int k = 0; k < 4; ++k) yrow[k] = (size_t)(F.MISC[MW_ROFF + ce[k]] + cp[k]) * DM;
        u32x2 yw[4][4];
#pragma unroll
        for (int j = 0; j < 4; ++j)
#pragma unroll
            for (int k = 0; k < 4; ++k) yw[j][k] = *(const u32x2*)(YD + yrow[k] + 4 * F.lane + 256 * j);
        const int mn = m + NGW;
        if (mn < T) { ne = *(const u32x4*)(tope + mn * 4); np = *(const u32x4*)(topp + mn * 4); nw = *(const f32x4*)(topw + mn * 4);
#pragma unroll
            for (int j = 0; j < 4; ++j) { nx[j] = ((const f32x4*)(X0 + (size_t)mn * DM) + F.lane)[64 * j]; nm[j] = ((const u32x2*)(MIX + (size_t)mn * DM) + F.lane)[64 * j]; } }
        f32x4 v[4]; float s = 0.f;
#pragma unroll
        for (int j = 0; j < 4; ++j) { const int c = 4 * F.lane + 256 * j;
            f32x4 mo = (f32x4){0.f, 0.f, 0.f, 0.f};
#pragma unroll
            for (int k = 0; k < 4; ++k) mo += cw[k] * (f32x4){bflo(yw[j][k].x), bfhi(yw[j][k].x), bflo(yw[j][k].y), bfhi(yw[j][k].y)};
            const f32x4 gt = *(const f32x4*)(mod + (size_t)b * 6144 + 5 * 1024 + c);
            v[j] = cx[j] + gt * mo;
            s += (v[j][0] * v[j][0] + v[j][1] * v[j][1]) + (v[j][2] * v[j][2] + v[j][3] * v[j][3]); }
        const float rinv = __builtin_amdgcn_rsqf(wave_sum(s) * (1.0f / DM) + EPS);
        f32x4* orow = (f32x4*)(F.out + (size_t)m * DM) + F.lane;
#pragma unroll
        for (int j = 0; j < 4; ++j) orow[64 * j] = v[j] * rinv * *(const f32x4*)(gf + 4 * F.lane + 256 * j);
    }
}

constexpr int N_PHASES = 10;
#define REP0 1
#define REPB 1
#define REP1 1
#define REP6 1
#define REP2 1
#define REP3 1
#define REP4 1
#define REP5 1
#define REP7 1
#define REP8 1
#define REP9 1
__global__ void __launch_bounds__(NTHREADS, 2) mk_fwd(Args args) {
#ifdef EMU
    unsigned char* lds = emu_blk->lds;
#else
    extern __shared__ __attribute__((aligned(16))) unsigned char lds[];
#endif
    Frame F;
    F.lds = (LAS unsigned char*)lds;
    F.MISC = (volatile LAS unsigned*)(F.lds + MISC_OFF);
    F.tid = threadIdx.x; F.lane = F.tid & 63; F.wave = __builtin_amdgcn_readfirstlane(F.tid >> 6);
    F.G = gridDim.x; { const int bx = blockIdx.x; F.vcu = (F.G % 8 == 0) ? (bx % 8) * (F.G / 8) + bx / 8 : bx; }
    F.ws = args.ws; F.ctl = (unsigned*)(args.ws + WS_CTL); F.out = args.out;
#pragma unroll
    for (int k = 0; k < 24; ++k) F.in[k] = args.in[k];
    for (int u = F.tid; u < (LDS_BYTES - MISC_OFF) / 4; u += NTHREADS) F.MISC[u] = 0u;
    __syncthreads();
    XcdBarrier bar = xcd_barrier_post(F.ctl + CW_BAR, F.MISC + 8);
    const int lo = args.ph_lo, hi = args.ph_hi;
#ifndef EMU
#define STAMP(k) do { if (PROBE_K >= 0 && blockIdx.x == 0 && F.tid == 0) { const unsigned long long t_ = __builtin_amdgcn_s_memrealtime(); F.MISC[((k) >= 20 ? 360 : 256) + 2 * (k)] = (unsigned)t_; F.MISC[((k) >= 20 ? 361 : 257) + 2 * (k)] = (unsigned)(t_ >> 32); } } while (0)
#else
#define STAMP(k) ((void)0)
#endif
    STAMP(0);
#ifndef PH_MASK
#define PH_MASK 0xffff
#endif
#define IN(k) (((PH_MASK >> (k)) & 1) && lo <= (k) && (k) < hi)
#define SEAM(k) do { if (IN(k) && IN((k) + 1)) { xcd_barrier(bar); if (REPB > 1) xcd_barrier(bar); } } while (0)

    if (IN(0)) { p0_prologue(F); if (REP0 > 1) p0_prologue(F); }
    STAMP(20); SEAM(0); STAMP(1);
#ifndef EMU
    if (IN(0) && IN(1)) {
        if (F.tid == 0) { unsigned ok = 1u; for (int j = 0; j < 8; ++j) ok &= (xb_ld(F.ctl + CW_BAR + XB_XCNT(j)) == (unsigned)(F.G / 8)) ? 1u : 0u;
            F.MISC[12] = (ok && bar.x < 8u) ? (bar.x * (unsigned)(F.G / 8) + F.MISC[10]) : (unsigned)F.vcu; }
        __syncthreads();
        F.vcu = (int)F.MISC[12];
    }
#endif
    if (IN(1)) { norm_rows(F, F.in[I_X], F.in[I_GMIX], 0, 1, (bf16_t*)(F.ws + WS_HB)); if (REP1 > 1) norm_rows(F, F.in[I_X], F.in[I_GMIX], 0, 1, (bf16_t*)(F.ws + WS_HB)); }
    STAMP(21); SEAM(1); STAMP(2);
    if (IN(2)) {
        {
        pg8::DenseProb P{(const char*)(F.ws + WS_HB), (const char*)(F.ws + WS_WINT), DM * 2};
        pg8::DenseOrder S; S.init(T, ZP, F.G, (F.G % 8 == 0) ? (F.vcu % (F.G / 8)) * 8 + F.vcu / (F.G / 8) : (int)blockIdx.x);
        EpiZ E{(bf16_t*)(F.ws + WS_ZB)};
        pg8::gemm_phase<false>(F.lds, P, S, E);
        if (p2_fill_items(F) && S.c >= 128) {
            LAS float* scr = (LAS float*)(F.lds + 8192 + F.wave * 16384);
            const int base = P0_NITEMS - p2_fill_items(F) + (S.c - 128) * P2_FILL_PER_CU;
            for (int k = F.wave; k < P2_FILL_PER_CU; k += NWAVES) p0_item(F, scr, base + k);
        }
        }
        if (REP2 > 1) {
        pg8::DenseProb P{(const char*)(F.ws + WS_HB), (const char*)(F.ws + WS_WINT), DM * 2};
        pg8::DenseOrder S; S.init(T, ZP, F.G, (F.G % 8 == 0) ? (F.vcu % (F.G / 8)) * 8 + F.vcu / (F.G / 8) : (int)blockIdx.x);
        EpiZ E{(bf16_t*)(F.ws + WS_ZB)};
        pg8::gemm_phase<false>(F.lds, P, S, E);
        }
    }
    STAMP(22); SEAM(2); STAMP(3);
    if (IN(3)) {
        constexpr int NGM = BATCH * (SEQ / GMC) * GMG, NCT = 2 * BATCH * NG * (NCP / 32);
        for (int rep = 0; rep < (REP3 > 1 ? 2 : 1); ++rep) {
            if (F.G == 2 * NCT && NGM == 8 * NCT) {
                if (F.vcu < NCT) { cmp_tile(F, F.vcu); gmlp_run(F, 3 * F.vcu, 1, 3); }
                else gmlp_run(F, 3 * NCT + 5 * (F.vcu - NCT), 1, 5);
            } else { for (int it = F.vcu; it < NCT; it += F.G) cmp_tile(F, it);
                     const int first = ((F.vcu - NCT) % F.G + F.G) % F.G; gmlp_run(F, first, F.G, (NGM - first + F.G - 1) / F.G); }
        }
    }
    STAMP(23); SEAM(3); STAMP(4);
    if (IN(4)) {
        constexpr int NQT_ = SEQ / 64, NPAIR = BATCH * NQT_;
        for (int rep = 0; rep < (REP4 > 1 ? 2 : 1); ++rep)
        for (int pr = F.vcu; pr < NPAIR; pr += F.G) { const int b_ = pr / NQT_, x_ = pr % NQT_;
            for (int k2 = 0; k2 < 2; ++k2) nsa_task(F, k2 ? (b_ * NG + 0) * NQT_ + x_ : (b_ * NG + 1) * NQT_ + (NQT_ - 1 - x_)); }
    }
    STAMP(24); SEAM(4); STAMP(5);
    if (IN(5)) {
        {
        pg8::DenseProb P{(const char*)(F.ws + WS_YMIX), (const char*)(F.ws + WS_WOUTT), DM * 2};
        pg8::DenseOrder S; S.init(T, DM, F.G, (F.G % 8 == 0) ? (F.vcu % (F.G / 8)) * 8 + F.vcu / (F.G / 8) : (int)blockIdx.x);
        EpiMix E{(bf16_t*)(F.ws + WS_MIX)};
        pg8::gemm_phase<false>(F.lds, P, S, E);
        }
        if (REP5 > 1) {
        pg8::DenseProb P{(const char*)(F.ws + WS_YMIX), (const char*)(F.ws + WS_WOUTT), DM * 2};
        pg8::DenseOrder S; S.init(T, DM, F.G, (F.G % 8 == 0) ? (F.vcu % (F.G / 8)) * 8 + F.vcu / (F.G / 8) : (int)blockIdx.x);
        EpiMix E{(bf16_t*)(F.ws + WS_MIX)};
        pg8::gemm_phase<false>(F.lds, P, S, E);
        }
    }
    STAMP(25); SEAM(5); STAMP(6);
    if (IN(6)) { for (int it = F.vcu; it < T / 32; it += F.G) router_task<false>(F, it); if (REP6 > 1) for (int it = F.vcu; it < T / 32; it += F.G) router_task<true>(F, it); }
    STAMP(26); SEAM(6); STAMP(7);
    if (IN(7)) {
        {
        moe_tables(F);
        MoeProb1 P{(const char*)(F.ws + WS_H2), (const char*)(F.ws + WS_WGUT), (const int*)(F.ws + WS_LISTS), F.in[I_BGU], F.MISC + MW_CNT, DM};
        pg8::MoeOrder S{F.MISC + MW_TPFX, 8, F.G, F.vcu, 0};
        EpiAct E{(unsigned char*)(F.ws + WS_ACT), F.in[I_BGU], F.MISC + MW_ROFF};
        pg8::gemm_phase<true>(F.lds, P, S, E);
        }
        if (REP7 > 1) {
        moe_tables(F);
        MoeProb1 P{(const char*)(F.ws + WS_H2), (const char*)(F.ws + WS_WGUT), (const int*)(F.ws + WS_LISTS), F.in[I_BGU], F.MISC + MW_CNT, DM};
        pg8::MoeOrder S{F.MISC + MW_TPFX, 8, F.G, F.vcu, 0};
        EpiAct E{(unsigned char*)(F.ws + WS_ACT), F.in[I_BGU], F.MISC + MW_ROFF};
        pg8::gemm_phase<true>(F.lds, P, S, E);
        }
    }
    STAMP(27); SEAM(7); STAMP(8);
    if (IN(8)) {
        {
        moe_tables(F);
        MoeProb2 P{(const char*)(F.ws + WS_ACT), (const char*)(F.ws + WS_WDNT), F.in[I_BDN], F.MISC + MW_ROFF, DFF};
        pg8::MoeOrder S{F.MISC + MW_TPFX, 4, F.G, F.vcu, 0};
        EpiYd E{(bf16_t*)(F.ws + WS_YD), F.in[I_BDN], F.MISC + MW_ROFF};
        pg8::gemm_phase<true>(F.lds, P, S, E);
        }
        if (REP8 > 1) {
        moe_tables(F);
        MoeProb2 P{(const char*)(F.ws + WS_ACT), (const char*)(F.ws + WS_WDNT), F.in[I_BDN], F.MISC + MW_ROFF, DFF};
        pg8::MoeOrder S{F.MISC + MW_TPFX, 4, F.G, F.vcu, 0};
        EpiYd E{(bf16_t*)(F.ws + WS_YD), F.in[I_BDN], F.MISC + MW_ROFF};
        pg8::gemm_phase<true>(F.lds, P, S, E);
        }
    }
    STAMP(28); SEAM(8); STAMP(9);
    if (IN(9)) { moe_tables(F); final_rows(F); if (REP9 > 1) final_rows(F); }
#ifndef EMU
    if (PROBE_K >= 0 && blockIdx.x == 0 && F.tid == 0) {
        STAMP(10);
        unsigned long long a_ = 0, b_ = 0;
        if (PROBE_K == 19) { a_ = ((unsigned long long)F.MISC[257] << 32) | F.MISC[256]; b_ = ((unsigned long long)F.MISC[257 + 20] << 32) | F.MISC[256 + 20]; }
        else if (PROBE_K < 20) { a_ = ((unsigned long long)F.MISC[257 + 2 * (PROBE_K % 20)] << 32) | F.MISC[256 + 2 * (PROBE_K % 20)];
                            b_ = ((unsigned long long)F.MISC[259 + 2 * (PROBE_K % 20)] << 32) | F.MISC[258 + 2 * (PROBE_K % 20)]; }
        else if (PROBE_K >= 30 && PROBE_K < 40) { a_ = ((unsigned long long)F.MISC[361 + 2 * (20 + PROBE_K - 30)] << 32) | F.MISC[360 + 2 * (20 + PROBE_K - 30)]; b_ = ((unsigned long long)F.MISC[257 + 2 * (PROBE_K - 30 + 1)] << 32) | F.MISC[256 + 2 * (PROBE_K - 30 + 1)]; }
        else if (PROBE_K >= 50) b_ = F.MISC[300 + 6 + (PROBE_K % 10)];
        else b_ = F.MISC[300 + (PROBE_K - 20)];
        const unsigned long long t0_ = __builtin_amdgcn_s_memrealtime();
        while (__builtin_amdgcn_s_memrealtime() - t0_ < (b_ - a_)) __builtin_amdgcn_s_sleep(8);
    }
#endif
#undef IN
#undef SEAM
}

#ifdef EMU
struct EmuDump { const char* name; size_t off; size_t bytes; };
EmuDump emu_dumps[] = {
    {"mod", WS_MOD, (size_t)BATCH * 6144 * 4}, {"bpe", WS_BPE, 512 * 4}, {"wint", WS_WINT, (size_t)ZP * DM * 2}, {"hb", WS_HB, (size_t)T * DM * 2},
    {"zb", WS_ZB, (size_t)T * ZP * 2}, {"kc", WS_KC, (size_t)BATCH * NG * NCP * 64 * 2}, {"vc", WS_VC, (size_t)BATCH * NG * NCP * 64 * 2},
    {"ymix", WS_YMIX, (size_t)T * DM * 2}, {"mix", WS_MIX, (size_t)T * DM * 2}, {"h2", WS_H2, (size_t)T * DM * 2},
    {"tope", WS_TOPE, (size_t)T * 16}, {"topw", WS_TOPW, (size_t)T * 16}, {"topp", WS_TOPP, (size_t)T * 16}, {"ctl", WS_CTL, CTL_ZERO_BYTES},
};
int emu_ndumps = sizeof(emu_dumps) / sizeof(emu_dumps[0]);
size_t emu_ws_bytes = WS_END;
int emu_out_elems = T * DM;
#endif

extern "C" void kernel_launch(void* const* d_in, const int* in_sizes, int n_in, void* d_out, int out_size, void* d_ws, size_t ws_size, hipStream_t stream) {
    (void)in_sizes; (void)out_size; (void)ws_size;
    Args a{};
    for (int i = 0; i < 24 && i < n_in; ++i) a.in[i] = (const float*)d_in[i];
    a.out = (float*)d_out; a.ws = (unsigned char*)d_ws;
#ifndef EMU
    (void)hipMemsetAsync((char*)d_ws + WS_CTL, 0, CTL_ZERO_BYTES, stream);
#endif
#ifdef EMU
    int plo = 0, phi = N_PHASES;
    if (const char* e = getenv("EMU_PH_LO")) plo = atoi(e);
    if (const char* e = getenv("EMU_PH_HI")) phi = atoi(e);
    if (plo == 0) (void)hipMemsetAsync((char*)d_ws + WS_CTL, 0, CTL_ZERO_BYTES, stream);
    const int grid = emu_num_cus();
    for (int ph = plo; ph < phi; ++ph) { a.ph_lo = ph; a.ph_hi = ph + 1; Args ac = a; fprintf(stderr, "EMU phase %d\n", ph);
        emu_launch(grid, NTHREADS, LDS_BYTES, [ac]() { mk_fwd(ac); }); }
#else
    static int grid = 0;
    if (grid == 0) {
        int dev = 0, cus = 0, per_cu = 0;
        (void)hipGetDevice(&dev);
        (void)hipDeviceGetAttribute(&cus, hipDeviceAttributeMultiprocessorCount, dev);
        (void)hipFuncSetAttribute((const void*)mk_fwd, hipFuncAttributeMaxDynamicSharedMemorySize, LDS_BYTES);
        (void)hipOccupancyMaxActiveBlocksPerMultiprocessor(&per_cu, (const void*)mk_fwd, NTHREADS, LDS_BYTES);
        if (per_cu < 1) fprintf(stderr, "kernel_launch: occupancy query reports %d blocks/CU\n", per_cu);
        grid = cus;
        (void)hipGetLastError();
    }
    a.ph_lo = 0; a.ph_hi = N_PHASES;
    void* kargs[] = {&a};
    hipError_t e = hipLaunchCooperativeKernel((const void*)mk_fwd, dim3(grid), dim3(NTHREADS), kargs, LDS_BYTES, stream);
    if (e != hipSuccess) fprintf(stderr, "cooperative launch failed: %s (grid %d)\n", hipGetErrorString(e), grid);
#endif
}
```

```cpp
#ifndef EMU
#include <hip/hip_runtime.h>
#endif
#include <cstdio>
#include <cstdint>

#ifndef CFG_BATCH
#define CFG_BATCH 2
#endif
#ifndef CFG_SEQ
#define CFG_SEQ 8192
#endif

#define PROBE_K -1
#ifdef EMU
#define NOSPEC() ((void)0)
#define LAS
#define ASM_VMCNT(n) ((void)0)
#define ASM_LGKMCNT(n) ((void)0)
#define WAVE_SYNC() emu_wave_sync()
#define FENCE() ((void)0)
#else
#define NOSPEC() asm volatile("; rare path" ::: "memory")
#define LAS __attribute__((address_space(3)))
#define ASM_VMCNT(n) asm volatile("s_waitcnt vmcnt(" #n ")" ::: "memory")
#define ASM_LGKMCNT(n) asm volatile("s_waitcnt lgkmcnt(" #n ")" ::: "memory")
#define WAVE_SYNC() asm volatile("s_waitcnt lgkmcnt(0)" ::: "memory")
#define FENCE() asm volatile("" ::: "memory")
#endif

typedef unsigned short bf16_t;
typedef short bf16x8 __attribute__((ext_vector_type(8)));
typedef short s16x4 __attribute__((ext_vector_type(4)));
typedef float f32x4 __attribute__((ext_vector_type(4)));
typedef float f32x16 __attribute__((ext_vector_type(16)));
typedef unsigned u32x4 __attribute__((ext_vector_type(4)));
typedef unsigned u32x2 __attribute__((ext_vector_type(2)));

constexpr int NWAVES = 8, NTHREADS = 512;
constexpr int BATCH = CFG_BATCH, SEQ = CFG_SEQ, DM = 1024, T = BATCH * SEQ;
constexpr int GMW = 512, GMG = 8, GMC = 128;
constexpr int NH = 8, NG = 2, NR = 4, HD = 64;
constexpr int INC = 2328, ZP = 2560;
constexpr int ZC_U = 0, ZC_V = 512, ZC_Q = 1024, ZC_KC = 1536, ZC_VC = 1664, ZC_KS = 1792, ZC_VS = 1920, ZC_KW = 2048, ZC_VW = 2176, ZC_GL = 2304;
constexpr int NCMP = SEQ / 16 - 1, NCP = SEQ / 16;
constexpr int NBLK = SEQ / 64;
constexpr int NSEL = NBLK < 16 ? NBLK : 16;
constexpr int NE = 32, TOPK = 4, DFF = 1024;
constexpr int TK = T * TOPK;
constexpr int ACT_ROWS = TK + NE * 256;
constexpr float EPS = 1e-6f;
constexpr float LOG2E = 1.4426950408889634f;
constexpr float F8_ACT_SCALE = 8.0f, F8_W_SCALE = 64.0f, F8_ACC_SCALE = 1.0f / 512.0f;

constexpr size_t MiB = 1u << 20;
constexpr size_t WS_CTL = 0, CTL_ZERO_BYTES = 192 * 1024;
constexpr size_t WS_MOD = 1 * MiB;
constexpr size_t WS_BPE = 1 * MiB + 512 * 1024;
constexpr size_t WS_LISTS = 2 * MiB;
constexpr size_t WS_TOPE = 4 * MiB;
constexpr size_t WS_TOPW = 4 * MiB + 512 * 1024;
constexpr size_t WS_TOPP = 5 * MiB;
constexpr size_t WS_WSBF = 6 * MiB;
constexpr size_t WS_W2KT = 6 * MiB + 512 * 1024;
constexpr size_t WS_W2VT = WS_W2KT + 64 * 1024;
constexpr size_t WS_W1KT = 7 * MiB;
constexpr size_t WS_W1VT = 8 * MiB;
constexpr size_t WS_WOUTT = 9 * MiB;
constexpr size_t WS_WINT = 11 * MiB;
constexpr size_t WS_KC = 16 * MiB;
constexpr size_t WS_VC = 16 * MiB + 512 * 1024;
constexpr size_t WS_WGUT = 32 * MiB;
constexpr size_t WS_WDNT = 160 * MiB;
constexpr size_t WS_HB = 224 * MiB;
constexpr size_t WS_H2 = 256 * MiB;
constexpr size_t WS_ZB = 288 * MiB;
constexpr size_t WS_YMIX = 368 * MiB;
constexpr size_t WS_MIX = 400 * MiB;
constexpr size_t WS_ACT = 464 * MiB;
constexpr size_t WS_YD = 608 * MiB;
constexpr size_t WS_YACC = 768 * MiB;
constexpr size_t WS_END = 804 * MiB;
constexpr int CW_BAR = 4096;
constexpr int CW_CNT = 16384;
constexpr int CW_CNT2 = 32768;
constexpr size_t WS_SHADOW = 752 * MiB;

constexpr int RING_BYTES = 131072;
constexpr int MISC_OFF = 155648;
constexpr int LDS_BYTES = 159744;
constexpr int MW_CNT = 16, MW_TPFX = 64, MW_ROFF = 128;

__device__ __forceinline__ unsigned f2bf(float f) { unsigned u = __builtin_bit_cast(unsigned, f); return (u + 0x7fffu + ((u >> 16) & 1u)) >> 16; }
#ifdef EMU
__device__ __forceinline__ unsigned pk2(float lo, float hi) { return f2bf(lo) | (f2bf(hi) << 16); }
#else
typedef float f32x2_t __attribute__((ext_vector_type(2))); typedef __bf16 bf16x2_t __attribute__((ext_vector_type(2)));
__device__ __forceinline__ unsigned pk2(float lo, float hi) { f32x2_t v = {lo, hi}; bf16x2_t bb = __builtin_convertvector(v, bf16x2_t); return __builtin_bit_cast(unsigned, bb); }
#endif
__device__ __forceinline__ unsigned pk4_fp8(float a, float b, float c, float d) {
    a = fminf(fmaxf(a, -448.f), 448.f); b = fminf(fmaxf(b, -448.f), 448.f); c = fminf(fmaxf(c, -448.f), 448.f); d = fminf(fmaxf(d, -448.f), 448.f);
    int w = 0; w = __builtin_amdgcn_cvt_pk_fp8_f32(a, b, w, false); w = __builtin_amdgcn_cvt_pk_fp8_f32(c, d, w, true); return (unsigned)w;
}
__device__ __forceinline__ unsigned pk4_fp8_nc(float a, float b, float c, float d) {
    int w = 0; w = __builtin_amdgcn_cvt_pk_fp8_f32(a, b, w, false); w = __builtin_amdgcn_cvt_pk_fp8_f32(c, d, w, true); return (unsigned)w;
}
typedef int v8i_t __attribute__((ext_vector_type(8)));
typedef int v4i_t __attribute__((ext_vector_type(4)));
__device__ __forceinline__ float bf2f(unsigned short h) { return __builtin_bit_cast(float, (unsigned)h << 16); }
__device__ __forceinline__ float bflo(unsigned w) { return __builtin_bit_cast(float, w << 16); }
__device__ __forceinline__ float bfhi(unsigned w) { return __builtin_bit_cast(float, w & 0xffff0000u); }
__device__ __forceinline__ float fexp2(float x) { return __builtin_amdgcn_exp2f(x); }
__device__ __forceinline__ float gelu_tanh(float x) {
    const float y2 = 1.5957691216057308f * (x + 0.044715f * x * x * x);
    return x * __builtin_amdgcn_rcpf(1.0f + fexp2(-y2 * LOG2E));
}
__device__ __forceinline__ float sigmoidf_(float x) { return __builtin_amdgcn_rcpf(1.0f + fexp2(-x * LOG2E)); }
__device__ __forceinline__ float wave_sum(float v) {
#pragma unroll
    for (int o = 1; o < 64; o <<= 1) v += __shfl_xor(v, o);
    return v;
}
__device__ __forceinline__ int crow(int r, int hi) { return (r & 3) + 8 * (r >> 2) + 4 * hi; }

#define XB_TMO      128
#define XB_XCNT(j)  (256  + 64 * (j))
#define XB_XSUB(j)  (1280 + 64 * (j))
#define XB_XGEN(j)  (2304 + 64 * (j))
#define XB_TOP      3328
#define XB_TOPGEN   3392
#define XCD_BAR_WORDS 3456
#define XB_SPIN_CAP (1u << 18)
struct XcdBarrier { unsigned* bar; unsigned x; volatile LAS unsigned* st; };
#ifndef EMU
__device__ __forceinline__ unsigned xb_ld(unsigned* p)              { return __hip_atomic_load(p, __ATOMIC_RELAXED, __HIP_MEMORY_SCOPE_AGENT); }
__device__ __forceinline__ unsigned xb_add(unsigned* p, unsigned v) { return __hip_atomic_fetch_add(p, v, __ATOMIC_RELAXED, __HIP_MEMORY_SCOPE_AGENT); }
__device__ __forceinline__ unsigned xb_xcc_id() { return (unsigned)__builtin_amdgcn_s_getreg((3 << 11) | 20) & 0xFu; }
#define XB_SPIN(cond, bar) do { unsigned _sp = 0; while (cond) { __builtin_amdgcn_s_sleep(1); \
    if ((++_sp & 255u) == 0u) { if (xb_ld(&(bar)[XB_TMO])) break; if (_sp > XB_SPIN_CAP) { atomicAdd(&(bar)[XB_TMO], 1u); break; } } } } while (0)
__device__ __forceinline__ XcdBarrier xcd_barrier_post(unsigned* bar, volatile LAS unsigned* st) {
    XcdBarrier b; b.bar = bar; b.x = xb_xcc_id(); b.st = st;
    if (threadIdx.x == 0) st[2] = xb_add(&bar[XB_XCNT(b.x)], 1u);
    return b;
}
__device__ __forceinline__ void xcd_barrier_complete(unsigned* bar, unsigned x, unsigned& nloc, unsigned& nx) {
    const unsigned G = gridDim.x * gridDim.y * gridDim.z;
    unsigned sum, cnt, mine, sp = 0u;
    for (;;) {
        sum = 0u; cnt = 0u; mine = 0u;
#pragma unroll
        for (unsigned j = 0; j < 16; ++j) { const unsigned c = xb_ld(&bar[XB_XCNT(j)]); sum += c; cnt += (c > 0u) ? 1u : 0u; mine = (j == x) ? c : mine; }
        if (sum == G) break;
        __builtin_amdgcn_s_sleep(1);
        if ((++sp & 255u) == 0u) { if (xb_ld(&bar[XB_TMO])) break; if (sp > XB_SPIN_CAP) { atomicAdd(&bar[XB_TMO], 1u); break; } }
    }
    nloc = mine > 0u ? mine : 1u; nx = cnt > 0u ? cnt : 1u;
}
__device__ __forceinline__ void xcd_barrier(const XcdBarrier& b) {
    asm volatile("s_waitcnt vmcnt(0)" ::: "memory");
    __syncthreads();
    if (threadIdx.x == 0) {
        unsigned* bar = b.bar;
        __builtin_amdgcn_s_waitcnt(0);
        unsigned nloc = b.st[0], nx = b.st[1];
        if (nloc == 0u) { xcd_barrier_complete(bar, b.x, nloc, nx); b.st[0] = nloc; b.st[1] = nx; }
        const unsigned old = xb_add(&bar[XB_XSUB(b.x)], 1u);
        const unsigned gen = old / nloc;
        if (old + 1u == (gen + 1u) * nloc) {
            __builtin_amdgcn_fence(__ATOMIC_RELEASE, "agent");
            asm volatile("s_waitcnt vmcnt(0)" ::: "memory");
            const unsigned og = xb_add(&bar[XB_TOP], 1u);
            const unsigned tg = og / nx;
            if (og + 1u == (tg + 1u) * nx) xb_add(&bar[XB_TOPGEN], 1u);
            else XB_SPIN(xb_ld(&bar[XB_TOPGEN]) == tg, bar);
            __builtin_amdgcn_fence(__ATOMIC_ACQUIRE, "agent");
            xb_add(&bar[XB_XGEN(b.x)], 1u);
            asm volatile("s_waitcnt vmcnt(0)" ::: "memory");
        } else {
            XB_SPIN(xb_ld(&bar[XB_XGEN(b.x)]) == gen, bar);
            __builtin_amdgcn_fence(__ATOMIC_ACQUIRE, "agent");
            asm volatile("s_waitcnt vmcnt(0)" ::: "memory");
        }
    }
    __syncthreads();
}
#else
__device__ __forceinline__ XcdBarrier xcd_barrier_post(unsigned* bar, volatile unsigned* st) { XcdBarrier b; b.bar = bar; b.x = 0; b.st = st; return b; }
__device__ __forceinline__ void xcd_barrier(const XcdBarrier&) { fprintf(stderr, "EMU: grid barrier inside a launch\n"); abort(); }
#endif

struct Args { const float* in[24]; float* out; unsigned char* ws; int ph_lo, ph_hi; };
enum { I_X = 0, I_C, I_WADA, I_BADA, I_GMIX, I_WIN, I_GMWS, I_GMBS, I_GMNG, I_PEK, I_W1K, I_W2K, I_PEV, I_W1V, I_W2V, I_WOUT, I_GFFN, I_WR, I_BR, I_WGU, I_BGU, I_WDN, I_BDN, I_GFIN };

struct Frame {
    LAS unsigned char* lds;
    volatile LAS unsigned* MISC;
    unsigned* ctl;
    unsigned char* ws;
    const float* in[24];
    float* out;
    int tid, lane, wave, vcu, G;
};

namespace pg8 {
constexpr int BM = 256, BK = 64, HALF = 128, HTB = HALF * BK * 2, STAGE_BYTES = 8 * HTB;
__device__ __forceinline__ int lds_byte(int r, int c) { const int st = (r >> 4) * 2 + (c >> 5), rr = r & 15, cc = c & 31, ob = rr * 64 + cc * 2; return st * 1024 + (ob ^ (((ob >> 9) & 1) << 5)); }
__device__ __forceinline__ void stage_rc(int b, int& R, int& C) { const int st = b / 1024, sb = b % 1024, swz = sb ^ (((sb >> 9) & 1) << 5); R = (st >> 1) * 16 + swz / 64; C = (st & 1) * 32 + (swz % 64) / 2; }
__device__ __forceinline__ int perm32(int rho) { const int n = rho >> 4, i = rho & 15; return 8 * (i >> 2) + 4 * n + (i & 3); }
struct Unit { int pm, pn, e; };

template <bool FP8, class Prob, class Sched, class Epi>
__device__ __forceinline__ void gemm_phase(LAS unsigned char* lds, const Prob& P, const Sched& S, const Epi& E) {
    const int tid = threadIdx.x, wid = __builtin_amdgcn_readfirstlane(tid >> 6), lane = tid & 63, wr = wid >> 2, wc = wid & 3, fr = lane & 15, fq = lane >> 4;
    const int KB = P.KB, nt = KB / 128;
    int Rr[2], Cc[2]; unsigned voffB[2];
#pragma unroll
    for (int i = 0; i < 2; ++i) { int R, C; stage_rc(tid * 16 + i * 8192, R, C); Rr[i] = R; Cc[i] = C; const int Rb = Epi::PERM ? ((R & ~31) + perm32(R & 31)) : R; voffB[i] = (unsigned)(Rb * KB + C * 2); }
    const size_t kstep = (size_t)(BK * 2);
    const size_t hstepB = (size_t)HALF * KB;
    const unsigned ldsw = (unsigned)wid * 1024u;
    const int aoff = lds_byte(wr * 64 + fr, fq * 8), boff = lds_byte(wc * 32 + fr, fq * 8);
#define PG8_SA(b, h) (((b) * 2 + (h)) * HTB)
#define PG8_SB(b, h) ((4 + (b) * 2 + (h)) * HTB)
#define PG8_STAGE(bufoff, gbase, voff) do { _Pragma("unroll") for (int _i = 0; _i < 2; ++_i) \
        __builtin_amdgcn_global_load_lds((const unsigned*)((const char*)(gbase) + (voff)[_i]), (LAS unsigned*)(lds + (bufoff) + ldsw + _i * 8192), 16, 0, 0); } while (0)
#define PG8_LD8(p) __builtin_shufflevector(*(const LAS v4i_t*)(p), *(const LAS v4i_t*)((p) + 1024), 0, 1, 2, 3, 4, 5, 6, 7)
#define PG8_LDA(dst, b, h) do { _Pragma("unroll") for (int m = 0; m < 4; ++m) dst[m] = PG8_LD8(lds + PG8_SA(b, h) + aoff + m * 2048); } while (0)
#define PG8_LDB(dst, b, h) do { _Pragma("unroll") for (int n = 0; n < 2; ++n) dst[n] = PG8_LD8(lds + PG8_SB(b, h) + boff + n * 2048); } while (0)
#define PG8_LO(x) __builtin_bit_cast(bf16x8, __builtin_shufflevector(x, x, 0, 1, 2, 3))
#define PG8_HI(x) __builtin_bit_cast(bf16x8, __builtin_shufflevector(x, x, 4, 5, 6, 7))
#ifdef EMU
#define PG8_MFMA_F8(c_, b_, a_) c_ = __builtin_amdgcn_mfma_scale_f32_16x16x128_f8f6f4(b_, a_, c_, 0, 0, 0, 0x7F7F7F7F, 0, 0x7F7F7F7F)
#else
#define PG8_MFMA_F8(c_, b_, a_) asm volatile("v_mfma_scale_f32_16x16x128_f8f6f4 %0, %1, %2, %0, %3, %3 op_sel_hi:[0,0,0]" : "+v"(c_) : "v"(b_), "v"(a_), "v"(f8one))
#endif
#define PG8_MMA(ai, bj, At, Bt) do { __builtin_amdgcn_s_setprio(1); \
        if (FP8) { _Pragma("unroll") for (int m = 0; m < 4; ++m) _Pragma("unroll") for (int n = 0; n < 2; ++n) PG8_MFMA_F8(acc[ai][bj][m][n], Bt[n], At[m]); } \
        else { _Pragma("unroll") for (int m = 0; m < 4; ++m) _Pragma("unroll") for (int n = 0; n < 2; ++n) { \
            acc[ai][bj][m][n] = __builtin_amdgcn_mfma_f32_16x16x32_bf16(PG8_LO(Bt[n]), PG8_LO(At[m]), acc[ai][bj][m][n], 0, 0, 0); \
            acc[ai][bj][m][n] = __builtin_amdgcn_mfma_f32_16x16x32_bf16(PG8_HI(Bt[n]), PG8_HI(At[m]), acc[ai][bj][m][n], 0, 0, 0); } } \
        __builtin_amdgcn_s_setprio(0); } while (0)
#define PG8_WAIT_V(n) ASM_VMCNT(n)
#define PG8_WAIT_L(n) ASM_LGKMCNT(n)
#define PG8_BAR __builtin_amdgcn_s_barrier()
#define PG8_SCHED __builtin_amdgcn_sched_barrier(0)
#ifndef EMU
    unsigned long long ge0_ = 0; const bool gprobe0_ = (PROBE_K / 10 == Epi::PID) && blockIdx.x == 0 && tid == 0;
    if (gprobe0_) ge0_ = __builtin_amdgcn_s_memrealtime();
#endif
    Unit cur, nxt; int ui = 0;
    if (!S.next(0, cur)) return;
    f32x4 acc[2][2][4][2];
#pragma unroll
    for (int a = 0; a < 2; ++a)
#pragma unroll
        for (int b = 0; b < 2; ++b)
#pragma unroll
            for (int m = 0; m < 4; ++m)
#pragma unroll
                for (int n = 0; n < 2; ++n) acc[a][b][m][n] = (f32x4){0.f, 0.f, 0.f, 0.f};
    v8i_t At[4], B0[2], B1[2];
    int f8one = 0x7F7F7F7F;
#ifndef EMU
    asm volatile("" : "+v"(f8one));
#endif
    (void)f8one;
    unsigned vA0[2], vA1[2], nA0[2], nA1[2];
#define PG8_SIDE(k) (lds + STAGE_BYTES + ((k) % 3) * 2048)
    if (Prob::SIDE) { P.side_issue(cur, PG8_SIDE(0), wid, lane); PG8_WAIT_V(0); PG8_BAR; }
#pragma unroll
    for (int i = 0; i < 2; ++i) { vA0[i] = P.a_rowoff(cur, Rr[i], PG8_SIDE(0)) + (unsigned)Cc[i] * 2u; vA1[i] = P.a_rowoff(cur, HALF + Rr[i], PG8_SIDE(0)) + (unsigned)Cc[i] * 2u; }
    const char* cA = P.a_base(cur); const char* cB = P.b_base(cur);
    PG8_STAGE(PG8_SB(0, 0), cB, voffB); PG8_STAGE(PG8_SB(0, 1), cB + hstepB, voffB); PG8_STAGE(PG8_SA(0, 0), cA, vA0); PG8_STAGE(PG8_SA(0, 1), cA, vA1);
    if (wr == 1) PG8_BAR;
    PG8_WAIT_V(2); PG8_BAR;
    PG8_STAGE(PG8_SB(1, 0), cB + kstep, voffB); PG8_STAGE(PG8_SA(1, 0), cA + kstep, vA0); PG8_STAGE(PG8_SB(1, 1), cB + hstepB + kstep, voffB);
    PG8_WAIT_V(6); PG8_BAR;
    for (;;) {
        const bool has_next = S.next(ui + 1, nxt);
        const char* nA = has_next ? P.a_base(nxt) : cA; const char* nB = has_next ? P.b_base(nxt) : cB;
        if (Prob::SIDE && has_next) P.side_issue(nxt, PG8_SIDE(ui + 1), wid, lane);
#pragma unroll
        for (int i = 0; i < 2; ++i) { nA0[i] = vA0[i]; nA1[i] = vA1[i]; }
        if (!Prob::SIDE && has_next) {
#pragma unroll
            for (int i = 0; i < 2; ++i) { nA0[i] = P.a_rowoff(nxt, Rr[i], PG8_SIDE(0)) + (unsigned)Cc[i] * 2u; nA1[i] = P.a_rowoff(nxt, HALF + Rr[i], PG8_SIDE(0)) + (unsigned)Cc[i] * 2u; }
        }
#ifndef EMU
        unsigned long long gt0_ = 0; const bool gprobe_ = (PROBE_K / 10 == Epi::PID) && blockIdx.x == 0 && tid == 0;
        if (gprobe_) { gt0_ = __builtin_amdgcn_s_memrealtime(); if (ui == 0) ((volatile LAS unsigned*)(lds + MISC_OFF))[300 + 8] += (unsigned)(gt0_ - ge0_); }
#endif
        for (int t = 0; t < nt; t += 2) {
            const bool last = (t == nt - 2);
            if (Prob::SIDE && has_next && t == nt - 4) {
#pragma unroll
                for (int i = 0; i < 2; ++i) { nA0[i] = P.a_rowoff(nxt, Rr[i], PG8_SIDE(ui + 1)) + (unsigned)Cc[i] * 2u; nA1[i] = P.a_rowoff(nxt, HALF + Rr[i], PG8_SIDE(ui + 1)) + (unsigned)Cc[i] * 2u; }
            }
            const char* a1 = cA + (size_t)(t + 1) * kstep;
            const char* a2 = last ? nA : cA + (size_t)(t + 2) * kstep; const char* b2 = last ? nB : cB + (size_t)(t + 2) * kstep;
            const char* a3 = a2 + kstep; const char* b3 = b2 + kstep;
            unsigned s0[2], s1[2];
#pragma unroll
            for (int i = 0; i < 2; ++i) { s0[i] = last ? nA0[i] : vA0[i]; s1[i] = last ? nA1[i] : vA1[i]; }
            PG8_LDB(B0, 0, 0); PG8_LDB(B1, 0, 1); PG8_SCHED; PG8_LDA(At, 0, 0); PG8_STAGE(PG8_SA(1, 1), a1, vA1);
            PG8_WAIT_V(8); PG8_WAIT_L(0); PG8_BAR; PG8_MMA(0, 0, At, B0); PG8_MMA(0, 1, At, B1); PG8_BAR; PG8_SCHED;
            PG8_LDA(At, 0, 1); PG8_STAGE(PG8_SB(0, 0), b2, voffB); PG8_STAGE(PG8_SB(0, 1), b2 + hstepB, voffB); PG8_STAGE(PG8_SA(0, 0), a2, s0);
            PG8_WAIT_V(8); PG8_WAIT_L(0); PG8_BAR; PG8_MMA(1, 0, At, B0); PG8_MMA(1, 1, At, B1); PG8_BAR; PG8_SCHED;
            PG8_LDB(B0, 1, 0); PG8_LDB(B1, 1, 1); PG8_SCHED; PG8_LDA(At, 1, 0); PG8_STAGE(PG8_SA(0, 1), a2, s1);
            PG8_WAIT_V(8); PG8_WAIT_L(0); PG8_BAR; PG8_MMA(0, 0, At, B0); PG8_MMA(0, 1, At, B1); PG8_BAR; PG8_SCHED;
            PG8_LDA(At, 1, 1); PG8_STAGE(PG8_SB(1, 0), b3, voffB); PG8_STAGE(PG8_SB(1, 1), b3 + hstepB, voffB); PG8_STAGE(PG8_SA(1, 0), a3, s0);
            PG8_WAIT_V(8); PG8_WAIT_L(0); PG8_BAR; PG8_MMA(1, 0, At, B0); PG8_MMA(1, 1, At, B1); PG8_BAR; PG8_SCHED;
        }
#ifndef EMU
        if (gprobe_) { const unsigned long long t1_ = __builtin_amdgcn_s_memrealtime(); ((volatile LAS unsigned*)(lds + MISC_OFF))[300 + 6] += (unsigned)(t1_ - gt0_); gt0_ = t1_; }
#endif
        if (wr == 0) PG8_BAR;
#ifndef EMU
        if (FP8) asm volatile("s_nop 15\n\ts_nop 15" ::: "memory");
#endif
        E(acc, cur, wr, wc, fr, fq, (const LAS float*)(PG8_SIDE(ui) + 1024));
        if (!has_next) break;
#pragma unroll
        for (int a = 0; a < 2; ++a)
#pragma unroll
            for (int b = 0; b < 2; ++b)
#pragma unroll
                for (int m = 0; m < 4; ++m)
#pragma unroll
                    for (int n = 0; n < 2; ++n) acc[a][b][m][n] = (f32x4){0.f, 0.f, 0.f, 0.f};
#ifndef EMU
        if (gprobe_) { const unsigned long long t1_ = __builtin_amdgcn_s_memrealtime(); ((volatile LAS unsigned*)(lds + MISC_OFF))[300 + 7] += (unsigned)(t1_ - gt0_); }
#endif
        cur = nxt; cA = nA; cB = nB; ++ui;
#pragma unroll
        for (int i = 0; i < 2; ++i) { vA0[i] = nA0[i]; vA1[i] = nA1[i]; }
        if (wr == 1) PG8_BAR;
    }
#ifndef EMU
    if (gprobe0_) ge0_ = __builtin_amdgcn_s_memrealtime();
#endif
    PG8_WAIT_V(0);
    PG8_BAR;
#ifndef EMU
    if (gprobe0_) ((volatile LAS unsigned*)(lds + MISC_OFF))[300 + 9] += (unsigned)(__builtin_amdgcn_s_memrealtime() - ge0_);
#endif
#undef PG8_SIDE
#undef PG8_SA
#undef PG8_SB
#undef PG8_STAGE
#undef PG8_LDA
#undef PG8_LDB
#undef PG8_MMA
#undef PG8_MFMA_F8
#undef PG8_LD8
#undef PG8_LO
#undef PG8_HI
#undef PG8_WAIT_V
#undef PG8_WAIT_L
#undef PG8_BAR
#undef PG8_SCHED
}

struct DenseOrder {
    int nM, nN, nwg, G, c;
    __device__ __forceinline__ void init(int M, int N, int G_, int c_) { nM = M / BM; nN = N / BM; nwg = nM * nN; G = G_; c = c_; }
    __device__ __forceinline__ bool next(int i, Unit& u) const {
        const long L = (long)i * G + c; if (L >= nwg) return false;
        int wgid = (int)L; { const int q = nwg / 8, r = nwg % 8, xcd = wgid % 8, off = wgid / 8; wgid = (xcd < r ? xcd * (q + 1) : r * (q + 1) + (xcd - r) * q) + off; }
        const int nig = 8 * nN, gid = wgid / nig, fm = gid * 8, gsz = (nM - fm) < 8 ? (nM - fm) : 8;
        u.pm = fm + ((wgid % nig) % gsz); u.pn = (wgid % nig) / gsz; u.e = 0; return true;
    }
};
struct DenseProb {
    static constexpr bool SIDE = false;
    const char* A; const char* Bt; int KB;
    __device__ __forceinline__ const char* a_base(const Unit& u) const { return A + (size_t)u.pm * BM * KB; }
    __device__ __forceinline__ unsigned a_rowoff(const Unit&, int r, const LAS unsigned char*) const { return (unsigned)(r * KB); }
    __device__ __forceinline__ const char* b_base(const Unit& u) const { return Bt + (size_t)u.pn * BM * KB; }
    __device__ __forceinline__ void side_issue(const Unit&, LAS unsigned char*, int, int) const {}
};
struct MoeOrder {
    volatile LAS unsigned* tpfx; int nN, G, c;
    mutable int ecur;
    __device__ __forceinline__ bool next(int i, Unit& u) const {
        const int L = i * G + c; const int total = (int)tpfx[NE] * nN; if (L >= total) return false;
        int e = ecur;
        if (L < (int)tpfx[e] * nN) e = 0;
        while (L >= (int)tpfx[e + 1] * nN) ++e;
        ecur = e;
        const int rem = L - (int)tpfx[e] * nN, tm = (int)tpfx[e + 1] - (int)tpfx[e];
        u.e = e; u.pm = rem % tm; u.pn = rem / tm; return true;
    }
};
}

struct EpiZ {
    static constexpr bool PERM = true; static constexpr int PID = 2;
    bf16_t* O;
    __device__ __forceinline__ void operator()(const f32x4 (&acc)[2][2][4][2], const pg8::Unit& u, int wr, int wc, int fr, int fq, const LAS float*) const {
        const int row0 = u.pm * 256 + wr * 64 + fr, col0 = u.pn * 256 + wc * 32 + 8 * fq;
#pragma unroll
        for (int ai = 0; ai < 2; ++ai)
#pragma unroll
            for (int m = 0; m < 4; ++m) { bf16_t* rowp = O + (size_t)(row0 + ai * 128 + m * 16) * ZP + col0;
#pragma unroll
                for (int bj = 0; bj < 2; ++bj) { const f32x4 v0 = acc[ai][bj][m][0], v1 = acc[ai][bj][m][1];
                    u32x4 w; w.x = pk2(v0[0], v0[1]); w.y = pk2(v0[2], v0[3]); w.z = pk2(v1[0], v1[1]); w.w = pk2(v1[2], v1[3]);
                    *(u32x4*)(rowp + bj * 128) = w; } }
    }
};
struct EpiMix {
    static constexpr bool PERM = true; static constexpr int PID = 5;
    bf16_t* O;
    __device__ __forceinline__ void operator()(const f32x4 (&acc)[2][2][4][2], const pg8::Unit& u, int wr, int wc, int fr, int fq, const LAS float*) const {
        const int row0 = u.pm * 256 + wr * 64 + fr, col0 = u.pn * 256 + wc * 32 + 8 * fq;
#pragma unroll
        for (int ai = 0; ai < 2; ++ai)
#pragma unroll
            for (int m = 0; m < 4; ++m) { bf16_t* rowp = O + (size_t)(row0 + ai * 128 + m * 16) * DM + col0;
#pragma unroll
                for (int bj = 0; bj < 2; ++bj) { const f32x4 v0 = acc[ai][bj][m][0], v1 = acc[ai][bj][m][1];
                    u32x4 w; w.x = pk2(v0[0], v0[1]); w.y = pk2(v0[2], v0[3]); w.z = pk2(v1[0], v1[1]); w.w = pk2(v1[2], v1[3]);
                    *(u32x4*)(rowp + bj * 128) = w; } }
    }
};
struct EpiAct {
    static constexpr bool PERM = true; static constexpr int PID = 7;
    unsigned char* O; const float* bgu; volatile LAS unsigned* roff;
    __device__ __forceinline__ void operator()(const f32x4 (&acc)[2][2][4][2], const pg8::Unit& u, int wr, int wc, int fr, int fq, const LAS float* sb) const {
        const int row0 = (int)roff[u.e] + u.pm * 256 + wr * 64 + fr, col0 = u.pn * 128 + wc * 32 + 8 * fq;
        const LAS float* bp = sb + 2 * (wc * 32 + 8 * fq);
        f32x4 bb[4];
#pragma unroll
        for (int j = 0; j < 4; ++j) bb[j] = *(const LAS f32x4*)(bp + 4 * j);
#pragma unroll
        for (int ai = 0; ai < 2; ++ai)
#pragma unroll
            for (int m = 0; m < 4; ++m) { float a8[8];
#pragma unroll
                for (int n = 0; n < 2; ++n)
#pragma unroll
                    for (int j = 0; j < 4; ++j) { const int cc = 4 * n + j;
                        float g = acc[ai][0][m][n][j] * F8_ACC_SCALE + bb[cc >> 1][(cc & 1) * 2], l = acc[ai][1][m][n][j] * F8_ACC_SCALE + bb[cc >> 1][(cc & 1) * 2 + 1];
                        g = fminf(g, 7.0f); l = fminf(fmaxf(l, -7.0f), 7.0f);
                        a8[cc] = (g * F8_ACT_SCALE) * __builtin_amdgcn_rcpf(1.0f + fexp2(g * (-1.702f * LOG2E))) * (l + 1.0f); }
                u32x2 w; w.x = pk4_fp8_nc(a8[0], a8[1], a8[2], a8[3]); w.y = pk4_fp8_nc(a8[4], a8[5], a8[6], a8[7]);
                *(u32x2*)(O + (size_t)(row0 + ai * 128 + m * 16) * DFF + col0) = w; }
    }
};
struct EpiYd {
    static constexpr bool PERM = true; static constexpr int PID = 8;
    bf16_t* O; const float* bdn; volatile LAS unsigned* roff;
    __device__ __forceinline__ void operator()(const f32x4 (&acc)[2][2][4][2], const pg8::Unit& u, int wr, int wc, int fr, int fq, const LAS float* sb) const {
        const int row0 = (int)roff[u.e] + u.pm * 256 + wr * 64 + fr, col0 = u.pn * 256 + wc * 32 + 8 * fq;
        f32x4 bv[2][2];
#pragma unroll
        for (int bj = 0; bj < 2; ++bj)
#pragma unroll
            for (int n = 0; n < 2; ++n) bv[bj][n] = *(const LAS f32x4*)(sb + wc * 32 + 8 * fq + bj * 128 + 4 * n);
#pragma unroll
        for (int ai = 0; ai < 2; ++ai)
#pragma unroll
            for (int m = 0; m < 4; ++m) { bf16_t* rowp = O + (size_t)(row0 + ai * 128 + m * 16) * DM + col0;
#pragma unroll
                for (int bj = 0; bj < 2; ++bj) { const f32x4 v0 = acc[ai][bj][m][0] * F8_ACC_SCALE + bv[bj][0], v1 = acc[ai][bj][m][1] * F8_ACC_SCALE + bv[bj][1];
                    u32x4 w; w.x = pk2(v0[0], v0[1]); w.y = pk2(v0[2], v0[3]); w.z = pk2(v1[0], v1[1]); w.w = pk2(v1[2], v1[3]);
                    *(u32x4*)(rowp + bj * 128) = w; } }
    }
};
struct MoeProb1 {
    static constexpr bool SIDE = true;
    const char* H2; const char* Bt; const int* lists; const float* bias; volatile LAS unsigned* cnt; int KB;
    __device__ __forceinline__ const char* a_base(const pg8::Unit&) const { return H2; }
    __device__ __forceinline__ unsigned a_rowoff(const pg8::Unit& u, int r, const LAS unsigned char* side) const { const int i = u.pm * 256 + r; const int tok = (i < (int)cnt[u.e]) ? ((const LAS int*)side)[r] : 0; return (unsigned)tok * 1024u; }
    __device__ __forceinline__ const char* b_base(const pg8::Unit& u) const { return Bt + ((size_t)u.e * 2048 + (size_t)u.pn * 256) * 1024; }
    __device__ __forceinline__ void side_issue(const pg8::Unit& u, LAS unsigned char* side, int wid, int lane) const {
        if (wid == 0) __builtin_amdgcn_global_load_lds((const unsigned*)(lists + (size_t)u.e * T + u.pm * 256 + lane * 4), (LAS unsigned*)side, 16, 0, 0);
        if (wid == 1) __builtin_amdgcn_global_load_lds((const unsigned*)(bias + (size_t)u.e * 2048 + u.pn * 256 + lane * 4), (LAS unsigned*)(side + 1024), 16, 0, 0);
    }
};
struct MoeProb2 {
    static constexpr bool SIDE = true;
    const char* A; const char* Bt; const float* bias; volatile LAS unsigned* roff; int KB;
    __device__ __forceinline__ const char* a_base(const pg8::Unit& u) const { return A + ((size_t)roff[u.e] + (size_t)u.pm * 256) * 1024; }
    __device__ __forceinline__ unsigned a_rowoff(const pg8::Unit&, int r, const LAS unsigned char*) const { return (unsigned)r * 1024u; }
    __device__ __forceinline__ const char* b_base(const pg8::Unit& u) const { return Bt + ((size_t)u.e * 1024 + (size_t)u.pn * 256) * 1024; }
    __device__ __forceinline__ void side_issue(const pg8::Unit& u, LAS unsigned char* side, int wid, int lane) const {
        if (wid == 1) __builtin_amdgcn_global_load_lds((const unsigned*)(bias + (size_t)u.e * 1024 + u.pn * 256 + lane * 4), (LAS unsigned*)(side + 1024), 16, 0, 0);
    }
};

template <int NB>
__device__ __forceinline__ void gemv_item(Frame& F, const float* vec, int vstride, const float* W, int K, int N, int n0, const float* bias, float* out, int ostride) {
    LAS float* red = (LAS float*)F.lds;
    const int col = n0 + F.lane, ks = K / NWAVES;
    float acc[NB];
#pragma unroll
    for (int b = 0; b < NB; ++b) acc[b] = 0.f;
    for (int k0 = F.wave * ks; k0 < (F.wave + 1) * ks; k0 += 32) {
        float wv[32];
#pragma unroll
        for (int j = 0; j < 32; ++j) wv[j] = __builtin_nontemporal_load(W + (size_t)(k0 + j) * N + col);
#pragma unroll
        for (int j = 0; j < 32; ++j)
#pragma unroll
            for (int b = 0; b < NB; ++b) acc[b] += vec[b * vstride + k0 + j] * wv[j]; }
#pragma unroll
    for (int b = 0; b < NB; ++b) red[(F.wave * NB + b) * 64 + F.lane] = acc[b];
    __syncthreads();
    if (F.wave == 0) {
#pragma unroll
        for (int b = 0; b < NB; ++b) { float s = bias ? bias[col] : 0.f;
            for (int w = 0; w < NWAVES; ++w) s += red[(w * NB + b) * 64 + F.lane];
            out[b * ostride + col] = s; }
    }
    __syncthreads();
}
template <int MAP>
__device__ __forceinline__ int t_rowmap(int n) {
    if (MAP == 0) return n;
    const int ac = n >> 1, bj = n & 1; return (ac >> 7) * 256 + bj * 128 + (ac & 127);
}
template <int MAP>
__device__ __forceinline__ void transpose_item(const float* W, int K, int Nsrc, int nblk, bf16_t* WT, LAS float* scr, int item, int lane) {
    const int kb = item / nblk, nb = item % nblk, k0 = 64 * kb, n0 = 32 * nb;
    const int nc = n0 + (lane & 31);
    float tv[32];
    if (nc < Nsrc) {
#pragma unroll
        for (int i = 0; i < 32; ++i) tv[i] = __builtin_nontemporal_load(W + (size_t)(k0 + 2 * i + (lane >> 5)) * Nsrc + nc);
    } else {
#pragma unroll
        for (int i = 0; i < 32; ++i) tv[i] = 0.f;
    }
#pragma unroll
    for (int i = 0; i < 32; ++i) scr[(2 * i + (lane >> 5)) * 33 + (lane & 31)] = tv[i];
    WAVE_SYNC(); FENCE();
    const int c = lane & 7;
#pragma unroll
    for (int j = 0; j < 4; ++j) { const int n = (lane >> 3) + 8 * j; const LAS float* s = scr + (8 * c) * 33 + n;
        u32x4 o; o.x = pk2(s[0 * 33], s[1 * 33]); o.y = pk2(s[2 * 33], s[3 * 33]); o.z = pk2(s[4 * 33], s[5 * 33]); o.w = pk2(s[6 * 33], s[7 * 33]);
        *(u32x4*)(WT + (size_t)t_rowmap<MAP>(n0 + n) * K + k0 + 8 * c) = o; }
    WAVE_SYNC(); FENCE();
}
template <int MAP>
__device__ __forceinline__ void transpose_item_f8(const float* W, int K, int Nsrc, int nblk, unsigned char* WT, LAS float* scr, int item, int lane, float scale) {
    const int kb = item / nblk, nb = item % nblk, k0 = 64 * kb, n0 = 32 * nb;
    const int nc = n0 + (lane & 31);
    (void)nc;
    f32x4 tv[8];
#pragma unroll
    for (int i = 0; i < 8; ++i) tv[i] = __builtin_nontemporal_load((const f32x4*)(W + (size_t)(k0 + 8 * i + (lane >> 3)) * Nsrc + n0 + 4 * (lane & 7)));
#pragma unroll
    for (int i = 0; i < 8; ++i) { LAS float* d = scr + (8 * i + (lane >> 3)) * 33 + 4 * (lane & 7);
        d[0] = tv[i][0] * scale; d[1] = tv[i][1] * scale; d[2] = tv[i][2] * scale; d[3] = tv[i][3] * scale; }
    WAVE_SYNC(); FENCE();
    const int c = lane & 7;
#pragma unroll
    for (int j = 0; j < 4; ++j) { const int n = (lane >> 3) + 8 * j; const LAS float* sp = scr + (8 * c) * 33 + n;
        u32x2 o; o.x = pk4_fp8(sp[0 * 33], sp[1 * 33], sp[2 * 33], sp[3 * 33]); o.y = pk4_fp8(sp[4 * 33], sp[5 * 33], sp[6 * 33], sp[7 * 33]);
        *(u32x2*)(WT + (size_t)t_rowmap<MAP>(n0 + n) * K + k0 + 8 * c) = o; }
    WAVE_SYNC(); FENCE();
}
constexpr int P0_I_IN = (DM / 64) * (ZP / 32), P0_I_OUT = (DM / 64) * (DM / 32), P0_I_W1 = (2048 / 64) * (256 / 32), P0_I_W2 = (256 / 64) * (64 / 32);
constexpr int P0_I_GU1 = (DM / 64) * (2048 / 32), P0_I_DN1 = (DFF / 64) * (DM / 32);
constexpr int P0_NITEMS = P0_I_IN + P0_I_OUT + 2 * P0_I_W1 + 2 * P0_I_W2 + NE * P0_I_GU1 + NE * P0_I_DN1;
constexpr int P2_FILL_PER_CU = 44;
__device__ __forceinline__ int p2_fill_items(const Frame& F) { return (F.G == 256 && (T / 256) * (ZP / 256) == 640) ? 128 * P2_FILL_PER_CU : 0; }
__device__ __forceinline__ void p0_item(Frame& F, LAS float* scr, int it) {
    int r = it;
    if (r < P0_I_IN) { transpose_item<0>(F.in[I_WIN], DM, INC, ZP / 32, (bf16_t*)(F.ws + WS_WINT), scr, r, F.lane); return; } r -= P0_I_IN;
    if (r < P0_I_OUT) { transpose_item<0>(F.in[I_WOUT], DM, DM, DM / 32, (bf16_t*)(F.ws + WS_WOUTT), scr, r, F.lane); return; } r -= P0_I_OUT;
    if (r < P0_I_W1) { transpose_item<0>(F.in[I_W1K], 2048, 256, 8, (bf16_t*)(F.ws + WS_W1KT), scr, r, F.lane); return; } r -= P0_I_W1;
    if (r < P0_I_W1) { transpose_item<0>(F.in[I_W1V], 2048, 256, 8, (bf16_t*)(F.ws + WS_W1VT), scr, r, F.lane); return; } r -= P0_I_W1;
    if (r < P0_I_W2) { transpose_item<0>(F.in[I_W2K], 256, 64, 2, (bf16_t*)(F.ws + WS_W2KT), scr, r, F.lane); return; } r -= P0_I_W2;
    if (r < P0_I_W2) { transpose_item<0>(F.in[I_W2V], 256, 64, 2, (bf16_t*)(F.ws + WS_W2VT), scr, r, F.lane); return; } r -= P0_I_W2;
    if (r < NE * P0_I_GU1) { const int e = r / P0_I_GU1; transpose_item_f8<1>(F.in[I_WGU] + (size_t)e * DM * 2048, DM, 2048, 64, (unsigned char*)(F.ws + WS_WGUT) + (size_t)e * 2048 * DM, scr, r % P0_I_GU1, F.lane, F8_W_SCALE); return; } r -= NE * P0_I_GU1;
    { const int e = r / P0_I_DN1; transpose_item_f8<0>(F.in[I_WDN] + (size_t)e * DFF * DM, DFF, DM, 32, (unsigned char*)(F.ws + WS_WDNT) + (size_t)e * DM * DFF, scr, r % P0_I_DN1, F.lane, F8_W_SCALE); }
}
__device__ __forceinline__ void p0_prologue(Frame& F) {
    for (int it = F.vcu; it < 96 + 8; it += F.G) {
        if (it < 96) gemv_item<BATCH>(F, F.in[I_C], DM, F.in[I_WADA], DM, 6 * DM, 64 * it, F.in[I_BADA], (float*)(F.ws + WS_MOD), 6 * DM);
        else { const int j = it - 96, kv = j >> 2, n0 = (j & 3) * 64;
            gemv_item<1>(F, F.in[kv ? I_PEV : I_PEK], 0, F.in[kv ? I_W1V : I_W1K], 2048, 256, n0, nullptr, (float*)(F.ws + WS_BPE) + kv * 256, 0); }
    }
    { const float* src = F.in[I_GMWS]; bf16_t* dst = (bf16_t*)(F.ws + WS_WSBF);
      for (int idx = F.vcu * NTHREADS + F.tid; idx < GMG * GMC * GMC; idx += F.G * NTHREADS) { const int i = (idx >> 7) & 127, j = idx & 127; dst[idx] = (bf16_t)f2bf(j <= i ? src[idx] : 0.f); } }
    LAS float* scr = (LAS float*)(F.lds + 8192 + F.wave * 16384);
    const int gw = F.vcu * NWAVES + F.wave, NGW = F.G * NWAVES;
    const int nit = P0_NITEMS - p2_fill_items(F);
    constexpr int NGEMV = 96 + 8;
    const int shift = (F.G > 2 * NGEMV) ? 2 * NGEMV * NWAVES : 0, n1 = nit - shift;
    for (int it = gw; it < n1; it += NGW) p0_item(F, scr, it);
    if (shift && F.vcu >= NGEMV) for (int it = n1 + (F.vcu - NGEMV) * NWAVES + F.wave; it < nit; it += (F.G - NGEMV) * NWAVES) p0_item(F, scr, it);
}

__device__ __forceinline__ void norm_rows(Frame& F, const float* xin, const float* g, int mod_shift, int mod_scale, bf16_t* outb) {
    const int gw = F.vcu * NWAVES + F.wave, NGW = F.G * NWAVES;
    const float* mod = (const float*)(F.ws + WS_MOD);
    for (int m0 = gw; m0 < T / 2; m0 += NGW) {
        f32x4 v[2][4]; float s[2] = {0.f, 0.f};
#pragma unroll
        for (int q = 0; q < 2; ++q) { const f32x4* xr = (const f32x4*)(xin + (size_t)(m0 + q * (T / 2)) * DM) + F.lane;
#pragma unroll
            for (int j = 0; j < 4; ++j) v[q][j] = __builtin_nontemporal_load(xr + 64 * j); }
#pragma unroll
        for (int q = 0; q < 2; ++q)
#pragma unroll
            for (int j = 0; j < 4; ++j) s[q] += (v[q][j][0] * v[q][j][0] + v[q][j][1] * v[q][j][1]) + (v[q][j][2] * v[q][j][2] + v[q][j][3] * v[q][j][3]);
#pragma unroll
        for (int o = 1; o < 64; o <<= 1) { s[0] += __shfl_xor(s[0], o); s[1] += __shfl_xor(s[1], o); }
#pragma unroll
        for (int q = 0; q < 2; ++q) { const int m = m0 + q * (T / 2), b = m / SEQ;
            const float rinv = __builtin_amdgcn_rsqf(s[q] * (1.0f / DM) + EPS);
            u32x2* o8 = (u32x2*)(outb + (size_t)m * DM) + F.lane;
#pragma unroll
            for (int j = 0; j < 4; ++j) { const int c = 4 * F.lane + 256 * j;
                const f32x4 gg = *(const f32x4*)(g + c), sc = *(const f32x4*)(mod + (size_t)b * 6144 + mod_scale * 1024 + c), sh = *(const f32x4*)(mod + (size_t)b * 6144 + mod_shift * 1024 + c);
                const f32x4 h = v[q][j] * rinv * gg * (sc + 1.0f) + sh;
                u32x2 w; w.x = pk2(h[0], h[1]); w.y = pk2(h[2], h[3]); o8[64 * j] = w; } }
    }
}

struct GmRegs { u32x4 v[2], u[2]; };
__device__ __forceinline__ void gmlp_load(Frame& F, int tile, GmRegs& R) {
    const int g = tile % GMG, ch = (tile / GMG) % (SEQ / GMC), b = tile / (GMG * (SEQ / GMC));
    const size_t row0 = (size_t)b * SEQ + (size_t)ch * GMC;
    const bf16_t* ZB = (const bf16_t*)(F.ws + WS_ZB);
#pragma unroll
    for (int it = 0; it < 2; ++it) { const int idx = F.tid + it * NTHREADS, row = idx >> 3, c8 = idx & 7;
        R.v[it] = *(const u32x4*)(ZB + (row0 + row) * ZP + ZC_V + g * 64 + c8 * 8);
        R.u[it] = *(const u32x4*)(ZB + (row0 + row) * ZP + ZC_U + g * 64 + c8 * 8); }
}
__device__ __forceinline__ void gmlp_compute(Frame& F, int tile, const GmRegs& R) {
    const int g = tile % GMG, ch = (tile / GMG) % (SEQ / GMC), b = tile / (GMG * (SEQ / GMC));
    const size_t row0 = (size_t)b * SEQ + (size_t)ch * GMC;
    LAS bf16_t* Vt = (LAS bf16_t*)F.lds;
    constexpr int VP = 136, UP = 68;
    LAS float* Us = (LAS float*)(F.lds + 64 * VP * 2);
    const float* gn = F.in[I_GMNG] + g * 64;
    const int fr = F.lane & 15, fq = F.lane >> 4, w = F.wave;
    const bf16_t* Wg = (const bf16_t*)(F.ws + WS_WSBF) + (size_t)g * GMC * GMC;
    bf16x8 af[4];
#pragma unroll
    for (int ks = 0; ks < 4; ++ks) af[ks] = *(const bf16x8*)(Wg + (size_t)(16 * w + fr) * GMC + 32 * ks + 8 * fq);
#pragma unroll
    for (int it = 0; it < 2; ++it) {
        const int idx = F.tid + it * NTHREADS, row = idx >> 3, c8 = idx & 7;
        const u32x4 raw = R.v[it];
        float v[8]; v[0] = bflo(raw.x); v[1] = bfhi(raw.x); v[2] = bflo(raw.y); v[3] = bfhi(raw.y); v[4] = bflo(raw.z); v[5] = bfhi(raw.z); v[6] = bflo(raw.w); v[7] = bfhi(raw.w);
        float ss = 0.f;
#pragma unroll
        for (int e = 0; e < 8; ++e) { v[e] = gelu_tanh(v[e]); ss += v[e] * v[e]; }
        ss += __shfl_xor(ss, 1); ss += __shfl_xor(ss, 2); ss += __shfl_xor(ss, 4);
        const float rinv = __builtin_amdgcn_rsqf(ss * (1.0f / 64.0f) + EPS);
#pragma unroll
        for (int e = 0; e < 8; ++e) Vt[(c8 * 8 + e) * VP + row] = (bf16_t)f2bf(v[e] * rinv * gn[c8 * 8 + e]);
        const u32x4 ur = R.u[it];
        f32x4 u0 = {gelu_tanh(bflo(ur.x)), gelu_tanh(bfhi(ur.x)), gelu_tanh(bflo(ur.y)), gelu_tanh(bfhi(ur.y))}, u1 = {gelu_tanh(bflo(ur.z)), gelu_tanh(bfhi(ur.z)), gelu_tanh(bflo(ur.w)), gelu_tanh(bfhi(ur.w))};
        *(LAS f32x4*)(Us + row * UP + c8 * 8) = u0; *(LAS f32x4*)(Us + row * UP + c8 * 8 + 4) = u1;
    }
    __syncthreads();
    f32x4 acc[4];
#pragma unroll
    for (int n = 0; n < 4; ++n) acc[n] = (f32x4){0.f, 0.f, 0.f, 0.f};
#pragma unroll
    for (int ks = 0; ks < 4; ++ks) {
        if (32 * ks <= 16 * w + 15) {
#pragma unroll
            for (int n = 0; n < 4; ++n) { const bf16x8 bb = *(const LAS bf16x8*)(Vt + (16 * n + fr) * VP + 32 * ks + 8 * fq);
                acc[n] = __builtin_amdgcn_mfma_f32_16x16x32_bf16(af[ks], bb, acc[n], 0, 0, 0); }
        }
    }
    bf16_t* Y = (bf16_t*)(F.ws + WS_YMIX);
    const float* bs = F.in[I_GMBS] + g * GMC;
#pragma unroll
    for (int n = 0; n < 4; ++n)
#pragma unroll
        for (int r = 0; r < 4; ++r) { const int i = 16 * w + 4 * fq + r, d = 16 * n + fr;
            Y[(row0 + i) * DM + g * 64 + d] = (bf16_t)f2bf(Us[i * UP + d] * (acc[n][r] + bs[i])); }
    __syncthreads();
}
__device__ __forceinline__ void gmlp_run(Frame& F, int base, int stride, int n) {
    if (n <= 0) return;
    GmRegs A, B;
    gmlp_load(F, base, A);
    for (int k = 0; k < n; k += 2) {
        if (k + 1 < n) gmlp_load(F, base + (k + 1) * stride, B);
        gmlp_compute(F, base + k * stride, A);
        if (k + 1 < n) { if (k + 2 < n) gmlp_load(F, base + (k + 2) * stride, A); gmlp_compute(F, base + (k + 1) * stride, B); }
    }
}

__device__ __forceinline__ void cmp_tile(Frame& F, int tile) {
    constexpr int NT = NCP / 32;
    const int nt = tile % NT, g = (tile / NT) % NG, b = (tile / (NT * NG)) % BATCH, kv = tile / (NT * NG * BATCH);
    const int n0 = 32 * nt, p0 = 16 * n0;
    const bf16_t* ZB = (const bf16_t*)(F.ws + WS_ZB);
    constexpr int RP = 72;
    LAS bf16_t* Rs = (LAS bf16_t*)F.lds;
    LAS bf16_t* Hs = (LAS bf16_t*)(F.lds + 528 * RP * 2);
    constexpr int HP = 264;
    const int zc = (kv ? ZC_VC : ZC_KC) + g * 64;
    {
        u32x4 sv[9];
#pragma unroll
        for (int it = 0; it < 9; ++it) { const int idx = F.tid + it * NTHREADS, row = idx >> 3, c8 = idx & 7; const int p = p0 + row;
            sv[it] = (u32x4){0u, 0u, 0u, 0u};
            if (idx < 528 * 8 && p < SEQ) sv[it] = *(const u32x4*)(ZB + ((size_t)b * SEQ + p) * ZP + zc + c8 * 8); }
#pragma unroll
        for (int it = 0; it < 9; ++it) { const int idx = F.tid + it * NTHREADS, row = idx >> 3, c8 = idx & 7;
            if (idx < 528 * 8) *(LAS u32x4*)(Rs + row * RP + c8 * 8) = sv[it]; }
    }
    __syncthreads();
    const int i = F.lane & 31, hi = F.lane >> 5, w = F.wave;
    const bf16_t* W1T = (const bf16_t*)(F.ws + (kv ? WS_W1VT : WS_W1KT)) + (size_t)(32 * w + i) * 2048;
    f32x16 acc;
#pragma unroll
    for (int r = 0; r < 16; ++r) acc[r] = 0.f;
    bf16x8 bq[16];
#pragma unroll
    for (int j = 0; j < 16; ++j) bq[j] = *(const bf16x8*)(W1T + 16 * j + 8 * hi);
    for (int kb = 0; kb < 8; ++kb) {
        bf16x8 bn[16];
        const int kn = (kb < 7) ? (kb + 1) * 16 : kb * 16;
#pragma unroll
        for (int j = 0; j < 16; ++j) bn[j] = *(const bf16x8*)(W1T + 16 * (kn + j) + 8 * hi);
#pragma unroll
        for (int j = 0; j < 16; ++j) { const int kk = kb * 16 + j; const int l = kk >> 2, d = (16 * j + 8 * hi) & 63;
            const bf16x8 a = *(const LAS bf16x8*)(Rs + (16 * i + l) * RP + d);
            acc = __builtin_amdgcn_mfma_f32_32x32x16_bf16(a, bq[j], acc, 0, 0, 0); }
#pragma unroll
        for (int j = 0; j < 16; ++j) bq[j] = bn[j];
    }
    const float bpe = ((const float*)(F.ws + WS_BPE))[kv * 256 + 32 * w + i];
#pragma unroll
    for (int r = 0; r < 16; ++r) Hs[crow(r, hi) * HP + 32 * w + i] = (bf16_t)f2bf(gelu_tanh(acc[r] + bpe));
    __syncthreads();
    if (w < 2) {
        const bf16_t* W2T = (const bf16_t*)(F.ws + (kv ? WS_W2VT : WS_W2KT)) + (size_t)(32 * w + i) * 256;
        f32x16 o;
#pragma unroll
        for (int r = 0; r < 16; ++r) o[r] = 0.f;
        for (int kk = 0; kk < 16; ++kk) {
            const bf16x8 a = *(const LAS bf16x8*)(Hs + i * HP + 16 * kk + 8 * hi);
            const bf16x8 bb = *(const bf16x8*)(W2T + 16 * kk + 8 * hi);
            o = __builtin_amdgcn_mfma_f32_32x32x16_bf16(a, bb, o, 0, 0, 0);
        }
        bf16_t* KC = (bf16_t*)(F.ws + (kv ? WS_VC : WS_KC)) + ((size_t)(b * NG + g) * NCP) * 64;
#pragma unroll
        for (int r = 0; r < 16; ++r) { const int n = n0 + crow(r, hi); KC[(size_t)n * 64 + 32 * w + i] = (n < NCMP) ? (bf16_t)f2bf(o[r]) : (bf16_t)0; }
    }
    __syncthreads();
}

constexpr int KPB = 128;
constexpr int NB_K = 64 * KPB;
constexpr int V_H1 = 4096;
constexpr int NB_BUF = NB_K + 8192;
constexpr int A_IMP = 3 * NB_BUF, A_SEL = A_IMP + 64 * 128 * 4, A_UNI = A_SEL + 64 * 8 * 2, A_WSF = A_UNI + 256, A_QF = A_WSF + 8 * 32 * 4, A_Y = A_QF + 8 * 4096, A_GATE = A_Y + 8 * 4096, A_END = A_GATE + 8 * 32 * 3 * 4;
static_assert(A_END <= MISC_OFF, "NSA LDS map");
#ifndef NSA_THR_VAL
#define NSA_THR_VAL 20.0f
#endif
constexpr float NSA_THR = NSA_THR_VAL, NEG_BIG = -1e30f;

#ifdef EMU
__device__ __forceinline__ int opaque_lane(int l) { return l; }
#else
__device__ __forceinline__ int opaque_lane(int) { int x; asm volatile("v_mbcnt_lo_u32_b32 %0, -1, 0\n\tv_mbcnt_hi_u32_b32 %0, -1, %0" : "=v"(x)); return x; }
#endif
#ifdef EMU
__device__ __forceinline__ int red8_add(int v) { v += __shfl_xor(v, 1); v += __shfl_xor(v, 2); v += __shfl_xor(v, 4); return v; }
__device__ __forceinline__ float quad_sum(float v) { v += __shfl_xor(v, 1); v += __shfl_xor(v, 2); return v; }
__device__ __forceinline__ float xor32f(float v) { return __shfl_xor(v, 32); }
#else
__device__ __forceinline__ int red8_add(int v) {
    v += __builtin_amdgcn_update_dpp(0, v, 0xB1, 0xF, 0xF, true);
    v += __builtin_amdgcn_update_dpp(0, v, 0x4E, 0xF, 0xF, true);
    v += __builtin_amdgcn_update_dpp(0, v, 0x141, 0xF, 0xF, true);
    return v;
}
__device__ __forceinline__ float quad_sum(float v) {
    v += __builtin_bit_cast(float, __builtin_amdgcn_update_dpp(0, __builtin_bit_cast(int, v), 0xB1, 0xF, 0xF, true));
    v += __builtin_bit_cast(float, __builtin_amdgcn_update_dpp(0, __builtin_bit_cast(int, v), 0x4E, 0xF, 0xF, true));
    return v;
}
__device__ __forceinline__ float xor32f(float v) {
    const unsigned u = __builtin_bit_cast(unsigned, v); auto rr = __builtin_amdgcn_permlane32_swap(u, u, false, false);
    return __builtin_bit_cast(float, (threadIdx.x & 32) ? rr[0] : rr[1]);
}
#endif

template <bool WITHV>
__device__ __forceinline__ void stage_dma(LAS unsigned char* buf, const bf16_t* Kg, const bf16_t* Vg, size_t pitch, long rbase, int wave, int lane) {
    const int krow = 8 * wave + (lane >> 3), kc = (lane & 7) ^ ((lane >> 3) & 7);
    __builtin_amdgcn_global_load_lds((const unsigned*)(Kg + (size_t)(rbase + krow) * pitch + kc * 8), (LAS unsigned*)(buf + wave * 1024), 16, 0, 0);
    if (WITHV) { const int vrow = 16 * (wave & 3) + (lane >> 2), vc = (wave >> 2) * 4 + (lane & 3);
        __builtin_amdgcn_global_load_lds((const unsigned*)(Vg + (size_t)(rbase + vrow) * pitch + vc * 8), (LAS unsigned*)(buf + NB_K + wave * 1024), 16, 0, 0); }
}
struct BrState { float mref, l; int has; unsigned qxm; f32x16 o0, o1; };
__device__ __forceinline__ unsigned ref_words(float m, float& meff) { const unsigned mh = f2bf(m); const float fh = bf2f((unsigned short)mh); const unsigned ml = f2bf(m - fh); meff = fh + bf2f((unsigned short)ml); return mh | (ml << 16); }

#ifdef EMU
#define VTR(p) __builtin_amdgcn_ds_read_tr16_b64_v4i16(p)
#else
typedef short v4i16_t __attribute__((ext_vector_type(4)));
#define VTR(p) __builtin_bit_cast(s16x4, __builtin_amdgcn_ds_read_tr16_b64_v4i16((LAS v4i16_t*)(p)))
#endif

__device__ __forceinline__ void nsa_qk(const LAS unsigned char* buf, const LAS unsigned char* qfl, unsigned qxs, unsigned qxm_t, unsigned klw0, unsigned klw1, unsigned tbw, unsigned neg1w,
                                       f32x16& p0, f32x16& p1, int lane) {
    const int i = lane & 31, hi = lane >> 5;
    const bf16x8 qx = __builtin_bit_cast(bf16x8, ((u32x4){qxs, qxs, qxm_t, 0u}));
    const bf16x8 kx0 = __builtin_bit_cast(bf16x8, ((u32x4){klw0, tbw, neg1w, 0u})), kx1 = __builtin_bit_cast(bf16x8, ((u32x4){klw1, tbw, neg1w, 0u}));
    const LAS unsigned char* kp = buf + i * KPB;
    {
        const f32x16 zero16 = {0.f, 0.f, 0.f, 0.f, 0.f, 0.f, 0.f, 0.f, 0.f, 0.f, 0.f, 0.f, 0.f, 0.f, 0.f, 0.f};
        p0 = __builtin_amdgcn_mfma_f32_32x32x16_bf16(kx0, qx, zero16, 0, 0, 0);
        p1 = __builtin_amdgcn_mfma_f32_32x32x16_bf16(kx1, qx, zero16, 0, 0, 0);
    }
#pragma unroll
    for (int d0 = 0; d0 < 4; ++d0) {
        const int ko = ((2 * d0 + hi) ^ (i & 7)) << 4;
        const bf16x8 k0 = *(const LAS bf16x8*)(kp + ko), k1 = *(const LAS bf16x8*)(kp + 32 * KPB + ko);
        const bf16x8 qd = *(const LAS bf16x8*)(qfl + d0 * 1024);
        p0 = __builtin_amdgcn_mfma_f32_32x32x16_bf16(k0, qd, p0, 0, 0, 0);
        p1 = __builtin_amdgcn_mfma_f32_32x32x16_bf16(k1, qd, p1, 0, 0, 0);
    }
}
template <bool PV, bool TRACK>
__device__ __forceinline__ void nsa_prep(int mode, int lim, BrState& st, f32x16& p0, f32x16& p1, int lane, LAS float* wsf) {
#ifndef EMU
    asm volatile("" : "+v"(lim));
#endif
    const int i = lane & 31, hi = lane >> 5;
    if (__builtin_amdgcn_readfirstlane(mode) != 0) {
        NOSPEC();
        const int lim2 = lim - 4 * hi; const bool inv = (mode == 2);
#pragma unroll
        for (int r = 0; r < 16; ++r) { const int c0 = (r & 3) + 8 * (r >> 2);
            const bool v0 = (c0 <= lim2) != inv, v1 = (c0 + 32 <= lim2) != inv;
            p0[r] = v0 ? p0[r] : -INFINITY; p1[r] = v1 ? p1[r] : -INFINITY; }
    }
    if (TRACK) {
        float mxa = fmaxf(p0[0], p1[0]), mxb = fmaxf(p0[1], p1[1]);
#pragma unroll
        for (int r = 2; r < 16; r += 2) { mxa = fmaxf(fmaxf(mxa, p0[r]), p1[r]); mxb = fmaxf(fmaxf(mxb, p0[r + 1]), p1[r + 1]); }
        float mx = fmaxf(mxa, mxb);
        mx = fmaxf(mx, xor32f(mx));
        const bool upd = (mx > (st.has ? NSA_THR : NEG_BIG)) && (mx > NEG_BIG);
        if (__any(upd)) {
            NOSPEC();
            float meff; const unsigned w = ref_words(st.mref + mx, meff);
            const float de = upd ? (meff - st.mref) : 0.f;
            const float f = (upd && st.has) ? fexp2(-de) : 1.0f;
#pragma unroll
            for (int r = 0; r < 16; ++r) { p0[r] -= de; p1[r] -= de; }
            st.l *= f;
            if (PV) {
                wsf[i] = f; WAVE_SYNC(); FENCE();
                const LAS float* wr_ = wsf + 4 * hi;
#pragma unroll
                for (int r = 0; r < 16; ++r) { const float a = wr_[(r & 3) + 8 * (r >> 2)]; st.o0[r] *= a; st.o1[r] *= a; }
                WAVE_SYNC(); FENCE();
            }
            if (upd) { st.mref = meff; st.qxm = hi ? 0u : w; st.has = 1; }
        }
    }
}
template <bool PV>
__device__ __forceinline__ void nsa_softmax_pv(const LAS unsigned char* buf, BrState& st, f32x16& p0, f32x16& p1, int lane) {
    const int hi = lane >> 5;
    float rs = 0.f;
#pragma unroll
    for (int r = 0; r < 16; ++r) { p0[r] = fexp2(p0[r]); p1[r] = fexp2(p1[r]); rs += p0[r] + p1[r]; }
    st.l += rs;
    if (PV) {
        const LAS unsigned char* vb = buf + NB_K + (4 * hi + ((lane & 15) >> 2)) * 64 + 32 * ((lane >> 4) & 1) + 8 * (lane & 3);
#pragma unroll
        for (int ks = 0; ks < 4; ++ks) {
            const f32x16& p = (ks < 2) ? p0 : p1; const int s = ks & 1;
            u32x4 pw; pw.x = pk2(p[8 * s + 0], p[8 * s + 1]); pw.y = pk2(p[8 * s + 2], p[8 * s + 3]); pw.z = pk2(p[8 * s + 4], p[8 * s + 5]); pw.w = pk2(p[8 * s + 6], p[8 * s + 7]);
            const bf16x8 pa = __builtin_bit_cast(bf16x8, pw);
#pragma unroll
            for (int d0 = 0; d0 < 2; ++d0) {
                const s16x4 lo = VTR(vb + d0 * V_H1 + ks * 1024), hh = VTR(vb + d0 * V_H1 + ks * 1024 + 512);
                const bf16x8 vf = (bf16x8){lo[0], lo[1], lo[2], lo[3], hh[0], hh[1], hh[2], hh[3]};
                if (d0 == 0) st.o0 = __builtin_amdgcn_mfma_f32_32x32x16_bf16(pa, vf, st.o0, 0, 0, 0);
                else         st.o1 = __builtin_amdgcn_mfma_f32_32x32x16_bf16(pa, vf, st.o1, 0, 0, 0);
            }
        }
    }
}

struct ImpSums { float G0[4], S0[4], G1[4], S1[4]; };
template <bool PRODUCE, bool IMP>
__device__ __forceinline__ void nsa_exp_qk(const LAS unsigned char* nbuf, const LAS unsigned char* qfl, unsigned qxs, unsigned qxm_t, unsigned klw0, unsigned klw1, unsigned tbw, unsigned neg1w,
                                           f32x16& n0, f32x16& n1, BrState& st, f32x16& p0, f32x16& p1, u32x4 (&pw)[4], ImpSums& im, int lane) {
    const int i = lane & 31, hi = lane >> 5;
    const LAS unsigned char* kp = nbuf + i * KPB;
    if (PRODUCE) {
        const bf16x8 qx = __builtin_bit_cast(bf16x8, ((u32x4){qxs, qxs, qxm_t, 0u}));
        const bf16x8 kx0 = __builtin_bit_cast(bf16x8, ((u32x4){klw0, tbw, neg1w, 0u})), kx1 = __builtin_bit_cast(bf16x8, ((u32x4){klw1, tbw, neg1w, 0u}));
        const f32x16 zero16 = {0.f, 0.f, 0.f, 0.f, 0.f, 0.f, 0.f, 0.f, 0.f, 0.f, 0.f, 0.f, 0.f, 0.f, 0.f, 0.f};
        n0 = __builtin_amdgcn_mfma_f32_32x32x16_bf16(kx0, qx, zero16, 0, 0, 0);
        n1 = __builtin_amdgcn_mfma_f32_32x32x16_bf16(kx1, qx, zero16, 0, 0, 0);
    }
    float rs = 0.f;
#pragma unroll
    for (int d0 = 0; d0 < 4; ++d0) {
        if (PRODUCE) {
            const int ko = ((2 * d0 + hi) ^ (i & 7)) << 4;
            const bf16x8 k0 = *(const LAS bf16x8*)(kp + ko), k1 = *(const LAS bf16x8*)(kp + 32 * KPB + ko);
            const bf16x8 qd = *(const LAS bf16x8*)(qfl + d0 * 1024);
            n0 = __builtin_amdgcn_mfma_f32_32x32x16_bf16(k0, qd, n0, 0, 0, 0);
            n1 = __builtin_amdgcn_mfma_f32_32x32x16_bf16(k1, qd, n1, 0, 0, 0);
        }
        const float a0 = fexp2(p0[4 * d0]), a1 = fexp2(p0[4 * d0 + 1]), a2 = fexp2(p0[4 * d0 + 2]), a3 = fexp2(p0[4 * d0 + 3]);
        const float b0 = fexp2(p1[4 * d0]), b1 = fexp2(p1[4 * d0 + 1]), b2 = fexp2(p1[4 * d0 + 2]), b3 = fexp2(p1[4 * d0 + 3]);
        const float ga = (a0 + a1) + (a2 + a3), gb = (b0 + b1) + (b2 + b3);
        rs += ga + gb;
        if (IMP) { im.G0[d0] = ga; im.S0[d0] = a3; im.G1[d0] = gb; im.S1[d0] = b3; }
        const unsigned w0 = pk2(a0, a1), w1 = pk2(a2, a3), v0 = pk2(b0, b1), v1 = pk2(b2, b3);
        if ((d0 & 1) == 0) { pw[d0 >> 1].x = w0; pw[d0 >> 1].y = w1; pw[2 + (d0 >> 1)].x = v0; pw[2 + (d0 >> 1)].y = v1; }
        else               { pw[d0 >> 1].z = w0; pw[d0 >> 1].w = w1; pw[2 + (d0 >> 1)].z = v0; pw[2 + (d0 >> 1)].w = v1; }
        __builtin_amdgcn_sched_barrier(0);
    }
    st.l += rs;
}
template <bool PV>
__device__ __forceinline__ void nsa_pv(const LAS unsigned char* buf, BrState& st, const u32x4 (&pw)[4], int lane) {
    if (!PV) return;
    const int hi = lane >> 5;
    const LAS unsigned char* vb = buf + NB_K + (4 * hi + ((lane & 15) >> 2)) * 64 + 32 * ((lane >> 4) & 1) + 8 * (lane & 3);
#pragma unroll
    for (int ks = 0; ks < 4; ++ks) {
        const bf16x8 pa = __builtin_bit_cast(bf16x8, pw[ks]);
#pragma unroll
        for (int d0 = 0; d0 < 2; ++d0) {
            const s16x4 lo = VTR(vb + d0 * V_H1 + ks * 1024), hh = VTR(vb + d0 * V_H1 + ks * 1024 + 512);
            const bf16x8 vf = (bf16x8){lo[0], lo[1], lo[2], lo[3], hh[0], hh[1], hh[2], hh[3]};
            if (d0 == 0) st.o0 = __builtin_amdgcn_mfma_f32_32x32x16_bf16(pa, vf, st.o0, 0, 0, 0);
            else         st.o1 = __builtin_amdgcn_mfma_f32_32x32x16_bf16(pa, vf, st.o1, 0, 0, 0);
        }
        __builtin_amdgcn_sched_barrier(0);
    }
}

__device__ __forceinline__ int bit128(const LAS unsigned* m, int j) { return (int)((m[j >> 5] >> (j & 31)) & 1u); }
__device__ __forceinline__ int next_below(const LAS unsigned* m, int j) { for (int k = j - 1; k >= 0; --k) if ((m[k >> 5] >> (k & 31)) & 1u) return k; return -1; }

struct NsaCtx {
    int qt, g, t, tloc, qloc, head, w, lane; const bf16_t* Zb;
    LAS unsigned char* lds; LAS float* imp; LAS float* wsf;
};
__device__ __forceinline__ void nsa_importance(const NsaCtx& C, const ImpSums& im, int cur) {
    const int i = C.lane & 31, hi = C.lane >> 5;
    float G0[4], G1[4], S0[4], S1[4];
#pragma unroll
    for (int k = 0; k < 4; ++k) { G0[k] = quad_sum(im.G0[k]); G1[k] = quad_sum(im.G1[k]); S0[k] = quad_sum(im.S0[k]); S1[k] = quad_sum(im.S1[k]); }
    float P0[4], P1[4];
#pragma unroll
    for (int k = 0; k < 4; ++k) { P0[k] = xor32f(S0[k]); P1[k] = xor32f(S1[k]); }
    if ((i & 3) == 0) {
        LAS float* row = C.imp + C.qloc * 128 + 16 * cur + hi;
#pragma unroll
        for (int k = 0; k < 4; ++k) {
            const float prev0 = hi ? P0[k] : (k == 0 ? 0.f : P0[k - 1]);
            const float prev1 = hi ? P1[k] : (k == 0 ? P0[3] : P1[k - 1]);
            row[2 * k] = G0[k] + prev0;
            row[8 + 2 * k] = G1[k] + prev1;
        }
        if (hi == 1 && 16 * (cur + 1) < 128) row[15] += S1[3];
    }
}
template <int KIND, int PRE>
__device__ __forceinline__ void nsa_branch(Frame& F, const NsaCtx& C, const LAS unsigned char* qf, const bf16_t* Kg, const bf16_t* Vg, size_t pitch,
                                           int first, int lo, const LAS unsigned* um, const LAS unsigned* wm, const LAS unsigned* qm, int cfull, int climit, BrState& st) {
    constexpr bool PV = (KIND != 1), TRACK = (KIND != 2), CMP = (KIND == 1 || KIND == 2);
    const int lane = C.lane, w = C.w, qt = C.qt;
    const int ln_ = opaque_lane(lane), hi_ = ln_ >> 5, i_ = ln_ & 31;
    unsigned qxs; { const float s2_ = fexp2(-(float)(4 * C.g + (i_ & 3) + 1)) * LOG2E; const unsigned sh_ = f2bf(s2_); const unsigned sl_ = f2bf(s2_ - bf2f((unsigned short)sh_)); qxs = hi_ ? 0u : (sh_ | (sl_ << 16)); }
    const unsigned neg1w = hi_ ? 0u : 0xBF80BF80u; const unsigned maskw = hi_ ? 0u : 0x00007E96u;
    const unsigned klw0 = hi_ ? 0u : (f2bf((float)(CMP ? 16 * i_ : i_)) * 0x10001u), klw1 = hi_ ? 0u : (f2bf((float)(CMP ? 16 * (i_ + 32) : (i_ + 32))) * 0x10001u);
#define SEQ_NEXT(c) ((c) < 0 ? -1 : (KIND == 3 ? next_below(um, (c)) : (((c) - 1 >= lo) ? (c) - 1 : -1)))
#define TILE_NEED(c) (KIND == 3 ? bit128(wm, (c)) : 1)
#define TILE_MODE(c) (KIND == 0 ? (((c) == qt) ? 1 : (((c) == qt - 8) ? 2 : 0)) : (CMP ? ((64 * (c) + 63 <= cfull) ? 0 : 1) : (((c) == qt) ? 1 : 0)))
#define TILE_LIM(c) (CMP ? (climit - 64 * (c)) : C.tloc)
#define TILE_TBW(c) (hi_ ? 0u : (f2bf((float)((CMP ? 1024 : 64) * (c))) * 0x10001u))
#define TILE_QXM(c) ((KIND == 3) ? (bit128(qm, (c)) ? st.qxm : maskw) : st.qxm)
#define SLOT(s) (C.lds + (s) * NB_BUF)
    f32x16 pA0, pA1, pB0, pB1;
    int c0 = first, c1 = SEQ_NEXT(c0), c2 = SEQ_NEXT(c1), s0 = 0;
    if (PRE == 0) { __syncthreads();
        stage_dma<PV>(SLOT(0), Kg, Vg, pitch, 64L * c0, w, lane); }
    if (PRE < 2 && c1 >= 0) stage_dma<PV>(SLOT(1), Kg, Vg, pitch, 64L * c1, w, lane);
    __syncthreads();
    if (TILE_NEED(c0)) nsa_qk(SLOT(0), qf, qxs, TILE_QXM(c0), klw0, klw1, TILE_TBW(c0), neg1w, pA0, pA1, lane);
#define NSA_STEP(P0, P1, N0, N1) do { \
        const int s1_ = (s0 == 2) ? 0 : s0 + 1, s2_ = (s1_ == 2) ? 0 : s1_ + 1; \
        if (c2 >= 0) stage_dma<PV>(SLOT(s2_), Kg, Vg, pitch, 64L * c2, w, lane); \
        const bool need0_ = TILE_NEED(c0) != 0; const int cn_ = (c1 >= 0) ? c1 : c0;     \
        if (need0_) { \
            u32x4 pw_[4]; ImpSums im_; \
            nsa_prep<PV, TRACK>(TILE_MODE(c0), TILE_LIM(c0), st, P0, P1, lane, C.wsf); \
            __builtin_amdgcn_sched_barrier(0); \
            nsa_exp_qk<true, KIND == 2>(SLOT(s1_), qf, qxs, TILE_QXM(cn_), klw0, klw1, TILE_TBW(cn_), neg1w, N0, N1, st, P0, P1, pw_, im_, lane); \
            nsa_pv<PV>(SLOT(s0), st, pw_, lane); \
            if (KIND == 2) nsa_importance(C, im_, c0); \
        } else nsa_qk(SLOT(s1_), qf, qxs, TILE_QXM(cn_), klw0, klw1, TILE_TBW(cn_), neg1w, N0, N1, lane); \
        __syncthreads(); \
        c0 = c1; c1 = c2; c2 = SEQ_NEXT(c2); s0 = s1_; } while (0)
    for (;;) {
        NSA_STEP(pA0, pA1, pB0, pB1); if (c0 < 0) break;
        NSA_STEP(pB0, pB1, pA0, pA1); if (c0 < 0) break;
    }
#undef NSA_STEP
#undef SEQ_NEXT
#undef TILE_NEED
#undef TILE_MODE
#undef TILE_LIM
#undef TILE_TBW
#undef TILE_QXM
#undef SLOT
}
#if !defined(EMU)
#define SUBT_BEGIN() unsigned long long st_t0_ = 0; if (PROBE_K >= 20 && blockIdx.x == 0 && F.tid == 0) st_t0_ = __builtin_amdgcn_s_memrealtime()
#define SUBT_END(i) do { if (PROBE_K >= 20 && blockIdx.x == 0 && F.tid == 0) { const unsigned long long t1_ = __builtin_amdgcn_s_memrealtime(); F.MISC[300 + (i)] += (unsigned)(t1_ - st_t0_); st_t0_ = t1_; } } while (0)
#else
#define SUBT_BEGIN() ((void)0)
#define SUBT_END(i) ((void)0)
#endif
__device__ __forceinline__ void nsa_task(Frame& F, int task) {
    constexpr int NQT = SEQ / 64;
    const int qt = task % NQT, g = (task / NQT) % NG, b = task / (NQT * NG);
    const int t0 = 64 * qt, w = F.wave;
    const bf16_t* Zb = (const bf16_t*)(F.ws + WS_ZB) + (size_t)b * SEQ * ZP;
    LAS float* imp = (LAS float*)(F.lds + A_IMP);
    LAS unsigned short* selm = (LAS unsigned short*)(F.lds + A_SEL);
    LAS unsigned* uniw = (LAS unsigned*)(F.lds + A_UNI);
#define SECTION_LANE() const int lane = opaque_lane(F.lane), i = lane & 31, hi = lane >> 5, ql = i >> 2, qloc = 8 * w + ql, t = t0 + qloc, head = 4 * g + (i & 3); \
        LAS float* wsf = (LAS float*)(F.lds + A_WSF) + w * 32; LAS unsigned char* qf = F.lds + A_QF + w * 4096 + lane * 16; \
        NsaCtx C; C.qt = qt; C.g = g; C.t = t; C.tloc = qloc; C.qloc = qloc; C.head = head; C.w = w; C.lane = lane; C.Zb = Zb; C.lds = F.lds; C.imp = imp; C.wsf = wsf; \
        LAS unsigned* ya = (LAS unsigned*)(F.lds + A_Y) + w * 1024 + hi * 128 + i; (void)ya; (void)head; (void)t
    const LAS unsigned* zz = (const LAS unsigned*)(F.lds + A_UNI);
#define INIT_ST(st) do { st.mref = 0.f; st.l = 0.f; st.has = 0; st.qxm = 0u; _Pragma("unroll") for (int r = 0; r < 16; ++r) { st.o0[r] = 0.f; st.o1[r] = 0.f; } } while (0)
#define ACC_PREP(st, gidx) float f_ = st.l + xor32f(st.l); { const float gate_ = ((const LAS float*)(F.lds + A_GATE))[w * 96 + i * 3 + gidx]; f_ = (f_ > 0.f) ? gate_ * __builtin_amdgcn_rcpf(f_) : 0.f; }     \
        wsf[i] = f_; WAVE_SYNC(); FENCE(); const LAS float* wr_ = wsf + 4 * hi;
    const bf16_t* KCg = (const bf16_t*)(F.ws + WS_KC) + (size_t)(b * NG + g) * NCP * 64;
    const bf16_t* VCg = (const bf16_t*)(F.ws + WS_VC) + (size_t)(b * NG + g) * NCP * 64;
    const int nct = (t0 + 63 >= 31) ? (((t0 + 63 - 31) >> 4) / 64 + 1) : 0;
#define NSA_PRELOAD_CMP(WV) do { if (nct > 0) { stage_dma<WV>(F.lds, KCg, VCg, 64, 64L * (nct - 1), w, lane); if (nct > 1) stage_dma<WV>(F.lds + NB_BUF, KCg, VCg, 64, 64L * (nct - 2), w, lane); } } while (0)
    bool sel_pre = false;
    SUBT_BEGIN();
    {
        SECTION_LANE();
        __syncthreads();
        stage_dma<true>(F.lds, Zb + ZC_KW + g * 64, Zb + ZC_VW + g * 64, ZP, 64L * qt, w, lane);
        if (qt - 1 >= ((qt - 8 > 0) ? qt - 8 : 0)) stage_dma<true>(F.lds + NB_BUF, Zb + ZC_KW + g * 64, Zb + ZC_VW + g * 64, ZP, 64L * (qt - 1), w, lane);
        for (int idx = F.tid; idx < 64 * 128; idx += NTHREADS) imp[idx] = 0.f;
#pragma unroll
        for (int d0 = 0; d0 < 4; ++d0) { const u32x4 raw = *(const u32x4*)(Zb + (size_t)t * ZP + ZC_Q + head * 64 + 16 * d0 + 8 * hi);
            const float sc = 0.125f * LOG2E; u32x4 o;
            o.x = pk2(bflo(raw.x) * sc, bfhi(raw.x) * sc); o.y = pk2(bflo(raw.y) * sc, bfhi(raw.y) * sc); o.z = pk2(bflo(raw.z) * sc, bfhi(raw.z) * sc); o.w = pk2(bflo(raw.w) * sc, bfhi(raw.w) * sc);
            *(LAS u32x4*)(qf + d0 * 1024) = o; }
        if (hi == 0) {
#pragma unroll
            for (int k = 0; k < 3; ++k) ((LAS float*)(F.lds + A_GATE))[w * 96 + i * 3 + k] = sigmoidf_(bf2f(Zb[(size_t)t * ZP + ZC_GL + head * 3 + k]));
        }
    }
    {
        SECTION_LANE();
        BrState st; INIT_ST(st);
        nsa_branch<0, 2>(F, C, qf, Zb + ZC_KW + g * 64, Zb + ZC_VW + g * 64, ZP, qt, (qt - 8 > 0) ? qt - 8 : 0, zz, zz, zz, 0, 0, st);
        NSA_PRELOAD_CMP(false);
        ACC_PREP(st, 2)
#pragma unroll
        for (int r = 0; r < 16; ++r) { const int c_ = (r & 3) + 8 * (r >> 2); const float a_ = wr_[c_]; ya[c_ * 32] = pk2(a_ * st.o0[r], a_ * st.o1[r]); }
        WAVE_SYNC(); FENCE();
    }
    SUBT_END(1);
    {
        SECTION_LANE();
        const bf16_t* Kg = KCg; const bf16_t* Vg = VCg;
        const int cfull = (t0 >= 31) ? ((t0 - 31) >> 4) : -1;
        const int climit = (t >= 31) ? ((t - 31) >> 4) : -1;
        if (nct > 0) {
            BrState st; INIT_ST(st);
            nsa_branch<1, 2>(F, C, qf, Kg, Vg, 64, nct - 1, 0, zz, zz, zz, cfull, climit, st);
            NSA_PRELOAD_CMP(true);
            SUBT_END(2);
            const float ltot = st.l + xor32f(st.l);
            float meff; const unsigned wfin = ref_words(st.mref + ((ltot > 0.f) ? __builtin_log2f(ltot) : 0.f), meff);
            BrState s2; INIT_ST(s2); s2.qxm = hi ? 0u : wfin;
            nsa_branch<2, 2>(F, C, qf, Kg, Vg, 64, nct - 1, 0, zz, zz, zz, cfull, climit, s2);
            stage_dma<true>(F.lds, Zb + ZC_KS + g * 64, Zb + ZC_VS + g * 64, ZP, 64L * qt, w, lane);
            sel_pre = true;
            s2.l = 0.5f;
            ACC_PREP(s2, 0)
#pragma unroll
            for (int r = 0; r < 16; ++r) { const int c_ = (r & 3) + 8 * (r >> 2); const float a_ = wr_[c_]; const unsigned y_ = ya[c_ * 32]; ya[c_ * 32] = pk2(bflo(y_) + a_ * s2.o0[r], bfhi(y_) + a_ * s2.o1[r]); }
            WAVE_SYNC(); FENCE();
        }
    }
    if (!sel_pre) stage_dma<true>(F.lds, Zb + ZC_KS + g * 64, Zb + ZC_VS + g * 64, ZP, 64L * qt, w, F.lane);
    __syncthreads();
    SUBT_END(3);
    {
        const int lane = opaque_lane(F.lane);
        const int q8 = lane >> 3, sub = lane & 7, qq = 8 * w + q8;
        unsigned key[16];
#pragma unroll
        for (int e = 0; e < 16; ++e) { const int j = 16 * sub + e; const bool valid = (j <= qt) && (j < NBLK);
            unsigned kk = valid ? (__builtin_bit_cast(unsigned, imp[qq * 128 + j]) + 1u) : 0u;
            if (valid && (j == 0 || j == qt || j == qt - 1)) kk = 0x7F000000u;
            key[e] = kk; }
        unsigned thr = 0u;
        for (int bit = 30; bit >= 0; --bit) { const unsigned cand = thr | (1u << bit); int c = 0;
#pragma unroll
            for (int e = 0; e < 16; ++e) c += (key[e] >= cand) ? 1 : 0;
            c = red8_add(c);
            if (c >= NSEL) thr = cand; }
        int ngt = 0, tl = 0;
#pragma unroll
        for (int e = 0; e < 16; ++e) { ngt += (key[e] > thr) ? 1 : 0; tl += (key[e] == thr) ? 1 : 0; }
        ngt = red8_add(ngt);
        int sc = tl;
#pragma unroll
        for (int d = 1; d < 8; d <<= 1) { const int o = __shfl(sc, (lane - d) & 63); if (sub >= d) sc += o; }
        int before = sc - tl; const int need = (thr == 0u) ? 0 : (NSEL - ngt);
        unsigned m16 = 0u;
#pragma unroll
        for (int e = 0; e < 16; ++e) { if (key[e] > thr) m16 |= 1u << e; else if (key[e] == thr) { if (before < need) m16 |= 1u << e; ++before; } }
        selm[qq * 8 + sub] = (unsigned short)m16;
        unsigned um = m16; um |= __shfl_xor(um, 8); um |= __shfl_xor(um, 16); um |= __shfl_xor(um, 32);
        if (q8 == 0) ((LAS unsigned short*)uniw)[w * 8 + sub] = (unsigned short)um;
    }
    __syncthreads();
    SUBT_END(4);
    {
        SECTION_LANE();
        BrState st; INIT_ST(st);
        if (F.tid < 4) { unsigned u = 0u; for (int ww = 0; ww < 8; ++ww) u |= uniw[ww * 4 + F.tid]; uniw[32 + F.tid] = u; }
        __syncthreads();
        const LAS unsigned* um = uniw + 32; const LAS unsigned* wm = uniw + w * 4; const LAS unsigned* qm = (const LAS unsigned*)selm + qloc * 4;
        nsa_branch<3, 1>(F, C, qf, Zb + ZC_KS + g * 64, Zb + ZC_VS + g * 64, ZP, qt, 0, um, wm, qm, 0, 0, st);
        ACC_PREP(st, 1)
        bf16_t* ym = (bf16_t*)(F.ws + WS_YMIX) + ((size_t)b * SEQ + t0 + 8 * w + hi) * DM + 512 + 4 * g * 64 + i;
#pragma unroll
        for (int r = 0; r < 16; ++r) { const int c_ = (r & 3) + 8 * (r >> 2); const float a_ = wr_[c_]; const unsigned y_ = ya[c_ * 32]; bf16_t* op = ym + (c_ >> 2) * DM + (c_ & 3) * 64;
            const unsigned o_ = pk2(bflo(y_) + a_ * st.o0[r], bfhi(y_) + a_ * st.o1[r]); op[0] = (bf16_t)(o_ & 0xffffu); op[32] = (bf16_t)(o_ >> 16); }
        WAVE_SYNC(); FENCE();
    }
    SUBT_END(5);
#undef ACC_PREP
#undef INIT_ST
#undef SECTION_LANE
#undef NSA_PRELOAD_CMP
}

__device__ __forceinline__ void argmax16(float& v, int& idx) {
#ifdef EMU
    for (int o = 1; o < 16; o <<= 1) { const float ov = __shfl_xor(v, o); const int oi = __shfl_xor(idx, o); if (ov > v || (ov == v && oi < idx)) { v = ov; idx = oi; } }
#else
#define AM_STEP(ctrl) do { const float ov = __builtin_bit_cast(float, __builtin_amdgcn_update_dpp(0, __builtin_bit_cast(int, v), ctrl, 0xF, 0xF, true)); \
        const int oi = __builtin_amdgcn_update_dpp(0, idx, ctrl, 0xF, 0xF, true); if (ov > v || (ov == v && oi < idx)) { v = ov; idx = oi; } } while (0)
    AM_STEP(0xB1); AM_STEP(0x4E); AM_STEP(0x141); AM_STEP(0x140);
#undef AM_STEP
#endif
}
template <bool SHADOW>
__device__ __forceinline__ void router_task(Frame& F, int task) {
    const int row0 = 32 * task;
    LAS float* Hs = (LAS float*)F.lds;
    const float* mod = (const float*)(F.ws + WS_MOD);
    const float* X0 = F.in[I_X]; const bf16_t* MIX = (const bf16_t*)(F.ws + WS_MIX);
    unsigned char* H2 = (unsigned char*)(F.ws + WS_H2);
    const float* g = F.in[I_GFFN];
    {
        const int b = row0 / SEQ;
        const float* mb = mod + (size_t)b * 6144;
#pragma unroll
        for (int rb = 0; rb < 2; ++rb) {
            f32x4 v[2][4]; u32x2 mw[2][4];
#pragma unroll
            for (int rr = 0; rr < 2; ++rr) { const size_t ro = (size_t)(row0 + 4 * F.wave + 2 * rb + rr) * DM; const f32x4* xr = (const f32x4*)(X0 + ro) + F.lane; const u32x2* mr = (const u32x2*)(MIX + ro) + F.lane;
#pragma unroll
                for (int j = 0; j < 4; ++j) { v[rr][j] = xr[64 * j]; mw[rr][j] = mr[64 * j]; } }
#pragma unroll
            for (int rr = 0; rr < 2; ++rr)
#pragma unroll
                for (int j = 0; j < 4; ++j) v[rr][j] += *(const f32x4*)(mb + 2 * 1024 + 4 * F.lane + 256 * j) * (f32x4){bflo(mw[rr][j].x), bfhi(mw[rr][j].x), bflo(mw[rr][j].y), bfhi(mw[rr][j].y)};
#pragma unroll
            for (int rr = 0; rr < 2; ++rr) {
                const int lr = 4 * F.wave + 2 * rb + rr, m = row0 + lr;
                float s = 0.f;
#pragma unroll
                for (int j = 0; j < 4; ++j) s += (v[rr][j][0] * v[rr][j][0] + v[rr][j][1] * v[rr][j][1]) + (v[rr][j][2] * v[rr][j][2] + v[rr][j][3] * v[rr][j][3]);
                const float rinv = __builtin_amdgcn_rsqf(wave_sum(s) * (1.0f / DM) + EPS);
                unsigned* o4 = (unsigned*)(H2 + (size_t)m * DM) + F.lane;
#pragma unroll
                for (int j = 0; j < 4; ++j) { const int c = 4 * F.lane + 256 * j;
                    const f32x4 h = v[rr][j] * rinv * (*(const f32x4*)(g + c) * (*(const f32x4*)(mb + 4 * 1024 + c) + 1.0f)) + *(const f32x4*)(mb + 3 * 1024 + c);
                    o4[64 * j] = pk4_fp8(h[0] * F8_ACT_SCALE, h[1] * F8_ACT_SCALE, h[2] * F8_ACT_SCALE, h[3] * F8_ACT_SCALE);
#pragma unroll
                    for (int e = 0; e < 4; ++e) Hs[(c + e) * 33 + lr] = h[e]; }
                __builtin_amdgcn_sched_barrier(0);
            }
        }
    }
    const int i = F.lane & 31, hi = F.lane >> 5;
    const float* WR = F.in[I_WR];
    __builtin_amdgcn_sched_barrier(0);
    float wr[32];
#pragma unroll
    for (int ks = 0; ks < 32; ++ks) wr[ks] = WR[(128 * F.wave + 2 * ks + hi) * 32 + i];
    __syncthreads();
    f32x16 acc;
#pragma unroll
    for (int r = 0; r < 16; ++r) acc[r] = 0.f;
    float wr2[32];
#pragma unroll
    for (int ks = 0; ks < 32; ++ks) wr2[ks] = WR[(128 * F.wave + 2 * (ks + 32) + hi) * 32 + i];
    __builtin_amdgcn_sched_barrier(0);
#pragma unroll
    for (int q4 = 0; q4 < 4; ++q4) {
#pragma unroll
        for (int ks = 8 * q4; ks < 8 * q4 + 8; ++ks) acc = __builtin_amdgcn_mfma_f32_32x32x2f32(Hs[(128 * F.wave + 2 * ks + hi) * 33 + i], wr[ks], acc, 0, 0, 0);
        __builtin_amdgcn_sched_barrier(0);
    }
#pragma unroll
    for (int q4 = 0; q4 < 4; ++q4) {
#pragma unroll
        for (int ks = 8 * q4; ks < 8 * q4 + 8; ++ks) acc = __builtin_amdgcn_mfma_f32_32x32x2f32(Hs[(128 * F.wave + 2 * (ks + 32) + hi) * 33 + i], wr2[ks], acc, 0, 0, 0);
        __builtin_amdgcn_sched_barrier(0);
    }
    __syncthreads();
    LAS float* Ls = (LAS float*)F.lds;
    LAS float* Lg = Ls + 8 * 1024;
    LAS unsigned* hist = (LAS unsigned*)(Lg + 32 * 33);
#pragma unroll
    for (int r = 0; r < 16; ++r) Ls[F.wave * 1024 + crow(r, hi) * 32 + i] = acc[r];
    if (F.tid < 64) hist[F.tid] = 0u;
    __syncthreads();
    const int tk = F.tid >> 4, sub = F.tid & 15;
    float l0 = F.in[I_BR][sub], l1 = F.in[I_BR][sub + 16];
#pragma unroll
    for (int w = 0; w < 8; ++w) { l0 += Ls[w * 1024 + tk * 32 + sub]; l1 += Ls[w * 1024 + tk * 32 + sub + 16]; }
    int be[4]; float bv[4];
#pragma unroll
    for (int k = 0; k < 4; ++k) { float v; int id;
        if (l0 >= l1) { v = l0; id = sub; } else { v = l1; id = sub + 16; }
        argmax16(v, id);
        be[k] = id; bv[k] = v;
        if (id == sub) l0 = -INFINITY;
        if (id == sub + 16) l1 = -INFINITY; }
    unsigned rank[4] = {0u, 0u, 0u, 0u};
    {
        float sum = 0.f; const float mx0 = bv[0];
#pragma unroll
        for (int k = 0; k < 4; ++k) { bv[k] = fexp2((bv[k] - mx0) * LOG2E); sum += bv[k]; }
        const float rs = 1.0f / sum;
#pragma unroll
        for (int k = 0; k < 4; ++k) bv[k] *= rs;
    }
    if (sub == 0) {
#pragma unroll
        for (int k = 0; k < 4; ++k) rank[k] = atomicAdd((unsigned*)&hist[be[k]], 1u);
    }
    __syncthreads();
    if (F.tid < 32) { const unsigned c = hist[F.tid]; hist[32 + F.tid] = c ? atomicAdd(F.ctl + (SHADOW ? CW_CNT2 : CW_CNT) + 64 * F.tid, c) : 0u; }
    __syncthreads();
    if (sub == 0) {
        const int tok = row0 + tk;
        const size_t sh_ = SHADOW ? WS_SHADOW : 0;
        int* lists = (int*)(F.ws + sh_ + WS_LISTS); int* tope = (int*)(F.ws + sh_ + WS_TOPE); float* topw = (float*)(F.ws + sh_ + WS_TOPW); int* topp = (int*)(F.ws + sh_ + WS_TOPP);
#pragma unroll
        for (int k = 0; k < 4; ++k) { const int pos = (int)(hist[32 + be[k]] + rank[k]);
            lists[(size_t)be[k] * T + pos] = tok; tope[tok * 4 + k] = be[k]; topw[tok * 4 + k] = bv[k]; topp[tok * 4 + k] = pos; }
    }
    __syncthreads();
}

__device__ __forceinline__ void moe_tables(Frame& F) {
    if (F.tid < 64) {
        const int e = F.lane & 31;
        const unsigned c = __hip_atomic_load(F.ctl + CW_CNT + 64 * e, __ATOMIC_RELAXED, __HIP_MEMORY_SCOPE_AGENT);
        const unsigned tl = (c + 255u) / 256u;
        unsigned incl = tl;
#pragma unroll
        for (int d = 1; d < 32; d <<= 1) { const unsigned o = __shfl(incl, (F.lane - d) & 63); if (e >= d) incl += o; }
        if (F.lane < 32) { F.MISC[MW_CNT + e] = c; F.MISC[MW_TPFX + e] = incl - tl; F.MISC[MW_ROFF + e] = (incl - tl) * 256u;
            if (e == 31) { F.MISC[MW_TPFX + NE] = incl; F.MISC[MW_ROFF + NE] = incl * 256u; } }
    }
    __syncthreads();
}

__device__ __forceinline__ void final_rows(Frame& F) {
    const int gw = F.vcu * NWAVES + F.wave, NGW = F.G * NWAVES;
    const float* mod = (const float*)(F.ws + WS_MOD);
    const float* X0 = F.in[I_X]; const bf16_t* MIX = (const bf16_t*)(F.ws + WS_MIX);
    const bf16_t* YD = (const bf16_t*)(F.ws + WS_YD);
    const int* tope = (const int*)(F.ws + WS_TOPE); const float* topw = (const float*)(F.ws + WS_TOPW); const int* topp = (const int*)(F.ws + WS_TOPP);
    const float* gf = F.in[I_GFIN];
    int m = gw;
    u32x4 ne = (u32x4){0u, 0u, 0u, 0u}, np = ne; f32x4 nw = (f32x4){0.f, 0.f, 0.f, 0.f}; f32x4 nx[4]; u32x2 nm[4];
    if (m < T) { ne = *(const u32x4*)(tope + m * 4); np = *(const u32x4*)(topp + m * 4); nw = *(const f32x4*)(topw + m * 4);
#pragma unroll
        for (int j = 0; j < 4; ++j) { nx[j] = ((const f32x4*)(X0 + (size_t)m * DM) + F.lane)[64 * j]; nm[j] = ((const u32x2*)(MIX + (size_t)m * DM) + F.lane)[64 * j]; } }
    for (; m < T; m += NGW) {
        const int b = m / SEQ;
        const u32x4 ce = ne, cp = np; const f32x4 cw = nw; f32x4 cx[4];
#pragma unroll
        for (int j = 0; j < 4; ++j) { const f32x4 g1 = *(const f32x4*)(mod + (size_t)b * 6144 + 2 * 1024 + 4 * F.lane + 256 * j);
            cx[j] = nx[j] + g1 * (f32x4){bflo(nm[j].x), bfhi(nm[j].x), bflo(nm[j].y), bfhi(nm[j].y)}; }
        size_t yrow[4];
#pragma unroll
        for (int k = 0; k < 4; ++k) yrow[k] = (size_t)(F.MISC[MW_ROFF + ce[k]] + cp[k]) * DM;
        u32x2 yw[4][4];
#pragma unroll
        for (int j = 0; j < 4; ++j)
#pragma unroll
            for (int k = 0; k < 4; ++k) yw[j][k] = *(const u32x2*)(YD + yrow[k] + 4 * F.lane + 256 * j);
        const int mn = m + NGW;
        if (mn < T) { ne = *(const u32x4*)(tope + mn * 4); np = *(const u32x4*)(topp + mn * 4); nw = *(const f32x4*)(topw + mn * 4);
#pragma unroll
            for (int j = 0; j < 4; ++j) { nx[j] = ((const f32x4*)(X0 + (size_t)mn * DM) + F.lane)[64 * j]; nm[j] = ((const u32x2*)(MIX + (size_t)mn * DM) + F.lane)[64 * j]; } }
        f32x4 v[4]; float s = 0.f;
#pragma unroll
        for (int j = 0; j < 4; ++j) { const int c = 4 * F.lane + 256 * j;
            f32x4 mo = (f32x4){0.f, 0.f, 0.f, 0.f};
#pragma unroll
            for (int k = 0; k < 4; ++k) mo += cw[k] * (f32x4){bflo(yw[j][k].x), bfhi(yw[j][k].x), bflo(yw[j][k].y), bfhi(yw[j][k].y)};
            const f32x4 gt = *(const f32x4*)(mod + (size_t)b * 6144 + 5 * 1024 + c);
            v[j] = cx[j] + gt * mo;
            s += (v[j][0] * v[j][0] + v[j][1] * v[j][1]) + (v[j][2] * v[j][2] + v[j][3] * v[j][3]); }
        const float rinv = __builtin_amdgcn_rsqf(wave_sum(s) * (1.0f / DM) + EPS);
        f32x4* orow = (f32x4*)(F.out + (size_t)m * DM) + F.lane;
#pragma unroll
        for (int j = 0; j < 4; ++j) orow[64 * j] = v[j] * rinv * *(const f32x4*)(gf + 4 * F.lane + 256 * j);
    }
}

constexpr int N_PHASES = 10;
#define REP0 1
#define REPB 1
#define REP1 1
#define REP6 1
#define REP2 1
#define REP3 1
#define REP4 1
#define REP5 1
#define REP7 1
#define REP8 1
#define REP9 1
__global__ void __launch_bounds__(NTHREADS, 2) mk_fwd(Args args) {
#ifdef EMU
    unsigned char* lds = emu_blk->lds;
#else
    extern __shared__ __attribute__((aligned(16))) unsigned char lds[];
#endif
    Frame F;
    F.lds = (LAS unsigned char*)lds;
    F.MISC = (volatile LAS unsigned*)(F.lds + MISC_OFF);
    F.tid = threadIdx.x; F.lane = F.tid & 63; F.wave = __builtin_amdgcn_readfirstlane(F.tid >> 6);
    F.G = gridDim.x; { const int bx = blockIdx.x; F.vcu = (F.G % 8 == 0) ? (bx % 8) * (F.G / 8) + bx / 8 : bx; }
    F.ws = args.ws; F.ctl = (unsigned*)(args.ws + WS_CTL); F.out = args.out;
#pragma unroll
    for (int k = 0; k < 24; ++k) F.in[k] = args.in[k];
    for (int u = F.tid; u < (LDS_BYTES - MISC_OFF) / 4; u += NTHREADS) F.MISC[u] = 0u;
    __syncthreads();
    XcdBarrier bar = xcd_barrier_post(F.ctl + CW_BAR, F.MISC + 8);
    const int lo = args.ph_lo, hi = args.ph_hi;
#ifndef EMU
#define STAMP(k) do { if (PROBE_K >= 0 && blockIdx.x == 0 && F.tid == 0) { const unsigned long long t_ = __builtin_amdgcn_s_memrealtime(); F.MISC[((k) >= 20 ? 360 : 256) + 2 * (k)] = (unsigned)t_; F.MISC[((k) >= 20 ? 361 : 257) + 2 * (k)] = (unsigned)(t_ >> 32); } } while (0)
#else
#define STAMP(k) ((void)0)
#endif
    STAMP(0);
#ifndef PH_MASK
#define PH_MASK 0xffff
#endif
#define IN(k) (((PH_MASK >> (k)) & 1) && lo <= (k) && (k) < hi)
#define SEAM(k) do { if (IN(k) && IN((k) + 1)) { xcd_barrier(bar); if (REPB > 1) xcd_barrier(bar); } } while (0)

    if (IN(0)) { p0_prologue(F); if (REP0 > 1) p0_prologue(F); }
    STAMP(20); SEAM(0); STAMP(1);
#ifndef EMU
    if (IN(0) && IN(1)) {
        if (F.tid == 0) { unsigned ok = 1u; for (int j = 0; j < 8; ++j) ok &= (xb_ld(F.ctl + CW_BAR + XB_XCNT(j)) == (unsigned)(F.G / 8)) ? 1u : 0u;
            F.MISC[12] = (ok && bar.x < 8u) ? (bar.x * (unsigned)(F.G / 8) + F.MISC[10]) : (unsigned)F.vcu; }
        __syncthreads();
        F.vcu = (int)F.MISC[12];
    }
#endif
    if (IN(1)) { norm_rows(F, F.in[I_X], F.in[I_GMIX], 0, 1, (bf16_t*)(F.ws + WS_HB)); if (REP1 > 1) norm_rows(F, F.in[I_X], F.in[I_GMIX], 0, 1, (bf16_t*)(F.ws + WS_HB)); }
    STAMP(21); SEAM(1); STAMP(2);
    if (IN(2)) {
        {
        pg8::DenseProb P{(const char*)(F.ws + WS_HB), (const char*)(F.ws + WS_WINT), DM * 2};
        pg8::DenseOrder S; S.init(T, ZP, F.G, (F.G % 8 == 0) ? (F.vcu % (F.G / 8)) * 8 + F.vcu / (F.G / 8) : (int)blockIdx.x);
        EpiZ E{(bf16_t*)(F.ws + WS_ZB)};
        pg8::gemm_phase<false>(F.lds, P, S, E);
        if (p2_fill_items(F) && S.c >= 128) {
            LAS float* scr = (LAS float*)(F.lds + 8192 + F.wave * 16384);
            const int base = P0_NITEMS - p2_fill_items(F) + (S.c - 128) * P2_FILL_PER_CU;
            for (int k = F.wave; k < P2_FILL_PER_CU; k += NWAVES) p0_item(F, scr, base + k);
        }
        }
        if (REP2 > 1) {
        pg8::DenseProb P{(const char*)(F.ws + WS_HB), (const char*)(F.ws + WS_WINT), DM * 2};
        pg8::DenseOrder S; S.init(T, ZP, F.G, (F.G % 8 == 0) ? (F.vcu % (F.G / 8)) * 8 + F.vcu / (F.G / 8) : (int)blockIdx.x);
        EpiZ E{(bf16_t*)(F.ws + WS_ZB)};
        pg8::gemm_phase<false>(F.lds, P, S, E);
        }
    }
    STAMP(22); SEAM(2); STAMP(3);
    if (IN(3)) {
        constexpr int NGM = BATCH * (SEQ / GMC) * GMG, NCT = 2 * BATCH * NG * (NCP / 32);
        for (int rep = 0; rep < (REP3 > 1 ? 2 : 1); ++rep) {
            if (F.G == 2 * NCT && NGM == 8 * NCT) {
                if (F.vcu < NCT) { cmp_tile(F, F.vcu); gmlp_run(F, 3 * F.vcu, 1, 3); }
                else gmlp_run(F, 3 * NCT + 5 * (F.vcu - NCT), 1, 5);
            } else { for (int it = F.vcu; it < NCT; it += F.G) cmp_tile(F, it);
                     const int first = ((F.vcu - NCT) % F.G + F.G) % F.G; gmlp_run(F, first, F.G, (NGM - first + F.G - 1) / F.G); }
        }
    }
    STAMP(23); SEAM(3); STAMP(4);
    if (IN(4)) {
        constexpr int NQT_ = SEQ / 64, NPAIR = BATCH * NQT_;
        for (int rep = 0; rep < (REP4 > 1 ? 2 : 1); ++rep)
        for (int pr = F.vcu; pr < NPAIR; pr += F.G) { const int b_ = pr / NQT_, x_ = pr % NQT_;
            for (int k2 = 0; k2 < 2; ++k2) nsa_task(F, k2 ? (b_ * NG + 0) * NQT_ + x_ : (b_ * NG + 1) * NQT_ + (NQT_ - 1 - x_)); }
    }
    STAMP(24); SEAM(4); STAMP(5);
    if (IN(5)) {
        {
        pg8::DenseProb P{(const char*)(F.ws + WS_YMIX), (const char*)(F.ws + WS_WOUTT), DM * 2};
        pg8::DenseOrder S; S.init(T, DM, F.G, (F.G % 8 == 0) ? (F.vcu % (F.G / 8)) * 8 + F.vcu / (F.G / 8) : (int)blockIdx.x);
        EpiMix E{(bf16_t*)(F.ws + WS_MIX)};
        pg8::gemm_phase<false>(F.lds, P, S, E);
        }
        if (REP5 > 1) {
        pg8::DenseProb P{(const char*)(F.ws + WS_YMIX), (const char*)(F.ws + WS_WOUTT), DM * 2};
        pg8::DenseOrder S; S.init(T, DM, F.G, (F.G % 8 == 0) ? (F.vcu % (F.G / 8)) * 8 + F.vcu / (F.G / 8) : (int)blockIdx.x);
        EpiMix E{(bf16_t*)(F.ws + WS_MIX)};
        pg8::gemm_phase<false>(F.lds, P, S, E);
        }
    }
    STAMP(25); SEAM(5); STAMP(6);
    if (IN(6)) { for (int it = F.vcu; it < T / 32; it += F.G) router_task<false>(F, it); if (REP6 > 1) for (int it = F.vcu; it < T / 32; it += F.G) router_task<true>(F, it); }
    STAMP(26); SEAM(6); STAMP(7);
    if (IN(7)) {
        {
        moe_tables(F);
        MoeProb1 P{(const char*)(F.ws + WS_H2), (const char*)(F.ws + WS_WGUT), (const int*)(F.ws + WS_LISTS), F.in[I_BGU], F.MISC + MW_CNT, DM};
        pg8::MoeOrder S{F.MISC + MW_TPFX, 8, F.G, F.vcu, 0};
        EpiAct E{(unsigned char*)(F.ws + WS_ACT), F.in[I_BGU], F.MISC + MW_ROFF};
        pg8::gemm_phase<true>(F.lds, P, S, E);
        }
        if (REP7 > 1) {
        moe_tables(F);
        MoeProb1 P{(const char*)(F.ws + WS_H2), (const char*)(F.ws + WS_WGUT), (const int*)(F.ws + WS_LISTS), F.in[I_BGU], F.MISC + MW_CNT, DM};
        pg8::MoeOrder S{F.MISC + MW_TPFX, 8, F.G, F.vcu, 0};
        EpiAct E{(unsigned char*)(F.ws + WS_ACT), F.in[I_BGU], F.MISC + MW_ROFF};
        pg8::gemm_phase<true>(F.lds, P, S, E);
        }
    }
    STAMP(27); SEAM(7); STAMP(8);
    if (IN(8)) {
        {
        moe_tables(F);
        MoeProb2 P{(const char*)(F.ws + WS_ACT), (const char*)(F.ws + WS_WDNT), F.in[I_BDN], F.MISC + MW_ROFF, DFF};
        pg8::MoeOrder S{F.MISC + MW_TPFX, 4, F.G, F.vcu, 0};
        EpiYd E{(bf16_t*)(F.ws + WS_YD), F.in[I_BDN], F.MISC + MW_ROFF};
        pg8::gemm_phase<true>(F.lds, P, S, E);
        }
        if (REP8 > 1) {
        moe_tables(F);
        MoeProb2 P{(const char*)(F.ws + WS_ACT), (const char*)(F.ws + WS_WDNT), F.in[I_BDN], F.MISC + MW_ROFF, DFF};
        pg8::MoeOrder S{F.MISC + MW_TPFX, 4, F.G, F.vcu, 0};
        EpiYd E{(bf16_t*)(F.ws + WS_YD), F.in[I_BDN], F.MISC + MW_ROFF};
        pg8::gemm_phase<true>(F.lds, P, S, E);
        }
    }
    STAMP(28); SEAM(8); STAMP(9);
    if (IN(9)) { moe_tables(F); final_rows(F); if (REP9 > 1) final_rows(F); }
#ifndef EMU
    if (PROBE_K >= 0 && blockIdx.x == 0 && F.tid == 0) {
        STAMP(10);
        unsigned long long a_ = 0, b_ = 0;
        if (PROBE_K == 19) { a_ = ((unsigned long long)F.MISC[257] << 32) | F.MISC[256]; b_ = ((unsigned long long)F.MISC[257 + 20] << 32) | F.MISC[256 + 20]; }
        else if (PROBE_K < 20) { a_ = ((unsigned long long)F.MISC[257 + 2 * (PROBE_K % 20)] << 32) | F.MISC[256 + 2 * (PROBE_K % 20)];
                            b_ = ((unsigned long long)F.MISC[259 + 2 * (PROBE_K % 20)] << 32) | F.MISC[258 + 2 * (PROBE_K % 20)]; }
        else if (PROBE_K >= 30 && PROBE_K < 40) { a_ = ((unsigned long long)F.MISC[361 + 2 * (20 + PROBE_K - 30)] << 32) | F.MISC[360 + 2 * (20 + PROBE_K - 30)]; b_ = ((unsigned long long)F.MISC[257 + 2 * (PROBE_K - 30 + 1)] << 32) | F.MISC[256 + 2 * (PROBE_K - 30 + 1)]; }
        else if (PROBE_K >= 50) b_ = F.MISC[300 + 6 + (PROBE_K % 10)];
        else b_ = F.MISC[300 + (PROBE_K - 20)];
        const unsigned long long t0_ = __builtin_amdgcn_s_memrealtime();
        while (__builtin_amdgcn_s_memrealtime() - t0_ < (b_ - a_)) __builtin_amdgcn_s_sleep(8);
    }
#endif
#undef IN
#undef SEAM
}

#ifdef EMU
struct EmuDump { const char* name; size_t off; size_t bytes; };
EmuDump emu_dumps[] = {
    {"mod", WS_MOD, (size_t)BATCH * 6144 * 4}, {"bpe", WS_BPE, 512 * 4}, {"wint", WS_WINT, (size_t)ZP * DM * 2}, {"hb", WS_HB, (size_t)T * DM * 2},
    {"zb", WS_ZB, (size_t)T * ZP * 2}, {"kc", WS_KC, (size_t)BATCH * NG * NCP * 64 * 2}, {"vc", WS_VC, (size_t)BATCH * NG * NCP * 64 * 2},
    {"ymix", WS_YMIX, (size_t)T * DM * 2}, {"mix", WS_MIX, (size_t)T * DM * 2}, {"h2", WS_H2, (size_t)T * DM * 2},
    {"tope", WS_TOPE, (size_t)T * 16}, {"topw", WS_TOPW, (size_t)T * 16}, {"topp", WS_TOPP, (size_t)T * 16}, {"ctl", WS_CTL, CTL_ZERO_BYTES},
};
int emu_ndumps = sizeof(emu_dumps) / sizeof(emu_dumps[0]);
size_t emu_ws_bytes = WS_END;
int emu_out_elems = T * DM;
#endif

extern "C" void kernel_launch(void* const* d_in, const int* in_sizes, int n_in, void* d_out, int out_size, void* d_ws, size_t ws_size, hipStream_t stream) {
    (void)in_sizes; (void)out_size; (void)ws_size;
    Args a{};
    for (int i = 0; i < 24 && i < n_in; ++i) a.in[i] = (const float*)d_in[i];
    a.out = (float*)d_out; a.ws = (unsigned char*)d_ws;
#ifndef EMU
    (void)hipMemsetAsync((char*)d_ws + WS_CTL, 0, CTL_ZERO_BYTES, stream);
#endif
#ifdef EMU
    int plo = 0, phi = N_PHASES;
    if (const char* e = getenv("EMU_PH_LO")) plo = atoi(e);
    if (const char* e = getenv("EMU_PH_HI")) phi = atoi(e);
    if (plo == 0) (void)hipMemsetAsync((char*)d_ws + WS_CTL, 0, CTL_ZERO_BYTES, stream);
    const int grid = emu_num_cus();
    for (int ph = plo; ph < phi; ++ph) { a.ph_lo = ph; a.ph_hi = ph + 1; Args ac = a; fprintf(stderr, "EMU phase %d\n", ph);
        emu_launch(grid, NTHREADS, LDS_BYTES, [ac]() { mk_fwd(ac); }); }
#else
    static int grid = 0;
    if (grid == 0) {
        int dev = 0, cus = 0, per_cu = 0;
        (void)hipGetDevice(&dev);
        (void)hipDeviceGetAttribute(&cus, hipDeviceAttributeMultiprocessorCount, dev);
        (void)hipFuncSetAttribute((const void*)mk_fwd, hipFuncAttributeMaxDynamicSharedMemorySize, LDS_BYTES);
        (void)hipOccupancyMaxActiveBlocksPerMultiprocessor(&per_cu, (const void*)mk_fwd, NTHREADS, LDS_BYTES);
        if (per_cu < 1) fprintf(stderr, "kernel_launch: occupancy query reports %d blocks/CU\n", per_cu);
        grid = cus;
        (void)hipGetLastError();
    }
    a.ph_lo = 0; a.ph_hi = N_PHASES;
    void* kargs[] = {&a};
    hipError_t e = hipLaunchCooperativeKernel((const void*)mk_fwd, dim3(grid), dim3(NTHREADS), kargs, LDS_BYTES, stream);
    if (e != hipSuccess) fprintf(stderr, "cooperative launch failed: %s (grid %d)\n", hipGetErrorString(e), grid);
#endif
}
```

```cpp
#ifndef EMU
#include <hip/hip_runtime.h>
#endif
#include <cstdio>
#include <cstdint>

#ifndef CFG_BATCH
#define CFG_BATCH 2
#endif
#ifndef CFG_SEQ
#define CFG_SEQ 8192
#endif

#define PROBE_K -1
#ifdef EMU
#define NOSPEC() ((void)0)
#define LAS
#define ASM_VMCNT(n) ((void)0)
#define ASM_LGKMCNT(n) ((void)0)
#define WAVE_SYNC() emu_wave_sync()
#define FENCE() ((void)0)
#else
#define NOSPEC() asm volatile("; rare path" ::: "memory")
#define LAS __attribute__((address_space(3)))
#define ASM_VMCNT(n) asm volatile("s_waitcnt vmcnt(" #n ")" ::: "memory")
#define ASM_LGKMCNT(n) asm volatile("s_waitcnt lgkmcnt(" #n ")" ::: "memory")
#define WAVE_SYNC() asm volatile("s_waitcnt lgkmcnt(0)" ::: "memory")
#define FENCE() asm volatile("" ::: "memory")
#endif

typedef unsigned short bf16_t;
typedef short bf16x8 __attribute__((ext_vector_type(8)));
typedef short s16x4 __attribute__((ext_vector_type(4)));
typedef float f32x4 __attribute__((ext_vector_type(4)));
typedef float f32x16 __attribute__((ext_vector_type(16)));
typedef unsigned u32x4 __attribute__((ext_vector_type(4)));
typedef unsigned u32x2 __attribute__((ext_vector_type(2)));

constexpr int NWAVES = 8, NTHREADS = 512;
constexpr int BATCH = CFG_BATCH, SEQ = CFG_SEQ, DM = 1024, T = BATCH * SEQ;
constexpr int GMW = 512, GMG = 8, GMC = 128;
constexpr int NH = 8, NG = 2, NR = 4, HD = 64;
constexpr int INC = 2328, ZP = 2560;
constexpr int ZC_U = 0, ZC_V = 512, ZC_Q = 1024, ZC_KC = 1536, ZC_VC = 1664, ZC_KS = 1792, ZC_VS = 1920, ZC_KW = 2048, ZC_VW = 2176, ZC_GL = 2304;
constexpr int NCMP = SEQ / 16 - 1, NCP = SEQ / 16;
constexpr int NBLK = SEQ / 64;
constexpr int NSEL = NBLK < 16 ? NBLK : 16;
constexpr int NE = 32, TOPK = 4, DFF = 1024;
constexpr int TK = T * TOPK;
constexpr int ACT_ROWS = TK + NE * 256;
constexpr float EPS = 1e-6f;
constexpr float LOG2E = 1.4426950408889634f;
constexpr float F8_ACT_SCALE = 8.0f, F8_W_SCALE = 64.0f, F8_ACC_SCALE = 1.0f / 512.0f;

constexpr size_t MiB = 1u << 20;
constexpr size_t WS_CTL = 0, CTL_ZERO_BYTES = 192 * 1024;
constexpr size_t WS_MOD = 1 * MiB;
constexpr size_t WS_BPE = 1 * MiB + 512 * 1024;
constexpr size_t WS_LISTS = 2 * MiB;
constexpr size_t WS_TOPE = 4 * MiB;
constexpr size_t WS_TOPW = 4 * MiB + 512 * 1024;
constexpr size_t WS_TOPP = 5 * MiB;
constexpr size_t WS_WSBF = 6 * MiB;
constexpr size_t WS_W2KT = 6 * MiB + 512 * 1024;
constexpr size_t WS_W2VT = WS_W2KT + 64 * 1024;
constexpr size_t WS_W1KT = 7 * MiB;
constexpr size_t WS_W1VT = 8 * MiB;
constexpr size_t WS_WOUTT = 9 * MiB;
constexpr size_t WS_WINT = 11 * MiB;
constexpr size_t WS_KC = 16 * MiB;
constexpr size_t WS_VC = 16 * MiB + 512 * 1024;
constexpr size_t WS_WGUT = 32 * MiB;
constexpr size_t WS_WDNT = 160 * MiB;
constexpr size_t WS_HB = 224 * MiB;
constexpr size_t WS_H2 = 256 * MiB;
constexpr size_t WS_ZB = 288 * MiB;
constexpr size_t WS_YMIX = 368 * MiB;
constexpr size_t WS_MIX = 400 * MiB;
constexpr size_t WS_ACT = 464 * MiB;
constexpr size_t WS_YD = 608 * MiB;
constexpr size_t WS_YACC = 768 * MiB;
constexpr size_t WS_END = 804 * MiB;
constexpr int CW_BAR = 4096;
constexpr int CW_CNT = 16384;
constexpr int CW_CNT2 = 32768;
constexpr size_t WS_SHADOW = 752 * MiB;

constexpr int RING_BYTES = 131072;
constexpr int MISC_OFF = 155648;
constexpr int LDS_BYTES = 159744;
constexpr int MW_CNT = 16, MW_TPFX = 64, MW_ROFF = 128;

__device__ __forceinline__ unsigned f2bf(float f) { unsigned u = __builtin_bit_cast(unsigned, f); return (u + 0x7fffu + ((u >> 16) & 1u)) >> 16; }
#ifdef EMU
__device__ __forceinline__ unsigned pk2(float lo, float hi) { return f2bf(lo) | (f2bf(hi) << 16); }
#else
typedef float f32x2_t __attribute__((ext_vector_type(2))); typedef __bf16 bf16x2_t __attribute__((ext_vector_type(2)));
__device__ __forceinline__ unsigned pk2(float lo, float hi) { f32x2_t v = {lo, hi}; bf16x2_t bb = __builtin_convertvector(v, bf16x2_t); return __builtin_bit_cast(unsigned, bb); }
#endif
__device__ __forceinline__ unsigned pk4_fp8(float a, float b, float c, float d) {
    a = fminf(fmaxf(a, -448.f), 448.f); b = fminf(fmaxf(b, -448.f), 448.f); c = fminf(fmaxf(c, -448.f), 448.f); d = fminf(fmaxf(d, -448.f), 448.f);
    int w = 0; w = __builtin_amdgcn_cvt_pk_fp8_f32(a, b, w, false); w = __builtin_amdgcn_cvt_pk_fp8_f32(c, d, w, true); return (unsigned)w;
}
__device__ __forceinline__ unsigned pk4_fp8_nc(float a, float b, float c, float d) {
    int w = 0; w = __builtin_amdgcn_cvt_pk_fp8_f32(a, b, w, false); w = __builtin_amdgcn_cvt_pk_fp8_f32(c, d, w, true); return (unsigned)w;
}
typedef int v8i_t __attribute__((ext_vector_type(8)));
typedef int v4i_t __attribute__((ext_vector_type(4)));
__device__ __forceinline__ float bf2f(unsigned short h) { return __builtin_bit_cast(float, (unsigned)h << 16); }
__device__ __forceinline__ float bflo(unsigned w) { return __builtin_bit_cast(float, w << 16); }
__device__ __forceinline__ float bfhi(unsigned w) { return __builtin_bit_cast(float, w & 0xffff0000u); }
__device__ __forceinline__ float fexp2(float x) { return __builtin_amdgcn_exp2f(x); }
__device__ __forceinline__ float gelu_tanh(float x) {
    const float y2 = 1.5957691216057308f * (x + 0.044715f * x * x * x);
    return x * __builtin_amdgcn_rcpf(1.0f + fexp2(-y2 * LOG2E));
}
__device__ __forceinline__ float sigmoidf_(float x) { return __builtin_amdgcn_rcpf(1.0f + fexp2(-x * LOG2E)); }
__device__ __forceinline__ float wave_sum(float v) {
#pragma unroll
    for (int o = 1; o < 64; o <<= 1) v += __shfl_xor(v, o);
    return v;
}
__device__ __forceinline__ int crow(int r, int hi) { return (r & 3) + 8 * (r >> 2) + 4 * hi; }

#define XB_TMO      128
#define XB_XCNT(j)  (256  + 64 * (j))
#define XB_XSUB(j)  (1280 + 64 * (j))
#define XB_XGEN(j)  (2304 + 64 * (j))
#define XB_TOP      3328
#define XB_TOPGEN   3392
#define XCD_BAR_WORDS 3456
#define XB_SPIN_CAP (1u << 18)
struct XcdBarrier { unsigned* bar; unsigned x; volatile LAS unsigned* st; };
#ifndef EMU
__device__ __forceinline__ unsigned xb_ld(unsigned* p)              { return __hip_atomic_load(p, __ATOMIC_RELAXED, __HIP_MEMORY_SCOPE_AGENT); }
__device__ __forceinline__ unsigned xb_add(unsigned* p, unsigned v) { return __hip_atomic_fetch_add(p, v, __ATOMIC_RELAXED, __HIP_MEMORY_SCOPE_AGENT); }
__device__ __forceinline__ unsigned xb_xcc_id() { return (unsigned)__builtin_amdgcn_s_getreg((3 << 11) | 20) & 0xFu; }
#define XB_SPIN(cond, bar) do { unsigned _sp = 0; while (cond) { __builtin_amdgcn_s_sleep(1); \
    if ((++_sp & 255u) == 0u) { if (xb_ld(&(bar)[XB_TMO])) break; if (_sp > XB_SPIN_CAP) { atomicAdd(&(bar)[XB_TMO], 1u); break; } } } } while (0)
__device__ __forceinline__ XcdBarrier xcd_barrier_post(unsigned* bar, volatile LAS unsigned* st) {
    XcdBarrier b; b.bar = bar; b.x = xb_xcc_id(); b.st = st;
    if (threadIdx.x == 0) st[2] = xb_add(&bar[XB_XCNT(b.x)], 1u);
    return b;
}
__device__ __forceinline__ void xcd_barrier_complete(unsigned* bar, unsigned x, unsigned& nloc, unsigned& nx) {
    const unsigned G = gridDim.x * gridDim.y * gridDim.z;
    unsigned sum, cnt, mine, sp = 0u;
    for (;;) {
        sum = 0u; cnt = 0u; mine = 0u;
#pragma unroll
        for (unsigned j = 0; j < 16; ++j) { const unsigned c = xb_ld(&bar[XB_XCNT(j)]); sum += c; cnt += (c > 0u) ? 1u : 0u; mine = (j == x) ? c : mine; }
        if (sum == G) break;
        __builtin_amdgcn_s_sleep(1);
        if ((++sp & 255u) == 0u) { if (xb_ld(&bar[XB_TMO])) break; if (sp > XB_SPIN_CAP) { atomicAdd(&bar[XB_TMO], 1u); break; } }
    }
    nloc = mine > 0u ? mine : 1u; nx = cnt > 0u ? cnt : 1u;
}
__device__ __forceinline__ void xcd_barrier(const XcdBarrier& b) {
    asm volatile("s_waitcnt vmcnt(0)" ::: "memory");
    __syncthreads();
    if (threadIdx.x == 0) {
        unsigned* bar = b.bar;
        __builtin_amdgcn_s_waitcnt(0);
        unsigned nloc = b.st[0], nx = b.st[1];
        if (nloc == 0u) { xcd_barrier_complete(bar, b.x, nloc, nx); b.st[0] = nloc; b.st[1] = nx; }
        const unsigned old = xb_add(&bar[XB_XSUB(b.x)], 1u);
        const unsigned gen = old / nloc;
        if (old + 1u == (gen + 1u) * nloc) {
            __builtin_amdgcn_fence(__ATOMIC_RELEASE, "agent");
            asm volatile("s_waitcnt vmcnt(0)" ::: "memory");
            const unsigned og = xb_add(&bar[XB_TOP], 1u);
            const unsigned tg = og / nx;
            if (og + 1u == (tg + 1u) * nx) xb_add(&bar[XB_TOPGEN], 1u);
            else XB_SPIN(xb_ld(&bar[XB_TOPGEN]) == tg, bar);
            __builtin_amdgcn_fence(__ATOMIC_ACQUIRE, "agent");
            xb_add(&bar[XB_XGEN(b.x)], 1u);
            asm volatile("s_waitcnt vmcnt(0)" ::: "memory");
        } else {
            XB_SPIN(xb_ld(&bar[XB_XGEN(b.x)]) == gen, bar);
            __builtin_amdgcn_fence(__ATOMIC_ACQUIRE, "agent");
            asm volatile("s_waitcnt vmcnt(0)" ::: "memory");
        }
    }
    __syncthreads();
}
#else
__device__ __forceinline__ XcdBarrier xcd_barrier_post(unsigned* bar, volatile unsigned* st) { XcdBarrier b; b.bar = bar; b.x = 0; b.st = st; return b; }
__device__ __forceinline__ void xcd_barrier(const XcdBarrier&) { fprintf(stderr, "EMU: grid barrier inside a launch\n"); abort(); }
#endif

struct Args { const float* in[24]; float* out; unsigned char* ws; int ph_lo, ph_hi; };
enum { I_X = 0, I_C, I_WADA, I_BADA, I_GMIX, I_WIN, I_GMWS, I_GMBS, I_GMNG, I_PEK, I_W1K, I_W2K, I_PEV, I_W1V, I_W2V, I_WOUT, I_GFFN, I_WR, I_BR, I_WGU, I_BGU, I_WDN, I_BDN, I_GFIN };

struct Frame {
    LAS unsigned char* lds;
    volatile LAS unsigned* MISC;
    unsigned* ctl;
    unsigned char* ws;
    const float* in[24];
    float* out;
    int tid, lane, wave, vcu, G;
};

namespace pg8 {
constexpr int BM = 256, BK = 64, HALF = 128, HTB = HALF * BK * 2, STAGE_BYTES = 8 * HTB;
__device__ __forceinline__ int lds_byte(int r, int c) { const int st = (r >> 4) * 2 + (c >> 5), rr = r & 15, cc = c & 31, ob = rr * 64 + cc * 2; return st * 1024 + (ob ^ (((ob >> 9) & 1) << 5)); }
__device__ __forceinline__ void stage_rc(int b, int& R, int& C) { const int st = b / 1024, sb = b % 1024, swz = sb ^ (((sb >> 9) & 1) << 5); R = (st >> 1) * 16 + swz / 64; C = (st & 1) * 32 + (swz % 64) / 2; }
__device__ __forceinline__ int perm32(int rho) { const int n = rho >> 4, i = rho & 15; return 8 * (i >> 2) + 4 * n + (i & 3); }
struct Unit { int pm, pn, e; };

template <bool FP8, class Prob, class Sched, class Epi>
__device__ __forceinline__ void gemm_phase(LAS unsigned char* lds, const Prob& P, const Sched& S, const Epi& E) {
    const int tid = threadIdx.x, wid = __builtin_amdgcn_readfirstlane(tid >> 6), lane = tid & 63, wr = wid >> 2, wc = wid & 3, fr = lane & 15, fq = lane >> 4;
    const int KB = P.KB, nt = KB / 128;
    int Rr[2], Cc[2]; unsigned voffB[2];
#pragma unroll
    for (int i = 0; i < 2; ++i) { int R, C; stage_rc(tid * 16 + i * 8192, R, C); Rr[i] = R; Cc[i] = C; const int Rb = Epi::PERM ? ((R & ~31) + perm32(R & 31)) : R; voffB[i] = (unsigned)(Rb * KB + C * 2); }
    const size_t kstep = (size_t)(BK * 2);
    const size_t hstepB = (size_t)HALF * KB;
    const unsigned ldsw = (unsigned)wid * 1024u;
    const int aoff = lds_byte(wr * 64 + fr, fq * 8), boff = lds_byte(wc * 32 + fr, fq * 8);
#define PG8_SA(b, h) (((b) * 2 + (h)) * HTB)
#define PG8_SB(b, h) ((4 + (b) * 2 + (h)) * HTB)
#define PG8_STAGE(bufoff, gbase, voff) do { _Pragma("unroll") for (int _i = 0; _i < 2; ++_i) \
        __builtin_amdgcn_global_load_lds((const unsigned*)((const char*)(gbase) + (voff)[_i]), (LAS unsigned*)(lds + (bufoff) + ldsw + _i * 8192), 16, 0, 0); } while (0)
#define PG8_LD8(p) __builtin_shufflevector(*(const LAS v4i_t*)(p), *(const LAS v4i_t*)((p) + 1024), 0, 1, 2, 3, 4, 5, 6, 7)
#define PG8_LDA(dst, b, h) do { _Pragma("unroll") for (int m = 0; m < 4; ++m) dst[m] = PG8_LD8(lds + PG8_SA(b, h) + aoff + m * 2048); } while (0)
#define PG8_LDB(dst, b, h) do { _Pragma("unroll") for (int n = 0; n < 2; ++n) dst[n] = PG8_LD8(lds + PG8_SB(b, h) + boff + n * 2048); } while (0)
#define PG8_LO(x) __builtin_bit_cast(bf16x8, __builtin_shufflevector(x, x, 0, 1, 2, 3))
#define PG8_HI(x) __builtin_bit_cast(bf16x8, __builtin_shufflevector(x, x, 4, 5, 6, 7))
#ifdef EMU
#define PG8_MFMA_F8(c_, b_, a_) c_ = __builtin_amdgcn_mfma_scale_f32_16x16x128_f8f6f4(b_, a_, c_, 0, 0, 0, 0x7F7F7F7F, 0, 0x7F7F7F7F)
#else
#define PG8_MFMA_F8(c_, b_, a_) asm volatile("v_mfma_scale_f32_16x16x128_f8f6f4 %0, %1, %2, %0, %3, %3 op_sel_hi:[0,0,0]" : "+v"(c_) : "v"(b_), "v"(a_), "v"(f8one))
#endif
#define PG8_MMA(ai, bj, At, Bt) do { __builtin_amdgcn_s_setprio(1); \
        if (FP8) { _Pragma("unroll") for (int m = 0; m < 4; ++m) _Pragma("unroll") for (int n = 0; n < 2; ++n) PG8_MFMA_F8(acc[ai][bj][m][n], Bt[n], At[m]); } \
        else { _Pragma("unroll") for (int m = 0; m < 4; ++m) _Pragma("unroll") for (int n = 0; n < 2; ++n) { \
            acc[ai][bj][m][n] = __builtin_amdgcn_mfma_f32_16x16x32_bf16(PG8_LO(Bt[n]), PG8_LO(At[m]), acc[ai][bj][m][n], 0, 0, 0); \
            acc[ai][bj][m][n] = __builtin_amdgcn_mfma_f32_16x16x32_bf16(PG8_HI(Bt[n]), PG8_HI(At[m]), acc[ai][bj][m][n], 0, 0, 0); } } \
        __builtin_amdgcn_s_setprio(0); } while (0)
#define PG8_WAIT_V(n) ASM_VMCNT(n)
#define PG8_WAIT_L(n) ASM_LGKMCNT(n)
#define PG8_BAR __builtin_amdgcn_s_barrier()
#define PG8_SCHED __builtin_amdgcn_sched_barrier(0)
#ifndef EMU
    unsigned long long ge0_ = 0; const bool gprobe0_ = (PROBE_K / 10 == Epi::PID) && blockIdx.x == 0 && tid == 0;
    if (gprobe0_) ge0_ = __builtin_amdgcn_s_memrealtime();
#endif
    Unit cur, nxt; int ui = 0;
    if (!S.next(0, cur)) return;
    f32x4 acc[2][2][4][2];
#pragma unroll
    for (int a = 0; a < 2; ++a)
#pragma unroll
        for (int b = 0; b < 2; ++b)
#pragma unroll
            for (int m = 0; m < 4; ++m)
#pragma unroll
                for (int n = 0; n < 2; ++n) acc[a][b][m][n] = (f32x4){0.f, 0.f, 0.f, 0.f};
    v8i_t At[4], B0[2], B1[2];
    int f8one = 0x7F7F7F7F;
#ifndef EMU
    asm volatile("" : "+v"(f8one));
#endif
    (void)f8one;
    unsigned vA0[2], vA1[2], nA0[2], nA1[2];
#define PG8_SIDE(k) (lds + STAGE_BYTES + ((k) % 3) * 2048)
    if (Prob::SIDE) { P.side_issue(cur, PG8_SIDE(0), wid, lane); PG8_WAIT_V(0); PG8_BAR; }
#pragma unroll
    for (int i = 0; i < 2; ++i) { vA0[i] = P.a_rowoff(cur, Rr[i], PG8_SIDE(0)) + (unsigned)Cc[i] * 2u; vA1[i] = P.a_rowoff(cur, HALF + Rr[i], PG8_SIDE(0)) + (unsigned)Cc[i] * 2u; }
    const char* cA = P.a_base(cur); const char* cB = P.b_base(cur);
    PG8_STAGE(PG8_SB(0, 0), cB, voffB); PG8_STAGE(PG8_SB(0, 1), cB + hstepB, voffB); PG8_STAGE(PG8_SA(0, 0), cA, vA0); PG8_STAGE(PG8_SA(0, 1), cA, vA1);
    if (wr == 1) PG8_BAR;
    PG8_WAIT_V(2); PG8_BAR;
    PG8_STAGE(PG8_SB(1, 0), cB + kstep, voffB); PG8_STAGE(PG8_SA(1, 0), cA + kstep, vA0); PG8_STAGE(PG8_SB(1, 1), cB + hstepB + kstep, voffB);
    PG8_WAIT_V(6); PG8_BAR;
    for (;;) {
        const bool has_next = S.next(ui + 1, nxt);
        const char* nA = has_next ? P.a_base(nxt) : cA; const char* nB = has_next ? P.b_base(nxt) : cB;
        if (Prob::SIDE && has_next) P.side_issue(nxt, PG8_SIDE(ui + 1), wid, lane);
#pragma unroll
        for (int i = 0; i < 2; ++i) { nA0[i] = vA0[i]; nA1[i] = vA1[i]; }
        if (!Prob::SIDE && has_next) {
#pragma unroll
            for (int i = 0; i < 2; ++i) { nA0[i] = P.a_rowoff(nxt, Rr[i], PG8_SIDE(0)) + (unsigned)Cc[i] * 2u; nA1[i] = P.a_rowoff(nxt, HALF + Rr[i], PG8_SIDE(0)) + (unsigned)Cc[i] * 2u; }
        }
#ifndef EMU
        unsigned long long gt0_ = 0; const bool gprobe_ = (PROBE_K / 10 == Epi::PID) && blockIdx.x == 0 && tid == 0;
        if (gprobe_) { gt0_ = __builtin_amdgcn_s_memrealtime(); if (ui == 0) ((volatile LAS unsigned*)(lds + MISC_OFF))[300 + 8] += (unsigned)(gt0_ - ge0_); }
#endif
        for (int t = 0; t < nt; t += 2) {
            const bool last = (t == nt - 2);
            if (Prob::SIDE && has_next && t == nt - 4) {
#pragma unroll
                for (int i = 0; i < 2; ++i) { nA0[i] = P.a_rowoff(nxt, Rr[i], PG8_SIDE(ui + 1)) + (unsigned)Cc[i] * 2u; nA1[i] = P.a_rowoff(nxt, HALF + Rr[i], PG8_SIDE(ui + 1)) + (unsigned)Cc[i] * 2u; }
            }
            const char* a1 = cA + (size_t)(t + 1) * kstep;
            const char* a2 = last ? nA : cA + (size_t)(t + 2) * kstep; const char* b2 = last ? nB : cB + (size_t)(t + 2) * kstep;
            const char* a3 = a2 + kstep; const char* b3 = b2 + kstep;
            unsigned s0[2], s1[2];
#pragma unroll
            for (int i = 0; i < 2; ++i) { s0[i] = last ? nA0[i] : vA0[i]; s1[i] = last ? nA1[i] : vA1[i]; }
            PG8_LDB(B0, 0, 0); PG8_LDB(B1, 0, 1); PG8_SCHED; PG8_LDA(At, 0, 0); PG8_STAGE(PG8_SA(1, 1), a1, vA1);
            PG8_WAIT_V(8); PG8_WAIT_L(0); PG8_BAR; PG8_MMA(0, 0, At, B0); PG8_MMA(0, 1, At, B1); PG8_BAR; PG8_SCHED;
            PG8_LDA(At, 0, 1); PG8_STAGE(PG8_SB(0, 0), b2, voffB); PG8_STAGE(PG8_SB(0, 1), b2 + hstepB, voffB); PG8_STAGE(PG8_SA(0, 0), a2, s0);
            PG8_WAIT_V(8); PG8_WAIT_L(0); PG8_BAR; PG8_MMA(1, 0, At, B0); PG8_MMA(1, 1, At, B1); PG8_BAR; PG8_SCHED;
            PG8_LDB(B0, 1, 0); PG8_LDB(B1, 1, 1); PG8_SCHED; PG8_LDA(At, 1, 0); PG8_STAGE(PG8_SA(0, 1), a2, s1);
            PG8_WAIT_V(8); PG8_WAIT_L(0); PG8_BAR; PG8_MMA(0, 0, At, B0); PG8_MMA(0, 1, At, B1); PG8_BAR; PG8_SCHED;
            PG8_LDA(At, 1, 1); PG8_STAGE(PG8_SB(1, 0), b3, voffB); PG8_STAGE(PG8_SB(1, 1), b3 + hstepB, voffB); PG8_STAGE(PG8_SA(1, 0), a3, s0);
            PG8_WAIT_V(8); PG8_WAIT_L(0); PG8_BAR; PG8_MMA(1, 0, At, B0); PG8_MMA(1, 1, At, B1); PG8_BAR; PG8_SCHED;
        }
#ifndef EMU
        if (gprobe_) { const unsigned long long t1_ = __builtin_amdgcn_s_memrealtime(); ((volatile LAS unsigned*)(lds + MISC_OFF))[300 + 6] += (unsigned)(t1_ - gt0_); gt0_ = t1_; }
#endif
        if (wr == 0) PG8_BAR;
#ifndef EMU
        if (FP8) asm volatile("s_nop 15\n\ts_nop 15" ::: "memory");
#endif
        E(acc, cur, wr, wc, fr, fq, (const LAS float*)(PG8_SIDE(ui) + 1024));
        if (!has_next) break;
#pragma unroll
        for (int a = 0; a < 2; ++a)
#pragma unroll
            for (int b = 0; b < 2; ++b)
#pragma unroll
                for (int m = 0; m < 4; ++m)
#pragma unroll
                    for (int n = 0; n < 2; ++n) acc[a][b][m][n] = (f32x4){0.f, 0.f, 0.f, 0.f};
#ifndef EMU
        if (gprobe_) { const unsigned long long t1_ = __builtin_amdgcn_s_memrealtime(); ((volatile LAS unsigned*)(lds + MISC_OFF))[300 + 7] += (unsigned)(t1_ - gt0_); }
#endif
        cur = nxt; cA = nA; cB = nB; ++ui;
#pragma unroll
        for (int i = 0; i < 2; ++i) { vA0[i] = nA0[i]; vA1[i] = nA1[i]; }
        if (wr == 1) PG8_BAR;
    }
#ifndef EMU
    if (gprobe0_) ge0_ = __builtin_amdgcn_s_memrealtime();
#endif
    PG8_WAIT_V(0);
    PG8_BAR;
#ifndef EMU
    if (gprobe0_) ((volatile LAS unsigned*)(lds + MISC_OFF))[300 + 9] += (unsigned)(__builtin_amdgcn_s_memrealtime() - ge0_);
#endif
#undef PG8_SIDE
#undef PG8_SA
#undef PG8_SB
#undef PG8_STAGE
#undef PG8_LDA
#undef PG8_LDB
#undef PG8_MMA
#undef PG8_MFMA_F8
#undef PG8_LD8
#undef PG8_LO
#undef PG8_HI
#undef PG8_WAIT_V
#undef PG8_WAIT_L
#undef PG8_BAR
#undef PG8_SCHED
}

struct DenseOrder {
    int nM, nN, nwg, G, c;
    __device__ __forceinline__ void init(int M, int N, int G_, int c_) { nM = M / BM; nN = N / BM; nwg = nM * nN; G = G_; c = c_; }
    __device__ __forceinline__ bool next(int i, Unit& u) const {
        const long L = (long)i * G + c; if (L >= nwg) return false;
        int wgid = (int)L; { const int q = nwg / 8, r = nwg % 8, xcd = wgid % 8, off = wgid / 8; wgid = (xcd < r ? xcd * (q + 1) : r * (q + 1) + (xcd - r) * q) + off; }
        const int nig = 8 * nN, gid = wgid / nig, fm = gid * 8, gsz = (nM - fm) < 8 ? (nM - fm) : 8;
        u.pm = fm + ((wgid % nig) % gsz); u.pn = (wgid % nig) / gsz; u.e = 0; return true;
    }
};
struct DenseProb {
    static constexpr bool SIDE = false;
    const char* A; const char* Bt; int KB;
    __device__ __forceinline__ const char* a_base(const Unit& u) const { return A + (size_t)u.pm * BM * KB; }
    __device__ __forceinline__ unsigned a_rowoff(const Unit&, int r, const LAS unsigned char*) const { return (unsigned)(r * KB); }
    __device__ __forceinline__ const char* b_base(const Unit& u) const { return Bt + (size_t)u.pn * BM * KB; }
    __device__ __forceinline__ void side_issue(const Unit&, LAS unsigned char*, int, int) const {}
};
struct MoeOrder {
    volatile LAS unsigned* tpfx; int nN, G, c;
    mutable int ecur;
    __device__ __forceinline__ bool next(int i, Unit& u) const {
        const int L = i * G + c; const int total = (int)tpfx[NE] * nN; if (L >= total) return false;
        int e = ecur;
        if (L < (int)tpfx[e] * nN) e = 0;
        while (L >= (int)tpfx[e + 1] * nN) ++e;
        ecur = e;
        const int rem = L - (int)tpfx[e] * nN, tm = (int)tpfx[e + 1] - (int)tpfx[e];
        u.e = e; u.pm = rem % tm; u.pn = rem / tm; return true;
    }
};
}

struct EpiZ {
    static constexpr bool PERM = true; static constexpr int PID = 2;
    bf16_t* O;
    __device__ __forceinline__ void operator()(const f32x4 (&acc)[2][2][4][2], const pg8::Unit& u, int wr, int wc, int fr, int fq, const LAS float*) const {
        const int row0 = u.pm * 256 + wr * 64 + fr, col0 = u.pn * 256 + wc * 32 + 8 * fq;
#pragma unroll
        for (int ai = 0; ai < 2; ++ai)
#pragma unroll
            for (int m = 0; m < 4; ++m) { bf16_t* rowp = O + (size_t)(row0 + ai * 128 + m * 16) * ZP + col0;
#pragma unroll
                for (int bj = 0; bj < 2; ++bj) { const f32x4 v0 = acc[ai][bj][m][0], v1 = acc[ai][bj][m][1];
                    u32x4 w; w.x = pk2(v0[0], v0[1]); w.y = pk2(v0[2], v0[3]); w.z = pk2(v1[0], v1[1]); w.w = pk2(v1[2], v1[3]);
                    *(u32x4*)(rowp + bj * 128) = w; } }
    }
};
struct EpiMix {
    static constexpr bool PERM = true; static constexpr int PID = 5;
    bf16_t* O;
    __device__ __forceinline__ void operator()(const f32x4 (&acc)[2][2][4][2], const pg8::Unit& u, int wr, int wc, int fr, int fq, const LAS float*) const {
        const int row0 = u.pm * 256 + wr * 64 + fr, col0 = u.pn * 256 + wc * 32 + 8 * fq;
#pragma unroll
        for (int ai = 0; ai < 2; ++ai)
#pragma unroll
            for (int m = 0; m < 4; ++m) { bf16_t* rowp = O + (size_t)(row0 + ai * 128 + m * 16) * DM + col0;
#pragma unroll
                for (int bj = 0; bj < 2; ++bj) { const f32x4 v0 = acc[ai][bj][m][0], v1 = acc[ai][bj][m][1];
                    u32x4 w; w.x = pk2(v0[0], v0[1]); w.y = pk2(v0[2], v0[3]); w.z = pk2(v1[0], v1[1]); w.w = pk2(v1[2], v1[3]);
                    *(u32x4*)(rowp + bj * 128) = w; } }
    }
};
struct EpiAct {
    static constexpr bool PERM = true; static constexpr int PID = 7;
    unsigned char* O; const float* bgu; volatile LAS unsigned* roff;
    __device__ __forceinline__ void operator()(const f32x4 (&acc)[2][2][4][2], const pg8::Unit& u, int wr, int wc, int fr, int fq, const LAS float* sb) const {
        const int row0 = (int)roff[u.e] + u.pm * 256 + wr * 64 + fr, col0 = u.pn * 128 + wc * 32 + 8 * fq;
        const LAS float* bp = sb + 2 * (wc * 32 + 8 * fq);
        f32x4 bb[4];
#pragma unroll
        for (int j = 0; j < 4; ++j) bb[j] = *(const LAS f32x4*)(bp + 4 * j);
#pragma unroll
        for (int ai = 0; ai < 2; ++ai)
#pragma unroll
            for (int m = 0; m < 4; ++m) { float a8[8];
#pragma unroll
                for (int n = 0; n < 2; ++n)
#pragma unroll
                    for (int j = 0; j < 4; ++j) { const int cc = 4 * n + j;
                        float g = acc[ai][0][m][n][j] * F8_ACC_SCALE + bb[cc >> 1][(cc & 1) * 2], l = acc[ai][1][m][n][j] * F8_ACC_SCALE + bb[cc >> 1][(cc & 1) * 2 + 1];
                        g = fminf(g, 7.0f); l = fminf(fmaxf(l, -7.0f), 7.0f);
                        a8[cc] = (g * F8_ACT_SCALE) * __builtin_amdgcn_rcpf(1.0f + fexp2(g * (-1.702f * LOG2E))) * (l + 1.0f); }
                u32x2 w; w.x = pk4_fp8_nc(a8[0], a8[1], a8[2], a8[3]); w.y = pk4_fp8_nc(a8[4], a8[5], a8[6], a8[7]);
                *(u32x2*)(O + (size_t)(row0 + ai * 128 + m * 16) * DFF + col0) = w; }
    }
};
struct EpiYd {
    static constexpr bool PERM = true; static constexpr int PID = 8;
    bf16_t* O; const float* bdn; volatile LAS unsigned* roff;
    __device__ __forceinline__ void operator()(const f32x4 (&acc)[2][2][4][2], const pg8::Unit& u, int wr, int wc, int fr, int fq, const LAS float* sb) const {
        const int row0 = (int)roff[u.e] + u.pm * 256 + wr * 64 + fr, col0 = u.pn * 256 + wc * 32 + 8 * fq;
        f32x4 bv[2][2];
#pragma unroll
        for (int bj = 0; bj < 2; ++bj)
#pragma unroll
            for (int n = 0; n < 2; ++n) bv[bj][n] = *(const LAS f32x4*)(sb + wc * 32 + 8 * fq + bj * 128 + 4 * n);
#pragma unroll
        for (int ai = 0; ai < 2; ++ai)
#pragma unroll
            for (int m = 0; m < 4; ++m) { bf16_t* rowp = O + (size_t)(row0 + ai * 128 + m * 16) * DM + col0;
#pragma unroll
                for (int bj = 0; bj < 2; ++bj) { const f32x4 v0 = acc[ai][bj][m][0] * F8_ACC_SCALE + bv[bj][0], v1 = acc[ai][bj][m][1] * F8_ACC_SCALE + bv[bj][1];
                    u32x4 w; w.x = pk2(v0[0], v0[1]); w.y = pk2(v0[2], v0[3]); w.z = pk2(v1[0], v1[1]); w.w = pk2(v1[2], v1[3]);
                    *(u32x4*)(rowp + bj * 128) = w; } }
    }
};
struct MoeProb1 {
    static constexpr bool SIDE = true;
    const char* H2; const char* Bt; const int* lists; const float* bias; volatile LAS unsigned* cnt; int KB;
    __device__ __forceinline__ const char* a_base(const pg8::Unit&) const { return H2; }
    __device__ __forceinline__ unsigned a_rowoff(const pg8::Unit& u, int r, const LAS unsigned char* side) const { const int i = u.pm * 256 + r; const int tok = (i < (int)cnt[u.e]) ? ((const LAS int*)side)[r] : 0; return (unsigned)tok * 1024u; }
    __device__ __forceinline__ const char* b_base(const pg8::Unit& u) const { return Bt + ((size_t)u.e * 2048 + (size_t)u.pn * 256) * 1024; }
    __device__ __forceinline__ void side_issue(const pg8::Unit& u, LAS unsigned char* side, int wid, int lane) const {
        if (wid == 0) __builtin_amdgcn_global_load_lds((const unsigned*)(lists + (size_t)u.e * T + u.pm * 256 + lane * 4), (LAS unsigned*)side, 16, 0, 0);
        if (wid == 1) __builtin_amdgcn_global_load_lds((const unsigned*)(bias + (size_t)u.e * 2048 + u.pn * 256 + lane * 4), (LAS unsigned*)(side + 1024), 16, 0, 0);
    }
};
struct MoeProb2 {
    static constexpr bool SIDE = true;
    const char* A; const char* Bt; const float* bias; volatile LAS unsigned* roff; int KB;
    __device__ __forceinline__ const char* a_base(const pg8::Unit& u) const { return A + ((size_t)roff[u.e] + (size_t)u.pm * 256) * 1024; }
    __device__ __forceinline__ unsigned a_rowoff(const pg8::Unit&, int r, const LAS unsigned char*) const { return (unsigned)r * 1024u; }
    __device__ __forceinline__ const char* b_base(const pg8::Unit& u) const { return Bt + ((size_t)u.e * 1024 + (size_t)u.pn * 256) * 1024; }
    __device__ __forceinline__ void side_issue(const pg8::Unit& u, LAS unsigned char* side, int wid, int lane) const {
        if (wid == 1) __builtin_amdgcn_global_load_lds((const unsigned*)(bias + (size_t)u.e * 1024 + u.pn * 256 + lane * 4), (LAS unsigned*)(side + 1024), 16, 0, 0);
    }
};

template <int NB>
__device__ __forceinline__ void gemv_item(Frame& F, const float* vec, int vstride, const float* W, int K, int N, int n0, const float* bias, float* out, int ostride) {
    LAS float* red = (LAS float*)F.lds;
    const int col = n0 + F.lane, ks = K / NWAVES;
    float acc[NB];
#pragma unroll
    for (int b = 0; b < NB; ++b) acc[b] = 0.f;
    for (int k0 = F.wave * ks; k0 < (F.wave + 1) * ks; k0 += 32) {
        float wv[32];
#pragma unroll
        for (int j = 0; j < 32; ++j) wv[j] = __builtin_nontemporal_load(W + (size_t)(k0 + j) * N + col);
#pragma unroll
        for (int j = 0; j < 32; ++j)
#pragma unroll
            for (int b = 0; b < NB; ++b) acc[b] += vec[b * vstride + k0 + j] * wv[j]; }
#pragma unroll
    for (int b = 0; b < NB; ++b) red[(F.wave * NB + b) * 64 + F.lane] = acc[b];
    __syncthreads();
    if (F.wave == 0) {
#pragma unroll
        for (int b = 0; b < NB; ++b) { float s = bias ? bias[col] : 0.f;
            for (int w = 0; w < NWAVES; ++w) s += red[(w * NB + b) * 64 + F.lane];
            out[b * ostride + col] = s; }
    }
    __syncthreads();
}
template <int MAP>
__device__ __forceinline__ int t_rowmap(int n) {
    if (MAP == 0) return n;
    const int ac = n >> 1, bj = n & 1; return (ac >> 7) * 256 + bj * 128 + (ac & 127);
}
template <int MAP>
__device__ __forceinline__ void transpose_item(const float* W, int K, int Nsrc, int nblk, bf16_t* WT, LAS float* scr, int item, int lane) {
    const int kb = item / nblk, nb = item % nblk, k0 = 64 * kb, n0 = 32 * nb;
    const int nc = n0 + (lane & 31);
    float tv[32];
    if (nc < Nsrc) {
#pragma unroll
        for (int i = 0; i < 32; ++i) tv[i] = __builtin_nontemporal_load(W + (size_t)(k0 + 2 * i + (lane >> 5)) * Nsrc + nc);
    } else {
#pragma unroll
        for (int i = 0; i < 32; ++i) tv[i] = 0.f;
    }
#pragma unroll
    for (int i = 0; i < 32; ++i) scr[(2 * i + (lane >> 5)) * 33 + (lane & 31)] = tv[i];
    WAVE_SYNC(); FENCE();
    const int c = lane & 7;
#pragma unroll
    for (int j = 0; j < 4; ++j) { const int n = (lane >> 3) + 8 * j; const LAS float* s = scr + (8 * c) * 33 + n;
        u32x4 o; o.x = pk2(s[0 * 33], s[1 * 33]); o.y = pk2(s[2 * 33], s[3 * 33]); o.z = pk2(s[4 * 33], s[5 * 33]); o.w = pk2(s[6 * 33], s[7 * 33]);
        *(u32x4*)(WT + (size_t)t_rowmap<MAP>(n0 + n) * K + k0 + 8 * c) = o; }
    WAVE_SYNC(); FENCE();
}
template <int MAP>
__device__ __forceinline__ void transpose_item_f8(const float* W, int K, int Nsrc, int nblk, unsigned char* WT, LAS float* scr, int item, int lane, float scale) {
    const int kb = item / nblk, nb = item % nblk, k0 = 64 * kb, n0 = 32 * nb;
    const int nc = n0 + (lane & 31);
    (void)nc;
    f32x4 tv[8];
#pragma unroll
    for (int i = 0; i < 8; ++i) tv[i] = __builtin_nontemporal_load((const f32x4*)(W + (size_t)(k0 + 8 * i + (lane >> 3)) * Nsrc + n0 + 4 * (lane & 7)));
#pragma unroll
    for (int i = 0; i < 8; ++i) { LAS float* d = scr + (8 * i + (lane >> 3)) * 33 + 4 * (lane & 7);
        d[0] = tv[i][0] * scale; d[1] = tv[i][1] * scale; d[2] = tv[i][2] * scale; d[3] = tv[i][3] * scale; }
    WAVE_SYNC(); FENCE();
    const int c = lane & 7;
#pragma unroll
    for (int j = 0; j < 4; ++j) { const int n = (lane >> 3) + 8 * j; const LAS float* sp = scr + (8 * c) * 33 + n;
        u32x2 o; o.x = pk4_fp8(sp[0 * 33], sp[1 * 33], sp[2 * 33], sp[3 * 33]); o.y = pk4_fp8(sp[4 * 33], sp[5 * 33], sp[6 * 33], sp[7 * 33]);
        *(u32x2*)(WT + (size_t)t_rowmap<MAP>(n0 + n) * K + k0 + 8 * c) = o; }
    WAVE_SYNC(); FENCE();
}
constexpr int P0_I_IN = (DM / 64) * (ZP / 32), P0_I_OUT = (DM / 64) * (DM / 32), P0_I_W1 = (2048 / 64) * (256 / 32), P0_I_W2 = (256 / 64) * (64 / 32);
constexpr int P0_I_GU1 = (DM / 64) * (2048 / 32), P0_I_DN1 = (DFF / 64) * (DM / 32);
constexpr int P0_NITEMS = P0_I_IN + P0_I_OUT + 2 * P0_I_W1 + 2 * P0_I_W2 + NE * P0_I_GU1 + NE * P0_I_DN1;
constexpr int P2_FILL_PER_CU = 44;
__device__ __forceinline__ int p2_fill_items(const Frame& F) { return (F.G == 256 && (T / 256) * (ZP / 256) == 640) ? 128 * P2_FILL_PER_CU : 0; }
#ifndef P7_FILL_ITEMS
#define P7_FILL_ITEMS 2816
#endif
__device__ __forceinline__ int p7_fill_items(const Frame& F) { return (F.G >= 8) ? P7_FILL_ITEMS : 0; }
__device__ __forceinline__ void p0_item(Frame& F, LAS float* scr, int it) {
    int r = it;
    if (r < P0_I_IN) { transpose_item<0>(F.in[I_WIN], DM, INC, ZP / 32, (bf16_t*)(F.ws + WS_WINT), scr, r, F.lane); return; } r -= P0_I_IN;
    if (r < P0_I_OUT) { transpose_item<0>(F.in[I_WOUT], DM, DM, DM / 32, (bf16_t*)(F.ws + WS_WOUTT), scr, r, F.lane); return; } r -= P0_I_OUT;
    if (r < P0_I_W1) { transpose_item<0>(F.in[I_W1K], 2048, 256, 8, (bf16_t*)(F.ws + WS_W1KT), scr, r, F.lane); return; } r -= P0_I_W1;
    if (r < P0_I_W1) { transpose_item<0>(F.in[I_W1V], 2048, 256, 8, (bf16_t*)(F.ws + WS_W1VT), scr, r, F.lane); return; } r -= P0_I_W1;
    if (r < P0_I_W2) { transpose_item<0>(F.in[I_W2K], 256, 64, 2, (bf16_t*)(F.ws + WS_W2KT), scr, r, F.lane); return; } r -= P0_I_W2;
    if (r < P0_I_W2) { transpose_item<0>(F.in[I_W2V], 256, 64, 2, (bf16_t*)(F.ws + WS_W2VT), scr, r, F.lane); return; } r -= P0_I_W2;
    if (r < NE * P0_I_GU1) { const int e = r / P0_I_GU1; transpose_item_f8<1>(F.in[I_WGU] + (size_t)e * DM * 2048, DM, 2048, 64, (unsigned char*)(F.ws + WS_WGUT) + (size_t)e * 2048 * DM, scr, r % P0_I_GU1, F.lane, F8_W_SCALE); return; } r -= NE * P0_I_GU1;
    { const int e = r / P0_I_DN1; transpose_item_f8<0>(F.in[I_WDN] + (size_t)e * DFF * DM, DFF, DM, 32, (unsigned char*)(F.ws + WS_WDNT) + (size_t)e * DM * DFF, scr, r % P0_I_DN1, F.lane, F8_W_SCALE); }
}
__device__ __forceinline__ void p0_prologue(Frame& F) {
    for (int it = F.vcu; it < 96 + 8; it += F.G) {
        if (it < 96) gemv_item<BATCH>(F, F.in[I_C], DM, F.in[I_WADA], DM, 6 * DM, 64 * it, F.in[I_BADA], (float*)(F.ws + WS_MOD), 6 * DM);
        else { const int j = it - 96, kv = j >> 2, n0 = (j & 3) * 64;
            gemv_item<1>(F, F.in[kv ? I_PEV : I_PEK], 0, F.in[kv ? I_W1V : I_W1K], 2048, 256, n0, nullptr, (float*)(F.ws + WS_BPE) + kv * 256, 0); }
    }
    { const float* src = F.in[I_GMWS]; bf16_t* dst = (bf16_t*)(F.ws + WS_WSBF);
      for (int idx = F.vcu * NTHREADS + F.tid; idx < GMG * GMC * GMC; idx += F.G * NTHREADS) { const int i = (idx >> 7) & 127, j = idx & 127; dst[idx] = (bf16_t)f2bf(j <= i ? src[idx] : 0.f); } }
    LAS float* scr = (LAS float*)(F.lds + 8192 + F.wave * 16384);
    const int gw = F.vcu * NWAVES + F.wave, NGW = F.G * NWAVES;
    const int nit = P0_NITEMS - p2_fill_items(F) - p7_fill_items(F);
    constexpr int NGEMV = 96 + 8;
    const int shift = (F.G > 2 * NGEMV) ? 2 * NGEMV * NWAVES : 0, n1 = nit - shift;
    for (int it = gw; it < n1; it += NGW) p0_item(F, scr, it);
    if (shift && F.vcu >= NGEMV) for (int it = n1 + (F.vcu - NGEMV) * NWAVES + F.wave; it < nit; it += (F.G - NGEMV) * NWAVES) p0_item(F, scr, it);
}

__device__ __forceinline__ void norm_rows(Frame& F, const float* xin, const float* g, int mod_shift, int mod_scale, bf16_t* outb) {
    const int gw = F.vcu * NWAVES + F.wave, NGW = F.G * NWAVES;
    const float* mod = (const float*)(F.ws + WS_MOD);
    for (int m0 = gw; m0 < T / 2; m0 += NGW) {
        f32x4 v[2][4]; float s[2] = {0.f, 0.f};
#pragma unroll
        for (int q = 0; q < 2; ++q) { const f32x4* xr = (const f32x4*)(xin + (size_t)(m0 + q * (T / 2)) * DM) + F.lane;
#pragma unroll
            for (int j = 0; j < 4; ++j) v[q][j] = __builtin_nontemporal_load(xr + 64 * j); }
#pragma unroll
        for (int q = 0; q < 2; ++q)
#pragma unroll
            for (int j = 0; j < 4; ++j) s[q] += (v[q][j][0] * v[q][j][0] + v[q][j][1] * v[q][j][1]) + (v[q][j][2] * v[q][j][2] + v[q][j][3] * v[q][j][3]);
#pragma unroll
        for (int o = 1; o < 64; o <<= 1) { s[0] += __shfl_xor(s[0], o); s[1] += __shfl_xor(s[1], o); }
#pragma unroll
        for (int q = 0; q < 2; ++q) { const int m = m0 + q * (T / 2), b = m / SEQ;
            const float rinv = __builtin_amdgcn_rsqf(s[q] * (1.0f / DM) + EPS);
            u32x2* o8 = (u32x2*)(outb + (size_t)m * DM) + F.lane;
#pragma unroll
            for (int j = 0; j < 4; ++j) { const int c = 4 * F.lane + 256 * j;
                const f32x4 gg = *(const f32x4*)(g + c), sc = *(const f32x4*)(mod + (size_t)b * 6144 + mod_scale * 1024 + c), sh = *(const f32x4*)(mod + (size_t)b * 6144 + mod_shift * 1024 + c);
                const f32x4 h = v[q][j] * rinv * gg * (sc + 1.0f) + sh;
                u32x2 w; w.x = pk2(h[0], h[1]); w.y = pk2(h[2], h[3]); o8[64 * j] = w; } }
    }
}

struct GmRegs { u32x4 v[2], u[2]; };
__device__ __forceinline__ void gmlp_load(Frame& F, int tile, GmRegs& R) {
    const int g = tile % GMG, ch = (tile / GMG) % (SEQ / GMC), b = tile / (GMG * (SEQ / GMC));
    const size_t row0 = (size_t)b * SEQ + (size_t)ch * GMC;
    const bf16_t* ZB = (const bf16_t*)(F.ws + WS_ZB);
#pragma unroll
    for (int it = 0; it < 2; ++it) { const int idx = F.tid + it * NTHREADS, row = idx >> 3, c8 = idx & 7;
        R.v[it] = *(const u32x4*)(ZB + (row0 + row) * ZP + ZC_V + g * 64 + c8 * 8);
        R.u[it] = *(const u32x4*)(ZB + (row0 + row) * ZP + ZC_U + g * 64 + c8 * 8); }
}
__device__ __forceinline__ void gmlp_compute(Frame& F, int tile, const GmRegs& R) {
    const int g = tile % GMG, ch = (tile / GMG) % (SEQ / GMC), b = tile / (GMG * (SEQ / GMC));
    const size_t row0 = (size_t)b * SEQ + (size_t)ch * GMC;
    LAS bf16_t* Vt = (LAS bf16_t*)F.lds;
    constexpr int VP = 136, UP = 68;
    LAS float* Us = (LAS float*)(F.lds + 64 * VP * 2);
    const float* gn = F.in[I_GMNG] + g * 64;
    const int fr = F.lane & 15, fq = F.lane >> 4, w = F.wave;
    const bf16_t* Wg = (const bf16_t*)(F.ws + WS_WSBF) + (size_t)g * GMC * GMC;
    bf16x8 af[4];
#pragma unroll
    for (int ks = 0; ks < 4; ++ks) af[ks] = *(const bf16x8*)(Wg + (size_t)(16 * w + fr) * GMC + 32 * ks + 8 * fq);
#pragma unroll
    for (int it = 0; it < 2; ++it) {
        const int idx = F.tid + it * NTHREADS, row = idx >> 3, c8 = idx & 7;
        const u32x4 raw = R.v[it];
        float v[8]; v[0] = bflo(raw.x); v[1] = bfhi(raw.x); v[2] = bflo(raw.y); v[3] = bfhi(raw.y); v[4] = bflo(raw.z); v[5] = bfhi(raw.z); v[6] = bflo(raw.w); v[7] = bfhi(raw.w);
        float ss = 0.f;
#pragma unroll
        for (int e = 0; e < 8; ++e) { v[e] = gelu_tanh(v[e]); ss += v[e] * v[e]; }
        ss += __shfl_xor(ss, 1); ss += __shfl_xor(ss, 2); ss += __shfl_xor(ss, 4);
        const float rinv = __builtin_amdgcn_rsqf(ss * (1.0f / 64.0f) + EPS);
#pragma unroll
        for (int e = 0; e < 8; ++e) Vt[(c8 * 8 + e) * VP + row] = (bf16_t)f2bf(v[e] * rinv * gn[c8 * 8 + e]);
        const u32x4 ur = R.u[it];
        f32x4 u0 = {gelu_tanh(bflo(ur.x)), gelu_tanh(bfhi(ur.x)), gelu_tanh(bflo(ur.y)), gelu_tanh(bfhi(ur.y))}, u1 = {gelu_tanh(bflo(ur.z)), gelu_tanh(bfhi(ur.z)), gelu_tanh(bflo(ur.w)), gelu_tanh(bfhi(ur.w))};
        *(LAS f32x4*)(Us + row * UP + c8 * 8) = u0; *(LAS f32x4*)(Us + row * UP + c8 * 8 + 4) = u1;
    }
    __syncthreads();
    f32x4 acc[4];
#pragma unroll
    for (int n = 0; n < 4; ++n) acc[n] = (f32x4){0.f, 0.f, 0.f, 0.f};
#pragma unroll
    for (int ks = 0; ks < 4; ++ks) {
        if (32 * ks <= 16 * w + 15) {
#pragma unroll
            for (int n = 0; n < 4; ++n) { const bf16x8 bb = *(const LAS bf16x8*)(Vt + (16 * n + fr) * VP + 32 * ks + 8 * fq);
                acc[n] = __builtin_amdgcn_mfma_f32_16x16x32_bf16(af[ks], bb, acc[n], 0, 0, 0); }
        }
    }
    bf16_t* Y = (bf16_t*)(F.ws + WS_YMIX);
    const float* bs = F.in[I_GMBS] + g * GMC;
#pragma unroll
    for (int n = 0; n < 4; ++n)
#pragma unroll
        for (int r = 0; r < 4; ++r) { const int i = 16 * w + 4 * fq + r, d = 16 * n + fr;
            Y[(row0 + i) * DM + g * 64 + d] = (bf16_t)f2bf(Us[i * UP + d] * (acc[n][r] + bs[i])); }
    __syncthreads();
}
__device__ __forceinline__ void gmlp_run(Frame& F, int base, int stride, int n) {
    if (n <= 0) return;
    GmRegs A, B;
    gmlp_load(F, base, A);
    for (int k = 0; k < n; k += 2) {
        if (k + 1 < n) gmlp_load(F, base + (k + 1) * stride, B);
        gmlp_compute(F, base + k * stride, A);
        if (k + 1 < n) { if (k + 2 < n) gmlp_load(F, base + (k + 2) * stride, A); gmlp_compute(F, base + (k + 1) * stride, B); }
    }
}

__device__ __forceinline__ void cmp_tile(Frame& F, int tile) {
    constexpr int NT = NCP / 32;
    const int nt = tile % NT, g = (tile / NT) % NG, b = (tile / (NT * NG)) % BATCH, kv = tile / (NT * NG * BATCH);
    const int n0 = 32 * nt, p0 = 16 * n0;
    const bf16_t* ZB = (const bf16_t*)(F.ws + WS_ZB);
    constexpr int RP = 72;
    LAS bf16_t* Rs = (LAS bf16_t*)F.lds;
    LAS bf16_t* Hs = (LAS bf16_t*)(F.lds + 528 * RP * 2);
    constexpr int HP = 264;
    const int zc = (kv ? ZC_VC : ZC_KC) + g * 64;
    {
        u32x4 sv[9];
#pragma unroll
        for (int it = 0; it < 9; ++it) { const int idx = F.tid + it * NTHREADS, row = idx >> 3, c8 = idx & 7; const int p = p0 + row;
            sv[it] = (u32x4){0u, 0u, 0u, 0u};
            if (idx < 528 * 8 && p < SEQ) sv[it] = *(const u32x4*)(ZB + ((size_t)b * SEQ + p) * ZP + zc + c8 * 8); }
#pragma unroll
        for (int it = 0; it < 9; ++it) { const int idx = F.tid + it * NTHREADS, row = idx >> 3, c8 = idx & 7;
            if (idx < 528 * 8) *(LAS u32x4*)(Rs + row * RP + c8 * 8) = sv[it]; }
    }
    __syncthreads();
    const int i = F.lane & 31, hi = F.lane >> 5, w = F.wave;
    const bf16_t* W1T = (const bf16_t*)(F.ws + (kv ? WS_W1VT : WS_W1KT)) + (size_t)(32 * w + i) * 2048;
    f32x16 acc;
#pragma unroll
    for (int r = 0; r < 16; ++r) acc[r] = 0.f;
    bf16x8 bq[16];
#pragma unroll
    for (int j = 0; j < 16; ++j) bq[j] = *(const bf16x8*)(W1T + 16 * j + 8 * hi);
    for (int kb = 0; kb < 8; ++kb) {
        bf16x8 bn[16];
        const int kn = (kb < 7) ? (kb + 1) * 16 : kb * 16;
#pragma unroll
        for (int j = 0; j < 16; ++j) bn[j] = *(const bf16x8*)(W1T + 16 * (kn + j) + 8 * hi);
#pragma unroll
        for (int j = 0; j < 16; ++j) { const int kk = kb * 16 + j; const int l = kk >> 2, d = (16 * j + 8 * hi) & 63;
            const bf16x8 a = *(const LAS bf16x8*)(Rs + (16 * i + l) * RP + d);
            acc = __builtin_amdgcn_mfma_f32_32x32x16_bf16(a, bq[j], acc, 0, 0, 0); }
#pragma unroll
        for (int j = 0; j < 16; ++j) bq[j] = bn[j];
    }
    const float bpe = ((const float*)(F.ws + WS_BPE))[kv * 256 + 32 * w + i];
#pragma unroll
    for (int r = 0; r < 16; ++r) Hs[crow(r, hi) * HP + 32 * w + i] = (bf16_t)f2bf(gelu_tanh(acc[r] + bpe));
    __syncthreads();
    if (w < 2) {
        const bf16_t* W2T = (const bf16_t*)(F.ws + (kv ? WS_W2VT : WS_W2KT)) + (size_t)(32 * w + i) * 256;
        f32x16 o;
#pragma unroll
        for (int r = 0; r < 16; ++r) o[r] = 0.f;
        for (int kk = 0; kk < 16; ++kk) {
            const bf16x8 a = *(const LAS bf16x8*)(Hs + i * HP + 16 * kk + 8 * hi);
            const bf16x8 bb = *(const bf16x8*)(W2T + 16 * kk + 8 * hi);
            o = __builtin_amdgcn_mfma_f32_32x32x16_bf16(a, bb, o, 0, 0, 0);
        }
        bf16_t* KC = (bf16_t*)(F.ws + (kv ? WS_VC : WS_KC)) + ((size_t)(b * NG + g) * NCP) * 64;
#pragma unroll
        for (int r = 0; r < 16; ++r) { const int n = n0 + crow(r, hi); KC[(size_t)n * 64 + 32 * w + i] = (n < NCMP) ? (bf16_t)f2bf(o[r]) : (bf16_t)0; }
    }
    __syncthreads();
}

constexpr int KPB = 128;
constexpr int NB_K = 64 * KPB;
constexpr int V_H1 = 4096;
constexpr int NB_BUF = NB_K + 8192;
constexpr int A_IMP = 3 * NB_BUF, A_SEL = A_IMP + 64 * 128 * 4, A_UNI = A_SEL + 64 * 8 * 2, A_WSF = A_UNI + 256, A_QF = A_WSF + 8 * 32 * 4, A_Y = A_QF + 8 * 4096, A_GATE = A_Y + 8 * 4096, A_END = A_GATE + 8 * 32 * 3 * 4;
static_assert(A_END <= MISC_OFF, "NSA LDS map");
#ifndef NSA_THR_VAL
#define NSA_THR_VAL 20.0f
#endif
constexpr float NSA_THR = NSA_THR_VAL, NEG_BIG = -1e30f;

#ifdef EMU
__device__ __forceinline__ int opaque_lane(int l) { return l; }
#else
__device__ __forceinline__ int opaque_lane(int) { int x; asm volatile("v_mbcnt_lo_u32_b32 %0, -1, 0\n\tv_mbcnt_hi_u32_b32 %0, -1, %0" : "=v"(x)); return x; }
#endif
#ifdef EMU
__device__ __forceinline__ int red8_add(int v) { v += __shfl_xor(v, 1); v += __shfl_xor(v, 2); v += __shfl_xor(v, 4); return v; }
__device__ __forceinline__ float quad_sum(float v) { v += __shfl_xor(v, 1); v += __shfl_xor(v, 2); return v; }
__device__ __forceinline__ float xor32f(float v) { return __shfl_xor(v, 32); }
#else
__device__ __forceinline__ int red8_add(int v) {
    v += __builtin_amdgcn_update_dpp(0, v, 0xB1, 0xF, 0xF, true);
    v += __builtin_amdgcn_update_dpp(0, v, 0x4E, 0xF, 0xF, true);
    v += __builtin_amdgcn_update_dpp(0, v, 0x141, 0xF, 0xF, true);
    return v;
}
__device__ __forceinline__ float quad_sum(float v) {
    v += __builtin_bit_cast(float, __builtin_amdgcn_update_dpp(0, __builtin_bit_cast(int, v), 0xB1, 0xF, 0xF, true));
    v += __builtin_bit_cast(float, __builtin_amdgcn_update_dpp(0, __builtin_bit_cast(int, v), 0x4E, 0xF, 0xF, true));
    return v;
}
__device__ __forceinline__ float xor32f(float v) {
    const unsigned u = __builtin_bit_cast(unsigned, v); auto rr = __builtin_amdgcn_permlane32_swap(u, u, false, false);
    return __builtin_bit_cast(float, (threadIdx.x & 32) ? rr[0] : rr[1]);
}
#endif

template <bool WITHV>
__device__ __forceinline__ void stage_dma(LAS unsigned char* buf, const bf16_t* Kg, const bf16_t* Vg, size_t pitch, long rbase, int wave, int lane) {
    const int krow = 8 * wave + (lane >> 3), kc = (lane & 7) ^ ((lane >> 3) & 7);
    __builtin_amdgcn_global_load_lds((const unsigned*)(Kg + (size_t)(rbase + krow) * pitch + kc * 8), (LAS unsigned*)(buf + wave * 1024), 16, 0, 0);
    if (WITHV) { const int vrow = 16 * (wave & 3) + (lane >> 2), vc = (wave >> 2) * 4 + (lane & 3);
        __builtin_amdgcn_global_load_lds((const unsigned*)(Vg + (size_t)(rbase + vrow) * pitch + vc * 8), (LAS unsigned*)(buf + NB_K + wave * 1024), 16, 0, 0); }
}
struct BrState { float mref, l; int has; unsigned qxm; f32x16 o0, o1; };
__device__ __forceinline__ unsigned ref_words(float m, float& meff) { const unsigned mh = f2bf(m); const float fh = bf2f((unsigned short)mh); const unsigned ml = f2bf(m - fh); meff = fh + bf2f((unsigned short)ml); return mh | (ml << 16); }

#ifdef EMU
#define VTR(p) __builtin_amdgcn_ds_read_tr16_b64_v4i16(p)
#else
typedef short v4i16_t __attribute__((ext_vector_type(4)));
#define VTR(p) __builtin_bit_cast(s16x4, __builtin_amdgcn_ds_read_tr16_b64_v4i16((LAS v4i16_t*)(p)))
#endif

__device__ __forceinline__ void nsa_qk(const LAS unsigned char* buf, const LAS unsigned char* qfl, unsigned qxs, unsigned qxm_t, unsigned klw0, unsigned klw1, unsigned tbw, unsigned neg1w,
                                       f32x16& p0, f32x16& p1, int lane) {
    const int i = lane & 31, hi = lane >> 5;
    const bf16x8 qx = __builtin_bit_cast(bf16x8, ((u32x4){qxs, qxs, qxm_t, 0u}));
    const bf16x8 kx0 = __builtin_bit_cast(bf16x8, ((u32x4){klw0, tbw, neg1w, 0u})), kx1 = __builtin_bit_cast(bf16x8, ((u32x4){klw1, tbw, neg1w, 0u}));
    const LAS unsigned char* kp = buf + i * KPB;
    {
        const f32x16 zero16 = {0.f, 0.f, 0.f, 0.f, 0.f, 0.f, 0.f, 0.f, 0.f, 0.f, 0.f, 0.f, 0.f, 0.f, 0.f, 0.f};
        p0 = __builtin_amdgcn_mfma_f32_32x32x16_bf16(kx0, qx, zero16, 0, 0, 0);
        p1 = __builtin_amdgcn_mfma_f32_32x32x16_bf16(kx1, qx, zero16, 0, 0, 0);
    }
#pragma unroll
    for (int d0 = 0; d0 < 4; ++d0) {
        const int ko = ((2 * d0 + hi) ^ (i & 7)) << 4;
        const bf16x8 k0 = *(const LAS bf16x8*)(kp + ko), k1 = *(const LAS bf16x8*)(kp + 32 * KPB + ko);
        const bf16x8 qd = *(const LAS bf16x8*)(qfl + d0 * 1024);
        p0 = __builtin_amdgcn_mfma_f32_32x32x16_bf16(k0, qd, p0, 0, 0, 0);
        p1 = __builtin_amdgcn_mfma_f32_32x32x16_bf16(k1, qd, p1, 0, 0, 0);
    }
}
template <bool PV, bool TRACK>
__device__ __forceinline__ void nsa_prep(int mode, int lim, BrState& st, f32x16& p0, f32x16& p1, int lane, LAS float* wsf) {
#ifndef EMU
    asm volatile("" : "+v"(lim));
#endif
    const int i = lane & 31, hi = lane >> 5;
    if (__builtin_amdgcn_readfirstlane(mode) != 0) {
        NOSPEC();
        const int lim2 = lim - 4 * hi; const bool inv = (mode == 2);
#pragma unroll
        for (int r = 0; r < 16; ++r) { const int c0 = (r & 3) + 8 * (r >> 2);
            const bool v0 = (c0 <= lim2) != inv, v1 = (c0 + 32 <= lim2) != inv;
            p0[r] = v0 ? p0[r] : -INFINITY; p1[r] = v1 ? p1[r] : -INFINITY; }
    }
    if (TRACK) {
        float mxa = fmaxf(p0[0], p1[0]), mxb = fmaxf(p0[1], p1[1]);
#pragma unroll
        for (int r = 2; r < 16; r += 2) { mxa = fmaxf(fmaxf(mxa, p0[r]), p1[r]); mxb = fmaxf(fmaxf(mxb, p0[r + 1]), p1[r + 1]); }
        float mx = fmaxf(mxa, mxb);
        mx = fmaxf(mx, xor32f(mx));
        const bool upd = (mx > (st.has ? NSA_THR : NEG_BIG)) && (mx > NEG_BIG);
        if (__any(upd)) {
            NOSPEC();
            float meff; const unsigned w = ref_words(st.mref + mx, meff);
            const float de = upd ? (meff - st.mref) : 0.f;
            const float f = (upd && st.has) ? fexp2(-de) : 1.0f;
#pragma unroll
            for (int r = 0; r < 16; ++r) { p0[r] -= de; p1[r] -= de; }
            st.l *= f;
            if (PV) {
                wsf[i] = f; WAVE_SYNC(); FENCE();
                const LAS float* wr_ = wsf + 4 * hi;
#pragma unroll
                for (int r = 0; r < 16; ++r) { const float a = wr_[(r & 3) + 8 * (r >> 2)]; st.o0[r] *= a; st.o1[r] *= a; }
                WAVE_SYNC(); FENCE();
            }
            if (upd) { st.mref = meff; st.qxm = hi ? 0u : w; st.has = 1; }
        }
    }
}
template <bool PV>
__device__ __forceinline__ void nsa_softmax_pv(const LAS unsigned char* buf, BrState& st, f32x16& p0, f32x16& p1, int lane) {
    const int hi = lane >> 5;
    float rs = 0.f;
#pragma unroll
    for (int r = 0; r < 16; ++r) { p0[r] = fexp2(p0[r]); p1[r] = fexp2(p1[r]); rs += p0[r] + p1[r]; }
    st.l += rs;
    if (PV) {
        const LAS unsigned char* vb = buf + NB_K + (4 * hi + ((lane & 15) >> 2)) * 64 + 32 * ((lane >> 4) & 1) + 8 * (lane & 3);
#pragma unroll
        for (int ks = 0; ks < 4; ++ks) {
            const f32x16& p = (ks < 2) ? p0 : p1; const int s = ks & 1;
            u32x4 pw; pw.x = pk2(p[8 * s + 0], p[8 * s + 1]); pw.y = pk2(p[8 * s + 2], p[8 * s + 3]); pw.z = pk2(p[8 * s + 4], p[8 * s + 5]); pw.w = pk2(p[8 * s + 6], p[8 * s + 7]);
            const bf16x8 pa = __builtin_bit_cast(bf16x8, pw);
#pragma unroll
            for (int d0 = 0; d0 < 2; ++d0) {
                const s16x4 lo = VTR(vb + d0 * V_H1 + ks * 1024), hh = VTR(vb + d0 * V_H1 + ks * 1024 + 512);
                const bf16x8 vf = (bf16x8){lo[0], lo[1], lo[2], lo[3], hh[0], hh[1], hh[2], hh[3]};
                if (d0 == 0) st.o0 = __builtin_amdgcn_mfma_f32_32x32x16_bf16(pa, vf, st.o0, 0, 0, 0);
                else         st.o1 = __builtin_amdgcn_mfma_f32_32x32x16_bf16(pa, vf, st.o1, 0, 0, 0);
            }
        }
    }
}

struct ImpSums { float G0[4], S0[4], G1[4], S1[4]; };
template <bool PRODUCE, bool IMP>
__device__ __forceinline__ void nsa_exp_qk(const LAS unsigned char* nbuf, const LAS unsigned char* qfl, unsigned qxs, unsigned qxm_t, unsigned klw0, unsigned klw1, unsigned tbw, unsigned neg1w,
                                           f32x16& n0, f32x16& n1, BrState& st, f32x16& p0, f32x16& p1, u32x4 (&pw)[4], ImpSums& im, int lane) {
    const int i = lane & 31, hi = lane >> 5;
    const LAS unsigned char* kp = nbuf + i * KPB;
    if (PRODUCE) {
        const bf16x8 qx = __builtin_bit_cast(bf16x8, ((u32x4){qxs, qxs, qxm_t, 0u}));
        const bf16x8 kx0 = __builtin_bit_cast(bf16x8, ((u32x4){klw0, tbw, neg1w, 0u})), kx1 = __builtin_bit_cast(bf16x8, ((u32x4){klw1, tbw, neg1w, 0u}));
        const f32x16 zero16 = {0.f, 0.f, 0.f, 0.f, 0.f, 0.f, 0.f, 0.f, 0.f, 0.f, 0.f, 0.f, 0.f, 0.f, 0.f, 0.f};
        n0 = __builtin_amdgcn_mfma_f32_32x32x16_bf16(kx0, qx, zero16, 0, 0, 0);
        n1 = __builtin_amdgcn_mfma_f32_32x32x16_bf16(kx1, qx, zero16, 0, 0, 0);
    }
    float rs = 0.f;
#pragma unroll
    for (int d0 = 0; d0 < 4; ++d0) {
        if (PRODUCE) {
            const int ko = ((2 * d0 + hi) ^ (i & 7)) << 4;
            const bf16x8 k0 = *(const LAS bf16x8*)(kp + ko), k1 = *(const LAS bf16x8*)(kp + 32 * KPB + ko);
            const bf16x8 qd = *(const LAS bf16x8*)(qfl + d0 * 1024);
            n0 = __builtin_amdgcn_mfma_f32_32x32x16_bf16(k0, qd, n0, 0, 0, 0);
            n1 = __builtin_amdgcn_mfma_f32_32x32x16_bf16(k1, qd, n1, 0, 0, 0);
        }
        const float a0 = fexp2(p0[4 * d0]), a1 = fexp2(p0[4 * d0 + 1]), a2 = fexp2(p0[4 * d0 + 2]), a3 = fexp2(p0[4 * d0 + 3]);
        const float b0 = fexp2(p1[4 * d0]), b1 = fexp2(p1[4 * d0 + 1]), b2 = fexp2(p1[4 * d0 + 2]), b3 = fexp2(p1[4 * d0 + 3]);
        const float ga = (a0 + a1) + (a2 + a3), gb = (b0 + b1) + (b2 + b3);
        rs += ga + gb;
        if (IMP) { im.G0[d0] = ga; im.S0[d0] = a3; im.G1[d0] = gb; im.S1[d0] = b3; }
        const unsigned w0 = pk2(a0, a1), w1 = pk2(a2, a3), v0 = pk2(b0, b1), v1 = pk2(b2, b3);
        if ((d0 & 1) == 0) { pw[d0 >> 1].x = w0; pw[d0 >> 1].y = w1; pw[2 + (d0 >> 1)].x = v0; pw[2 + (d0 >> 1)].y = v1; }
        else               { pw[d0 >> 1].z = w0; pw[d0 >> 1].w = w1; pw[2 + (d0 >> 1)].z = v0; pw[2 + (d0 >> 1)].w = v1; }
        __builtin_amdgcn_sched_barrier(0);
    }
    st.l += rs;
}
template <bool PV>
__device__ __forceinline__ void nsa_pv(const LAS unsigned char* buf, BrState& st, const u32x4 (&pw)[4], int lane) {
    if (!PV) return;
    const int hi = lane >> 5;
    const LAS unsigned char* vb = buf + NB_K + (4 * hi + ((lane & 15) >> 2)) * 64 + 32 * ((lane >> 4) & 1) + 8 * (lane & 3);
#pragma unroll
    for (int ks = 0; ks < 4; ++ks) {
        const bf16x8 pa = __builtin_bit_cast(bf16x8, pw[ks]);
#pragma unroll
        for (int d0 = 0; d0 < 2; ++d0) {
            const s16x4 lo = VTR(vb + d0 * V_H1 + ks * 1024), hh = VTR(vb + d0 * V_H1 + ks * 1024 + 512);
            const bf16x8 vf = (bf16x8){lo[0], lo[1], lo[2], lo[3], hh[0], hh[1], hh[2], hh[3]};
            if (d0 == 0) st.o0 = __builtin_amdgcn_mfma_f32_32x32x16_bf16(pa, vf, st.o0, 0, 0, 0);
            else         st.o1 = __builtin_amdgcn_mfma_f32_32x32x16_bf16(pa, vf, st.o1, 0, 0, 0);
        }
        __builtin_amdgcn_sched_barrier(0);
    }
}

__device__ __forceinline__ int bit128(const LAS unsigned* m, int j) { return (int)((m[j >> 5] >> (j & 31)) & 1u); }
__device__ __forceinline__ int next_below(const LAS unsigned* m, int j) { for (int k = j - 1; k >= 0; --k) if ((m[k >> 5] >> (k & 31)) & 1u) return k; return -1; }

struct NsaCtx {
    int qt, g, t, tloc, qloc, head, w, lane; const bf16_t* Zb;
    LAS unsigned char* lds; LAS float* imp; LAS float* wsf;
};
__device__ __forceinline__ void nsa_importance(const NsaCtx& C, const ImpSums& im, int cur) {
    const int i = C.lane & 31, hi = C.lane >> 5;
    float G0[4], G1[4], S0[4], S1[4];
#pragma unroll
    for (int k = 0; k < 4; ++k) { G0[k] = quad_sum(im.G0[k]); G1[k] = quad_sum(im.G1[k]); S0[k] = quad_sum(im.S0[k]); S1[k] = quad_sum(im.S1[k]); }
    float P0[4], P1[4];
#pragma unroll
    for (int k = 0; k < 4; ++k) { P0[k] = xor32f(S0[k]); P1[k] = xor32f(S1[k]); }
    if ((i & 3) == 0) {
        LAS float* row = C.imp + C.qloc * 128 + 16 * cur + hi;
#pragma unroll
        for (int k = 0; k < 4; ++k) {
            const float prev0 = hi ? P0[k] : (k == 0 ? 0.f : P0[k - 1]);
            const float prev1 = hi ? P1[k] : (k == 0 ? P0[3] : P1[k - 1]);
            row[2 * k] = G0[k] + prev0;
            row[8 + 2 * k] = G1[k] + prev1;
        }
        if (hi == 1 && 16 * (cur + 1) < 128) row[15] += S1[3];
    }
}
template <int KIND, int PRE>
__device__ __forceinline__ void nsa_branch(Frame& F, const NsaCtx& C, const LAS unsigned char* qf, const bf16_t* Kg, const bf16_t* Vg, size_t pitch,
                                           int first, int lo, const LAS unsigned* um, const LAS unsigned* wm, const LAS unsigned* qm, int cfull, int climit, BrState& st) {
    constexpr bool PV = (KIND != 1), TRACK = (KIND != 2), CMP = (KIND == 1 || KIND == 2);
    const int lane = C.lane, w = C.w, qt = C.qt;
    const int ln_ = opaque_lane(lane), hi_ = ln_ >> 5, i_ = ln_ & 31;
    unsigned qxs; { const float s2_ = fexp2(-(float)(4 * C.g + (i_ & 3) + 1)) * LOG2E; const unsigned sh_ = f2bf(s2_); const unsigned sl_ = f2bf(s2_ - bf2f((unsigned short)sh_)); qxs = hi_ ? 0u : (sh_ | (sl_ << 16)); }
    const unsigned neg1w = hi_ ? 0u : 0xBF80BF80u; const unsigned maskw = hi_ ? 0u : 0x00007E96u;
    const unsigned klw0 = hi_ ? 0u : (f2bf((float)(CMP ? 16 * i_ : i_)) * 0x10001u), klw1 = hi_ ? 0u : (f2bf((float)(CMP ? 16 * (i_ + 32) : (i_ + 32))) * 0x10001u);
#define SEQ_NEXT(c) ((c) < 0 ? -1 : (KIND == 3 ? next_below(um, (c)) : (((c) - 1 >= lo) ? (c) - 1 : -1)))
#define TILE_NEED(c) (KIND == 3 ? bit128(wm, (c)) : 1)
#define TILE_MODE(c) (KIND == 0 ? (((c) == qt) ? 1 : (((c) == qt - 8) ? 2 : 0)) : (CMP ? ((64 * (c) + 63 <= cfull) ? 0 : 1) : (((c) == qt) ? 1 : 0)))
#define TILE_LIM(c) (CMP ? (climit - 64 * (c)) : C.tloc)
#define TILE_TBW(c) (hi_ ? 0u : (f2bf((float)((CMP ? 1024 : 64) * (c))) * 0x10001u))
#define TILE_QXM(c) ((KIND == 3) ? (bit128(qm, (c)) ? st.qxm : maskw) : st.qxm)
#define SLOT(s) (C.lds + (s) * NB_BUF)
    f32x16 pA0, pA1, pB0, pB1;
    int c0 = first, c1 = SEQ_NEXT(c0), c2 = SEQ_NEXT(c1), s0 = 0;
    if (PRE == 0) { __syncthreads();
        stage_dma<PV>(SLOT(0), Kg, Vg, pitch, 64L * c0, w, lane); }
    if (PRE < 2 && c1 >= 0) stage_dma<PV>(SLOT(1), Kg, Vg, pitch, 64L * c1, w, lane);
    __syncthreads();
    if (TILE_NEED(c0)) nsa_qk(SLOT(0), qf, qxs, TILE_QXM(c0), klw0, klw1, TILE_TBW(c0), neg1w, pA0, pA1, lane);
#define NSA_STEP(P0, P1, N0, N1) do { \
        const int s1_ = (s0 == 2) ? 0 : s0 + 1, s2_ = (s1_ == 2) ? 0 : s1_ + 1; \
        if (c2 >= 0) stage_dma<PV>(SLOT(s2_), Kg, Vg, pitch, 64L * c2, w, lane); \
        const bool need0_ = TILE_NEED(c0) != 0; const int cn_ = (c1 >= 0) ? c1 : c0;     \
        if (need0_) { \
            u32x4 pw_[4]; ImpSums im_; \
            nsa_prep<PV, TRACK>(TILE_MODE(c0), TILE_LIM(c0), st, P0, P1, lane, C.wsf); \
            __builtin_amdgcn_sched_barrier(0); \
            nsa_exp_qk<true, KIND == 2>(SLOT(s1_), qf, qxs, TILE_QXM(cn_), klw0, klw1, TILE_TBW(cn_), neg1w, N0, N1, st, P0, P1, pw_, im_, lane); \
            nsa_pv<PV>(SLOT(s0), st, pw_, lane); \
            if (KIND == 2) nsa_importance(C, im_, c0); \
        } else nsa_qk(SLOT(s1_), qf, qxs, TILE_QXM(cn_), klw0, klw1, TILE_TBW(cn_), neg1w, N0, N1, lane); \
        __syncthreads(); \
        c0 = c1; c1 = c2; c2 = SEQ_NEXT(c2); s0 = s1_; } while (0)
    for (;;) {
        NSA_STEP(pA0, pA1, pB0, pB1); if (c0 < 0) break;
        NSA_STEP(pB0, pB1, pA0, pA1); if (c0 < 0) break;
    }
#undef NSA_STEP
#undef SEQ_NEXT
#undef TILE_NEED
#undef TILE_MODE
#undef TILE_LIM
#undef TILE_TBW
#undef TILE_QXM
#undef SLOT
}
#if !defined(EMU)
#define SUBT_BEGIN() unsigned long long st_t0_ = 0; if (PROBE_K >= 20 && blockIdx.x == 0 && F.tid == 0) st_t0_ = __builtin_amdgcn_s_memrealtime()
#define SUBT_END(i) do { if (PROBE_K >= 20 && blockIdx.x == 0 && F.tid == 0) { const unsigned long long t1_ = __builtin_amdgcn_s_memrealtime(); F.MISC[300 + (i)] += (unsigned)(t1_ - st_t0_); st_t0_ = t1_; } } while (0)
#else
#define SUBT_BEGIN() ((void)0)
#define SUBT_END(i) ((void)0)
#endif
__device__ __forceinline__ void nsa_task(Frame& F, int task) {
    constexpr int NQT = SEQ / 64;
    const int qt = task % NQT, g = (task / NQT) % NG, b = task / (NQT * NG);
    const int t0 = 64 * qt, w = F.wave;
    const bf16_t* Zb = (const bf16_t*)(F.ws + WS_ZB) + (size_t)b * SEQ * ZP;
    LAS float* imp = (LAS float*)(F.lds + A_IMP);
    LAS unsigned short* selm = (LAS unsigned short*)(F.lds + A_SEL);
    LAS unsigned* uniw = (LAS unsigned*)(F.lds + A_UNI);
#define SECTION_LANE() const int lane = opaque_lane(F.lane), i = lane & 31, hi = lane >> 5, ql = i >> 2, qloc = 8 * w + ql, t = t0 + qloc, head = 4 * g + (i & 3); \
        LAS float* wsf = (LAS float*)(F.lds + A_WSF) + w * 32; LAS unsigned char* qf = F.lds + A_QF + w * 4096 + lane * 16; \
        NsaCtx C; C.qt = qt; C.g = g; C.t = t; C.tloc = qloc; C.qloc = qloc; C.head = head; C.w = w; C.lane = lane; C.Zb = Zb; C.lds = F.lds; C.imp = imp; C.wsf = wsf; \
        LAS unsigned* ya = (LAS unsigned*)(F.lds + A_Y) + w * 1024 + hi * 128 + i; (void)ya; (void)head; (void)t
    const LAS unsigned* zz = (const LAS unsigned*)(F.lds + A_UNI);
#define INIT_ST(st) do { st.mref = 0.f; st.l = 0.f; st.has = 0; st.qxm = 0u; _Pragma("unroll") for (int r = 0; r < 16; ++r) { st.o0[r] = 0.f; st.o1[r] = 0.f; } } while (0)
#define ACC_PREP(st, gidx) float f_ = st.l + xor32f(st.l); { const float gate_ = ((const LAS float*)(F.lds + A_GATE))[w * 96 + i * 3 + gidx]; f_ = (f_ > 0.f) ? gate_ * __builtin_amdgcn_rcpf(f_) : 0.f; }     \
        wsf[i] = f_; WAVE_SYNC(); FENCE(); const LAS float* wr_ = wsf + 4 * hi;
    const bf16_t* KCg = (const bf16_t*)(F.ws + WS_KC) + (size_t)(b * NG + g) * NCP * 64;
    const bf16_t* VCg = (const bf16_t*)(F.ws + WS_VC) + (size_t)(b * NG + g) * NCP * 64;
    const int nct = (t0 + 63 >= 31) ? (((t0 + 63 - 31) >> 4) / 64 + 1) : 0;
#define NSA_PRELOAD_CMP(WV) do { if (nct > 0) { stage_dma<WV>(F.lds, KCg, VCg, 64, 64L * (nct - 1), w, lane); if (nct > 1) stage_dma<WV>(F.lds + NB_BUF, KCg, VCg, 64, 64L * (nct - 2), w, lane); } } while (0)
    bool sel_pre = false;
    SUBT_BEGIN();
    {
        SECTION_LANE();
        __syncthreads();
        stage_dma<true>(F.lds, Zb + ZC_KW + g * 64, Zb + ZC_VW + g * 64, ZP, 64L * qt, w, lane);
        if (qt - 1 >= ((qt - 8 > 0) ? qt - 8 : 0)) stage_dma<true>(F.lds + NB_BUF, Zb + ZC_KW + g * 64, Zb + ZC_VW + g * 64, ZP, 64L * (qt - 1), w, lane);
        for (int idx = F.tid; idx < 64 * 128; idx += NTHREADS) imp[idx] = 0.f;
#pragma unroll
        for (int d0 = 0; d0 < 4; ++d0) { const u32x4 raw = *(const u32x4*)(Zb + (size_t)t * ZP + ZC_Q + head * 64 + 16 * d0 + 8 * hi);
            const float sc = 0.125f * LOG2E; u32x4 o;
            o.x = pk2(bflo(raw.x) * sc, bfhi(raw.x) * sc); o.y = pk2(bflo(raw.y) * sc, bfhi(raw.y) * sc); o.z = pk2(bflo(raw.z) * sc, bfhi(raw.z) * sc); o.w = pk2(bflo(raw.w) * sc, bfhi(raw.w) * sc);
            *(LAS u32x4*)(qf + d0 * 1024) = o; }
        if (hi == 0) {
#pragma unroll
            for (int k = 0; k < 3; ++k) ((LAS float*)(F.lds + A_GATE))[w * 96 + i * 3 + k] = sigmoidf_(bf2f(Zb[(size_t)t * ZP + ZC_GL + head * 3 + k]));
        }
    }
    {
        SECTION_LANE();
        BrState st; INIT_ST(st);
        nsa_branch<0, 2>(F, C, qf, Zb + ZC_KW + g * 64, Zb + ZC_VW + g * 64, ZP, qt, (qt - 8 > 0) ? qt - 8 : 0, zz, zz, zz, 0, 0, st);
        NSA_PRELOAD_CMP(false);
        ACC_PREP(st, 2)
#pragma unroll
        for (int r = 0; r < 16; ++r) { const int c_ = (r & 3) + 8 * (r >> 2); const float a_ = wr_[c_]; ya[c_ * 32] = pk2(a_ * st.o0[r], a_ * st.o1[r]); }
        WAVE_SYNC(); FENCE();
    }
    SUBT_END(1);
    {
        SECTION_LANE();
        const bf16_t* Kg = KCg; const bf16_t* Vg = VCg;
        const int cfull = (t0 >= 31) ? ((t0 - 31) >> 4) : -1;
        const int climit = (t >= 31) ? ((t - 31) >> 4) : -1;
        if (nct > 0) {
            BrState st; INIT_ST(st);
            nsa_branch<1, 2>(F, C, qf, Kg, Vg, 64, nct - 1, 0, zz, zz, zz, cfull, climit, st);
            NSA_PRELOAD_CMP(true);
            SUBT_END(2);
            const float ltot = st.l + xor32f(st.l);
            float meff; const unsigned wfin = ref_words(st.mref + ((ltot > 0.f) ? __builtin_log2f(ltot) : 0.f), meff);
            BrState s2; INIT_ST(s2); s2.qxm = hi ? 0u : wfin;
            nsa_branch<2, 2>(F, C, qf, Kg, Vg, 64, nct - 1, 0, zz, zz, zz, cfull, climit, s2);
            stage_dma<true>(F.lds, Zb + ZC_KS + g * 64, Zb + ZC_VS + g * 64, ZP, 64L * qt, w, lane);
            sel_pre = true;
            s2.l = 0.5f;
            ACC_PREP(s2, 0)
#pragma unroll
            for (int r = 0; r < 16; ++r) { const int c_ = (r & 3) + 8 * (r >> 2); const float a_ = wr_[c_]; const unsigned y_ = ya[c_ * 32]; ya[c_ * 32] = pk2(bflo(y_) + a_ * s2.o0[r], bfhi(y_) + a_ * s2.o1[r]); }
            WAVE_SYNC(); FENCE();
        }
    }
    if (!sel_pre) stage_dma<true>(F.lds, Zb + ZC_KS + g * 64, Zb + ZC_VS + g * 64, ZP, 64L * qt, w, F.lane);
    __syncthreads();
    SUBT_END(3);
    {
        const int lane = opaque_lane(F.lane);
        const int q8 = lane >> 3, sub = lane & 7, qq = 8 * w + q8;
        unsigned key[16];
#pragma unroll
        for (int e = 0; e < 16; ++e) { const int j = 16 * sub + e; const bool valid = (j <= qt) && (j < NBLK);
            unsigned kk = valid ? (__builtin_bit_cast(unsigned, imp[qq * 128 + j]) + 1u) : 0u;
            if (valid && (j == 0 || j == qt || j == qt - 1)) kk = 0x7F000000u;
            key[e] = kk; }
        unsigned thr = 0u;
        for (int bit = 30; bit >= 0; --bit) { const unsigned cand = thr | (1u << bit); int c = 0;
#pragma unroll
            for (int e = 0; e < 16; ++e) c += (key[e] >= cand) ? 1 : 0;
            c = red8_add(c);
            if (c >= NSEL) thr = cand; }
        int ngt = 0, tl = 0;
#pragma unroll
        for (int e = 0; e < 16; ++e) { ngt += (key[e] > thr) ? 1 : 0; tl += (key[e] == thr) ? 1 : 0; }
        ngt = red8_add(ngt);
        int sc = tl;
#pragma unroll
        for (int d = 1; d < 8; d <<= 1) { const int o = __shfl(sc, (lane - d) & 63); if (sub >= d) sc += o; }
        int before = sc - tl; const int need = (thr == 0u) ? 0 : (NSEL - ngt);
        unsigned m16 = 0u;
#pragma unroll
        for (int e = 0; e < 16; ++e) { if (key[e] > thr) m16 |= 1u << e; else if (key[e] == thr) { if (before < need) m16 |= 1u << e; ++before; } }
        selm[qq * 8 + sub] = (unsigned short)m16;
        unsigned um = m16; um |= __shfl_xor(um, 8); um |= __shfl_xor(um, 16); um |= __shfl_xor(um, 32);
        if (q8 == 0) ((LAS unsigned short*)uniw)[w * 8 + sub] = (unsigned short)um;
    }
    __syncthreads();
    SUBT_END(4);
    {
        SECTION_LANE();
        BrState st; INIT_ST(st);
        if (F.tid < 4) { unsigned u = 0u; for (int ww = 0; ww < 8; ++ww) u |= uniw[ww * 4 + F.tid]; uniw[32 + F.tid] = u; }
        __syncthreads();
        const LAS unsigned* um = uniw + 32; const LAS unsigned* wm = uniw + w * 4; const LAS unsigned* qm = (const LAS unsigned*)selm + qloc * 4;
        nsa_branch<3, 1>(F, C, qf, Zb + ZC_KS + g * 64, Zb + ZC_VS + g * 64, ZP, qt, 0, um, wm, qm, 0, 0, st);
        ACC_PREP(st, 1)
        bf16_t* ym = (bf16_t*)(F.ws + WS_YMIX) + ((size_t)b * SEQ + t0 + 8 * w + hi) * DM + 512 + 4 * g * 64 + i;
#pragma unroll
        for (int r = 0; r < 16; ++r) { const int c_ = (r & 3) + 8 * (r >> 2); const float a_ = wr_[c_]; const unsigned y_ = ya[c_ * 32]; bf16_t* op = ym + (c_ >> 2) * DM + (c_ & 3) * 64;
            const unsigned o_ = pk2(bflo(y_) + a_ * st.o0[r], bfhi(y_) + a_ * st.o1[r]); op[0] = (bf16_t)(o_ & 0xffffu); op[32] = (bf16_t)(o_ >> 16); }
        WAVE_SYNC(); FENCE();
    }
    SUBT_END(5);
#undef ACC_PREP
#undef INIT_ST
#undef SECTION_LANE
#undef NSA_PRELOAD_CMP
}

__device__ __forceinline__ void argmax16(float& v, int& idx) {
#ifdef EMU
    for (int o = 1; o < 16; o <<= 1) { const float ov = __shfl_xor(v, o); const int oi = __shfl_xor(idx, o); if (ov > v || (ov == v && oi < idx)) { v = ov; idx = oi; } }
#else
#define AM_STEP(ctrl) do { const float ov = __builtin_bit_cast(float, __builtin_amdgcn_update_dpp(0, __builtin_bit_cast(int, v), ctrl, 0xF, 0xF, true)); \
        const int oi = __builtin_amdgcn_update_dpp(0, idx, ctrl, 0xF, 0xF, true); if (ov > v || (ov == v && oi < idx)) { v = ov; idx = oi; } } while (0)
    AM_STEP(0xB1); AM_STEP(0x4E); AM_STEP(0x141); AM_STEP(0x140);
#undef AM_STEP
#endif
}
template <bool SHADOW>
__device__ __forceinline__ void router_task(Frame& F, int task) {
    const int row0 = 32 * task;
    LAS float* Hs = (LAS float*)F.lds;
    const float* mod = (const float*)(F.ws + WS_MOD);
    const float* X0 = F.in[I_X]; const bf16_t* MIX = (const bf16_t*)(F.ws + WS_MIX);
    unsigned char* H2 = (unsigned char*)(F.ws + WS_H2);
    const float* g = F.in[I_GFFN];
    {
        const int b = row0 / SEQ;
        const float* mb = mod + (size_t)b * 6144;
#pragma unroll
        for (int rb = 0; rb < 2; ++rb) {
            f32x4 v[2][4]; u32x2 mw[2][4];
#pragma unroll
            for (int rr = 0; rr < 2; ++rr) { const size_t ro = (size_t)(row0 + 4 * F.wave + 2 * rb + rr) * DM; const f32x4* xr = (const f32x4*)(X0 + ro) + F.lane; const u32x2* mr = (const u32x2*)(MIX + ro) + F.lane;
#pragma unroll
                for (int j = 0; j < 4; ++j) { v[rr][j] = xr[64 * j]; mw[rr][j] = mr[64 * j]; } }
#pragma unroll
            for (int rr = 0; rr < 2; ++rr)
#pragma unroll
                for (int j = 0; j < 4; ++j) v[rr][j] += *(const f32x4*)(mb + 2 * 1024 + 4 * F.lane + 256 * j) * (f32x4){bflo(mw[rr][j].x), bfhi(mw[rr][j].x), bflo(mw[rr][j].y), bfhi(mw[rr][j].y)};
#pragma unroll
            for (int rr = 0; rr < 2; ++rr) {
                const int lr = 4 * F.wave + 2 * rb + rr, m = row0 + lr;
                float s = 0.f;
#pragma unroll
                for (int j = 0; j < 4; ++j) s += (v[rr][j][0] * v[rr][j][0] + v[rr][j][1] * v[rr][j][1]) + (v[rr][j][2] * v[rr][j][2] + v[rr][j][3] * v[rr][j][3]);
                const float rinv = __builtin_amdgcn_rsqf(wave_sum(s) * (1.0f / DM) + EPS);
                unsigned* o4 = (unsigned*)(H2 + (size_t)m * DM) + F.lane;
#pragma unroll
                for (int j = 0; j < 4; ++j) { const int c = 4 * F.lane + 256 * j;
                    const f32x4 h = v[rr][j] * rinv * (*(const f32x4*)(g + c) * (*(const f32x4*)(mb + 4 * 1024 + c) + 1.0f)) + *(const f32x4*)(mb + 3 * 1024 + c);
                    o4[64 * j] = pk4_fp8(h[0] * F8_ACT_SCALE, h[1] * F8_ACT_SCALE, h[2] * F8_ACT_SCALE, h[3] * F8_ACT_SCALE);
#pragma unroll
                    for (int e = 0; e < 4; ++e) Hs[(c + e) * 33 + lr] = h[e]; }
                __builtin_amdgcn_sched_barrier(0);
            }
        }
    }
    const int i = F.lane & 31, hi = F.lane >> 5;
    const float* WR = F.in[I_WR];
    __builtin_amdgcn_sched_barrier(0);
    float wr[32];
#pragma unroll
    for (int ks = 0; ks < 32; ++ks) wr[ks] = WR[(128 * F.wave + 2 * ks + hi) * 32 + i];
    __syncthreads();
    f32x16 acc;
#pragma unroll
    for (int r = 0; r < 16; ++r) acc[r] = 0.f;
    float wr2[32];
#pragma unroll
    for (int ks = 0; ks < 32; ++ks) wr2[ks] = WR[(128 * F.wave + 2 * (ks + 32) + hi) * 32 + i];
    __builtin_amdgcn_sched_barrier(0);
#pragma unroll
    for (int q4 = 0; q4 < 4; ++q4) {
#pragma unroll
        for (int ks = 8 * q4; ks < 8 * q4 + 8; ++ks) acc = __builtin_amdgcn_mfma_f32_32x32x2f32(Hs[(128 * F.wave + 2 * ks + hi) * 33 + i], wr[ks], acc, 0, 0, 0);
        __builtin_amdgcn_sched_barrier(0);
    }
#pragma unroll
    for (int q4 = 0; q4 < 4; ++q4) {
#pragma unroll
        for (int ks = 8 * q4; ks < 8 * q4 + 8; ++ks) acc = __builtin_amdgcn_mfma_f32_32x32x2f32(Hs[(128 * F.wave + 2 * (ks + 32) + hi) * 33 + i], wr2[ks], acc, 0, 0, 0);
        __builtin_amdgcn_sched_barrier(0);
    }
    __syncthreads();
    LAS float* Ls = (LAS float*)F.lds;
    LAS float* Lg = Ls + 8 * 1024;
    LAS unsigned* hist = (LAS unsigned*)(Lg + 32 * 33);
#pragma unroll
    for (int r = 0; r < 16; ++r) Ls[F.wave * 1024 + crow(r, hi) * 32 + i] = acc[r];
    if (F.tid < 64) hist[F.tid] = 0u;
    __syncthreads();
    const int tk = F.tid >> 4, sub = F.tid & 15;
    float l0 = F.in[I_BR][sub], l1 = F.in[I_BR][sub + 16];
#pragma unroll
    for (int w = 0; w < 8; ++w) { l0 += Ls[w * 1024 + tk * 32 + sub]; l1 += Ls[w * 1024 + tk * 32 + sub + 16]; }
    int be[4]; float bv[4];
#pragma unroll
    for (int k = 0; k < 4; ++k) { float v; int id;
        if (l0 >= l1) { v = l0; id = sub; } else { v = l1; id = sub + 16; }
        argmax16(v, id);
        be[k] = id; bv[k] = v;
        if (id == sub) l0 = -INFINITY;
        if (id == sub + 16) l1 = -INFINITY; }
    unsigned rank[4] = {0u, 0u, 0u, 0u};
    {
        float sum = 0.f; const float mx0 = bv[0];
#pragma unroll
        for (int k = 0; k < 4; ++k) { bv[k] = fexp2((bv[k] - mx0) * LOG2E); sum += bv[k]; }
        const float rs = 1.0f / sum;
#pragma unroll
        for (int k = 0; k < 4; ++k) bv[k] *= rs;
    }
    if (sub == 0) {
#pragma unroll
        for (int k = 0; k < 4; ++k) rank[k] = atomicAdd((unsigned*)&hist[be[k]], 1u);
    }
    __syncthreads();
    if (F.tid < 32) { const unsigned c = hist[F.tid]; hist[32 + F.tid] = c ? atomicAdd(F.ctl + (SHADOW ? CW_CNT2 : CW_CNT) + 64 * F.tid, c) : 0u; }
    __syncthreads();
    if (sub == 0) {
        const int tok = row0 + tk;
        const size_t sh_ = SHADOW ? WS_SHADOW : 0;
        int* lists = (int*)(F.ws + sh_ + WS_LISTS); int* tope = (int*)(F.ws + sh_ + WS_TOPE); float* topw = (float*)(F.ws + sh_ + WS_TOPW); int* topp = (int*)(F.ws + sh_ + WS_TOPP);
#pragma unroll
        for (int k = 0; k < 4; ++k) { const int pos = (int)(hist[32 + be[k]] + rank[k]);
            lists[(size_t)be[k] * T + pos] = tok; tope[tok * 4 + k] = be[k]; topw[tok * 4 + k] = bv[k]; topp[tok * 4 + k] = pos; }
    }
    __syncthreads();
}

__device__ __forceinline__ void moe_tables(Frame& F) {
    if (F.tid < 64) {
        const int e = F.lane & 31;
        const unsigned c = __hip_atomic_load(F.ctl + CW_CNT + 64 * e, __ATOMIC_RELAXED, __HIP_MEMORY_SCOPE_AGENT);
        const unsigned tl = (c + 255u) / 256u;
        unsigned incl = tl;
#pragma unroll
        for (int d = 1; d < 32; d <<= 1) { const unsigned o = __shfl(incl, (F.lane - d) & 63); if (e >= d) incl += o; }
        if (F.lane < 32) { F.MISC[MW_CNT + e] = c; F.MISC[MW_TPFX + e] = incl - tl; F.MISC[MW_ROFF + e] = (incl - tl) * 256u;
            if (e == 31) { F.MISC[MW_TPFX + NE] = incl; F.MISC[MW_ROFF + NE] = incl * 256u; } }
    }
    __syncthreads();
}

__device__ __forceinline__ void final_rows(Frame& F) {
    const int gw = F.vcu * NWAVES + F.wave, NGW = F.G * NWAVES;
    const float* mod = (const float*)(F.ws + WS_MOD);
    const float* X0 = F.in[I_X]; const bf16_t* MIX = (const bf16_t*)(F.ws + WS_MIX);
    const bf16_t* YD = (const bf16_t*)(F.ws + WS_YD);
    const int* tope = (const int*)(F.ws + WS_TOPE); const float* topw = (const float*)(F.ws + WS_TOPW); const int* topp = (const int*)(F.ws + WS_TOPP);
    const float* gf = F.in[I_GFIN];
    int m = gw;
    u32x4 ne = (u32x4){0u, 0u, 0u, 0u}, np = ne; f32x4 nw = (f32x4){0.f, 0.f, 0.f, 0.f}; f32x4 nx[4]; u32x2 nm[4];
    if (m < T) { ne = *(const u32x4*)(tope + m * 4); np = *(const u32x4*)(topp + m * 4); nw = *(const f32x4*)(topw + m * 4);
#pragma unroll
        for (int j = 0; j < 4; ++j) { nx[j] = ((const f32x4*)(X0 + (size_t)m * DM) + F.lane)[64 * j]; nm[j] = ((const u32x2*)(MIX + (size_t)m * DM) + F.lane)[64 * j]; } }
    for (; m < T; m += NGW) {
        const int b = m / SEQ;
        const u32x4 ce = ne, cp = np; const f32x4 cw = nw; f32x4 cx[4];
#pragma unroll
        for (int j = 0; j < 4; ++j) { const f32x4 g1 = *(const f32x4*)(mod + (size_t)b * 6144 + 2 * 1024 + 4 * F.lane + 256 * j);
            cx[j] = nx[j] + g1 * (f32x4){bflo(nm[j].x), bfhi(nm[j].x), bflo(nm[j].y), bfhi(nm[j].y)}; }
        size_t yrow[4];
#pragma unroll
        for (int k = 0; k < 4; ++k) yrow[k] = (size_t)(F.MISC[MW_ROFF + ce[k]] + cp[k]) * DM;
        u32x2 yw[4][4];
#pragma unroll
        for (int j = 0; j < 4; ++j)
#pragma unroll
            for (int k = 0; k < 4; ++k) yw[j][k] = *(const u32x2*)(YD + yrow[k] + 4 * F.lane + 256 * j);
        const int mn = m + NGW;
        if (mn < T) { ne = *(const u32x4*)(tope + mn * 4); np = *(const u32x4*)(topp + mn * 4); nw = *(const f32x4*)(topw + mn * 4);
#pragma unroll
            for (int j = 0; j < 4; ++j) { nx[j] = ((const f32x4*)(X0 + (size_t)mn * DM) + F.lane)[64 * j]; nm[j] = ((const u32x2*)(MIX + (size_t)mn * DM) + F.lane)[64 * j]; } }
        f32x4 v[4]; float s = 0.f;
#pragma unroll
        for (int j = 0; j < 4; ++j) { const int c = 4 * F.lane + 256 * j;
            f32x4 mo = (f32x4){0.f, 0.f, 0.f, 0.f};
#pragma unroll
            for (int k = 0; k < 4; ++k) mo += cw[k] * (f32x4){bflo(yw[j][k].x), bfhi(yw[j][k].x), bflo(yw[j][k].y), bfhi(yw[j][k].y)};
            const f32x4 gt = *(const f32x4*)(mod + (size_t)b * 6144 + 5 * 1024 + c);
            v[j] = cx[j] + gt * mo;
            s += (v[j][0] * v[j][0] + v[j][1] * v[j][1]) + (v[j][2] * v[j][2] + v[j][3] * v[j][3]); }
        const float rinv = __builtin_amdgcn_rsqf(wave_sum(s) * (1.0f / DM) + EPS);
        f32x4* orow = (f32x4*)(F.out + (size_t)m * DM) + F.lane;
#pragma unroll
        for (int j = 0; j < 4; ++j) orow[64 * j] = v[j] * rinv * *(const f32x4*)(gf + 4 * F.lane + 256 * j);
    }
}

constexpr int N_PHASES = 10;
#define REP0 1
#define REPB 1
#define REP1 1
#define REP6 1
#define REP2 1
#define REP3 1
#define REP4 1
#define REP5 1
#define REP7 1
#define REP8 1
#define REP9 1
__global__ void __launch_bounds__(NTHREADS, 2) mk_fwd(Args args) {
#ifdef EMU
    unsigned char* lds = emu_blk->lds;
#else
    extern __shared__ __attribute__((aligned(16))) unsigned char lds[];
#endif
    Frame F;
    F.lds = (LAS unsigned char*)lds;
    F.MISC = (volatile LAS unsigned*)(F.lds + MISC_OFF);
    F.tid = threadIdx.x; F.lane = F.tid & 63; F.wave = __builtin_amdgcn_readfirstlane(F.tid >> 6);
    F.G = gridDim.x; { const int bx = blockIdx.x; F.vcu = (F.G % 8 == 0) ? (bx % 8) * (F.G / 8) + bx / 8 : bx; }
    F.ws = args.ws; F.ctl = (unsigned*)(args.ws + WS_CTL); F.out = args.out;
#pragma unroll
    for (int k = 0; k < 24; ++k) F.in[k] = args.in[k];
    for (int u = F.tid; u < (LDS_BYTES - MISC_OFF) / 4; u += NTHREADS) F.MISC[u] = 0u;
    __syncthreads();
    XcdBarrier bar = xcd_barrier_post(F.ctl + CW_BAR, F.MISC + 8);
    const int lo = args.ph_lo, hi = args.ph_hi;
#ifndef EMU
#define STAMP(k) do { if (PROBE_K >= 0 && blockIdx.x == 0 && F.tid == 0) { const unsigned long long t_ = __builtin_amdgcn_s_memrealtime(); F.MISC[((k) >= 20 ? 360 : 256) + 2 * (k)] = (unsigned)t_; F.MISC[((k) >= 20 ? 361 : 257) + 2 * (k)] = (unsigned)(t_ >> 32); } } while (0)
#else
#define STAMP(k) ((void)0)
#endif
    STAMP(0);
#ifndef PH_MASK
#define PH_MASK 0xffff
#endif
#define IN(k) (((PH_MASK >> (k)) & 1) && lo <= (k) && (k) < hi)
#define SEAM(k) do { if (IN(k) && IN((k) + 1)) { xcd_barrier(bar); if (REPB > 1) xcd_barrier(bar); } } while (0)

    if (IN(0)) { p0_prologue(F); if (REP0 > 1) p0_prologue(F); }
    STAMP(20); SEAM(0); STAMP(1);
#ifndef EMU
    if (IN(0) && IN(1)) {
        if (F.tid == 0) { unsigned ok = 1u; for (int j = 0; j < 8; ++j) ok &= (xb_ld(F.ctl + CW_BAR + XB_XCNT(j)) == (unsigned)(F.G / 8)) ? 1u : 0u;
            F.MISC[12] = (ok && bar.x < 8u) ? (bar.x * (unsigned)(F.G / 8) + F.MISC[10]) : (unsigned)F.vcu; }
        __syncthreads();
        F.vcu = (int)F.MISC[12];
    }
#endif
    if (IN(1)) { norm_rows(F, F.in[I_X], F.in[I_GMIX], 0, 1, (bf16_t*)(F.ws + WS_HB)); if (REP1 > 1) norm_rows(F, F.in[I_X], F.in[I_GMIX], 0, 1, (bf16_t*)(F.ws + WS_HB)); }
    STAMP(21); SEAM(1); STAMP(2);
    if (IN(2)) {
        {
        pg8::DenseProb P{(const char*)(F.ws + WS_HB), (const char*)(F.ws + WS_WINT), DM * 2};
        pg8::DenseOrder S; S.init(T, ZP, F.G, (F.G % 8 == 0) ? (F.vcu % (F.G / 8)) * 8 + F.vcu / (F.G / 8) : (int)blockIdx.x);
        EpiZ E{(bf16_t*)(F.ws + WS_ZB)};
        pg8::gemm_phase<false>(F.lds, P, S, E);
        if (p2_fill_items(F) && S.c >= 128) {
            LAS float* scr = (LAS float*)(F.lds + 8192 + F.wave * 16384);
            const int base = P0_NITEMS - p7_fill_items(F) - p2_fill_items(F) + (S.c - 128) * P2_FILL_PER_CU;
            for (int k = F.wave; k < P2_FILL_PER_CU; k += NWAVES) p0_item(F, scr, base + k);
        }
        }
        if (REP2 > 1) {
        pg8::DenseProb P{(const char*)(F.ws + WS_HB), (const char*)(F.ws + WS_WINT), DM * 2};
        pg8::DenseOrder S; S.init(T, ZP, F.G, (F.G % 8 == 0) ? (F.vcu % (F.G / 8)) * 8 + F.vcu / (F.G / 8) : (int)blockIdx.x);
        EpiZ E{(bf16_t*)(F.ws + WS_ZB)};
        pg8::gemm_phase<false>(F.lds, P, S, E);
        }
    }
    STAMP(22); SEAM(2); STAMP(3);
    if (IN(3)) {
        constexpr int NGM = BATCH * (SEQ / GMC) * GMG, NCT = 2 * BATCH * NG * (NCP / 32);
        for (int rep = 0; rep < (REP3 > 1 ? 2 : 1); ++rep) {
            if (F.G == 2 * NCT && NGM == 8 * NCT) {
                if (F.vcu < NCT) { cmp_tile(F, F.vcu); gmlp_run(F, 3 * F.vcu, 1, 3); }
                else gmlp_run(F, 3 * NCT + 5 * (F.vcu - NCT), 1, 5);
            } else { for (int it = F.vcu; it < NCT; it += F.G) cmp_tile(F, it);
                     const int first = ((F.vcu - NCT) % F.G + F.G) % F.G; gmlp_run(F, first, F.G, (NGM - first + F.G - 1) / F.G); }
        }
    }
    STAMP(23); SEAM(3); STAMP(4);
    if (IN(4)) {
        constexpr int NQT_ = SEQ / 64, NPAIR = BATCH * NQT_;
        for (int rep = 0; rep < (REP4 > 1 ? 2 : 1); ++rep)
        for (int pr = F.vcu; pr < NPAIR; pr += F.G) { const int b_ = pr / NQT_, x_ = pr % NQT_;
            for (int k2 = 0; k2 < 2; ++k2) nsa_task(F, k2 ? (b_ * NG + 0) * NQT_ + x_ : (b_ * NG + 1) * NQT_ + (NQT_ - 1 - x_)); }
    }
    STAMP(24); SEAM(4); STAMP(5);
    if (IN(5)) {
        {
        pg8::DenseProb P{(const char*)(F.ws + WS_YMIX), (const char*)(F.ws + WS_WOUTT), DM * 2};
        pg8::DenseOrder S; S.init(T, DM, F.G, (F.G % 8 == 0) ? (F.vcu % (F.G / 8)) * 8 + F.vcu / (F.G / 8) : (int)blockIdx.x);
        EpiMix E{(bf16_t*)(F.ws + WS_MIX)};
        pg8::gemm_phase<false>(F.lds, P, S, E);
        }
        if (REP5 > 1) {
        pg8::DenseProb P{(const char*)(F.ws + WS_YMIX), (const char*)(F.ws + WS_WOUTT), DM * 2};
        pg8::DenseOrder S; S.init(T, DM, F.G, (F.G % 8 == 0) ? (F.vcu % (F.G / 8)) * 8 + F.vcu / (F.G / 8) : (int)blockIdx.x);
        EpiMix E{(bf16_t*)(F.ws + WS_MIX)};
        pg8::gemm_phase<false>(F.lds, P, S, E);
        }
    }
    STAMP(25); SEAM(5); STAMP(6);
    if (IN(6)) { for (int it = F.vcu; it < T / 32; it += F.G) router_task<false>(F, it); if (REP6 > 1) for (int it = F.vcu; it < T / 32; it += F.G) router_task<true>(F, it); }
    STAMP(26); SEAM(6); STAMP(7);
    if (IN(7)) {
        {
        moe_tables(F);
        MoeProb1 P{(const char*)(F.ws + WS_H2), (const char*)(F.ws + WS_WGUT), (const int*)(F.ws + WS_LISTS), F.in[I_BGU], F.MISC + MW_CNT, DM};
        pg8::MoeOrder S{F.MISC + MW_TPFX, 8, F.G, F.vcu, 0};
        EpiAct E{(unsigned char*)(F.ws + WS_ACT), F.in[I_BGU], F.MISC + MW_ROFF};
        pg8::gemm_phase<true>(F.lds, P, S, E);
        if (p7_fill_items(F)) {
            const int rem = ((int)F.MISC[MW_TPFX + NE] * 8) % F.G;
            int nidle = rem ? F.G - rem : 0, j = F.vcu - rem;
            if (nidle < F.G / 4) { nidle = F.G; j = F.vcu; }
            if (j >= 0) {
                __syncthreads();
                LAS float* scr = (LAS float*)(F.lds + F.wave * 8704);
                const int base = P0_NITEMS - p7_fill_items(F);
                for (int k = j * NWAVES + F.wave; k < p7_fill_items(F); k += nidle * NWAVES) p0_item(F, scr, base + k);
            }
        }
        }
        if (REP7 > 1) {
        moe_tables(F);
        MoeProb1 P{(const char*)(F.ws + WS_H2), (const char*)(F.ws + WS_WGUT), (const int*)(F.ws + WS_LISTS), F.in[I_BGU], F.MISC + MW_CNT, DM};
        pg8::MoeOrder S{F.MISC + MW_TPFX, 8, F.G, F.vcu, 0};
        EpiAct E{(unsigned char*)(F.ws + WS_ACT), F.in[I_BGU], F.MISC + MW_ROFF};
        pg8::gemm_phase<true>(F.lds, P, S, E);
        }
    }
    STAMP(27); SEAM(7); STAMP(8);
    if (IN(8)) {
        {
        moe_tables(F);
        MoeProb2 P{(const char*)(F.ws + WS_ACT), (const char*)(F.ws + WS_WDNT), F.in[I_BDN], F.MISC + MW_ROFF, DFF};
        pg8::MoeOrder S{F.MISC + MW_TPFX, 4, F.G, F.vcu, 0};
        EpiYd E{(bf16_t*)(F.ws + WS_YD), F.in[I_BDN], F.MISC + MW_ROFF};
        pg8::gemm_phase<true>(F.lds, P, S, E);
        }
        if (REP8 > 1) {
        moe_tables(F);
        MoeProb2 P{(const char*)(F.ws + WS_ACT), (const char*)(F.ws + WS_WDNT), F.in[I_BDN], F.MISC + MW_ROFF, DFF};
        pg8::MoeOrder S{F.MISC + MW_TPFX, 4, F.G, F.vcu, 0};
        EpiYd E{(bf16_t*)(F.ws + WS_YD), F.in[I_BDN], F.MISC + MW_ROFF};
        pg8::gemm_phase<true>(F.lds, P, S, E);
        }
    }
    STAMP(28); SEAM(8); STAMP(9);
    if (IN(9)) { moe_tables(F); final_rows(F); if (REP9 > 1) final_rows(F); }
#ifndef EMU
    if (PROBE_K >= 0 && blockIdx.x == 0 && F.tid == 0) {
        STAMP(10);
        unsigned long long a_ = 0, b_ = 0;
        if (PROBE_K == 19) { a_ = ((unsigned long long)F.MISC[257] << 32) | F.MISC[256]; b_ = ((unsigned long long)F.MISC[257 + 20] << 32) | F.MISC[256 + 20]; }
        else if (PROBE_K < 20) { a_ = ((unsigned long long)F.MISC[257 + 2 * (PROBE_K % 20)] << 32) | F.MISC[256 + 2 * (PROBE_K % 20)];
                            b_ = ((unsigned long long)F.MISC[259 + 2 * (PROBE_K % 20)] << 32) | F.MISC[258 + 2 * (PROBE_K % 20)]; }
        else if (PROBE_K >= 30 && PROBE_K < 40) { a_ = ((unsigned long long)F.MISC[361 + 2 * (20 + PROBE_K - 30)] << 32) | F.MISC[360 + 2 * (20 + PROBE_K - 30)]; b_ = ((unsigned long long)F.MISC[257 + 2 * (PROBE_K - 30 + 1)] << 32) | F.MISC[256 + 2 * (PROBE_K - 30 + 1)]; }
        else if (PROBE_K >= 50) b_ = F.MISC[300 + 6 + (PROBE_K % 10)];
        else b_ = F.MISC[300 + (PROBE_K - 20)];
        const unsigned long long t0_ = __builtin_amdgcn_s_memrealtime();
        while (__builtin_amdgcn_s_memrealtime() - t0_ < (b_ - a_)) __builtin_amdgcn_s_sleep(8);
    }
#endif
#undef IN
#undef SEAM
}

#ifdef EMU
struct EmuDump { const char* name; size_t off; size_t bytes; };
EmuDump emu_dumps[] = {
    {"mod", WS_MOD, (size_t)BATCH * 6144 * 4}, {"bpe", WS_BPE, 512 * 4}, {"wint", WS_WINT, (size_t)ZP * DM * 2}, {"hb", WS_HB, (size_t)T * DM * 2},
    {"zb", WS_ZB, (size_t)T * ZP * 2}, {"kc", WS_KC, (size_t)BATCH * NG * NCP * 64 * 2}, {"vc", WS_VC, (size_t)BATCH * NG * NCP * 64 * 2},
    {"ymix", WS_YMIX, (size_t)T * DM * 2}, {"mix", WS_MIX, (size_t)T * DM * 2}, {"h2", WS_H2, (size_t)T * DM * 2},
    {"tope", WS_TOPE, (size_t)T * 16}, {"topw", WS_TOPW, (size_t)T * 16}, {"topp", WS_TOPP, (size_t)T * 16}, {"ctl", WS_CTL, CTL_ZERO_BYTES},
};
int emu_ndumps = sizeof(emu_dumps) / sizeof(emu_dumps[0]);
size_t emu_ws_bytes = WS_END;
int emu_out_elems = T * DM;
#endif

extern "C" void kernel_launch(void* const* d_in, const int* in_sizes, int n_in, void* d_out, int out_size, void* d_ws, size_t ws_size, hipStream_t stream) {
    (void)in_sizes; (void)out_size; (void)ws_size;
    Args a{};
    for (int i = 0; i < 24 && i < n_in; ++i) a.in[i] = (const float*)d_in[i];
    a.out = (float*)d_out; a.ws = (unsigned char*)d_ws;
#ifndef EMU
    (void)hipMemsetAsync((char*)d_ws + WS_CTL, 0, CTL_ZERO_BYTES, stream);
#endif
#ifdef EMU
    int plo = 0, phi = N_PHASES;
    if (const char* e = getenv("EMU_PH_LO")) plo = atoi(e);
    if (const char* e = getenv("EMU_PH_HI")) phi = atoi(e);
    if (plo == 0) (void)hipMemsetAsync((char*)d_ws + WS_CTL, 0, CTL_ZERO_BYTES, stream);
    const int grid = emu_num_cus();
    for (int ph = plo; ph < phi; ++ph) { a.ph_lo = ph; a.ph_hi = ph + 1; Args ac = a; fprintf(stderr, "EMU phase %d\n", ph);
        emu_launch(grid, NTHREADS, LDS_BYTES, [ac]() { mk_fwd(ac); }); }
#else
    static int grid = 0;
    if (grid == 0) {
        int dev = 0, cus = 0, per_cu = 0;
        (void)hipGetDevice(&dev);
        (void)hipDeviceGetAttribute(&cus, hipDeviceAttributeMultiprocessorCount, dev);
        (void)hipFuncSetAttribute((const void*)mk_fwd, hipFuncAttributeMaxDynamicSharedMemorySize, LDS_BYTES);
        (void)hipOccupancyMaxActiveBlocksPerMultiprocessor(&per_cu, (const void*)mk_fwd, NTHREADS, LDS_BYTES);
        if (per_cu < 1) fprintf(stderr, "kernel_launch: occupancy query reports %d blocks/CU\n", per_cu);
        grid = cus;
        (void)hipGetLastError();
    }
    a.ph_lo = 0; a.ph_hi = N_PHASES;
    void* kargs[] = {&a};
    hipError_t e = hipLaunchCooperativeKernel((const void*)mk_fwd, dim3(grid), dim3(NTHREADS), kargs, LDS_BYTES, stream);
    if (e != hipSuccess) fprintf(stderr, "cooperative launch failed: %s (grid %d)\n", hipGetErrorString(e), grid);
#endif
}
```

```cpp
#ifndef EMU
#include <hip/hip_runtime.h>
#endif
#include <cstdio>
#include <cstdint>

#ifndef CFG_BATCH
#define CFG_BATCH 2
#endif
#ifndef CFG_SEQ
#define CFG_SEQ 8192
#endif

#define PROBE_K -1
#ifdef EMU
#define NOSPEC() ((void)0)
#define LAS
#define ASM_VMCNT(n) ((void)0)
#define ASM_LGKMCNT(n) ((void)0)
#define WAVE_SYNC() emu_wave_sync()
#define FENCE() ((void)0)
#else
#define NOSPEC() asm volatile("; rare path" ::: "memory")
#define LAS __attribute__((address_space(3)))
#define ASM_VMCNT(n) asm volatile("s_waitcnt vmcnt(" #n ")" ::: "memory")
#define ASM_LGKMCNT(n) asm volatile("s_waitcnt lgkmcnt(" #n ")" ::: "memory")
#define WAVE_SYNC() asm volatile("s_waitcnt lgkmcnt(0)" ::: "memory")
#define FENCE() asm volatile("" ::: "memory")
#endif

typedef unsigned short bf16_t;
typedef short bf16x8 __attribute__((ext_vector_type(8)));
typedef short s16x4 __attribute__((ext_vector_type(4)));
typedef float f32x4 __attribute__((ext_vector_type(4)));
typedef float f32x16 __attribute__((ext_vector_type(16)));
typedef unsigned u32x4 __attribute__((ext_vector_type(4)));
typedef unsigned u32x2 __attribute__((ext_vector_type(2)));

constexpr int NWAVES = 8, NTHREADS = 512;
constexpr int BATCH = CFG_BATCH, SEQ = CFG_SEQ, DM = 1024, T = BATCH * SEQ;
constexpr int GMW = 512, GMG = 8, GMC = 128;
constexpr int NH = 8, NG = 2, NR = 4, HD = 64;
constexpr int INC = 2328, ZP = 2560;
constexpr int ZC_U = 0, ZC_V = 512, ZC_Q = 1024, ZC_KC = 1536, ZC_VC = 1664, ZC_KS = 1792, ZC_VS = 1920, ZC_KW = 2048, ZC_VW = 2176, ZC_GL = 2304;
constexpr int NCMP = SEQ / 16 - 1, NCP = SEQ / 16;
constexpr int NBLK = SEQ / 64;
constexpr int NSEL = NBLK < 16 ? NBLK : 16;
constexpr int NE = 32, TOPK = 4, DFF = 1024;
constexpr int TK = T * TOPK;
constexpr int ACT_ROWS = TK + NE * 256;
constexpr float EPS = 1e-6f;
constexpr float LOG2E = 1.4426950408889634f;
constexpr float F8_ACT_SCALE = 8.0f, F8_W_SCALE = 64.0f, F8_ACC_SCALE = 1.0f / 512.0f;

constexpr size_t MiB = 1u << 20;
constexpr size_t WS_CTL = 0, CTL_ZERO_BYTES = 192 * 1024;
constexpr size_t WS_MOD = 1 * MiB;
constexpr size_t WS_BPE = 1 * MiB + 512 * 1024;
constexpr size_t WS_LISTS = 2 * MiB;
constexpr size_t WS_TOPE = 4 * MiB;
constexpr size_t WS_TOPW = 4 * MiB + 512 * 1024;
constexpr size_t WS_TOPP = 5 * MiB;
constexpr size_t WS_WSBF = 6 * MiB;
constexpr size_t WS_W2KT = 6 * MiB + 512 * 1024;
constexpr size_t WS_W2VT = WS_W2KT + 64 * 1024;
constexpr size_t WS_W1KT = 7 * MiB;
constexpr size_t WS_W1VT = 8 * MiB;
constexpr size_t WS_WOUTT = 9 * MiB;
constexpr size_t WS_WINT = 11 * MiB;
constexpr size_t WS_KC = 16 * MiB;
constexpr size_t WS_VC = 16 * MiB + 512 * 1024;
constexpr size_t WS_WGUT = 32 * MiB;
constexpr size_t WS_WDNT = 160 * MiB;
constexpr size_t WS_HB = 224 * MiB;
constexpr size_t WS_H2 = 256 * MiB;
constexpr size_t WS_ZB = 288 * MiB;
constexpr size_t WS_YMIX = 368 * MiB;
constexpr size_t WS_MIX = 400 * MiB;
constexpr size_t WS_ACT = 464 * MiB;
constexpr size_t WS_YD = 608 * MiB;
constexpr size_t WS_YACC = 768 * MiB;
constexpr size_t WS_END = 804 * MiB;
constexpr int CW_BAR = 4096;
constexpr int CW_CNT = 16384;
constexpr int CW_CNT2 = 32768;
constexpr size_t WS_SHADOW = 752 * MiB;

constexpr int RING_BYTES = 131072;
constexpr int MISC_OFF = 155648;
constexpr int LDS_BYTES = 159744;
constexpr int MW_CNT = 16, MW_TPFX = 64, MW_ROFF = 128;

__device__ __forceinline__ unsigned f2bf(float f) { unsigned u = __builtin_bit_cast(unsigned, f); return (u + 0x7fffu + ((u >> 16) & 1u)) >> 16; }
#ifdef EMU
__device__ __forceinline__ unsigned pk2(float lo, float hi) { return f2bf(lo) | (f2bf(hi) << 16); }
#else
typedef float f32x2_t __attribute__((ext_vector_type(2))); typedef __bf16 bf16x2_t __attribute__((ext_vector_type(2)));
__device__ __forceinline__ unsigned pk2(float lo, float hi) { f32x2_t v = {lo, hi}; bf16x2_t bb = __builtin_convertvector(v, bf16x2_t); return __builtin_bit_cast(unsigned, bb); }
#endif
__device__ __forceinline__ unsigned pk4_fp8(float a, float b, float c, float d) {
    a = fminf(fmaxf(a, -448.f), 448.f); b = fminf(fmaxf(b, -448.f), 448.f); c = fminf(fmaxf(c, -448.f), 448.f); d = fminf(fmaxf(d, -448.f), 448.f);
    int w = 0; w = __builtin_amdgcn_cvt_pk_fp8_f32(a, b, w, false); w = __builtin_amdgcn_cvt_pk_fp8_f32(c, d, w, true); return (unsigned)w;
}
__device__ __forceinline__ unsigned pk4_fp8_nc(float a, float b, float c, float d) {
    int w = 0; w = __builtin_amdgcn_cvt_pk_fp8_f32(a, b, w, false); w = __builtin_amdgcn_cvt_pk_fp8_f32(c, d, w, true); return (unsigned)w;
}
typedef int v8i_t __attribute__((ext_vector_type(8)));
typedef int v4i_t __attribute__((ext_vector_type(4)));
__device__ __forceinline__ float bf2f(unsigned short h) { return __builtin_bit_cast(float, (unsigned)h << 16); }
__device__ __forceinline__ float bflo(unsigned w) { return __builtin_bit_cast(float, w << 16); }
__device__ __forceinline__ float bfhi(unsigned w) { return __builtin_bit_cast(float, w & 0xffff0000u); }
__device__ __forceinline__ float fexp2(float x) { return __builtin_amdgcn_exp2f(x); }
__device__ __forceinline__ float gelu_tanh(float x) {
    const float y2 = 1.5957691216057308f * (x + 0.044715f * x * x * x);
    return x * __builtin_amdgcn_rcpf(1.0f + fexp2(-y2 * LOG2E));
}
__device__ __forceinline__ float sigmoidf_(float x) { return __builtin_amdgcn_rcpf(1.0f + fexp2(-x * LOG2E)); }
__device__ __forceinline__ float wave_sum(float v) {
#pragma unroll
    for (int o = 1; o < 64; o <<= 1) v += __shfl_xor(v, o);
    return v;
}
__device__ __forceinline__ int crow(int r, int hi) { return (r & 3) + 8 * (r >> 2) + 4 * hi; }

#define XB_TMO      128
#define XB_XCNT(j)  (256  + 64 * (j))
#define XB_XSUB(j)  (1280 + 64 * (j))
#define XB_XGEN(j)  (2304 + 64 * (j))
#define XB_TOP      3328
#define XB_TOPGEN   3392
#define XCD_BAR_WORDS 3456
#define XB_SPIN_CAP (1u << 18)
struct XcdBarrier { unsigned* bar; unsigned x; volatile LAS unsigned* st; };
#ifndef EMU
__device__ __forceinline__ unsigned xb_ld(unsigned* p)              { return __hip_atomic_load(p, __ATOMIC_RELAXED, __HIP_MEMORY_SCOPE_AGENT); }
__device__ __forceinline__ unsigned xb_add(unsigned* p, unsigned v) { return __hip_atomic_fetch_add(p, v, __ATOMIC_RELAXED, __HIP_MEMORY_SCOPE_AGENT); }
__device__ __forceinline__ unsigned xb_xcc_id() { return (unsigned)__builtin_amdgcn_s_getreg((3 << 11) | 20) & 0xFu; }
#define XB_SPIN(cond, bar) do { unsigned _sp = 0; while (cond) { __builtin_amdgcn_s_sleep(1); \
    if ((++_sp & 255u) == 0u) { if (xb_ld(&(bar)[XB_TMO])) break; if (_sp > XB_SPIN_CAP) { atomicAdd(&(bar)[XB_TMO], 1u); break; } } } } while (0)
__device__ __forceinline__ XcdBarrier xcd_barrier_post(unsigned* bar, volatile LAS unsigned* st) {
    XcdBarrier b; b.bar = bar; b.x = xb_xcc_id(); b.st = st;
    if (threadIdx.x == 0) st[2] = xb_add(&bar[XB_XCNT(b.x)], 1u);
    return b;
}
__device__ __forceinline__ void xcd_barrier_complete(unsigned* bar, unsigned x, unsigned& nloc, unsigned& nx) {
    const unsigned G = gridDim.x * gridDim.y * gridDim.z;
    unsigned sum, cnt, mine, sp = 0u;
    for (;;) {
        sum = 0u; cnt = 0u; mine = 0u;
#pragma unroll
        for (unsigned j = 0; j < 16; ++j) { const unsigned c = xb_ld(&bar[XB_XCNT(j)]); sum += c; cnt += (c > 0u) ? 1u : 0u; mine = (j == x) ? c : mine; }
        if (sum == G) break;
        __builtin_amdgcn_s_sleep(1);
        if ((++sp & 255u) == 0u) { if (xb_ld(&bar[XB_TMO])) break; if (sp > XB_SPIN_CAP) { atomicAdd(&bar[XB_TMO], 1u); break; } }
    }
    nloc = mine > 0u ? mine : 1u; nx = cnt > 0u ? cnt : 1u;
}
__device__ __forceinline__ void xcd_barrier(const XcdBarrier& b) {
    asm volatile("s_waitcnt vmcnt(0)" ::: "memory");
    __syncthreads();
    if (threadIdx.x == 0) {
        unsigned* bar = b.bar;
        __builtin_amdgcn_s_waitcnt(0);
        unsigned nloc = b.st[0], nx = b.st[1];
        if (nloc == 0u) { xcd_barrier_complete(bar, b.x, nloc, nx); b.st[0] = nloc; b.st[1] = nx; }
        const unsigned old = xb_add(&bar[XB_XSUB(b.x)], 1u);
        const unsigned gen = old / nloc;
        if (old + 1u == (gen + 1u) * nloc) {
            __builtin_amdgcn_fence(__ATOMIC_RELEASE, "agent");
            asm volatile("s_waitcnt vmcnt(0)" ::: "memory");
            const unsigned og = xb_add(&bar[XB_TOP], 1u);
            const unsigned tg = og / nx;
            if (og + 1u == (tg + 1u) * nx) xb_add(&bar[XB_TOPGEN], 1u);
            else XB_SPIN(xb_ld(&bar[XB_TOPGEN]) == tg, bar);
            __builtin_amdgcn_fence(__ATOMIC_ACQUIRE, "agent");
            xb_add(&bar[XB_XGEN(b.x)], 1u);
            asm volatile("s_waitcnt vmcnt(0)" ::: "memory");
        } else {
            XB_SPIN(xb_ld(&bar[XB_XGEN(b.x)]) == gen, bar);
            __builtin_amdgcn_fence(__ATOMIC_ACQUIRE, "agent");
            asm volatile("s_waitcnt vmcnt(0)" ::: "memory");
        }
    }
    __syncthreads();
}
#else
__device__ __forceinline__ XcdBarrier xcd_barrier_post(unsigned* bar, volatile unsigned* st) { XcdBarrier b; b.bar = bar; b.x = 0; b.st = st; return b; }
__device__ __forceinline__ void xcd_barrier(const XcdBarrier&) { fprintf(stderr, "EMU: grid barrier inside a launch\n"); abort(); }
#endif

struct Args { const float* in[24]; float* out; unsigned char* ws; int ph_lo, ph_hi; };
enum { I_X = 0, I_C, I_WADA, I_BADA, I_GMIX, I_WIN, I_GMWS, I_GMBS, I_GMNG, I_PEK, I_W1K, I_W2K, I_PEV, I_W1V, I_W2V, I_WOUT, I_GFFN, I_WR, I_BR, I_WGU, I_BGU, I_WDN, I_BDN, I_GFIN };

struct Frame {
    LAS unsigned char* lds;
    volatile LAS unsigned* MISC;
    unsigned* ctl;
    unsigned char* ws;
    const float* in[24];
    float* out;
    int tid, lane, wave, vcu, G;
};

namespace pg8 {
constexpr int BM = 256, BK = 64, HALF = 128, HTB = HALF * BK * 2, STAGE_BYTES = 8 * HTB;
__device__ __forceinline__ int lds_byte(int r, int c) { const int st = (r >> 4) * 2 + (c >> 5), rr = r & 15, cc = c & 31, ob = rr * 64 + cc * 2; return st * 1024 + (ob ^ (((ob >> 9) & 1) << 5)); }
__device__ __forceinline__ void stage_rc(int b, int& R, int& C) { const int st = b / 1024, sb = b % 1024, swz = sb ^ (((sb >> 9) & 1) << 5); R = (st >> 1) * 16 + swz / 64; C = (st & 1) * 32 + (swz % 64) / 2; }
__device__ __forceinline__ int perm32(int rho) { const int n = rho >> 4, i = rho & 15; return 8 * (i >> 2) + 4 * n + (i & 3); }
struct Unit { int pm, pn, e; };

template <bool FP8, class Prob, class Sched, class Epi>
__device__ __forceinline__ void gemm_phase(LAS unsigned char* lds, const Prob& P, const Sched& S, const Epi& E) {
    const int tid = threadIdx.x, wid = __builtin_amdgcn_readfirstlane(tid >> 6), lane = tid & 63, wr = wid >> 2, wc = wid & 3, fr = lane & 15, fq = lane >> 4;
    const int KB = P.KB, nt = KB / 128;
    int Rr[2], Cc[2]; unsigned voffB[2];
#pragma unroll
    for (int i = 0; i < 2; ++i) { int R, C; stage_rc(tid * 16 + i * 8192, R, C); Rr[i] = R; Cc[i] = C; const int Rb = Epi::PERM ? ((R & ~31) + perm32(R & 31)) : R; voffB[i] = (unsigned)(Rb * KB + C * 2); }
    const size_t kstep = (size_t)(BK * 2);
    const size_t hstepB = (size_t)HALF * KB;
    const unsigned ldsw = (unsigned)wid * 1024u;
    const int aoff = lds_byte(wr * 64 + fr, fq * 8), boff = lds_byte(wc * 32 + fr, fq * 8);
#define PG8_SA(b, h) (((b) * 2 + (h)) * HTB)
#define PG8_SB(b, h) ((4 + (b) * 2 + (h)) * HTB)
#define PG8_STAGE(bufoff, gbase, voff) do { _Pragma("unroll") for (int _i = 0; _i < 2; ++_i) \
        __builtin_amdgcn_global_load_lds((const unsigned*)((const char*)(gbase) + (voff)[_i]), (LAS unsigned*)(lds + (bufoff) + ldsw + _i * 8192), 16, 0, 0); } while (0)
#define PG8_LD8(p) __builtin_shufflevector(*(const LAS v4i_t*)(p), *(const LAS v4i_t*)((p) + 1024), 0, 1, 2, 3, 4, 5, 6, 7)
#define PG8_LDA(dst, b, h) do { _Pragma("unroll") for (int m = 0; m < 4; ++m) dst[m] = PG8_LD8(lds + PG8_SA(b, h) + aoff + m * 2048); } while (0)
#define PG8_LDB(dst, b, h) do { _Pragma("unroll") for (int n = 0; n < 2; ++n) dst[n] = PG8_LD8(lds + PG8_SB(b, h) + boff + n * 2048); } while (0)
#define PG8_LO(x) __builtin_bit_cast(bf16x8, __builtin_shufflevector(x, x, 0, 1, 2, 3))
#define PG8_HI(x) __builtin_bit_cast(bf16x8, __builtin_shufflevector(x, x, 4, 5, 6, 7))
#ifdef EMU
#define PG8_MFMA_F8(c_, b_, a_) c_ = __builtin_amdgcn_mfma_scale_f32_16x16x128_f8f6f4(b_, a_, c_, 0, 0, 0, 0x7F7F7F7F, 0, 0x7F7F7F7F)
#else
#define PG8_MFMA_F8(c_, b_, a_) asm volatile("v_mfma_scale_f32_16x16x128_f8f6f4 %0, %1, %2, %0, %3, %3 op_sel_hi:[0,0,0]" : "+v"(c_) : "v"(b_), "v"(a_), "v"(f8one))
#endif
#define PG8_MMA(ai, bj, At, Bt) do { __builtin_amdgcn_s_setprio(1); \
        if (FP8) { _Pragma("unroll") for (int m = 0; m < 4; ++m) _Pragma("unroll") for (int n = 0; n < 2; ++n) PG8_MFMA_F8(acc[ai][bj][m][n], Bt[n], At[m]); } \
        else { _Pragma("unroll") for (int m = 0; m < 4; ++m) _Pragma("unroll") for (int n = 0; n < 2; ++n) { \
            acc[ai][bj][m][n] = __builtin_amdgcn_mfma_f32_16x16x32_bf16(PG8_LO(Bt[n]), PG8_LO(At[m]), acc[ai][bj][m][n], 0, 0, 0); \
            acc[ai][bj][m][n] = __builtin_amdgcn_mfma_f32_16x16x32_bf16(PG8_HI(Bt[n]), PG8_HI(At[m]), acc[ai][bj][m][n], 0, 0, 0); } } \
        __builtin_amdgcn_s_setprio(0); } while (0)
#define PG8_WAIT_V(n) ASM_VMCNT(n)
#define PG8_WAIT_L(n) ASM_LGKMCNT(n)
#define PG8_BAR __builtin_amdgcn_s_barrier()
#define PG8_SCHED __builtin_amdgcn_sched_barrier(0)
#ifndef EMU
    unsigned long long ge0_ = 0; const bool gprobe0_ = (PROBE_K / 10 == Epi::PID) && blockIdx.x == 0 && tid == 0;
    if (gprobe0_) ge0_ = __builtin_amdgcn_s_memrealtime();
#endif
    Unit cur, nxt; int ui = 0;
    if (!S.next(0, cur)) return;
    f32x4 acc[2][2][4][2];
#pragma unroll
    for (int a = 0; a < 2; ++a)
#pragma unroll
        for (int b = 0; b < 2; ++b)
#pragma unroll
            for (int m = 0; m < 4; ++m)
#pragma unroll
                for (int n = 0; n < 2; ++n) acc[a][b][m][n] = (f32x4){0.f, 0.f, 0.f, 0.f};
    v8i_t At[4], B0[2], B1[2];
    int f8one = 0x7F7F7F7F;
#ifndef EMU
    asm volatile("" : "+v"(f8one));
#endif
    (void)f8one;
    unsigned vA0[2], vA1[2], nA0[2], nA1[2];
#define PG8_SIDE(k) (lds + STAGE_BYTES + ((k) % 3) * 2048)
    if (Prob::SIDE) { P.side_issue(cur, PG8_SIDE(0), wid, lane); PG8_WAIT_V(0); PG8_BAR; }
#pragma unroll
    for (int i = 0; i < 2; ++i) { vA0[i] = P.a_rowoff(cur, Rr[i], PG8_SIDE(0)) + (unsigned)Cc[i] * 2u; vA1[i] = P.a_rowoff(cur, HALF + Rr[i], PG8_SIDE(0)) + (unsigned)Cc[i] * 2u; }
    const char* cA = P.a_base(cur); const char* cB = P.b_base(cur);
    PG8_STAGE(PG8_SB(0, 0), cB, voffB); PG8_STAGE(PG8_SB(0, 1), cB + hstepB, voffB); PG8_STAGE(PG8_SA(0, 0), cA, vA0); PG8_STAGE(PG8_SA(0, 1), cA, vA1);
    if (wr == 1) PG8_BAR;
    PG8_WAIT_V(2); PG8_BAR;
    PG8_STAGE(PG8_SB(1, 0), cB + kstep, voffB); PG8_STAGE(PG8_SA(1, 0), cA + kstep, vA0); PG8_STAGE(PG8_SB(1, 1), cB + hstepB + kstep, voffB);
    PG8_WAIT_V(6); PG8_BAR;
    for (;;) {
        const bool has_next = S.next(ui + 1, nxt);
        const char* nA = has_next ? P.a_base(nxt) : cA; const char* nB = has_next ? P.b_base(nxt) : cB;
        if (Prob::SIDE && has_next) P.side_issue(nxt, PG8_SIDE(ui + 1), wid, lane);
#pragma unroll
        for (int i = 0; i < 2; ++i) { nA0[i] = vA0[i]; nA1[i] = vA1[i]; }
        if (!Prob::SIDE && has_next) {
#pragma unroll
            for (int i = 0; i < 2; ++i) { nA0[i] = P.a_rowoff(nxt, Rr[i], PG8_SIDE(0)) + (unsigned)Cc[i] * 2u; nA1[i] = P.a_rowoff(nxt, HALF + Rr[i], PG8_SIDE(0)) + (unsigned)Cc[i] * 2u; }
        }
#ifndef EMU
        unsigned long long gt0_ = 0; const bool gprobe_ = (PROBE_K / 10 == Epi::PID) && blockIdx.x == 0 && tid == 0;
        if (gprobe_) { gt0_ = __builtin_amdgcn_s_memrealtime(); if (ui == 0) ((volatile LAS unsigned*)(lds + MISC_OFF))[300 + 8] += (unsigned)(gt0_ - ge0_); }
#endif
        for (int t = 0; t < nt; t += 2) {
            const bool last = (t == nt - 2);
            if (Prob::SIDE && has_next && t == nt - 4) {
#pragma unroll
                for (int i = 0; i < 2; ++i) { nA0[i] = P.a_rowoff(nxt, Rr[i], PG8_SIDE(ui + 1)) + (unsigned)Cc[i] * 2u; nA1[i] = P.a_rowoff(nxt, HALF + Rr[i], PG8_SIDE(ui + 1)) + (unsigned)Cc[i] * 2u; }
            }
            const char* a1 = cA + (size_t)(t + 1) * kstep;
            const char* a2 = last ? nA : cA + (size_t)(t + 2) * kstep; const char* b2 = last ? nB : cB + (size_t)(t + 2) * kstep;
            const char* a3 = a2 + kstep; const char* b3 = b2 + kstep;
            unsigned s0[2], s1[2];
#pragma unroll
            for (int i = 0; i < 2; ++i) { s0[i] = last ? nA0[i] : vA0[i]; s1[i] = last ? nA1[i] : vA1[i]; }
            PG8_LDB(B0, 0, 0); PG8_LDB(B1, 0, 1); PG8_SCHED; PG8_LDA(At, 0, 0); PG8_STAGE(PG8_SA(1, 1), a1, vA1);
            PG8_WAIT_V(8); PG8_WAIT_L(0); PG8_BAR; PG8_MMA(0, 0, At, B0); PG8_MMA(0, 1, At, B1); PG8_BAR; PG8_SCHED;
            PG8_LDA(At, 0, 1); PG8_STAGE(PG8_SB(0, 0), b2, voffB); PG8_STAGE(PG8_SB(0, 1), b2 + hstepB, voffB); PG8_STAGE(PG8_SA(0, 0), a2, s0);
            PG8_WAIT_V(8); PG8_WAIT_L(0); PG8_BAR; PG8_MMA(1, 0, At, B0); PG8_MMA(1, 1, At, B1); PG8_BAR; PG8_SCHED;
            PG8_LDB(B0, 1, 0); PG8_LDB(B1, 1, 1); PG8_SCHED; PG8_LDA(At, 1, 0); PG8_STAGE(PG8_SA(0, 1), a2, s1);
            PG8_WAIT_V(8); PG8_WAIT_L(0); PG8_BAR; PG8_MMA(0, 0, At, B0); PG8_MMA(0, 1, At, B1); PG8_BAR; PG8_SCHED;
            PG8_LDA(At, 1, 1); PG8_STAGE(PG8_SB(1, 0), b3, voffB); PG8_STAGE(PG8_SB(1, 1), b3 + hstepB, voffB); PG8_STAGE(PG8_SA(1, 0), a3, s0);
            PG8_WAIT_V(8); PG8_WAIT_L(0); PG8_BAR; PG8_MMA(1, 0, At, B0); PG8_MMA(1, 1, At, B1); PG8_BAR; PG8_SCHED;
        }
#ifndef EMU
        if (gprobe_) { const unsigned long long t1_ = __builtin_amdgcn_s_memrealtime(); ((volatile LAS unsigned*)(lds + MISC_OFF))[300 + 6] += (unsigned)(t1_ - gt0_); gt0_ = t1_; }
#endif
        if (wr == 0) PG8_BAR;
#ifndef EMU
        if (FP8) asm volatile("s_nop 15\n\ts_nop 15" ::: "memory");
#endif
        E(acc, cur, wr, wc, fr, fq, (const LAS float*)(PG8_SIDE(ui) + 1024));
        if (!has_next) break;
#pragma unroll
        for (int a = 0; a < 2; ++a)
#pragma unroll
            for (int b = 0; b < 2; ++b)
#pragma unroll
                for (int m = 0; m < 4; ++m)
#pragma unroll
                    for (int n = 0; n < 2; ++n) acc[a][b][m][n] = (f32x4){0.f, 0.f, 0.f, 0.f};
#ifndef EMU
        if (gprobe_) { const unsigned long long t1_ = __builtin_amdgcn_s_memrealtime(); ((volatile LAS unsigned*)(lds + MISC_OFF))[300 + 7] += (unsigned)(t1_ - gt0_); }
#endif
        cur = nxt; cA = nA; cB = nB; ++ui;
#pragma unroll
        for (int i = 0; i < 2; ++i) { vA0[i] = nA0[i]; vA1[i] = nA1[i]; }
        if (wr == 1) PG8_BAR;
    }
#ifndef EMU
    if (gprobe0_) ge0_ = __builtin_amdgcn_s_memrealtime();
#endif
    PG8_WAIT_V(0);
    PG8_BAR;
#ifndef EMU
    if (gprobe0_) ((volatile LAS unsigned*)(lds + MISC_OFF))[300 + 9] += (unsigned)(__builtin_amdgcn_s_memrealtime() - ge0_);
#endif
#undef PG8_SIDE
#undef PG8_SA
#undef PG8_SB
#undef PG8_STAGE
#undef PG8_LDA
#undef PG8_LDB
#undef PG8_MMA
#undef PG8_MFMA_F8
#undef PG8_LD8
#undef PG8_LO
#undef PG8_HI
#undef PG8_WAIT_V
#undef PG8_WAIT_L
#undef PG8_BAR
#undef PG8_SCHED
}

struct DenseOrder {
    int nM, nN, nwg, G, c;
    __device__ __forceinline__ void init(int M, int N, int G_, int c_) { nM = M / BM; nN = N / BM; nwg = nM * nN; G = G_; c = c_; }
    __device__ __forceinline__ bool next(int i, Unit& u) const {
        const long L = (long)i * G + c; if (L >= nwg) return false;
        int wgid = (int)L; { const int q = nwg / 8, r = nwg % 8, xcd = wgid % 8, off = wgid / 8; wgid = (xcd < r ? xcd * (q + 1) : r * (q + 1) + (xcd - r) * q) + off; }
        const int nig = 8 * nN, gid = wgid / nig, fm = gid * 8, gsz = (nM - fm) < 8 ? (nM - fm) : 8;
        u.pm = fm + ((wgid % nig) % gsz); u.pn = (wgid % nig) / gsz; u.e = 0; return true;
    }
};
struct DenseProb {
    static constexpr bool SIDE = false;
    const char* A; const char* Bt; int KB;
    __device__ __forceinline__ const char* a_base(const Unit& u) const { return A + (size_t)u.pm * BM * KB; }
    __device__ __forceinline__ unsigned a_rowoff(const Unit&, int r, const LAS unsigned char*) const { return (unsigned)(r * KB); }
    __device__ __forceinline__ const char* b_base(const Unit& u) const { return Bt + (size_t)u.pn * BM * KB; }
    __device__ __forceinline__ void side_issue(const Unit&, LAS unsigned char*, int, int) const {}
};
struct MoeOrder {
    volatile LAS unsigned* tpfx; int nN, G, c;
    mutable int ecur;
    __device__ __forceinline__ bool next(int i, Unit& u) const {
        const int L = i * G + c; const int total = (int)tpfx[NE] * nN; if (L >= total) return false;
        int e = ecur;
        if (L < (int)tpfx[e] * nN) e = 0;
        while (L >= (int)tpfx[e + 1] * nN) ++e;
        ecur = e;
        const int rem = L - (int)tpfx[e] * nN, tm = (int)tpfx[e + 1] - (int)tpfx[e];
        u.e = e; u.pm = rem % tm; u.pn = rem / tm; return true;
    }
};
}

struct EpiZ {
    static constexpr bool PERM = true; static constexpr int PID = 2;
    bf16_t* O;
    __device__ __forceinline__ void operator()(const f32x4 (&acc)[2][2][4][2], const pg8::Unit& u, int wr, int wc, int fr, int fq, const LAS float*) const {
        const int row0 = u.pm * 256 + wr * 64 + fr, col0 = u.pn * 256 + wc * 32 + 8 * fq;
#pragma unroll
        for (int ai = 0; ai < 2; ++ai)
#pragma unroll
            for (int m = 0; m < 4; ++m) { bf16_t* rowp = O + (size_t)(row0 + ai * 128 + m * 16) * ZP + col0;
#pragma unroll
                for (int bj = 0; bj < 2; ++bj) { const f32x4 v0 = acc[ai][bj][m][0], v1 = acc[ai][bj][m][1];
                    u32x4 w; w.x = pk2(v0[0], v0[1]); w.y = pk2(v0[2], v0[3]); w.z = pk2(v1[0], v1[1]); w.w = pk2(v1[2], v1[3]);
                    *(u32x4*)(rowp + bj * 128) = w; } }
    }
};
struct EpiMix {
    static constexpr bool PERM = true; static constexpr int PID = 5;
    bf16_t* O;
    __device__ __forceinline__ void operator()(const f32x4 (&acc)[2][2][4][2], const pg8::Unit& u, int wr, int wc, int fr, int fq, const LAS float*) const {
        const int row0 = u.pm * 256 + wr * 64 + fr, col0 = u.pn * 256 + wc * 32 + 8 * fq;
#pragma unroll
        for (int ai = 0; ai < 2; ++ai)
#pragma unroll
            for (int m = 0; m < 4; ++m) { bf16_t* rowp = O + (size_t)(row0 + ai * 128 + m * 16) * DM + col0;
#pragma unroll
                for (int bj = 0; bj < 2; ++bj) { const f32x4 v0 = acc[ai][bj][m][0], v1 = acc[ai][bj][m][1];
                    u32x4 w; w.x = pk2(v0[0], v0[1]); w.y = pk2(v0[2], v0[3]); w.z = pk2(v1[0], v1[1]); w.w = pk2(v1[2], v1[3]);
                    *(u32x4*)(rowp + bj * 128) = w; } }
    }
};
struct EpiAct {
    static constexpr bool PERM = true; static constexpr int PID = 7;
    unsigned char* O; const float* bgu; volatile LAS unsigned* roff;
    __device__ __forceinline__ void operator()(const f32x4 (&acc)[2][2][4][2], const pg8::Unit& u, int wr, int wc, int fr, int fq, const LAS float* sb) const {
        const int row0 = (int)roff[u.e] + u.pm * 256 + wr * 64 + fr, col0 = u.pn * 128 + wc * 32 + 8 * fq;
        const LAS float* bp = sb + 2 * (wc * 32 + 8 * fq);
        f32x4 bb[4];
#pragma unroll
        for (int j = 0; j < 4; ++j) bb[j] = *(const LAS f32x4*)(bp + 4 * j);
#pragma unroll
        for (int ai = 0; ai < 2; ++ai)
#pragma unroll
            for (int m = 0; m < 4; ++m) { float a8[8];
#pragma unroll
                for (int n = 0; n < 2; ++n)
#pragma unroll
                    for (int j = 0; j < 4; ++j) { const int cc = 4 * n + j;
                        float g = acc[ai][0][m][n][j] * F8_ACC_SCALE + bb[cc >> 1][(cc & 1) * 2], l = acc[ai][1][m][n][j] * F8_ACC_SCALE + bb[cc >> 1][(cc & 1) * 2 + 1];
                        g = fminf(g, 7.0f); l = fminf(fmaxf(l, -7.0f), 7.0f);
                        a8[cc] = (g * F8_ACT_SCALE) * __builtin_amdgcn_rcpf(1.0f + fexp2(g * (-1.702f * LOG2E))) * (l + 1.0f); }
                u32x2 w; w.x = pk4_fp8_nc(a8[0], a8[1], a8[2], a8[3]); w.y = pk4_fp8_nc(a8[4], a8[5], a8[6], a8[7]);
                *(u32x2*)(O + (size_t)(row0 + ai * 128 + m * 16) * DFF + col0) = w; }
    }
};
struct EpiYd {
    static constexpr bool PERM = true; static constexpr int PID = 8;
    bf16_t* O; const float* bdn; volatile LAS unsigned* roff;
    __device__ __forceinline__ void operator()(const f32x4 (&acc)[2][2][4][2], const pg8::Unit& u, int wr, int wc, int fr, int fq, const LAS float* sb) const {
        const int row0 = (int)roff[u.e] + u.pm * 256 + wr * 64 + fr, col0 = u.pn * 256 + wc * 32 + 8 * fq;
        f32x4 bv[2][2];
#pragma unroll
        for (int bj = 0; bj < 2; ++bj)
#pragma unroll
            for (int n = 0; n < 2; ++n) bv[bj][n] = *(const LAS f32x4*)(sb + wc * 32 + 8 * fq + bj * 128 + 4 * n);
#pragma unroll
        for (int ai = 0; ai < 2; ++ai)
#pragma unroll
            for (int m = 0; m < 4; ++m) { bf16_t* rowp = O + (size_t)(row0 + ai * 128 + m * 16) * DM + col0;
#pragma unroll
                for (int bj = 0; bj < 2; ++bj) { const f32x4 v0 = acc[ai][bj][m][0] * F8_ACC_SCALE + bv[bj][0], v1 = acc[ai][bj][m][1] * F8_ACC_SCALE + bv[bj][1];
                    u32x4 w; w.x = pk2(v0[0], v0[1]); w.y = pk2(v0[2], v0[3]); w.z = pk2(v1[0], v1[1]); w.w = pk2(v1[2], v1[3]);
                    *(u32x4*)(rowp + bj * 128) = w; } }
    }
};
struct MoeProb1 {
    static constexpr bool SIDE = true;
    const char* H2; const char* Bt; const int* lists; const float* bias; volatile LAS unsigned* cnt; int KB;
    __device__ __forceinline__ const char* a_base(const pg8::Unit&) const { return H2; }
    __device__ __forceinline__ unsigned a_rowoff(const pg8::Unit& u, int r, const LAS unsigned char* side) const { const int i = u.pm * 256 + r; const int tok = (i < (int)cnt[u.e]) ? ((const LAS int*)side)[r] : 0; return (unsigned)tok * 1024u; }
    __device__ __forceinline__ const char* b_base(const pg8::Unit& u) const { return Bt + ((size_t)u.e * 2048 + (size_t)u.pn * 256) * 1024; }
    __device__ __forceinline__ void side_issue(const pg8::Unit& u, LAS unsigned char* side, int wid, int lane) const {
        if (wid == 0) __builtin_amdgcn_global_load_lds((const unsigned*)(lists + (size_t)u.e * T + u.pm * 256 + lane * 4), (LAS unsigned*)side, 16, 0, 0);
        if (wid == 1) __builtin_amdgcn_global_load_lds((const unsigned*)(bias + (size_t)u.e * 2048 + u.pn * 256 + lane * 4), (LAS unsigned*)(side + 1024), 16, 0, 0);
    }
};
struct MoeProb2 {
    static constexpr bool SIDE = true;
    const char* A; const char* Bt; const float* bias; volatile LAS unsigned* roff; int KB;
    __device__ __forceinline__ const char* a_base(const pg8::Unit& u) const { return A + ((size_t)roff[u.e] + (size_t)u.pm * 256) * 1024; }
    __device__ __forceinline__ unsigned a_rowoff(const pg8::Unit&, int r, const LAS unsigned char*) const { return (unsigned)r * 1024u; }
    __device__ __forceinline__ const char* b_base(const pg8::Unit& u) const { return Bt + ((size_t)u.e * 1024 + (size_t)u.pn * 256) * 1024; }
    __device__ __forceinline__ void side_issue(const pg8::Unit& u, LAS unsigned char* side, int wid, int lane) const {
        if (wid == 1) __builtin_amdgcn_global_load_lds((const unsigned*)(bias + (size_t)u.e * 1024 + u.pn * 256 + lane * 4), (LAS unsigned*)(side + 1024), 16, 0, 0);
    }
};

template <int NB>
__device__ __forceinline__ void gemv_item(Frame& F, const float* vec, int vstride, const float* W, int K, int N, int n0, const float* bias, float* out, int ostride) {
    LAS float* red = (LAS float*)F.lds;
    const int col = n0 + F.lane, ks = K / NWAVES;
    float acc[NB];
#pragma unroll
    for (int b = 0; b < NB; ++b) acc[b] = 0.f;
    for (int k0 = F.wave * ks; k0 < (F.wave + 1) * ks; k0 += 32) {
        float wv[32];
#pragma unroll
        for (int j = 0; j < 32; ++j) wv[j] = __builtin_nontemporal_load(W + (size_t)(k0 + j) * N + col);
#pragma unroll
        for (int j = 0; j < 32; ++j)
#pragma unroll
            for (int b = 0; b < NB; ++b) acc[b] += vec[b * vstride + k0 + j] * wv[j]; }
#pragma unroll
    for (int b = 0; b < NB; ++b) red[(F.wave * NB + b) * 64 + F.lane] = acc[b];
    __syncthreads();
    if (F.wave == 0) {
#pragma unroll
        for (int b = 0; b < NB; ++b) { float s = bias ? bias[col] : 0.f;
            for (int w = 0; w < NWAVES; ++w) s += red[(w * NB + b) * 64 + F.lane];
            out[b * ostride + col] = s; }
    }
    __syncthreads();
}
template <int MAP>
__device__ __forceinline__ int t_rowmap(int n) {
    if (MAP == 0) return n;
    const int ac = n >> 1, bj = n & 1; return (ac >> 7) * 256 + bj * 128 + (ac & 127);
}
template <int MAP>
__device__ __forceinline__ void transpose_item(const float* W, int K, int Nsrc, int nblk, bf16_t* WT, LAS float* scr, int item, int lane) {
    const int kb = item / nblk, nb = item % nblk, k0 = 64 * kb, n0 = 32 * nb;
    const int nc = n0 + (lane & 31);
    float tv[32];
    if (nc < Nsrc) {
#pragma unroll
        for (int i = 0; i < 32; ++i) tv[i] = __builtin_nontemporal_load(W + (size_t)(k0 + 2 * i + (lane >> 5)) * Nsrc + nc);
    } else {
#pragma unroll
        for (int i = 0; i < 32; ++i) tv[i] = 0.f;
    }
#pragma unroll
    for (int i = 0; i < 32; ++i) scr[(2 * i + (lane >> 5)) * 33 + (lane & 31)] = tv[i];
    WAVE_SYNC(); FENCE();
    const int c = lane & 7;
#pragma unroll
    for (int j = 0; j < 4; ++j) { const int n = (lane >> 3) + 8 * j; const LAS float* s = scr + (8 * c) * 33 + n;
        u32x4 o; o.x = pk2(s[0 * 33], s[1 * 33]); o.y = pk2(s[2 * 33], s[3 * 33]); o.z = pk2(s[4 * 33], s[5 * 33]); o.w = pk2(s[6 * 33], s[7 * 33]);
        *(u32x4*)(WT + (size_t)t_rowmap<MAP>(n0 + n) * K + k0 + 8 * c) = o; }
    WAVE_SYNC(); FENCE();
}
template <int MAP>
__device__ __forceinline__ void transpose_item_f8(const float* W, int K, int Nsrc, int nblk, unsigned char* WT, LAS float* scr, int item, int lane, float scale) {
    const int kb = item / nblk, nb = item % nblk, k0 = 64 * kb, n0 = 32 * nb;
    const int nc = n0 + (lane & 31);
    (void)nc;
    f32x4 tv[8];
#pragma unroll
    for (int i = 0; i < 8; ++i) tv[i] = __builtin_nontemporal_load((const f32x4*)(W + (size_t)(k0 + 8 * i + (lane >> 3)) * Nsrc + n0 + 4 * (lane & 7)));
#pragma unroll
    for (int i = 0; i < 8; ++i) { LAS float* d = scr + (8 * i + (lane >> 3)) * 33 + 4 * (lane & 7);
        d[0] = tv[i][0] * scale; d[1] = tv[i][1] * scale; d[2] = tv[i][2] * scale; d[3] = tv[i][3] * scale; }
    WAVE_SYNC(); FENCE();
    const int c = lane & 7;
#pragma unroll
    for (int j = 0; j < 4; ++j) { const int n = (lane >> 3) + 8 * j; const LAS float* sp = scr + (8 * c) * 33 + n;
        u32x2 o; o.x = pk4_fp8(sp[0 * 33], sp[1 * 33], sp[2 * 33], sp[3 * 33]); o.y = pk4_fp8(sp[4 * 33], sp[5 * 33], sp[6 * 33], sp[7 * 33]);
        *(u32x2*)(WT + (size_t)t_rowmap<MAP>(n0 + n) * K + k0 + 8 * c) = o; }
    WAVE_SYNC(); FENCE();
}
constexpr int P0_I_IN = (DM / 64) * (ZP / 32), P0_I_OUT = (DM / 64) * (DM / 32), P0_I_W1 = (2048 / 64) * (256 / 32), P0_I_W2 = (256 / 64) * (64 / 32);
constexpr int P0_I_GU1 = (DM / 64) * (2048 / 32), P0_I_DN1 = (DFF / 64) * (DM / 32);
constexpr int P0_NITEMS = P0_I_IN + P0_I_OUT + 2 * P0_I_W1 + 2 * P0_I_W2 + NE * P0_I_GU1 + NE * P0_I_DN1;
constexpr int P2_FILL_PER_CU = 44;
__device__ __forceinline__ int p2_fill_items(const Frame& F) { return (F.G == 256 && (T / 256) * (ZP / 256) == 640) ? 128 * P2_FILL_PER_CU : 0; }
#ifndef P7_FILL_ITEMS
#define P7_FILL_ITEMS 4096
#endif
__device__ __forceinline__ int p7_fill_items(const Frame& F) { return (F.G >= 8) ? P7_FILL_ITEMS : 0; }
__device__ __forceinline__ void p0_item(Frame& F, LAS float* scr, int it) {
    int r = it;
    if (r < P0_I_IN) { transpose_item<0>(F.in[I_WIN], DM, INC, ZP / 32, (bf16_t*)(F.ws + WS_WINT), scr, r, F.lane); return; } r -= P0_I_IN;
    if (r < P0_I_OUT) { transpose_item<0>(F.in[I_WOUT], DM, DM, DM / 32, (bf16_t*)(F.ws + WS_WOUTT), scr, r, F.lane); return; } r -= P0_I_OUT;
    if (r < P0_I_W1) { transpose_item<0>(F.in[I_W1K], 2048, 256, 8, (bf16_t*)(F.ws + WS_W1KT), scr, r, F.lane); return; } r -= P0_I_W1;
    if (r < P0_I_W1) { transpose_item<0>(F.in[I_W1V], 2048, 256, 8, (bf16_t*)(F.ws + WS_W1VT), scr, r, F.lane); return; } r -= P0_I_W1;
    if (r < P0_I_W2) { transpose_item<0>(F.in[I_W2K], 256, 64, 2, (bf16_t*)(F.ws + WS_W2KT), scr, r, F.lane); return; } r -= P0_I_W2;
    if (r < P0_I_W2) { transpose_item<0>(F.in[I_W2V], 256, 64, 2, (bf16_t*)(F.ws + WS_W2VT), scr, r, F.lane); return; } r -= P0_I_W2;
    if (r < NE * P0_I_GU1) { const int e = r / P0_I_GU1; transpose_item_f8<1>(F.in[I_WGU] + (size_t)e * DM * 2048, DM, 2048, 64, (unsigned char*)(F.ws + WS_WGUT) + (size_t)e * 2048 * DM, scr, r % P0_I_GU1, F.lane, F8_W_SCALE); return; } r -= NE * P0_I_GU1;
    { const int e = r / P0_I_DN1; transpose_item_f8<0>(F.in[I_WDN] + (size_t)e * DFF * DM, DFF, DM, 32, (unsigned char*)(F.ws + WS_WDNT) + (size_t)e * DM * DFF, scr, r % P0_I_DN1, F.lane, F8_W_SCALE); }
}
__device__ __forceinline__ void p0_prologue(Frame& F) {
    for (int it = F.vcu; it < 96 + 8; it += F.G) {
        if (it < 96) gemv_item<BATCH>(F, F.in[I_C], DM, F.in[I_WADA], DM, 6 * DM, 64 * it, F.in[I_BADA], (float*)(F.ws + WS_MOD), 6 * DM);
        else { const int j = it - 96, kv = j >> 2, n0 = (j & 3) * 64;
            gemv_item<1>(F, F.in[kv ? I_PEV : I_PEK], 0, F.in[kv ? I_W1V : I_W1K], 2048, 256, n0, nullptr, (float*)(F.ws + WS_BPE) + kv * 256, 0); }
    }
    { const float* src = F.in[I_GMWS]; bf16_t* dst = (bf16_t*)(F.ws + WS_WSBF);
      for (int idx = F.vcu * NTHREADS + F.tid; idx < GMG * GMC * GMC; idx += F.G * NTHREADS) { const int i = (idx >> 7) & 127, j = idx & 127; dst[idx] = (bf16_t)f2bf(j <= i ? src[idx] : 0.f); } }
    LAS float* scr = (LAS float*)(F.lds + 8192 + F.wave * 16384);
    const int gw = F.vcu * NWAVES + F.wave, NGW = F.G * NWAVES;
    const int nit = P0_NITEMS - p2_fill_items(F) - p7_fill_items(F);
    constexpr int NGEMV = 96 + 8;
    const int shift = (F.G > 2 * NGEMV) ? 2 * NGEMV * NWAVES : 0, n1 = nit - shift;
    for (int it = gw; it < n1; it += NGW) p0_item(F, scr, it);
    if (shift && F.vcu >= NGEMV) for (int it = n1 + (F.vcu - NGEMV) * NWAVES + F.wave; it < nit; it += (F.G - NGEMV) * NWAVES) p0_item(F, scr, it);
}

__device__ __forceinline__ void norm_rows(Frame& F, const float* xin, const float* g, int mod_shift, int mod_scale, bf16_t* outb) {
    const int gw = F.vcu * NWAVES + F.wave, NGW = F.G * NWAVES;
    const float* mod = (const float*)(F.ws + WS_MOD);
    for (int m0 = gw; m0 < T / 2; m0 += NGW) {
        f32x4 v[2][4]; float s[2] = {0.f, 0.f};
#pragma unroll
        for (int q = 0; q < 2; ++q) { const f32x4* xr = (const f32x4*)(xin + (size_t)(m0 + q * (T / 2)) * DM) + F.lane;
#pragma unroll
            for (int j = 0; j < 4; ++j) v[q][j] = __builtin_nontemporal_load(xr + 64 * j); }
#pragma unroll
        for (int q = 0; q < 2; ++q)
#pragma unroll
            for (int j = 0; j < 4; ++j) s[q] += (v[q][j][0] * v[q][j][0] + v[q][j][1] * v[q][j][1]) + (v[q][j][2] * v[q][j][2] + v[q][j][3] * v[q][j][3]);
#pragma unroll
        for (int o = 1; o < 64; o <<= 1) { s[0] += __shfl_xor(s[0], o); s[1] += __shfl_xor(s[1], o); }
#pragma unroll
        for (int q = 0; q < 2; ++q) { const int m = m0 + q * (T / 2), b = m / SEQ;
            const float rinv = __builtin_amdgcn_rsqf(s[q] * (1.0f / DM) + EPS);
            u32x2* o8 = (u32x2*)(outb + (size_t)m * DM) + F.lane;
#pragma unroll
            for (int j = 0; j < 4; ++j) { const int c = 4 * F.lane + 256 * j;
                const f32x4 gg = *(const f32x4*)(g + c), sc = *(const f32x4*)(mod + (size_t)b * 6144 + mod_scale * 1024 + c), sh = *(const f32x4*)(mod + (size_t)b * 6144 + mod_shift * 1024 + c);
                const f32x4 h = v[q][j] * rinv * gg * (sc + 1.0f) + sh;
                u32x2 w; w.x = pk2(h[0], h[1]); w.y = pk2(h[2], h[3]); o8[64 * j] = w; } }
    }
}

struct GmRegs { u32x4 v[2], u[2]; };
__device__ __forceinline__ void gmlp_load(Frame& F, int tile, GmRegs& R) {
    const int g = tile % GMG, ch = (tile / GMG) % (SEQ / GMC), b = tile / (GMG * (SEQ / GMC));
    const size_t row0 = (size_t)b * SEQ + (size_t)ch * GMC;
    const bf16_t* ZB = (const bf16_t*)(F.ws + WS_ZB);
#pragma unroll
    for (int it = 0; it < 2; ++it) { const int idx = F.tid + it * NTHREADS, row = idx >> 3, c8 = idx & 7;
        R.v[it] = *(const u32x4*)(ZB + (row0 + row) * ZP + ZC_V + g * 64 + c8 * 8);
        R.u[it] = *(const u32x4*)(ZB + (row0 + row) * ZP + ZC_U + g * 64 + c8 * 8); }
}
__device__ __forceinline__ void gmlp_compute(Frame& F, int tile, const GmRegs& R) {
    const int g = tile % GMG, ch = (tile / GMG) % (SEQ / GMC), b = tile / (GMG * (SEQ / GMC));
    const size_t row0 = (size_t)b * SEQ + (size_t)ch * GMC;
    LAS bf16_t* Vt = (LAS bf16_t*)F.lds;
    constexpr int VP = 136, UP = 68;
    LAS float* Us = (LAS float*)(F.lds + 64 * VP * 2);
    const float* gn = F.in[I_GMNG] + g * 64;
    const int fr = F.lane & 15, fq = F.lane >> 4, w = F.wave;
    const bf16_t* Wg = (const bf16_t*)(F.ws + WS_WSBF) + (size_t)g * GMC * GMC;
    bf16x8 af[4];
#pragma unroll
    for (int ks = 0; ks < 4; ++ks) af[ks] = *(const bf16x8*)(Wg + (size_t)(16 * w + fr) * GMC + 32 * ks + 8 * fq);
#pragma unroll
    for (int it = 0; it < 2; ++it) {
        const int idx = F.tid + it * NTHREADS, row = idx >> 3, c8 = idx & 7;
        const u32x4 raw = R.v[it];
        float v[8]; v[0] = bflo(raw.x); v[1] = bfhi(raw.x); v[2] = bflo(raw.y); v[3] = bfhi(raw.y); v[4] = bflo(raw.z); v[5] = bfhi(raw.z); v[6] = bflo(raw.w); v[7] = bfhi(raw.w);
        float ss = 0.f;
#pragma unroll
        for (int e = 0; e < 8; ++e) { v[e] = gelu_tanh(v[e]); ss += v[e] * v[e]; }
        ss += __shfl_xor(ss, 1); ss += __shfl_xor(ss, 2); ss += __shfl_xor(ss, 4);
        const float rinv = __builtin_amdgcn_rsqf(ss * (1.0f / 64.0f) + EPS);
#pragma unroll
        for (int e = 0; e < 8; ++e) Vt[(c8 * 8 + e) * VP + row] = (bf16_t)f2bf(v[e] * rinv * gn[c8 * 8 + e]);
        const u32x4 ur = R.u[it];
        f32x4 u0 = {gelu_tanh(bflo(ur.x)), gelu_tanh(bfhi(ur.x)), gelu_tanh(bflo(ur.y)), gelu_tanh(bfhi(ur.y))}, u1 = {gelu_tanh(bflo(ur.z)), gelu_tanh(bfhi(ur.z)), gelu_tanh(bflo(ur.w)), gelu_tanh(bfhi(ur.w))};
        *(LAS f32x4*)(Us + row * UP + c8 * 8) = u0; *(LAS f32x4*)(Us + row * UP + c8 * 8 + 4) = u1;
    }
    __syncthreads();
    f32x4 acc[4];
#pragma unroll
    for (int n = 0; n < 4; ++n) acc[n] = (f32x4){0.f, 0.f, 0.f, 0.f};
#pragma unroll
    for (int ks = 0; ks < 4; ++ks) {
        if (32 * ks <= 16 * w + 15) {
#pragma unroll
            for (int n = 0; n < 4; ++n) { const bf16x8 bb = *(const LAS bf16x8*)(Vt + (16 * n + fr) * VP + 32 * ks + 8 * fq);
                acc[n] = __builtin_amdgcn_mfma_f32_16x16x32_bf16(af[ks], bb, acc[n], 0, 0, 0); }
        }
    }
    bf16_t* Y = (bf16_t*)(F.ws + WS_YMIX);
    const float* bs = F.in[I_GMBS] + g * GMC;
#pragma unroll
    for (int n = 0; n < 4; ++n)
#pragma unroll
        for (int r = 0; r < 4; ++r) { const int i = 16 * w + 4 * fq + r, d = 16 * n + fr;
            Y[(row0 + i) * DM + g * 64 + d] = (bf16_t)f2bf(Us[i * UP + d] * (acc[n][r] + bs[i])); }
    __syncthreads();
}
__device__ __forceinline__ void gmlp_run(Frame& F, int base, int stride, int n) {
    if (n <= 0) return;
    GmRegs A, B;
    gmlp_load(F, base, A);
    for (int k = 0; k < n; k += 2) {
        if (k + 1 < n) gmlp_load(F, base + (k + 1) * stride, B);
        gmlp_compute(F, base + k * stride, A);
        if (k + 1 < n) { if (k + 2 < n) gmlp_load(F, base + (k + 2) * stride, A); gmlp_compute(F, base + (k + 1) * stride, B); }
    }
}

__device__ __forceinline__ void cmp_tile(Frame& F, int tile) {
    constexpr int NT = NCP / 32;
    const int nt = tile % NT, g = (tile / NT) % NG, b = (tile / (NT * NG)) % BATCH, kv = tile / (NT * NG * BATCH);
    const int n0 = 32 * nt, p0 = 16 * n0;
    const bf16_t* ZB = (const bf16_t*)(F.ws + WS_ZB);
    constexpr int RP = 72;
    LAS bf16_t* Rs = (LAS bf16_t*)F.lds;
    LAS bf16_t* Hs = (LAS bf16_t*)(F.lds + 528 * RP * 2);
    constexpr int HP = 264;
    const int zc = (kv ? ZC_VC : ZC_KC) + g * 64;
    {
        u32x4 sv[9];
#pragma unroll
        for (int it = 0; it < 9; ++it) { const int idx = F.tid + it * NTHREADS, row = idx >> 3, c8 = idx & 7; const int p = p0 + row;
            sv[it] = (u32x4){0u, 0u, 0u, 0u};
            if (idx < 528 * 8 && p < SEQ) sv[it] = *(const u32x4*)(ZB + ((size_t)b * SEQ + p) * ZP + zc + c8 * 8); }
#pragma unroll
        for (int it = 0; it < 9; ++it) { const int idx = F.tid + it * NTHREADS, row = idx >> 3, c8 = idx & 7;
            if (idx < 528 * 8) *(LAS u32x4*)(Rs + row * RP + c8 * 8) = sv[it]; }
    }
    __syncthreads();
    const int i = F.lane & 31, hi = F.lane >> 5, w = F.wave;
    const bf16_t* W1T = (const bf16_t*)(F.ws + (kv ? WS_W1VT : WS_W1KT)) + (size_t)(32 * w + i) * 2048;
    f32x16 acc;
#pragma unroll
    for (int r = 0; r < 16; ++r) acc[r] = 0.f;
    bf16x8 bq[16];
#pragma unroll
    for (int j = 0; j < 16; ++j) bq[j] = *(const bf16x8*)(W1T + 16 * j + 8 * hi);
    for (int kb = 0; kb < 8; ++kb) {
        bf16x8 bn[16];
        const int kn = (kb < 7) ? (kb + 1) * 16 : kb * 16;
#pragma unroll
        for (int j = 0; j < 16; ++j) bn[j] = *(const bf16x8*)(W1T + 16 * (kn + j) + 8 * hi);
#pragma unroll
        for (int j = 0; j < 16; ++j) { const int kk = kb * 16 + j; const int l = kk >> 2, d = (16 * j + 8 * hi) & 63;
            const bf16x8 a = *(const LAS bf16x8*)(Rs + (16 * i + l) * RP + d);
            acc = __builtin_amdgcn_mfma_f32_32x32x16_bf16(a, bq[j], acc, 0, 0, 0); }
#pragma unroll
        for (int j = 0; j < 16; ++j) bq[j] = bn[j];
    }
    const float bpe = ((const float*)(F.ws + WS_BPE))[kv * 256 + 32 * w + i];
#pragma unroll
    for (int r = 0; r < 16; ++r) Hs[crow(r, hi) * HP + 32 * w + i] = (bf16_t)f2bf(gelu_tanh(acc[r] + bpe));
    __syncthreads();
    if (w < 2) {
        const bf16_t* W2T = (const bf16_t*)(F.ws + (kv ? WS_W2VT : WS_W2KT)) + (size_t)(32 * w + i) * 256;
        f32x16 o;
#pragma unroll
        for (int r = 0; r < 16; ++r) o[r] = 0.f;
        for (int kk = 0; kk < 16; ++kk) {
            const bf16x8 a = *(const LAS bf16x8*)(Hs + i * HP + 16 * kk + 8 * hi);
            const bf16x8 bb = *(const bf16x8*)(W2T + 16 * kk + 8 * hi);
            o = __builtin_amdgcn_mfma_f32_32x32x16_bf16(a, bb, o, 0, 0, 0);
        }
        bf16_t* KC = (bf16_t*)(F.ws + (kv ? WS_VC : WS_KC)) + ((size_t)(b * NG + g) * NCP) * 64;
#pragma unroll
        for (int r = 0; r < 16; ++r) { const int n = n0 + crow(r, hi); KC[(size_t)n * 64 + 32 * w + i] = (n < NCMP) ? (bf16_t)f2bf(o[r]) : (bf16_t)0; }
    }
    __syncthreads();
}

constexpr int KPB = 128;
constexpr int NB_K = 64 * KPB;
constexpr int V_H1 = 4096;
constexpr int NB_BUF = NB_K + 8192;
constexpr int A_IMP = 3 * NB_BUF, A_SEL = A_IMP + 64 * 128 * 4, A_UNI = A_SEL + 64 * 8 * 2, A_WSF = A_UNI + 256, A_QF = A_WSF + 8 * 32 * 4, A_Y = A_QF + 8 * 4096, A_GATE = A_Y + 8 * 4096, A_END = A_GATE + 8 * 32 * 3 * 4;
static_assert(A_END <= MISC_OFF, "NSA LDS map");
#ifndef NSA_THR_VAL
#define NSA_THR_VAL 20.0f
#endif
constexpr float NSA_THR = NSA_THR_VAL, NEG_BIG = -1e30f;

#ifdef EMU
__device__ __forceinline__ int opaque_lane(int l) { return l; }
#else
__device__ __forceinline__ int opaque_lane(int) { int x; asm volatile("v_mbcnt_lo_u32_b32 %0, -1, 0\n\tv_mbcnt_hi_u32_b32 %0, -1, %0" : "=v"(x)); return x; }
#endif
#ifdef EMU
__device__ __forceinline__ int red8_add(int v) { v += __shfl_xor(v, 1); v += __shfl_xor(v, 2); v += __shfl_xor(v, 4); return v; }
__device__ __forceinline__ float quad_sum(float v) { v += __shfl_xor(v, 1); v += __shfl_xor(v, 2); return v; }
__device__ __forceinline__ float xor32f(float v) { return __shfl_xor(v, 32); }
#else
__device__ __forceinline__ int red8_add(int v) {
    v += __builtin_amdgcn_update_dpp(0, v, 0xB1, 0xF, 0xF, true);
    v += __builtin_amdgcn_update_dpp(0, v, 0x4E, 0xF, 0xF, true);
    v += __builtin_amdgcn_update_dpp(0, v, 0x141, 0xF, 0xF, true);
    return v;
}
__device__ __forceinline__ float quad_sum(float v) {
    v += __builtin_bit_cast(float, __builtin_amdgcn_update_dpp(0, __builtin_bit_cast(int, v), 0xB1, 0xF, 0xF, true));
    v += __builtin_bit_cast(float, __builtin_amdgcn_update_dpp(0, __builtin_bit_cast(int, v), 0x4E, 0xF, 0xF, true));
    return v;
}
__device__ __forceinline__ float xor32f(float v) {
    const unsigned u = __builtin_bit_cast(unsigned, v); auto rr = __builtin_amdgcn_permlane32_swap(u, u, false, false);
    return __builtin_bit_cast(float, (threadIdx.x & 32) ? rr[0] : rr[1]);
}
#endif

template <bool WITHV>
__device__ __forceinline__ void stage_dma(LAS unsigned char* buf, const bf16_t* Kg, const bf16_t* Vg, size_t pitch, long rbase, int wave, int lane) {
    const int krow = 8 * wave + (lane >> 3), kc = (lane & 7) ^ ((lane >> 3) & 7);
    __builtin_amdgcn_global_load_lds((const unsigned*)(Kg + (size_t)(rbase + krow) * pitch + kc * 8), (LAS unsigned*)(buf + wave * 1024), 16, 0, 0);
    if (WITHV) { const int vrow = 16 * (wave & 3) + (lane >> 2), vc = (wave >> 2) * 4 + (lane & 3);
        __builtin_amdgcn_global_load_lds((const unsigned*)(Vg + (size_t)(rbase + vrow) * pitch + vc * 8), (LAS unsigned*)(buf + NB_K + wave * 1024), 16, 0, 0); }
}
struct BrState { float mref, l; int has; unsigned qxm; f32x16 o0, o1; };
__device__ __forceinline__ unsigned ref_words(float m, float& meff) { const unsigned mh = f2bf(m); const float fh = bf2f((unsigned short)mh); const unsigned ml = f2bf(m - fh); meff = fh + bf2f((unsigned short)ml); return mh | (ml << 16); }

#ifdef EMU
#define VTR(p) __builtin_amdgcn_ds_read_tr16_b64_v4i16(p)
#else
typedef short v4i16_t __attribute__((ext_vector_type(4)));
#define VTR(p) __builtin_bit_cast(s16x4, __builtin_amdgcn_ds_read_tr16_b64_v4i16((LAS v4i16_t*)(p)))
#endif

__device__ __forceinline__ void nsa_qk(const LAS unsigned char* buf, const LAS unsigned char* qfl, unsigned qxs, unsigned qxm_t, unsigned klw0, unsigned klw1, unsigned tbw, unsigned neg1w,
                                       f32x16& p0, f32x16& p1, int lane) {
    const int i = lane & 31, hi = lane >> 5;
    const bf16x8 qx = __builtin_bit_cast(bf16x8, ((u32x4){qxs, qxs, qxm_t, 0u}));
    const bf16x8 kx0 = __builtin_bit_cast(bf16x8, ((u32x4){klw0, tbw, neg1w, 0u})), kx1 = __builtin_bit_cast(bf16x8, ((u32x4){klw1, tbw, neg1w, 0u}));
    const LAS unsigned char* kp = buf + i * KPB;
    {
        const f32x16 zero16 = {0.f, 0.f, 0.f, 0.f, 0.f, 0.f, 0.f, 0.f, 0.f, 0.f, 0.f, 0.f, 0.f, 0.f, 0.f, 0.f};
        p0 = __builtin_amdgcn_mfma_f32_32x32x16_bf16(kx0, qx, zero16, 0, 0, 0);
        p1 = __builtin_amdgcn_mfma_f32_32x32x16_bf16(kx1, qx, zero16, 0, 0, 0);
    }
#pragma unroll
    for (int d0 = 0; d0 < 4; ++d0) {
        const int ko = ((2 * d0 + hi) ^ (i & 7)) << 4;
        const bf16x8 k0 = *(const LAS bf16x8*)(kp + ko), k1 = *(const LAS bf16x8*)(kp + 32 * KPB + ko);
        const bf16x8 qd = *(const LAS bf16x8*)(qfl + d0 * 1024);
        p0 = __builtin_amdgcn_mfma_f32_32x32x16_bf16(k0, qd, p0, 0, 0, 0);
        p1 = __builtin_amdgcn_mfma_f32_32x32x16_bf16(k1, qd, p1, 0, 0, 0);
    }
}
template <bool PV, bool TRACK>
__device__ __forceinline__ void nsa_prep(int mode, int lim, BrState& st, f32x16& p0, f32x16& p1, int lane, LAS float* wsf) {
#ifndef EMU
    asm volatile("" : "+v"(lim));
#endif
    const int i = lane & 31, hi = lane >> 5;
    if (__builtin_amdgcn_readfirstlane(mode) != 0) {
        NOSPEC();
        const int lim2 = lim - 4 * hi; const bool inv = (mode == 2);
#pragma unroll
        for (int r = 0; r < 16; ++r) { const int c0 = (r & 3) + 8 * (r >> 2);
            const bool v0 = (c0 <= lim2) != inv, v1 = (c0 + 32 <= lim2) != inv;
            p0[r] = v0 ? p0[r] : -INFINITY; p1[r] = v1 ? p1[r] : -INFINITY; }
    }
    if (TRACK) {
        float mxa = fmaxf(p0[0], p1[0]), mxb = fmaxf(p0[1], p1[1]);
#pragma unroll
        for (int r = 2; r < 16; r += 2) { mxa = fmaxf(fmaxf(mxa, p0[r]), p1[r]); mxb = fmaxf(fmaxf(mxb, p0[r + 1]), p1[r + 1]); }
        float mx = fmaxf(mxa, mxb);
        mx = fmaxf(mx, xor32f(mx));
        const bool upd = (mx > (st.has ? NSA_THR : NEG_BIG)) && (mx > NEG_BIG);
        if (__any(upd)) {
            NOSPEC();
            float meff; const unsigned w = ref_words(st.mref + mx, meff);
            const float de = upd ? (meff - st.mref) : 0.f;
            const float f = (upd && st.has) ? fexp2(-de) : 1.0f;
#pragma unroll
            for (int r = 0; r < 16; ++r) { p0[r] -= de; p1[r] -= de; }
            st.l *= f;
            if (PV) {
                wsf[i] = f; WAVE_SYNC(); FENCE();
                const LAS float* wr_ = wsf + 4 * hi;
#pragma unroll
                for (int r = 0; r < 16; ++r) { const float a = wr_[(r & 3) + 8 * (r >> 2)]; st.o0[r] *= a; st.o1[r] *= a; }
                WAVE_SYNC(); FENCE();
            }
            if (upd) { st.mref = meff; st.qxm = hi ? 0u : w; st.has = 1; }
        }
    }
}
template <bool PV>
__device__ __forceinline__ void nsa_softmax_pv(const LAS unsigned char* buf, BrState& st, f32x16& p0, f32x16& p1, int lane) {
    const int hi = lane >> 5;
    float rs = 0.f;
#pragma unroll
    for (int r = 0; r < 16; ++r) { p0[r] = fexp2(p0[r]); p1[r] = fexp2(p1[r]); rs += p0[r] + p1[r]; }
    st.l += rs;
    if (PV) {
        const LAS unsigned char* vb = buf + NB_K + (4 * hi + ((lane & 15) >> 2)) * 64 + 32 * ((lane >> 4) & 1) + 8 * (lane & 3);
#pragma unroll
        for (int ks = 0; ks < 4; ++ks) {
            const f32x16& p = (ks < 2) ? p0 : p1; const int s = ks & 1;
            u32x4 pw; pw.x = pk2(p[8 * s + 0], p[8 * s + 1]); pw.y = pk2(p[8 * s + 2], p[8 * s + 3]); pw.z = pk2(p[8 * s + 4], p[8 * s + 5]); pw.w = pk2(p[8 * s + 6], p[8 * s + 7]);
            const bf16x8 pa = __builtin_bit_cast(bf16x8, pw);
#pragma unroll
            for (int d0 = 0; d0 < 2; ++d0) {
                const s16x4 lo = VTR(vb + d0 * V_H1 + ks * 1024), hh = VTR(vb + d0 * V_H1 + ks * 1024 + 512);
                const bf16x8 vf = (bf16x8){lo[0], lo[1], lo[2], lo[3], hh[0], hh[1], hh[2], hh[3]};
                if (d0 == 0) st.o0 = __builtin_amdgcn_mfma_f32_32x32x16_bf16(pa, vf, st.o0, 0, 0, 0);
                else         st.o1 = __builtin_amdgcn_mfma_f32_32x32x16_bf16(pa, vf, st.o1, 0, 0, 0);
            }
        }
    }
}

struct ImpSums { float G0[4], S0[4], G1[4], S1[4]; };
template <bool PRODUCE, bool IMP>
__device__ __forceinline__ void nsa_exp_qk(const LAS unsigned char* nbuf, const LAS unsigned char* qfl, unsigned qxs, unsigned qxm_t, unsigned klw0, unsigned klw1, unsigned tbw, unsigned neg1w,
                                           f32x16& n0, f32x16& n1, BrState& st, f32x16& p0, f32x16& p1, u32x4 (&pw)[4], ImpSums& im, int lane) {
    const int i = lane & 31, hi = lane >> 5;
    const LAS unsigned char* kp = nbuf + i * KPB;
    if (PRODUCE) {
        const bf16x8 qx = __builtin_bit_cast(bf16x8, ((u32x4){qxs, qxs, qxm_t, 0u}));
        const bf16x8 kx0 = __builtin_bit_cast(bf16x8, ((u32x4){klw0, tbw, neg1w, 0u})), kx1 = __builtin_bit_cast(bf16x8, ((u32x4){klw1, tbw, neg1w, 0u}));
        const f32x16 zero16 = {0.f, 0.f, 0.f, 0.f, 0.f, 0.f, 0.f, 0.f, 0.f, 0.f, 0.f, 0.f, 0.f, 0.f, 0.f, 0.f};
        n0 = __builtin_amdgcn_mfma_f32_32x32x16_bf16(kx0, qx, zero16, 0, 0, 0);
        n1 = __builtin_amdgcn_mfma_f32_32x32x16_bf16(kx1, qx, zero16, 0, 0, 0);
    }
    float rs = 0.f;
#pragma unroll
    for (int d0 = 0; d0 < 4; ++d0) {
        if (PRODUCE) {
            const int ko = ((2 * d0 + hi) ^ (i & 7)) << 4;
            const bf16x8 k0 = *(const LAS bf16x8*)(kp + ko), k1 = *(const LAS bf16x8*)(kp + 32 * KPB + ko);
            const bf16x8 qd = *(const LAS bf16x8*)(qfl + d0 * 1024);
            n0 = __builtin_amdgcn_mfma_f32_32x32x16_bf16(k0, qd, n0, 0, 0, 0);
            n1 = __builtin_amdgcn_mfma_f32_32x32x16_bf16(k1, qd, n1, 0, 0, 0);
        }
        const float a0 = fexp2(p0[4 * d0]), a1 = fexp2(p0[4 * d0 + 1]), a2 = fexp2(p0[4 * d0 + 2]), a3 = fexp2(p0[4 * d0 + 3]);
        const float b0 = fexp2(p1[4 * d0]), b1 = fexp2(p1[4 * d0 + 1]), b2 = fexp2(p1[4 * d0 + 2]), b3 = fexp2(p1[4 * d0 + 3]);
        const float ga = (a0 + a1) + (a2 + a3), gb = (b0 + b1) + (b2 + b3);
        rs += ga + gb;
        if (IMP) { im.G0[d0] = ga; im.S0[d0] = a3; im.G1[d0] = gb; im.S1[d0] = b3; }
        const unsigned w0 = pk2(a0, a1), w1 = pk2(a2, a3), v0 = pk2(b0, b1), v1 = pk2(b2, b3);
        if ((d0 & 1) == 0) { pw[d0 >> 1].x = w0; pw[d0 >> 1].y = w1; pw[2 + (d0 >> 1)].x = v0; pw[2 + (d0 >> 1)].y = v1; }
        else               { pw[d0 >> 1].z = w0; pw[d0 >> 1].w = w1; pw[2 + (d0 >> 1)].z = v0; pw[2 + (d0 >> 1)].w = v1; }
        __builtin_amdgcn_sched_barrier(0);
    }
    st.l += rs;
}
template <bool PV>
__device__ __forceinline__ void nsa_pv(const LAS unsigned char* buf, BrState& st, const u32x4 (&pw)[4], int lane) {
    if (!PV) return;
    const int hi = lane >> 5;
    const LAS unsigned char* vb = buf + NB_K + (4 * hi + ((lane & 15) >> 2)) * 64 + 32 * ((lane >> 4) & 1) + 8 * (lane & 3);
#pragma unroll
    for (int ks = 0; ks < 4; ++ks) {
        const bf16x8 pa = __builtin_bit_cast(bf16x8, pw[ks]);
#pragma unroll
        for (int d0 = 0; d0 < 2; ++d0) {
            const s16x4 lo = VTR(vb + d0 * V_H1 + ks * 1024), hh = VTR(vb + d0 * V_H1 + ks * 1024 + 512);
            const bf16x8 vf = (bf16x8){lo[0], lo[1], lo[2], lo[3], hh[0], hh[1], hh[2], hh[3]};
            if (d0 == 0) st.o0 = __builtin_amdgcn_mfma_f32_32x32x16_bf16(pa, vf, st.o0, 0, 0, 0);
            else         st.o1 = __builtin_amdgcn_mfma_f32_32x32x16_bf16(pa, vf, st.o1, 0, 0, 0);
        }
        __builtin_amdgcn_sched_barrier(0);
    }
}

__device__ __forceinline__ int bit128(const LAS unsigned* m, int j) { return (int)((m[j >> 5] >> (j & 31)) & 1u); }
__device__ __forceinline__ int next_below(const LAS unsigned* m, int j) { for (int k = j - 1; k >= 0; --k) if ((m[k >> 5] >> (k & 31)) & 1u) return k; return -1; }

struct NsaCtx {
    int qt, g, t, tloc, qloc, head, w, lane; const bf16_t* Zb;
    LAS unsigned char* lds; LAS float* imp; LAS float* wsf;
};
__device__ __forceinline__ void nsa_importance(const NsaCtx& C, const ImpSums& im, int cur) {
    const int i = C.lane & 31, hi = C.lane >> 5;
    float G0[4], G1[4], S0[4], S1[4];
#pragma unroll
    for (int k = 0; k < 4; ++k) { G0[k] = quad_sum(im.G0[k]); G1[k] = quad_sum(im.G1[k]); S0[k] = quad_sum(im.S0[k]); S1[k] = quad_sum(im.S1[k]); }
    float P0[4], P1[4];
#pragma unroll
    for (int k = 0; k < 4; ++k) { P0[k] = xor32f(S0[k]); P1[k] = xor32f(S1[k]); }
    if ((i & 3) == 0) {
        LAS float* row = C.imp + C.qloc * 128 + 16 * cur + hi;
#pragma unroll
        for (int k = 0; k < 4; ++k) {
            const float prev0 = hi ? P0[k] : (k == 0 ? 0.f : P0[k - 1]);
            const float prev1 = hi ? P1[k] : (k == 0 ? P0[3] : P1[k - 1]);
            row[2 * k] = G0[k] + prev0;
            row[8 + 2 * k] = G1[k] + prev1;
        }
        if (hi == 1 && 16 * (cur + 1) < 128) row[15] += S1[3];
    }
}
template <int KIND, int PRE>
__device__ __forceinline__ void nsa_branch(Frame& F, const NsaCtx& C, const LAS unsigned char* qf, const bf16_t* Kg, const bf16_t* Vg, size_t pitch,
                                           int first, int lo, const LAS unsigned* um, const LAS unsigned* wm, const LAS unsigned* qm, int cfull, int climit, BrState& st) {
    constexpr bool PV = (KIND != 1), TRACK = (KIND != 2), CMP = (KIND == 1 || KIND == 2);
    const int lane = C.lane, w = C.w, qt = C.qt;
    const int ln_ = opaque_lane(lane), hi_ = ln_ >> 5, i_ = ln_ & 31;
    unsigned qxs; { const float s2_ = fexp2(-(float)(4 * C.g + (i_ & 3) + 1)) * LOG2E; const unsigned sh_ = f2bf(s2_); const unsigned sl_ = f2bf(s2_ - bf2f((unsigned short)sh_)); qxs = hi_ ? 0u : (sh_ | (sl_ << 16)); }
    const unsigned neg1w = hi_ ? 0u : 0xBF80BF80u; const unsigned maskw = hi_ ? 0u : 0x00007E96u;
    const unsigned klw0 = hi_ ? 0u : (f2bf((float)(CMP ? 16 * i_ : i_)) * 0x10001u), klw1 = hi_ ? 0u : (f2bf((float)(CMP ? 16 * (i_ + 32) : (i_ + 32))) * 0x10001u);
#define SEQ_NEXT(c) ((c) < 0 ? -1 : (KIND == 3 ? next_below(um, (c)) : (((c) - 1 >= lo) ? (c) - 1 : -1)))
#define TILE_NEED(c) (KIND == 3 ? bit128(wm, (c)) : 1)
#define TILE_MODE(c) (KIND == 0 ? (((c) == qt) ? 1 : (((c) == qt - 8) ? 2 : 0)) : (CMP ? ((64 * (c) + 63 <= cfull) ? 0 : 1) : (((c) == qt) ? 1 : 0)))
#define TILE_LIM(c) (CMP ? (climit - 64 * (c)) : C.tloc)
#define TILE_TBW(c) (hi_ ? 0u : (f2bf((float)((CMP ? 1024 : 64) * (c))) * 0x10001u))
#define TILE_QXM(c) ((KIND == 3) ? (bit128(qm, (c)) ? st.qxm : maskw) : st.qxm)
#define SLOT(s) (C.lds + (s) * NB_BUF)
    f32x16 pA0, pA1, pB0, pB1;
    int c0 = first, c1 = SEQ_NEXT(c0), c2 = SEQ_NEXT(c1), s0 = 0;
    if (PRE == 0) { __syncthreads();
        stage_dma<PV>(SLOT(0), Kg, Vg, pitch, 64L * c0, w, lane); }
    if (PRE < 2 && c1 >= 0) stage_dma<PV>(SLOT(1), Kg, Vg, pitch, 64L * c1, w, lane);
    __syncthreads();
    if (TILE_NEED(c0)) nsa_qk(SLOT(0), qf, qxs, TILE_QXM(c0), klw0, klw1, TILE_TBW(c0), neg1w, pA0, pA1, lane);
#define NSA_STEP(P0, P1, N0, N1) do { \
        const int s1_ = (s0 == 2) ? 0 : s0 + 1, s2_ = (s1_ == 2) ? 0 : s1_ + 1; \
        if (c2 >= 0) stage_dma<PV>(SLOT(s2_), Kg, Vg, pitch, 64L * c2, w, lane); \
        const bool need0_ = TILE_NEED(c0) != 0; const int cn_ = (c1 >= 0) ? c1 : c0;     \
        if (need0_) { \
            u32x4 pw_[4]; ImpSums im_; \
            nsa_prep<PV, TRACK>(TILE_MODE(c0), TILE_LIM(c0), st, P0, P1, lane, C.wsf); \
            __builtin_amdgcn_sched_barrier(0); \
            nsa_exp_qk<true, KIND == 2>(SLOT(s1_), qf, qxs, TILE_QXM(cn_), klw0, klw1, TILE_TBW(cn_), neg1w, N0, N1, st, P0, P1, pw_, im_, lane); \
            nsa_pv<PV>(SLOT(s0), st, pw_, lane); \
            if (KIND == 2) nsa_importance(C, im_, c0); \
        } else nsa_qk(SLOT(s1_), qf, qxs, TILE_QXM(cn_), klw0, klw1, TILE_TBW(cn_), neg1w, N0, N1, lane); \
        __syncthreads(); \
        c0 = c1; c1 = c2; c2 = SEQ_NEXT(c2); s0 = s1_; } while (0)
    for (;;) {
        NSA_STEP(pA0, pA1, pB0, pB1); if (c0 < 0) break;
        NSA_STEP(pB0, pB1, pA0, pA1); if (c0 < 0) break;
    }
#undef NSA_STEP
#undef SEQ_NEXT
#undef TILE_NEED
#undef TILE_MODE
#undef TILE_LIM
#undef TILE_TBW
#undef TILE_QXM
#undef SLOT
}
#if !defined(EMU)
#define SUBT_BEGIN() unsigned long long st_t0_ = 0; if (PROBE_K >= 20 && blockIdx.x == 0 && F.tid == 0) st_t0_ = __builtin_amdgcn_s_memrealtime()
#define SUBT_END(i) do { if (PROBE_K >= 20 && blockIdx.x == 0 && F.tid == 0) { const unsigned long long t1_ = __builtin_amdgcn_s_memrealtime(); F.MISC[300 + (i)] += (unsigned)(t1_ - st_t0_); st_t0_ = t1_; } } while (0)
#else
#define SUBT_BEGIN() ((void)0)
#define SUBT_END(i) ((void)0)
#endif
__device__ __forceinline__ void nsa_task(Frame& F, int task) {
    constexpr int NQT = SEQ / 64;
    const int qt = task % NQT, g = (task / NQT) % NG, b = task / (NQT * NG);
    const int t0 = 64 * qt, w = F.wave;
    const bf16_t* Zb = (const bf16_t*)(F.ws + WS_ZB) + (size_t)b * SEQ * ZP;
    LAS float* imp = (LAS float*)(F.lds + A_IMP);
    LAS unsigned short* selm = (LAS unsigned short*)(F.lds + A_SEL);
    LAS unsigned* uniw = (LAS unsigned*)(F.lds + A_UNI);
#define SECTION_LANE() const int lane = opaque_lane(F.lane), i = lane & 31, hi = lane >> 5, ql = i >> 2, qloc = 8 * w + ql, t = t0 + qloc, head = 4 * g + (i & 3); \
        LAS float* wsf = (LAS float*)(F.lds + A_WSF) + w * 32; LAS unsigned char* qf = F.lds + A_QF + w * 4096 + lane * 16; \
        NsaCtx C; C.qt = qt; C.g = g; C.t = t; C.tloc = qloc; C.qloc = qloc; C.head = head; C.w = w; C.lane = lane; C.Zb = Zb; C.lds = F.lds; C.imp = imp; C.wsf = wsf; \
        LAS unsigned* ya = (LAS unsigned*)(F.lds + A_Y) + w * 1024 + hi * 128 + i; (void)ya; (void)head; (void)t
    const LAS unsigned* zz = (const LAS unsigned*)(F.lds + A_UNI);
#define INIT_ST(st) do { st.mref = 0.f; st.l = 0.f; st.has = 0; st.qxm = 0u; _Pragma("unroll") for (int r = 0; r < 16; ++r) { st.o0[r] = 0.f; st.o1[r] = 0.f; } } while (0)
#define ACC_PREP(st, gidx) float f_ = st.l + xor32f(st.l); { const float gate_ = ((const LAS float*)(F.lds + A_GATE))[w * 96 + i * 3 + gidx]; f_ = (f_ > 0.f) ? gate_ * __builtin_amdgcn_rcpf(f_) : 0.f; }     \
        wsf[i] = f_; WAVE_SYNC(); FENCE(); const LAS float* wr_ = wsf + 4 * hi;
    const bf16_t* KCg = (const bf16_t*)(F.ws + WS_KC) + (size_t)(b * NG + g) * NCP * 64;
    const bf16_t* VCg = (const bf16_t*)(F.ws + WS_VC) + (size_t)(b * NG + g) * NCP * 64;
    const int nct = (t0 + 63 >= 31) ? (((t0 + 63 - 31) >> 4) / 64 + 1) : 0;
#define NSA_PRELOAD_CMP(WV) do { if (nct > 0) { stage_dma<WV>(F.lds, KCg, VCg, 64, 64L * (nct - 1), w, lane); if (nct > 1) stage_dma<WV>(F.lds + NB_BUF, KCg, VCg, 64, 64L * (nct - 2), w, lane); } } while (0)
    bool sel_pre = false;
    SUBT_BEGIN();
    {
        SECTION_LANE();
        __syncthreads();
        stage_dma<true>(F.lds, Zb + ZC_KW + g * 64, Zb + ZC_VW + g * 64, ZP, 64L * qt, w, lane);
        if (qt - 1 >= ((qt - 8 > 0) ? qt - 8 : 0)) stage_dma<true>(F.lds + NB_BUF, Zb + ZC_KW + g * 64, Zb + ZC_VW + g * 64, ZP, 64L * (qt - 1), w, lane);
        for (int idx = F.tid; idx < 64 * 128; idx += NTHREADS) imp[idx] = 0.f;
#pragma unroll
        for (int d0 = 0; d0 < 4; ++d0) { const u32x4 raw = *(const u32x4*)(Zb + (size_t)t * ZP + ZC_Q + head * 64 + 16 * d0 + 8 * hi);
            const float sc = 0.125f * LOG2E; u32x4 o;
            o.x = pk2(bflo(raw.x) * sc, bfhi(raw.x) * sc); o.y = pk2(bflo(raw.y) * sc, bfhi(raw.y) * sc); o.z = pk2(bflo(raw.z) * sc, bfhi(raw.z) * sc); o.w = pk2(bflo(raw.w) * sc, bfhi(raw.w) * sc);
            *(LAS u32x4*)(qf + d0 * 1024) = o; }
        if (hi == 0) {
#pragma unroll
            for (int k = 0; k < 3; ++k) ((LAS float*)(F.lds + A_GATE))[w * 96 + i * 3 + k] = sigmoidf_(bf2f(Zb[(size_t)t * ZP + ZC_GL + head * 3 + k]));
        }
    }
    {
        SECTION_LANE();
        BrState st; INIT_ST(st);
        nsa_branch<0, 2>(F, C, qf, Zb + ZC_KW + g * 64, Zb + ZC_VW + g * 64, ZP, qt, (qt - 8 > 0) ? qt - 8 : 0, zz, zz, zz, 0, 0, st);
        NSA_PRELOAD_CMP(false);
        ACC_PREP(st, 2)
#pragma unroll
        for (int r = 0; r < 16; ++r) { const int c_ = (r & 3) + 8 * (r >> 2); const float a_ = wr_[c_]; ya[c_ * 32] = pk2(a_ * st.o0[r], a_ * st.o1[r]); }
        WAVE_SYNC(); FENCE();
    }
    SUBT_END(1);
    {
        SECTION_LANE();
        const bf16_t* Kg = KCg; const bf16_t* Vg = VCg;
        const int cfull = (t0 >= 31) ? ((t0 - 31) >> 4) : -1;
        const int climit = (t >= 31) ? ((t - 31) >> 4) : -1;
        if (nct > 0) {
            BrState st; INIT_ST(st);
            nsa_branch<1, 2>(F, C, qf, Kg, Vg, 64, nct - 1, 0, zz, zz, zz, cfull, climit, st);
            NSA_PRELOAD_CMP(true);
            SUBT_END(2);
            const float ltot = st.l + xor32f(st.l);
            float meff; const unsigned wfin = ref_words(st.mref + ((ltot > 0.f) ? __builtin_log2f(ltot) : 0.f), meff);
            BrState s2; INIT_ST(s2); s2.qxm = hi ? 0u : wfin;
            nsa_branch<2, 2>(F, C, qf, Kg, Vg, 64, nct - 1, 0, zz, zz, zz, cfull, climit, s2);
            stage_dma<true>(F.lds, Zb + ZC_KS + g * 64, Zb + ZC_VS + g * 64, ZP, 64L * qt, w, lane);
            sel_pre = true;
            s2.l = 0.5f;
            ACC_PREP(s2, 0)
#pragma unroll
            for (int r = 0; r < 16; ++r) { const int c_ = (r & 3) + 8 * (r >> 2); const float a_ = wr_[c_]; const unsigned y_ = ya[c_ * 32]; ya[c_ * 32] = pk2(bflo(y_) + a_ * s2.o0[r], bfhi(y_) + a_ * s2.o1[r]); }
            WAVE_SYNC(); FENCE();
        }
    }
    if (!sel_pre) stage_dma<true>(F.lds, Zb + ZC_KS + g * 64, Zb + ZC_VS + g * 64, ZP, 64L * qt, w, F.lane);
    __syncthreads();
    SUBT_END(3);
    {
        const int lane = opaque_lane(F.lane);
        const int q8 = lane >> 3, sub = lane & 7, qq = 8 * w + q8;
        unsigned key[16];
#pragma unroll
        for (int e = 0; e < 16; ++e) { const int j = 16 * sub + e; const bool valid = (j <= qt) && (j < NBLK);
            unsigned kk = valid ? (__builtin_bit_cast(unsigned, imp[qq * 128 + j]) + 1u) : 0u;
            if (valid && (j == 0 || j == qt || j == qt - 1)) kk = 0x7F000000u;
            key[e] = kk; }
        unsigned thr = 0u;
        for (int bit = 30; bit >= 0; --bit) { const unsigned cand = thr | (1u << bit); int c = 0;
#pragma unroll
            for (int e = 0; e < 16; ++e) c += (key[e] >= cand) ? 1 : 0;
            c = red8_add(c);
            if (c >= NSEL) thr = cand; }
        int ngt = 0, tl = 0;
#pragma unroll
        for (int e = 0; e < 16; ++e) { ngt += (key[e] > thr) ? 1 : 0; tl += (key[e] == thr) ? 1 : 0; }
        ngt = red8_add(ngt);
        int sc = tl;
#pragma unroll
        for (int d = 1; d < 8; d <<= 1) { const int o = __shfl(sc, (lane - d) & 63); if (sub >= d) sc += o; }
        int before = sc - tl; const int need = (thr == 0u) ? 0 : (NSEL - ngt);
        unsigned m16 = 0u;
#pragma unroll
        for (int e = 0; e < 16; ++e) { if (key[e] > thr) m16 |= 1u << e; else if (key[e] == thr) { if (before < need) m16 |= 1u << e; ++before; } }
        selm[qq * 8 + sub] = (unsigned short)m16;
        unsigned um = m16; um |= __shfl_xor(um, 8); um |= __shfl_xor(um, 16); um |= __shfl_xor(um, 32);
        if (q8 == 0) ((LAS unsigned short*)uniw)[w * 8 + sub] = (unsigned short)um;
    }
    __syncthreads();
    SUBT_END(4);
    {
        SECTION_LANE();
        BrState st; INIT_ST(st);
        if (F.tid < 4) { unsigned u = 0u; for (int ww = 0; ww < 8; ++ww) u |= uniw[ww * 4 + F.tid]; uniw[32 + F.tid] = u; }
        __syncthreads();
        const LAS unsigned* um = uniw + 32; const LAS unsigned* wm = uniw + w * 4; const LAS unsigned* qm = (const LAS unsigned*)selm + qloc * 4;
        nsa_branch<3, 1>(F, C, qf, Zb + ZC_KS + g * 64, Zb + ZC_VS + g * 64, ZP, qt, 0, um, wm, qm, 0, 0, st);
        ACC_PREP(st, 1)
        bf16_t* ym = (bf16_t*)(F.ws + WS_YMIX) + ((size_t)b * SEQ + t0 + 8 * w + hi) * DM + 512 + 4 * g * 64 + i;
#pragma unroll
        for (int r = 0; r < 16; ++r) { const int c_ = (r & 3) + 8 * (r >> 2); const float a_ = wr_[c_]; const unsigned y_ = ya[c_ * 32]; bf16_t* op = ym + (c_ >> 2) * DM + (c_ & 3) * 64;
            const unsigned o_ = pk2(bflo(y_) + a_ * st.o0[r], bfhi(y_) + a_ * st.o1[r]); op[0] = (bf16_t)(o_ & 0xffffu); op[32] = (bf16_t)(o_ >> 16); }
        WAVE_SYNC(); FENCE();
    }
    SUBT_END(5);
#undef ACC_PREP
#undef INIT_ST
#undef SECTION_LANE
#undef NSA_PRELOAD_CMP
}

__device__ __forceinline__ void argmax16(float& v, int& idx) {
#ifdef EMU
    for (int o = 1; o < 16; o <<= 1) { const float ov = __shfl_xor(v, o); const int oi = __shfl_xor(idx, o); if (ov > v || (ov == v && oi < idx)) { v = ov; idx = oi; } }
#else
#define AM_STEP(ctrl) do { const float ov = __builtin_bit_cast(float, __builtin_amdgcn_update_dpp(0, __builtin_bit_cast(int, v), ctrl, 0xF, 0xF, true)); \
        const int oi = __builtin_amdgcn_update_dpp(0, idx, ctrl, 0xF, 0xF, true); if (ov > v || (ov == v && oi < idx)) { v = ov; idx = oi; } } while (0)
    AM_STEP(0xB1); AM_STEP(0x4E); AM_STEP(0x141); AM_STEP(0x140);
#undef AM_STEP
#endif
}
template <bool SHADOW>
__device__ __forceinline__ void router_task(Frame& F, int task) {
    const int row0 = 32 * task;
    LAS float* Hs = (LAS float*)F.lds;
    const float* mod = (const float*)(F.ws + WS_MOD);
    const float* X0 = F.in[I_X]; const bf16_t* MIX = (const bf16_t*)(F.ws + WS_MIX);
    unsigned char* H2 = (unsigned char*)(F.ws + WS_H2);
    const float* g = F.in[I_GFFN];
    {
        const int b = row0 / SEQ;
        const float* mb = mod + (size_t)b * 6144;
#pragma unroll
        for (int rb = 0; rb < 2; ++rb) {
            f32x4 v[2][4]; u32x2 mw[2][4];
#pragma unroll
            for (int rr = 0; rr < 2; ++rr) { const size_t ro = (size_t)(row0 + 4 * F.wave + 2 * rb + rr) * DM; const f32x4* xr = (const f32x4*)(X0 + ro) + F.lane; const u32x2* mr = (const u32x2*)(MIX + ro) + F.lane;
#pragma unroll
                for (int j = 0; j < 4; ++j) { v[rr][j] = xr[64 * j]; mw[rr][j] = mr[64 * j]; } }
#pragma unroll
            for (int rr = 0; rr < 2; ++rr)
#pragma unroll
                for (int j = 0; j < 4; ++j) v[rr][j] += *(const f32x4*)(mb + 2 * 1024 + 4 * F.lane + 256 * j) * (f32x4){bflo(mw[rr][j].x), bfhi(mw[rr][j].x), bflo(mw[rr][j].y), bfhi(mw[rr][j].y)};
#pragma unroll
            for (int rr = 0; rr < 2; ++rr) {
                const int lr = 4 * F.wave + 2 * rb + rr, m = row0 + lr;
                float s = 0.f;
#pragma unroll
                for (int j = 0; j < 4; ++j) s += (v[rr][j][0] * v[rr][j][0] + v[rr][j][1] * v[rr][j][1]) + (v[rr][j][2] * v[rr][j][2] + v[rr][j][3] * v[rr][j][3]);
                const float rinv = __builtin_amdgcn_rsqf(wave_sum(s) * (1.0f / DM) + EPS);
                unsigned* o4 = (unsigned*)(H2 + (size_t)m * DM) + F.lane;
#pragma unroll
                for (int j = 0; j < 4; ++j) { const int c = 4 * F.lane + 256 * j;
                    const f32x4 h = v[rr][j] * rinv * (*(const f32x4*)(g + c) * (*(const f32x4*)(mb + 4 * 1024 + c) + 1.0f)) + *(const f32x4*)(mb + 3 * 1024 + c);
                    o4[64 * j] = pk4_fp8(h[0] * F8_ACT_SCALE, h[1] * F8_ACT_SCALE, h[2] * F8_ACT_SCALE, h[3] * F8_ACT_SCALE);
#pragma unroll
                    for (int e = 0; e < 4; ++e) Hs[(c + e) * 33 + lr] = h[e]; }
                __builtin_amdgcn_sched_barrier(0);
            }
        }
    }
    const int i = F.lane & 31, hi = F.lane >> 5;
    const float* WR = F.in[I_WR];
    __builtin_amdgcn_sched_barrier(0);
    float wr[32];
#pragma unroll
    for (int ks = 0; ks < 32; ++ks) wr[ks] = WR[(128 * F.wave + 2 * ks + hi) * 32 + i];
    __syncthreads();
    f32x16 acc;
#pragma unroll
    for (int r = 0; r < 16; ++r) acc[r] = 0.f;
    float wr2[32];
#pragma unroll
    for (int ks = 0; ks < 32; ++ks) wr2[ks] = WR[(128 * F.wave + 2 * (ks + 32) + hi) * 32 + i];
    __builtin_amdgcn_sched_barrier(0);
#pragma unroll
    for (int q4 = 0; q4 < 4; ++q4) {
#pragma unroll
        for (int ks = 8 * q4; ks < 8 * q4 + 8; ++ks) acc = __builtin_amdgcn_mfma_f32_32x32x2f32(Hs[(128 * F.wave + 2 * ks + hi) * 33 + i], wr[ks], acc, 0, 0, 0);
        __builtin_amdgcn_sched_barrier(0);
    }
#pragma unroll
    for (int q4 = 0; q4 < 4; ++q4) {
#pragma unroll
        for (int ks = 8 * q4; ks < 8 * q4 + 8; ++ks) acc = __builtin_amdgcn_mfma_f32_32x32x2f32(Hs[(128 * F.wave + 2 * (ks + 32) + hi) * 33 + i], wr2[ks], acc, 0, 0, 0);
        __builtin_amdgcn_sched_barrier(0);
    }
    __syncthreads();
    LAS float* Ls = (LAS float*)F.lds;
    LAS float* Lg = Ls + 8 * 1024;
    LAS unsigned* hist = (LAS unsigned*)(Lg + 32 * 33);
#pragma unroll
    for (int r = 0; r < 16; ++r) Ls[F.wave * 1024 + crow(r, hi) * 32 + i] = acc[r];
    if (F.tid < 64) hist[F.tid] = 0u;
    __syncthreads();
    const int tk = F.tid >> 4, sub = F.tid & 15;
    float l0 = F.in[I_BR][sub], l1 = F.in[I_BR][sub + 16];
#pragma unroll
    for (int w = 0; w < 8; ++w) { l0 += Ls[w * 1024 + tk * 32 + sub]; l1 += Ls[w * 1024 + tk * 32 + sub + 16]; }
    int be[4]; float bv[4];
#pragma unroll
    for (int k = 0; k < 4; ++k) { float v; int id;
        if (l0 >= l1) { v = l0; id = sub; } else { v = l1; id = sub + 16; }
        argmax16(v, id);
        be[k] = id; bv[k] = v;
        if (id == sub) l0 = -INFINITY;
        if (id == sub + 16) l1 = -INFINITY; }
    unsigned rank[4] = {0u, 0u, 0u, 0u};
    {
        float sum = 0.f; const float mx0 = bv[0];
#pragma unroll
        for (int k = 0; k < 4; ++k) { bv[k] = fexp2((bv[k] - mx0) * LOG2E); sum += bv[k]; }
        const float rs = 1.0f / sum;
#pragma unroll
        for (int k = 0; k < 4; ++k) bv[k] *= rs;
    }
    if (sub == 0) {
#pragma unroll
        for (int k = 0; k < 4; ++k) rank[k] = atomicAdd((unsigned*)&hist[be[k]], 1u);
    }
    __syncthreads();
    if (F.tid < 32) { const unsigned c = hist[F.tid]; hist[32 + F.tid] = c ? atomicAdd(F.ctl + (SHADOW ? CW_CNT2 : CW_CNT) + 64 * F.tid, c) : 0u; }
    __syncthreads();
    if (sub == 0) {
        const int tok = row0 + tk;
        const size_t sh_ = SHADOW ? WS_SHADOW : 0;
        int* lists = (int*)(F.ws + sh_ + WS_LISTS); int* tope = (int*)(F.ws + sh_ + WS_TOPE); float* topw = (float*)(F.ws + sh_ + WS_TOPW); int* topp = (int*)(F.ws + sh_ + WS_TOPP);
#pragma unroll
        for (int k = 0; k < 4; ++k) { const int pos = (int)(hist[32 + be[k]] + rank[k]);
            lists[(size_t)be[k] * T + pos] = tok; tope[tok * 4 + k] = be[k]; topw[tok * 4 + k] = bv[k]; topp[tok * 4 + k] = pos; }
    }
    __syncthreads();
}

__device__ __forceinline__ void moe_tables(Frame& F) {
    if (F.tid < 64) {
        const int e = F.lane & 31;
        const unsigned c = __hip_atomic_load(F.ctl + CW_CNT + 64 * e, __ATOMIC_RELAXED, __HIP_MEMORY_SCOPE_AGENT);
        const unsigned tl = (c + 255u) / 256u;
        unsigned incl = tl;
#pragma unroll
        for (int d = 1; d < 32; d <<= 1) { const unsigned o = __shfl(incl, (F.lane - d) & 63); if (e >= d) incl += o; }
        if (F.lane < 32) { F.MISC[MW_CNT + e] = c; F.MISC[MW_TPFX + e] = incl - tl; F.MISC[MW_ROFF + e] = (incl - tl) * 256u;
            if (e == 31) { F.MISC[MW_TPFX + NE] = incl; F.MISC[MW_ROFF + NE] = incl * 256u; } }
    }
    __syncthreads();
}

__device__ __forceinline__ void final_rows(Frame& F) {
    const int gw = F.vcu * NWAVES + F.wave, NGW = F.G * NWAVES;
    const float* mod = (const float*)(F.ws + WS_MOD);
    const float* X0 = F.in[I_X]; const bf16_t* MIX = (const bf16_t*)(F.ws + WS_MIX);
    const bf16_t* YD = (const bf16_t*)(F.ws + WS_YD);
    const int* tope = (const int*)(F.ws + WS_TOPE); const float* topw = (const float*)(F.ws + WS_TOPW); const int* topp = (const int*)(F.ws + WS_TOPP);
    const float* gf = F.in[I_GFIN];
    int m = gw;
    u32x4 ne = (u32x4){0u, 0u, 0u, 0u}, np = ne; f32x4 nw = (f32x4){0.f, 0.f, 0.f, 0.f}; f32x4 nx[4]; u32x2 nm[4];
    if (m < T) { ne = *(const u32x4*)(tope + m * 4); np = *(const u32x4*)(topp + m * 4); nw = *(const f32x4*)(topw + m * 4);
#pragma unroll
        for (int j = 0; j < 4; ++j) { nx[j] = ((const f32x4*)(X0 + (size_t)m * DM) + F.lane)[64 * j]; nm[j] = ((const u32x2*)(MIX + (size_t)m * DM) + F.lane)[64 * j]; } }
    for (; m < T; m += NGW) {
        const int b = m / SEQ;
        const u32x4 ce = ne, cp = np; const f32x4 cw = nw; f32x4 cx[4];
#pragma unroll
        for (int j = 0; j < 4; ++j) { const f32x4 g1 = *(const f32x4*)(mod + (size_t)b * 6144 + 2 * 1024 + 4 * F.lane + 256 * j);
            cx[j] = nx[j] + g1 * (f32x4){bflo(nm[j].x), bfhi(nm[j].x), bflo(nm[j].y), bfhi(nm[j].y)}; }
        size_t yrow[4];
#pragma unroll
        for (int k = 0; k < 4; ++k) yrow[k] = (size_t)(F.MISC[MW_ROFF + ce[k]] + cp[k]) * DM;
        u32x2 yw[4][4];
#pragma unroll
        for (int j = 0; j < 4; ++j)
#pragma unroll
            for (int k = 0; k < 4; ++k) yw[j][k] = *(const u32x2*)(YD + yrow[k] + 4 * F.lane + 256 * j);
        const int mn = m + NGW;
        if (mn < T) { ne = *(const u32x4*)(tope + mn * 4); np = *(const u32x4*)(topp + mn * 4); nw = *(const f32x4*)(topw + mn * 4);
#pragma unroll
            for (int j = 0; j < 4; ++j) { nx[j] = ((const f32x4*)(X0 + (size_t)mn * DM) + F.lane)[64 * j]; nm[j] = ((const u32x2*)(MIX + (size_t)mn * DM) + F.lane)[64 * j]; } }
        f32x4 v[4]; float s = 0.f;
#pragma unroll
        for (int j = 0; j < 4; ++j) { const int c = 4 * F.lane + 256 * j;
            f32x4 mo = (f32x4){0.f, 0.f, 0.f, 0.f};
#pragma unroll
            for (int k = 0; k < 4; ++k) mo += cw[k] * (f32x4){bflo(yw[j][k].x), bfhi(yw[j][k].x), bflo(yw[j][k].y), bfhi(yw[j][k].y)};
            const f32x4 gt = *(const f32x4*)(mod + (size_t)b * 6144 + 5 * 1024 + c);
            v[j] = cx[j] + gt * mo;
            s += (v[j][0] * v[j][0] + v[j][1] * v[j][1]) + (v[j][2] * v[j][2] + v[j][3] * v[j][3]); }
        const float rinv = __builtin_amdgcn_rsqf(wave_sum(s) * (1.0f / DM) + EPS);
        f32x4* orow = (f32x4*)(F.out + (size_t)m * DM) + F.lane;
#pragma unroll
        for (int j = 0; j < 4; ++j) orow[64 * j] = v[j] * rinv * *(const f32x4*)(gf + 4 * F.lane + 256 * j);
    }
}

constexpr int N_PHASES = 10;
#define REP0 1
#define REPB 1
#define REP1 1
#define REP6 1
#define REP2 1
#define REP3 1
#define REP4 1
#define REP5 1
#define REP7 1
#define REP8 1
#define REP9 1
__global__ void __launch_bounds__(NTHREADS, 2) mk_fwd(Args args) {
#ifdef EMU
    unsigned char* lds = emu_blk->lds;
#else
    extern __shared__ __attribute__((aligned(16))) unsigned char lds[];
#endif
    Frame F;
    F.lds = (LAS unsigned char*)lds;
    F.MISC = (volatile LAS unsigned*)(F.lds + MISC_OFF);
    F.tid = threadIdx.x; F.lane = F.tid & 63; F.wave = __builtin_amdgcn_readfirstlane(F.tid >> 6);
    F.G = gridDim.x; { const int bx = blockIdx.x; F.vcu = (F.G % 8 == 0) ? (bx % 8) * (F.G / 8) + bx / 8 : bx; }
    F.ws = args.ws; F.ctl = (unsigned*)(args.ws + WS_CTL); F.out = args.out;
#pragma unroll
    for (int k = 0; k < 24; ++k) F.in[k] = args.in[k];
    for (int u = F.tid; u < (LDS_BYTES - MISC_OFF) / 4; u += NTHREADS) F.MISC[u] = 0u;
    __syncthreads();
    XcdBarrier bar = xcd_barrier_post(F.ctl + CW_BAR, F.MISC + 8);
    const int lo = args.ph_lo, hi = args.ph_hi;
#ifndef EMU
#define STAMP(k) do { if (PROBE_K >= 0 && blockIdx.x == 0 && F.tid == 0) { const unsigned long long t_ = __builtin_amdgcn_s_memrealtime(); F.MISC[((k) >= 20 ? 360 : 256) + 2 * (k)] = (unsigned)t_; F.MISC[((k) >= 20 ? 361 : 257) + 2 * (k)] = (unsigned)(t_ >> 32); } } while (0)
#else
#define STAMP(k) ((void)0)
#endif
    STAMP(0);
#ifndef PH_MASK
#define PH_MASK 0xffff
#endif
#define IN(k) (((PH_MASK >> (k)) & 1) && lo <= (k) && (k) < hi)
#define SEAM(k) do { if (IN(k) && IN((k) + 1)) { xcd_barrier(bar); if (REPB > 1) xcd_barrier(bar); } } while (0)

    if (IN(0)) { p0_prologue(F); if (REP0 > 1) p0_prologue(F); }
    STAMP(20); SEAM(0); STAMP(1);
#ifndef EMU
    if (IN(0) && IN(1)) {
        if (F.tid == 0) { unsigned ok = 1u; for (int j = 0; j < 8; ++j) ok &= (xb_ld(F.ctl + CW_BAR + XB_XCNT(j)) == (unsigned)(F.G / 8)) ? 1u : 0u;
            F.MISC[12] = (ok && bar.x < 8u) ? (bar.x * (unsigned)(F.G / 8) + F.MISC[10]) : (unsigned)F.vcu; }
        __syncthreads();
        F.vcu = (int)F.MISC[12];
    }
#endif
    if (IN(1)) { norm_rows(F, F.in[I_X], F.in[I_GMIX], 0, 1, (bf16_t*)(F.ws + WS_HB)); if (REP1 > 1) norm_rows(F, F.in[I_X], F.in[I_GMIX], 0, 1, (bf16_t*)(F.ws + WS_HB)); }
    STAMP(21); SEAM(1); STAMP(2);
    if (IN(2)) {
        {
        pg8::DenseProb P{(const char*)(F.ws + WS_HB), (const char*)(F.ws + WS_WINT), DM * 2};
        pg8::DenseOrder S; S.init(T, ZP, F.G, (F.G % 8 == 0) ? (F.vcu % (F.G / 8)) * 8 + F.vcu / (F.G / 8) : (int)blockIdx.x);
        EpiZ E{(bf16_t*)(F.ws + WS_ZB)};
        pg8::gemm_phase<false>(F.lds, P, S, E);
        if (p2_fill_items(F) && S.c >= 128) {
            LAS float* scr = (LAS float*)(F.lds + 8192 + F.wave * 16384);
            const int base = P0_NITEMS - p7_fill_items(F) - p2_fill_items(F) + (S.c - 128) * P2_FILL_PER_CU;
            for (int k = F.wave; k < P2_FILL_PER_CU; k += NWAVES) p0_item(F, scr, base + k);
        }
        }
        if (REP2 > 1) {
        pg8::DenseProb P{(const char*)(F.ws + WS_HB), (const char*)(F.ws + WS_WINT), DM * 2};
        pg8::DenseOrder S; S.init(T, ZP, F.G, (F.G % 8 == 0) ? (F.vcu % (F.G / 8)) * 8 + F.vcu / (F.G / 8) : (int)blockIdx.x);
        EpiZ E{(bf16_t*)(F.ws + WS_ZB)};
        pg8::gemm_phase<false>(F.lds, P, S, E);
        }
    }
    STAMP(22); SEAM(2); STAMP(3);
    if (IN(3)) {
        constexpr int NGM = BATCH * (SEQ / GMC) * GMG, NCT = 2 * BATCH * NG * (NCP / 32);
        for (int rep = 0; rep < (REP3 > 1 ? 2 : 1); ++rep) {
            if (F.G == 2 * NCT && NGM == 8 * NCT) {
                if (F.vcu < NCT) { cmp_tile(F, F.vcu); gmlp_run(F, 3 * F.vcu, 1, 3); }
                else gmlp_run(F, 3 * NCT + 5 * (F.vcu - NCT), 1, 5);
            } else { for (int it = F.vcu; it < NCT; it += F.G) cmp_tile(F, it);
                     const int first = ((F.vcu - NCT) % F.G + F.G) % F.G; gmlp_run(F, first, F.G, (NGM - first + F.G - 1) / F.G); }
        }
    }
    STAMP(23); SEAM(3); STAMP(4);
    if (IN(4)) {
        constexpr int NQT_ = SEQ / 64, NPAIR = BATCH * NQT_;
        for (int rep = 0; rep < (REP4 > 1 ? 2 : 1); ++rep)
        for (int pr = F.vcu; pr < NPAIR; pr += F.G) { const int b_ = pr / NQT_, x_ = pr % NQT_;
            for (int k2 = 0; k2 < 2; ++k2) nsa_task(F, k2 ? (b_ * NG + 0) * NQT_ + x_ : (b_ * NG + 1) * NQT_ + (NQT_ - 1 - x_)); }
    }
    STAMP(24); SEAM(4); STAMP(5);
    if (IN(5)) {
        {
        pg8::DenseProb P{(const char*)(F.ws + WS_YMIX), (const char*)(F.ws + WS_WOUTT), DM * 2};
        pg8::DenseOrder S; S.init(T, DM, F.G, (F.G % 8 == 0) ? (F.vcu % (F.G / 8)) * 8 + F.vcu / (F.G / 8) : (int)blockIdx.x);
        EpiMix E{(bf16_t*)(F.ws + WS_MIX)};
        pg8::gemm_phase<false>(F.lds, P, S, E);
        }
        if (REP5 > 1) {
        pg8::DenseProb P{(const char*)(F.ws + WS_YMIX), (const char*)(F.ws + WS_WOUTT), DM * 2};
        pg8::DenseOrder S; S.init(T, DM, F.G, (F.G % 8 == 0) ? (F.vcu % (F.G / 8)) * 8 + F.vcu / (F.G / 8) : (int)blockIdx.x);
        EpiMix E{(bf16_t*)(F.ws + WS_MIX)};
        pg8::gemm_phase<false>(F.lds, P, S, E);
        }
    }
    STAMP(25); SEAM(5); STAMP(6);
    if (IN(6)) { for (int it = F.vcu; it < T / 32; it += F.G) router_task<false>(F, it); if (REP6 > 1) for (int it = F.vcu; it < T / 32; it += F.G) router_task<true>(F, it); }
    STAMP(26); SEAM(6); STAMP(7);
    if (IN(7)) {
        {
        moe_tables(F);
        MoeProb1 P{(const char*)(F.ws + WS_H2), (const char*)(F.ws + WS_WGUT), (const int*)(F.ws + WS_LISTS), F.in[I_BGU], F.MISC + MW_CNT, DM};
        pg8::MoeOrder S{F.MISC + MW_TPFX, 8, F.G, F.vcu, 0};
        EpiAct E{(unsigned char*)(F.ws + WS_ACT), F.in[I_BGU], F.MISC + MW_ROFF};
        pg8::gemm_phase<true>(F.lds, P, S, E);
        if (p7_fill_items(F)) {
            const int rem = ((int)F.MISC[MW_TPFX + NE] * 8) % F.G;
            int nidle = rem ? F.G - rem : 0, j = F.vcu - rem;
            if (nidle < F.G / 4) { nidle = F.G; j = F.vcu; }
            if (j >= 0) {
                __syncthreads();
                LAS float* scr = (LAS float*)(F.lds + F.wave * 8704);
                const int base = P0_NITEMS - p7_fill_items(F);
                for (int k = j * NWAVES + F.wave; k < p7_fill_items(F); k += nidle * NWAVES) p0_item(F, scr, base + k);
            }
        }
        }
        if (REP7 > 1) {
        moe_tables(F);
        MoeProb1 P{(const char*)(F.ws + WS_H2), (const char*)(F.ws + WS_WGUT), (const int*)(F.ws + WS_LISTS), F.in[I_BGU], F.MISC + MW_CNT, DM};
        pg8::MoeOrder S{F.MISC + MW_TPFX, 8, F.G, F.vcu, 0};
        EpiAct E{(unsigned char*)(F.ws + WS_ACT), F.in[I_BGU], F.MISC + MW_ROFF};
        pg8::gemm_phase<true>(F.lds, P, S, E);
        }
    }
    STAMP(27); SEAM(7); STAMP(8);
    if (IN(8)) {
        {
        moe_tables(F);
        MoeProb2 P{(const char*)(F.ws + WS_ACT), (const char*)(F.ws + WS_WDNT), F.in[I_BDN], F.MISC + MW_ROFF, DFF};
        pg8::MoeOrder S{F.MISC + MW_TPFX, 4, F.G, F.vcu, 0};
        EpiYd E{(bf16_t*)(F.ws + WS_YD), F.in[I_BDN], F.MISC + MW_ROFF};
        pg8::gemm_phase<true>(F.lds, P, S, E);
        }
        if (REP8 > 1) {
        moe_tables(F);
        MoeProb2 P{(const char*)(F.ws + WS_ACT), (const char*)(F.ws + WS_WDNT), F.in[I_BDN], F.MISC + MW_ROFF, DFF};
        pg8::MoeOrder S{F.MISC + MW_TPFX, 4, F.G, F.vcu, 0};
        EpiYd E{(bf16_t*)(F.ws + WS_YD), F.in[I_BDN], F.MISC + MW_ROFF};
        pg8::gemm_phase<true>(F.lds, P, S, E);
        }
    }
    STAMP(28); SEAM(8); STAMP(9);
    if (IN(9)) { moe_tables(F); final_rows(F); if (REP9 > 1) final_rows(F); }
#ifndef EMU
    if (PROBE_K >= 0 && blockIdx.x == 0 && F.tid == 0) {
        STAMP(10);
        unsigned long long a_ = 0, b_ = 0;
        if (PROBE_K == 19) { a_ = ((unsigned long long)F.MISC[257] << 32) | F.MISC[256]; b_ = ((unsigned long long)F.MISC[257 + 20] << 32) | F.MISC[256 + 20]; }
        else if (PROBE_K < 20) { a_ = ((unsigned long long)F.MISC[257 + 2 * (PROBE_K % 20)] << 32) | F.MISC[256 + 2 * (PROBE_K % 20)];
                            b_ = ((unsigned long long)F.MISC[259 + 2 * (PROBE_K % 20)] << 32) | F.MISC[258 + 2 * (PROBE_K % 20)]; }
        else if (PROBE_K >= 30 && PROBE_K < 40) { a_ = ((unsigned long long)F.MISC[361 + 2 * (20 + PROBE_K - 30)] << 32) | F.MISC[360 + 2 * (20 + PROBE_K - 30)]; b_ = ((unsigned long long)F.MISC[257 + 2 * (PROBE_K - 30 + 1)] << 32) | F.MISC[256 + 2 * (PROBE_K - 30 + 1)]; }
        else if (PROBE_K >= 50) b_ = F.MISC[300 + 6 + (PROBE_K % 10)];
        else b_ = F.MISC[300 + (PROBE_K - 20)];
        const unsigned long long t0_ = __builtin_amdgcn_s_memrealtime();
        while (__builtin_amdgcn_s_memrealtime() - t0_ < (b_ - a_)) __builtin_amdgcn_s_sleep(8);
    }
#endif
#undef IN
#undef SEAM
}

#ifdef EMU
struct EmuDump { const char* name; size_t off; size_t bytes; };
EmuDump emu_dumps[] = {
    {"mod", WS_MOD, (size_t)BATCH * 6144 * 4}, {"bpe", WS_BPE, 512 * 4}, {"wint", WS_WINT, (size_t)ZP * DM * 2}, {"hb", WS_HB, (size_t)T * DM * 2},
    {"zb", WS_ZB, (size_t)T * ZP * 2}, {"kc", WS_KC, (size_t)BATCH * NG * NCP * 64 * 2}, {"vc", WS_VC, (size_t)BATCH * NG * NCP * 64 * 2},
    {"ymix", WS_YMIX, (size_t)T * DM * 2}, {"mix", WS_MIX, (size_t)T * DM * 2}, {"h2", WS_H2, (size_t)T * DM * 2},
    {"tope", WS_TOPE, (size_t)T * 16}, {"topw", WS_TOPW, (size_t)T * 16}, {"topp", WS_TOPP, (size_t)T * 16}, {"ctl", WS_CTL, CTL_ZERO_BYTES},
};
int emu_ndumps = sizeof(emu_dumps) / sizeof(emu_dumps[0]);
size_t emu_ws_bytes = WS_END;
int emu_out_elems = T * DM;
#endif

extern "C" void kernel_launch(void* const* d_in, const int* in_sizes, int n_in, void* d_out, int out_size, void* d_ws, size_t ws_size, hipStream_t stream) {
    (void)in_sizes; (void)out_size; (void)ws_size;
    Args a{};
    for (int i = 0; i < 24 && i < n_in; ++i) a.in[i] = (const float*)d_in[i];
    a.out = (float*)d_out; a.ws = (unsigned char*)d_ws;
#ifndef EMU
    (void)hipMemsetAsync((char*)d_ws + WS_CTL, 0, CTL_ZERO_BYTES, stream);
#endif
#ifdef EMU
    int plo = 0, phi = N_PHASES;
    if (const char* e = getenv("EMU_PH_LO")) plo = atoi(e);
    if (const char* e = getenv("EMU_PH_HI")) phi = atoi(e);
    if (plo == 0) (void)hipMemsetAsync((char*)d_ws + WS_CTL, 0, CTL_ZERO_BYTES, stream);
    const int grid = emu_num_cus();
    for (int ph = plo; ph < phi; ++ph) { a.ph_lo = ph; a.ph_hi = ph + 1; Args ac = a; fprintf(stderr, "EMU phase %d\n", ph);
        emu_launch(grid, NTHREADS, LDS_BYTES, [ac]() { mk_fwd(ac); }); }
#else
    static int grid = 0;
    if (grid == 0) {
        int dev = 0, cus = 0, per_cu = 0;
        (void)hipGetDevice(&dev);
        (void)hipDeviceGetAttribute(&cus, hipDeviceAttributeMultiprocessorCount, dev);
        (void)hipFuncSetAttribute((const void*)mk_fwd, hipFuncAttributeMaxDynamicSharedMemorySize, LDS_BYTES);
        (void)hipOccupancyMaxActiveBlocksPerMultiprocessor(&per_cu, (const void*)mk_fwd, NTHREADS, LDS_BYTES);
        if (per_cu < 1) fprintf(stderr, "kernel_launch: occupancy query reports %d blocks/CU\n", per_cu);
        grid = cus;
        (void)hipGetLastError();
    }
    a.ph_lo = 0; a.ph_hi = N_PHASES;
    void* kargs[] = {&a};
    hipError_t e = hipLaunchCooperativeKernel((const void*)mk_fwd, dim3(grid), dim3(NTHREADS), kargs, LDS_BYTES, stream);
    if (e != hipSuccess) fprintf(stderr, "cooperative launch failed: %s (grid %d)\n", hipGetErrorString(e), grid);
#endif
}
```

```cpp
#ifndef EMU
#include <hip/hip_runtime.h>
#endif
#include <cstdio>
#include <cstdint>

#ifndef CFG_BATCH
#define CFG_BATCH 2
#endif
#ifndef CFG_SEQ
#define CFG_SEQ 8192
#endif

#define PROBE_K -1
#ifdef EMU
#define NOSPEC() ((void)0)
#define LAS
#define ASM_VMCNT(n) ((void)0)
#define ASM_LGKMCNT(n) ((void)0)
#define WAVE_SYNC() emu_wave_sync()
#define FENCE() ((void)0)
#else
#define NOSPEC() asm volatile("; rare path" ::: "memory")
#define LAS __attribute__((address_space(3)))
#define ASM_VMCNT(n) asm volatile("s_waitcnt vmcnt(" #n ")" ::: "memory")
#define ASM_LGKMCNT(n) asm volatile("s_waitcnt lgkmcnt(" #n ")" ::: "memory")
#define WAVE_SYNC() asm volatile("s_waitcnt lgkmcnt(0)" ::: "memory")
#define FENCE() asm volatile("" ::: "memory")
#endif

typedef unsigned short bf16_t;
typedef short bf16x8 __attribute__((ext_vector_type(8)));
typedef short s16x4 __attribute__((ext_vector_type(4)));
typedef float f32x4 __attribute__((ext_vector_type(4)));
typedef float f32x16 __attribute__((ext_vector_type(16)));
typedef unsigned u32x4 __attribute__((ext_vector_type(4)));
typedef unsigned u32x2 __attribute__((ext_vector_type(2)));

constexpr int NWAVES = 8, NTHREADS = 512;
constexpr int BATCH = CFG_BATCH, SEQ = CFG_SEQ, DM = 1024, T = BATCH * SEQ;
constexpr int GMW = 512, GMG = 8, GMC = 128;
constexpr int NH = 8, NG = 2, NR = 4, HD = 64;
constexpr int INC = 2328, ZP = 2560;
constexpr int ZC_U = 0, ZC_V = 512, ZC_Q = 1024, ZC_KC = 1536, ZC_VC = 1664, ZC_KS = 1792, ZC_VS = 1920, ZC_KW = 2048, ZC_VW = 2176, ZC_GL = 2304;
constexpr int NCMP = SEQ / 16 - 1, NCP = SEQ / 16;
constexpr int NBLK = SEQ / 64;
constexpr int NSEL = NBLK < 16 ? NBLK : 16;
constexpr int NE = 32, TOPK = 4, DFF = 1024;
constexpr int TK = T * TOPK;
constexpr int ACT_ROWS = TK + NE * 256;
constexpr float EPS = 1e-6f;
constexpr float LOG2E = 1.4426950408889634f;
constexpr float F8_ACT_SCALE = 8.0f, F8_W_SCALE = 64.0f, F8_ACC_SCALE = 1.0f / 512.0f;

constexpr size_t MiB = 1u << 20;
constexpr size_t WS_CTL = 0, CTL_ZERO_BYTES = 192 * 1024;
constexpr size_t WS_MOD = 1 * MiB;
constexpr size_t WS_BPE = 1 * MiB + 512 * 1024;
constexpr size_t WS_LISTS = 2 * MiB;
constexpr size_t WS_TOPE = 4 * MiB;
constexpr size_t WS_TOPW = 4 * MiB + 512 * 1024;
constexpr size_t WS_TOPP = 5 * MiB;
constexpr size_t WS_WSBF = 6 * MiB;
constexpr size_t WS_W2KT = 6 * MiB + 512 * 1024;
constexpr size_t WS_W2VT = WS_W2KT + 64 * 1024;
constexpr size_t WS_W1KT = 7 * MiB;
constexpr size_t WS_W1VT = 8 * MiB;
constexpr size_t WS_WOUTT = 9 * MiB;
constexpr size_t WS_WINT = 11 * MiB;
constexpr size_t WS_KC = 16 * MiB;
constexpr size_t WS_VC = 16 * MiB + 512 * 1024;
constexpr size_t WS_WGUT = 32 * MiB;
constexpr size_t WS_WDNT = 160 * MiB;
constexpr size_t WS_HB = 224 * MiB;
constexpr size_t WS_H2 = 256 * MiB;
constexpr size_t WS_ZB = 288 * MiB;
constexpr size_t WS_YMIX = 368 * MiB;
constexpr size_t WS_MIX = 400 * MiB;
constexpr size_t WS_ACT = 464 * MiB;
constexpr size_t WS_YD = 608 * MiB;
constexpr size_t WS_YACC = 768 * MiB;
constexpr size_t WS_END = 804 * MiB;
constexpr int CW_BAR = 4096;
constexpr int CW_CNT = 16384;
constexpr int CW_CNT2 = 32768;
constexpr size_t WS_SHADOW = 752 * MiB;

constexpr int RING_BYTES = 131072;
constexpr int MISC_OFF = 155648;
constexpr int LDS_BYTES = 159744;
constexpr int MW_CNT = 16, MW_TPFX = 64, MW_ROFF = 128;

__device__ __forceinline__ unsigned f2bf(float f) { unsigned u = __builtin_bit_cast(unsigned, f); return (u + 0x7fffu + ((u >> 16) & 1u)) >> 16; }
#ifdef EMU
__device__ __forceinline__ unsigned pk2(float lo, float hi) { return f2bf(lo) | (f2bf(hi) << 16); }
#else
typedef float f32x2_t __attribute__((ext_vector_type(2))); typedef __bf16 bf16x2_t __attribute__((ext_vector_type(2)));
__device__ __forceinline__ unsigned pk2(float lo, float hi) { f32x2_t v = {lo, hi}; bf16x2_t bb = __builtin_convertvector(v, bf16x2_t); return __builtin_bit_cast(unsigned, bb); }
#endif
__device__ __forceinline__ unsigned pk4_fp8(float a, float b, float c, float d) {
    a = fminf(fmaxf(a, -448.f), 448.f); b = fminf(fmaxf(b, -448.f), 448.f); c = fminf(fmaxf(c, -448.f), 448.f); d = fminf(fmaxf(d, -448.f), 448.f);
    int w = 0; w = __builtin_amdgcn_cvt_pk_fp8_f32(a, b, w, false); w = __builtin_amdgcn_cvt_pk_fp8_f32(c, d, w, true); return (unsigned)w;
}
__device__ __forceinline__ unsigned pk4_fp8_nc(float a, float b, float c, float d) {
    int w = 0; w = __builtin_amdgcn_cvt_pk_fp8_f32(a, b, w, false); w = __builtin_amdgcn_cvt_pk_fp8_f32(c, d, w, true); return (unsigned)w;
}
typedef int v8i_t __attribute__((ext_vector_type(8)));
typedef int v4i_t __attribute__((ext_vector_type(4)));
__device__ __forceinline__ float bf2f(unsigned short h) { return __builtin_bit_cast(float, (unsigned)h << 16); }
__device__ __forceinline__ float bflo(unsigned w) { return __builtin_bit_cast(float, w << 16); }
__device__ __forceinline__ float bfhi(unsigned w) { return __builtin_bit_cast(float, w & 0xffff0000u); }
__device__ __forceinline__ float fexp2(float x) { return __builtin_amdgcn_exp2f(x); }
__device__ __forceinline__ float gelu_tanh(float x) {
    const float y2 = 1.5957691216057308f * (x + 0.044715f * x * x * x);
    return x * __builtin_amdgcn_rcpf(1.0f + fexp2(-y2 * LOG2E));
}
__device__ __forceinline__ float sigmoidf_(float x) { return __builtin_amdgcn_rcpf(1.0f + fexp2(-x * LOG2E)); }
__device__ __forceinline__ float wave_sum(float v) {
#pragma unroll
    for (int o = 1; o < 64; o <<= 1) v += __shfl_xor(v, o);
    return v;
}
__device__ __forceinline__ int crow(int r, int hi) { return (r & 3) + 8 * (r >> 2) + 4 * hi; }

#define XB_TMO      128
#define XB_XCNT(j)  (256  + 64 * (j))
#define XB_XSUB(j)  (1280 + 64 * (j))
#define XB_XGEN(j)  (2304 + 64 * (j))
#define XB_TOP      3328
#define XB_TOPGEN   3392
#define XCD_BAR_WORDS 3456
#define XB_SPIN_CAP (1u << 18)
struct XcdBarrier { unsigned* bar; unsigned x; volatile LAS unsigned* st; };
#ifndef EMU
__device__ __forceinline__ unsigned xb_ld(unsigned* p)              { return __hip_atomic_load(p, __ATOMIC_RELAXED, __HIP_MEMORY_SCOPE_AGENT); }
__device__ __forceinline__ unsigned xb_add(unsigned* p, unsigned v) { return __hip_atomic_fetch_add(p, v, __ATOMIC_RELAXED, __HIP_MEMORY_SCOPE_AGENT); }
__device__ __forceinline__ unsigned xb_xcc_id() { return (unsigned)__builtin_amdgcn_s_getreg((3 << 11) | 20) & 0xFu; }
#define XB_SPIN(cond, bar) do { unsigned _sp = 0; while (cond) { __builtin_amdgcn_s_sleep(1); \
    if ((++_sp & 255u) == 0u) { if (xb_ld(&(bar)[XB_TMO])) break; if (_sp > XB_SPIN_CAP) { atomicAdd(&(bar)[XB_TMO], 1u); break; } } } } while (0)
__device__ __forceinline__ XcdBarrier xcd_barrier_post(unsigned* bar, volatile LAS unsigned* st) {
    XcdBarrier b; b.bar = bar; b.x = xb_xcc_id(); b.st = st;
    if (threadIdx.x == 0) st[2] = xb_add(&bar[XB_XCNT(b.x)], 1u);
    return b;
}
__device__ __forceinline__ void xcd_barrier_complete(unsigned* bar, unsigned x, unsigned& nloc, unsigned& nx) {
    const unsigned G = gridDim.x * gridDim.y * gridDim.z;
    unsigned sum, cnt, mine, sp = 0u;
    for (;;) {
        sum = 0u; cnt = 0u; mine = 0u;
#pragma unroll
        for (unsigned j = 0; j < 16; ++j) { const unsigned c = xb_ld(&bar[XB_XCNT(j)]); sum += c; cnt += (c > 0u) ? 1u : 0u; mine = (j == x) ? c : mine; }
        if (sum == G) break;
        __builtin_amdgcn_s_sleep(1);
        if ((++sp & 255u) == 0u) { if (xb_ld(&bar[XB_TMO])) break; if (sp > XB_SPIN_CAP) { atomicAdd(&bar[XB_TMO], 1u); break; } }
    }
    nloc = mine > 0u ? mine : 1u; nx = cnt > 0u ? cnt : 1u;
}
__device__ __forceinline__ void xcd_barrier(const XcdBarrier& b) {
    asm volatile("s_waitcnt vmcnt(0)" ::: "memory");
    __syncthreads();
    if (threadIdx.x == 0) {
        unsigned* bar = b.bar;
        __builtin_amdgcn_s_waitcnt(0);
        unsigned nloc = b.st[0], nx = b.st[1];
        if (nloc == 0u) { xcd_barrier_complete(bar, b.x, nloc, nx); b.st[0] = nloc; b.st[1] = nx; }
        const unsigned old = xb_add(&bar[XB_XSUB(b.x)], 1u);
        const unsigned gen = old / nloc;
        if (old + 1u == (gen + 1u) * nloc) {
            __builtin_amdgcn_fence(__ATOMIC_RELEASE, "agent");
            asm volatile("s_waitcnt vmcnt(0)" ::: "memory");
            const unsigned og = xb_add(&bar[XB_TOP], 1u);
            const unsigned tg = og / nx;
            if (og + 1u == (tg + 1u) * nx) xb_add(&bar[XB_TOPGEN], 1u);
            else XB_SPIN(xb_ld(&bar[XB_TOPGEN]) == tg, bar);
            __builtin_amdgcn_fence(__ATOMIC_ACQUIRE, "agent");
            xb_add(&bar[XB_XGEN(b.x)], 1u);
            asm volatile("s_waitcnt vmcnt(0)" ::: "memory");
        } else {
            XB_SPIN(xb_ld(&bar[XB_XGEN(b.x)]) == gen, bar);
            __builtin_amdgcn_fence(__ATOMIC_ACQUIRE, "agent");
            asm volatile("s_waitcnt vmcnt(0)" ::: "memory");
        }
    }
    __syncthreads();
}
#else
__device__ __forceinline__ XcdBarrier xcd_barrier_post(unsigned* bar, volatile unsigned* st) { XcdBarrier b; b.bar = bar; b.x = 0; b.st = st; return b; }
__device__ __forceinline__ void xcd_barrier(const XcdBarrier&) { fprintf(stderr, "EMU: grid barrier inside a launch\n"); abort(); }
#endif

struct Args { const float* in[24]; float* out; unsigned char* ws; int ph_lo, ph_hi; };
enum { I_X = 0, I_C, I_WADA, I_BADA, I_GMIX, I_WIN, I_GMWS, I_GMBS, I_GMNG, I_PEK, I_W1K, I_W2K, I_PEV, I_W1V, I_W2V, I_WOUT, I_GFFN, I_WR, I_BR, I_WGU, I_BGU, I_WDN, I_BDN, I_GFIN };

struct Frame {
    LAS unsigned char* lds;
    volatile LAS unsigned* MISC;
    unsigned* ctl;
    unsigned char* ws;
    const float* in[24];
    float* out;
    int tid, lane, wave, vcu, G;
};

namespace pg8 {
constexpr int BM = 256, BK = 64, HALF = 128, HTB = HALF * BK * 2, STAGE_BYTES = 8 * HTB;
__device__ __forceinline__ int lds_byte(int r, int c) { const int st = (r >> 4) * 2 + (c >> 5), rr = r & 15, cc = c & 31, ob = rr * 64 + cc * 2; return st * 1024 + (ob ^ (((ob >> 9) & 1) << 5)); }
__device__ __forceinline__ void stage_rc(int b, int& R, int& C) { const int st = b / 1024, sb = b % 1024, swz = sb ^ (((sb >> 9) & 1) << 5); R = (st >> 1) * 16 + swz / 64; C = (st & 1) * 32 + (swz % 64) / 2; }
__device__ __forceinline__ int perm32(int rho) { const int n = rho >> 4, i = rho & 15; return 8 * (i >> 2) + 4 * n + (i & 3); }
struct Unit { int pm, pn, e; };

template <bool FP8, class Prob, class Sched, class Epi>
__device__ __forceinline__ void gemm_phase(LAS unsigned char* lds, const Prob& P, const Sched& S, const Epi& E) {
    const int tid = threadIdx.x, wid = __builtin_amdgcn_readfirstlane(tid >> 6), lane = tid & 63, wr = wid >> 2, wc = wid & 3, fr = lane & 15, fq = lane >> 4;
    const int KB = P.KB, nt = KB / 128;
    int Rr[2], Cc[2]; unsigned voffB[2];
#pragma unroll
    for (int i = 0; i < 2; ++i) { int R, C; stage_rc(tid * 16 + i * 8192, R, C); Rr[i] = R; Cc[i] = C; const int Rb = Epi::PERM ? ((R & ~31) + perm32(R & 31)) : R; voffB[i] = (unsigned)(Rb * KB + C * 2); }
    const size_t kstep = (size_t)(BK * 2);
    const size_t hstepB = (size_t)HALF * KB;
    const unsigned ldsw = (unsigned)wid * 1024u;
    const int aoff = lds_byte(wr * 64 + fr, fq * 8), boff = lds_byte(wc * 32 + fr, fq * 8);
#define PG8_SA(b, h) (((b) * 2 + (h)) * HTB)
#define PG8_SB(b, h) ((4 + (b) * 2 + (h)) * HTB)
#define PG8_STAGE(bufoff, gbase, voff) do { _Pragma("unroll") for (int _i = 0; _i < 2; ++_i) \
        __builtin_amdgcn_global_load_lds((const unsigned*)((const char*)(gbase) + (voff)[_i]), (LAS unsigned*)(lds + (bufoff) + ldsw + _i * 8192), 16, 0, 0); } while (0)
#define PG8_LD8(p) __builtin_shufflevector(*(const LAS v4i_t*)(p), *(const LAS v4i_t*)((p) + 1024), 0, 1, 2, 3, 4, 5, 6, 7)
#define PG8_LDA(dst, b, h) do { _Pragma("unroll") for (int m = 0; m < 4; ++m) dst[m] = PG8_LD8(lds + PG8_SA(b, h) + aoff + m * 2048); } while (0)
#define PG8_LDB(dst, b, h) do { _Pragma("unroll") for (int n = 0; n < 2; ++n) dst[n] = PG8_LD8(lds + PG8_SB(b, h) + boff + n * 2048); } while (0)
#define PG8_LO(x) __builtin_bit_cast(bf16x8, __builtin_shufflevector(x, x, 0, 1, 2, 3))
#define PG8_HI(x) __builtin_bit_cast(bf16x8, __builtin_shufflevector(x, x, 4, 5, 6, 7))
#ifdef EMU
#define PG8_MFMA_F8(c_, b_, a_) c_ = __builtin_amdgcn_mfma_scale_f32_16x16x128_f8f6f4(b_, a_, c_, 0, 0, 0, 0x7F7F7F7F, 0, 0x7F7F7F7F)
#else
#define PG8_MFMA_F8(c_, b_, a_) asm volatile("v_mfma_scale_f32_16x16x128_f8f6f4 %0, %1, %2, %0, %3, %3 op_sel_hi:[0,0,0]" : "+v"(c_) : "v"(b_), "v"(a_), "v"(f8one))
#endif
#define PG8_MMA(ai, bj, At, Bt) do { __builtin_amdgcn_s_setprio(1); \
        if (FP8) { _Pragma("unroll") for (int m = 0; m < 4; ++m) _Pragma("unroll") for (int n = 0; n < 2; ++n) PG8_MFMA_F8(acc[ai][bj][m][n], Bt[n], At[m]); } \
        else { _Pragma("unroll") for (int m = 0; m < 4; ++m) _Pragma("unroll") for (int n = 0; n < 2; ++n) { \
            acc[ai][bj][m][n] = __builtin_amdgcn_mfma_f32_16x16x32_bf16(PG8_LO(Bt[n]), PG8_LO(At[m]), acc[ai][bj][m][n], 0, 0, 0); \
            acc[ai][bj][m][n] = __builtin_amdgcn_mfma_f32_16x16x32_bf16(PG8_HI(Bt[n]), PG8_HI(At[m]), acc[ai][bj][m][n], 0, 0, 0); } } \
        __builtin_amdgcn_s_setprio(0); } while (0)
#define PG8_WAIT_V(n) ASM_VMCNT(n)
#define PG8_WAIT_L(n) ASM_LGKMCNT(n)
#define PG8_BAR __builtin_amdgcn_s_barrier()
#define PG8_SCHED __builtin_amdgcn_sched_barrier(0)
#ifndef EMU
    unsigned long long ge0_ = 0; const bool gprobe0_ = (PROBE_K / 10 == Epi::PID) && blockIdx.x == 0 && tid == 0;
    if (gprobe0_) ge0_ = __builtin_amdgcn_s_memrealtime();
#endif
    Unit cur, nxt; int ui = 0;
    if (!S.next(0, cur)) return;
    f32x4 acc[2][2][4][2];
#pragma unroll
    for (int a = 0; a < 2; ++a)
#pragma unroll
        for (int b = 0; b < 2; ++b)
#pragma unroll
            for (int m = 0; m < 4; ++m)
#pragma unroll
                for (int n = 0; n < 2; ++n) acc[a][b][m][n] = (f32x4){0.f, 0.f, 0.f, 0.f};
    v8i_t At[4], B0[2], B1[2];
    int f8one = 0x7F7F7F7F;
#ifndef EMU
    asm volatile("" : "+v"(f8one));
#endif
    (void)f8one;
    unsigned vA0[2], vA1[2], nA0[2], nA1[2];
#define PG8_SIDE(k) (lds + STAGE_BYTES + ((k) % 3) * 2048)
    if (Prob::SIDE) { P.side_issue(cur, PG8_SIDE(0), wid, lane); PG8_WAIT_V(0); PG8_BAR; }
#pragma unroll
    for (int i = 0; i < 2; ++i) { vA0[i] = P.a_rowoff(cur, Rr[i], PG8_SIDE(0)) + (unsigned)Cc[i] * 2u; vA1[i] = P.a_rowoff(cur, HALF + Rr[i], PG8_SIDE(0)) + (unsigned)Cc[i] * 2u; }
    const char* cA = P.a_base(cur); const char* cB = P.b_base(cur);
    PG8_STAGE(PG8_SB(0, 0), cB, voffB); PG8_STAGE(PG8_SB(0, 1), cB + hstepB, voffB); PG8_STAGE(PG8_SA(0, 0), cA, vA0); PG8_STAGE(PG8_SA(0, 1), cA, vA1);
    if (wr == 1) PG8_BAR;
    PG8_WAIT_V(2); PG8_BAR;
    PG8_STAGE(PG8_SB(1, 0), cB + kstep, voffB); PG8_STAGE(PG8_SA(1, 0), cA + kstep, vA0); PG8_STAGE(PG8_SB(1, 1), cB + hstepB + kstep, voffB);
    PG8_WAIT_V(6); PG8_BAR;
    for (;;) {
        const bool has_next = S.next(ui + 1, nxt);
        const char* nA = has_next ? P.a_base(nxt) : cA; const char* nB = has_next ? P.b_base(nxt) : cB;
        if (Prob::SIDE && has_next) P.side_issue(nxt, PG8_SIDE(ui + 1), wid, lane);
#pragma unroll
        for (int i = 0; i < 2; ++i) { nA0[i] = vA0[i]; nA1[i] = vA1[i]; }
        if (!Prob::SIDE && has_next) {
#pragma unroll
            for (int i = 0; i < 2; ++i) { nA0[i] = P.a_rowoff(nxt, Rr[i], PG8_SIDE(0)) + (unsigned)Cc[i] * 2u; nA1[i] = P.a_rowoff(nxt, HALF + Rr[i], PG8_SIDE(0)) + (unsigned)Cc[i] * 2u; }
        }
#ifndef EMU
        unsigned long long gt0_ = 0; const bool gprobe_ = (PROBE_K / 10 == Epi::PID) && blockIdx.x == 0 && tid == 0;
        if (gprobe_) { gt0_ = __builtin_amdgcn_s_memrealtime(); if (ui == 0) ((volatile LAS unsigned*)(lds + MISC_OFF))[300 + 8] += (unsigned)(gt0_ - ge0_); }
#endif
        for (int t = 0; t < nt; t += 2) {
            const bool last = (t == nt - 2);
            if (Prob::SIDE && has_next && t == nt - 4) {
#pragma unroll
                for (int i = 0; i < 2; ++i) { nA0[i] = P.a_rowoff(nxt, Rr[i], PG8_SIDE(ui + 1)) + (unsigned)Cc[i] * 2u; nA1[i] = P.a_rowoff(nxt, HALF + Rr[i], PG8_SIDE(ui + 1)) + (unsigned)Cc[i] * 2u; }
            }
            const char* a1 = cA + (size_t)(t + 1) * kstep;
            const char* a2 = last ? nA : cA + (size_t)(t + 2) * kstep; const char* b2 = last ? nB : cB + (size_t)(t + 2) * kstep;
            const char* a3 = a2 + kstep; const char* b3 = b2 + kstep;
            unsigned s0[2], s1[2];
#pragma unroll
            for (int i = 0; i < 2; ++i) { s0[i] = last ? nA0[i] : vA0[i]; s1[i] = last ? nA1[i] : vA1[i]; }
            PG8_LDB(B0, 0, 0); PG8_LDB(B1, 0, 1); PG8_SCHED; PG8_LDA(At, 0, 0); PG8_STAGE(PG8_SA(1, 1), a1, vA1);
            PG8_WAIT_V(8); PG8_WAIT_L(0); PG8_BAR; PG8_MMA(0, 0, At, B0); PG8_MMA(0, 1, At, B1); PG8_BAR; PG8_SCHED;
            PG8_LDA(At, 0, 1); PG8_STAGE(PG8_SB(0, 0), b2, voffB); PG8_STAGE(PG8_SB(0, 1), b2 + hstepB, voffB); PG8_STAGE(PG8_SA(0, 0), a2, s0);
            PG8_WAIT_V(8); PG8_WAIT_L(0); PG8_BAR; PG8_MMA(1, 0, At, B0); PG8_MMA(1, 1, At, B1); PG8_BAR; PG8_SCHED;
            PG8_LDB(B0, 1, 0); PG8_LDB(B1, 1, 1); PG8_SCHED; PG8_LDA(At, 1, 0); PG8_STAGE(PG8_SA(0, 1), a2, s1);
            PG8_WAIT_V(8); PG8_WAIT_L(0); PG8_BAR; PG8_MMA(0, 0, At, B0); PG8_MMA(0, 1, At, B1); PG8_BAR; PG8_SCHED;
            PG8_LDA(At, 1, 1); PG8_STAGE(PG8_SB(1, 0), b3, voffB); PG8_STAGE(PG8_SB(1, 1), b3 + hstepB, voffB); PG8_STAGE(PG8_SA(1, 0), a3, s0);
            PG8_WAIT_V(8); PG8_WAIT_L(0); PG8_BAR; PG8_MMA(1, 0, At, B0); PG8_MMA(1, 1, At, B1); PG8_BAR; PG8_SCHED;
        }
#ifndef EMU
        if (gprobe_) { const unsigned long long t1_ = __builtin_amdgcn_s_memrealtime(); ((volatile LAS unsigned*)(lds + MISC_OFF))[300 + 6] += (unsigned)(t1_ - gt0_); gt0_ = t1_; }
#endif
        if (wr == 0) PG8_BAR;
#ifndef EMU
        if (FP8) asm volatile("s_nop 15\n\ts_nop 15" ::: "memory");
#endif
        E(acc, cur, wr, wc, fr, fq, (const LAS float*)(PG8_SIDE(ui) + 1024));
        if (!has_next) break;
#pragma unroll
        for (int a = 0; a < 2; ++a)
#pragma unroll
            for (int b = 0; b < 2; ++b)
#pragma unroll
                for (int m = 0; m < 4; ++m)
#pragma unroll
                    for (int n = 0; n < 2; ++n) acc[a][b][m][n] = (f32x4){0.f, 0.f, 0.f, 0.f};
#ifndef EMU
        if (gprobe_) { const unsigned long long t1_ = __builtin_amdgcn_s_memrealtime(); ((volatile LAS unsigned*)(lds + MISC_OFF))[300 + 7] += (unsigned)(t1_ - gt0_); }
#endif
        cur = nxt; cA = nA; cB = nB; ++ui;
#pragma unroll
        for (int i = 0; i < 2; ++i) { vA0[i] = nA0[i]; vA1[i] = nA1[i]; }
        if (wr == 1) PG8_BAR;
    }
#ifndef EMU
    if (gprobe0_) ge0_ = __builtin_amdgcn_s_memrealtime();
#endif
    PG8_WAIT_V(0);
    PG8_BAR;
#ifndef EMU
    if (gprobe0_) ((volatile LAS unsigned*)(lds + MISC_OFF))[300 + 9] += (unsigned)(__builtin_amdgcn_s_memrealtime() - ge0_);
#endif
#undef PG8_SIDE
#undef PG8_SA
#undef PG8_SB
#undef PG8_STAGE
#undef PG8_LDA
#undef PG8_LDB
#undef PG8_MMA
#undef PG8_MFMA_F8
#undef PG8_LD8
#undef PG8_LO
#undef PG8_HI
#undef PG8_WAIT_V
#undef PG8_WAIT_L
#undef PG8_BAR
#undef PG8_SCHED
}

struct DenseOrder {
    int nM, nN, nwg, G, c;
    __device__ __forceinline__ void init(int M, int N, int G_, int c_) { nM = M / BM; nN = N / BM; nwg = nM * nN; G = G_; c = c_; }
    __device__ __forceinline__ bool next(int i, Unit& u) const {
        const long L = (long)i * G + c; if (L >= nwg) return false;
        int wgid = (int)L; { const int q = nwg / 8, r = nwg % 8, xcd = wgid % 8, off = wgid / 8; wgid = (xcd < r ? xcd * (q + 1) : r * (q + 1) + (xcd - r) * q) + off; }
        const int nig = 8 * nN, gid = wgid / nig, fm = gid * 8, gsz = (nM - fm) < 8 ? (nM - fm) : 8;
        u.pm = fm + ((wgid % nig) % gsz); u.pn = (wgid % nig) / gsz; u.e = 0; return true;
    }
};
struct DenseProb {
    static constexpr bool SIDE = false;
    const char* A; const char* Bt; int KB;
    __device__ __forceinline__ const char* a_base(const Unit& u) const { return A + (size_t)u.pm * BM * KB; }
    __device__ __forceinline__ unsigned a_rowoff(const Unit&, int r, const LAS unsigned char*) const { return (unsigned)(r * KB); }
    __device__ __forceinline__ const char* b_base(const Unit& u) const { return Bt + (size_t)u.pn * BM * KB; }
    __device__ __forceinline__ void side_issue(const Unit&, LAS unsigned char*, int, int) const {}
};
struct MoeOrder {
    volatile LAS unsigned* tpfx; int nN, G, c;
    mutable int ecur;
    __device__ __forceinline__ bool next(int i, Unit& u) const {
        const int L = i * G + c; const int total = (int)tpfx[NE] * nN; if (L >= total) return false;
        int e = ecur;
        if (L < (int)tpfx[e] * nN) e = 0;
        while (L >= (int)tpfx[e + 1] * nN) ++e;
        ecur = e;
        const int rem = L - (int)tpfx[e] * nN, tm = (int)tpfx[e + 1] - (int)tpfx[e];
        u.e = e; u.pm = rem % tm; u.pn = rem / tm; return true;
    }
};
}

struct EpiZ {
    static constexpr bool PERM = true; static constexpr int PID = 2;
    bf16_t* O;
    __device__ __forceinline__ void operator()(const f32x4 (&acc)[2][2][4][2], const pg8::Unit& u, int wr, int wc, int fr, int fq, const LAS float*) const {
        const int row0 = u.pm * 256 + wr * 64 + fr, col0 = u.pn * 256 + wc * 32 + 8 * fq;
#pragma unroll
        for (int ai = 0; ai < 2; ++ai)
#pragma unroll
            for (int m = 0; m < 4; ++m) { bf16_t* rowp = O + (size_t)(row0 + ai * 128 + m * 16) * ZP + col0;
#pragma unroll
                for (int bj = 0; bj < 2; ++bj) { const f32x4 v0 = acc[ai][bj][m][0], v1 = acc[ai][bj][m][1];
                    u32x4 w; w.x = pk2(v0[0], v0[1]); w.y = pk2(v0[2], v0[3]); w.z = pk2(v1[0], v1[1]); w.w = pk2(v1[2], v1[3]);
                    *(u32x4*)(rowp + bj * 128) = w; } }
    }
};
struct EpiMix {
    static constexpr bool PERM = true; static constexpr int PID = 5;
    bf16_t* O;
    __device__ __forceinline__ void operator()(const f32x4 (&acc)[2][2][4][2], const pg8::Unit& u, int wr, int wc, int fr, int fq, const LAS float*) const {
        const int row0 = u.pm * 256 + wr * 64 + fr, col0 = u.pn * 256 + wc * 32 + 8 * fq;
#pragma unroll
        for (int ai = 0; ai < 2; ++ai)
#pragma unroll
            for (int m = 0; m < 4; ++m) { bf16_t* rowp = O + (size_t)(row0 + ai * 128 + m * 16) * DM + col0;
#pragma unroll
                for (int bj = 0; bj < 2; ++bj) { const f32x4 v0 = acc[ai][bj][m][0], v1 = acc[ai][bj][m][1];
                    u32x4 w; w.x = pk2(v0[0], v0[1]); w.y = pk2(v0[2], v0[3]); w.z = pk2(v1[0], v1[1]); w.w = pk2(v1[2], v1[3]);
                    *(u32x4*)(rowp + bj * 128) = w; } }
    }
};
struct EpiAct {
    static constexpr bool PERM = true; static constexpr int PID = 7;
    unsigned char* O; const float* bgu; volatile LAS unsigned* roff;
    __device__ __forceinline__ void operator()(const f32x4 (&acc)[2][2][4][2], const pg8::Unit& u, int wr, int wc, int fr, int fq, const LAS float* sb) const {
        const int row0 = (int)roff[u.e] + u.pm * 256 + wr * 64 + fr, col0 = u.pn * 128 + wc * 32 + 8 * fq;
        const LAS float* bp = sb + 2 * (wc * 32 + 8 * fq);
        f32x4 bb[4];
#pragma unroll
        for (int j = 0; j < 4; ++j) bb[j] = *(const LAS f32x4*)(bp + 4 * j);
#pragma unroll
        for (int ai = 0; ai < 2; ++ai)
#pragma unroll
            for (int m = 0; m < 4; ++m) { float a8[8];
#pragma unroll
                for (int n = 0; n < 2; ++n)
#pragma unroll
                    for (int j = 0; j < 4; ++j) { const int cc = 4 * n + j;
                        float g = acc[ai][0][m][n][j] * F8_ACC_SCALE + bb[cc >> 1][(cc & 1) * 2], l = acc[ai][1][m][n][j] * F8_ACC_SCALE + bb[cc >> 1][(cc & 1) * 2 + 1];
                        g = fminf(g, 7.0f); l = fminf(fmaxf(l, -7.0f), 7.0f);
                        a8[cc] = (g * F8_ACT_SCALE) * __builtin_amdgcn_rcpf(1.0f + fexp2(g * (-1.702f * LOG2E))) * (l + 1.0f); }
                u32x2 w; w.x = pk4_fp8_nc(a8[0], a8[1], a8[2], a8[3]); w.y = pk4_fp8_nc(a8[4], a8[5], a8[6], a8[7]);
                *(u32x2*)(O + (size_t)(row0 + ai * 128 + m * 16) * DFF + col0) = w; }
    }
};
struct EpiYd {
    static constexpr bool PERM = true; static constexpr int PID = 8;
    bf16_t* O; const float* bdn; volatile LAS unsigned* roff;
    __device__ __forceinline__ void operator()(const f32x4 (&acc)[2][2][4][2], const pg8::Unit& u, int wr, int wc, int fr, int fq, const LAS float* sb) const {
        const int row0 = (int)roff[u.e] + u.pm * 256 + wr * 64 + fr, col0 = u.pn * 256 + wc * 32 + 8 * fq;
        f32x4 bv[2][2];
#pragma unroll
        for (int bj = 0; bj < 2; ++bj)
#pragma unroll
            for (int n = 0; n < 2; ++n) bv[bj][n] = *(const LAS f32x4*)(sb + wc * 32 + 8 * fq + bj * 128 + 4 * n);
#pragma unroll
        for (int ai = 0; ai < 2; ++ai)
#pragma unroll
            for (int m = 0; m < 4; ++m) { bf16_t* rowp = O + (size_t)(row0 + ai * 128 + m * 16) * DM + col0;
#pragma unroll
                for (int bj = 0; bj < 2; ++bj) { const f32x4 v0 = acc[ai][bj][m][0] * F8_ACC_SCALE + bv[bj][0], v1 = acc[ai][bj][m][1] * F8_ACC_SCALE + bv[bj][1];
                    u32x4 w; w.x = pk2(v0[0], v0[1]); w.y = pk2(v0[2], v0[3]); w.z = pk2(v1[0], v1[1]); w.w = pk2(v1[2], v1[3]);
                    *(u32x4*)(rowp + bj * 128) = w; } }
    }
};
struct MoeProb1 {
    static constexpr bool SIDE = true;
    const char* H2; const char* Bt; const int* lists; const float* bias; volatile LAS unsigned* cnt; int KB;
    __device__ __forceinline__ const char* a_base(const pg8::Unit&) const { return H2; }
    __device__ __forceinline__ unsigned a_rowoff(const pg8::Unit& u, int r, const LAS unsigned char* side) const { const int i = u.pm * 256 + r; const int tok = (i < (int)cnt[u.e]) ? ((const LAS int*)side)[r] : 0; return (unsigned)tok * 1024u; }
    __device__ __forceinline__ const char* b_base(const pg8::Unit& u) const { return Bt + ((size_t)u.e * 2048 + (size_t)u.pn * 256) * 1024; }
    __device__ __forceinline__ void side_issue(const pg8::Unit& u, LAS unsigned char* side, int wid, int lane) const {
        if (wid == 0) __builtin_amdgcn_global_load_lds((const unsigned*)(lists + (size_t)u.e * T + u.pm * 256 + lane * 4), (LAS unsigned*)side, 16, 0, 0);
        if (wid == 1) __builtin_amdgcn_global_load_lds((const unsigned*)(bias + (size_t)u.e * 2048 + u.pn * 256 + lane * 4), (LAS unsigned*)(side + 1024), 16, 0, 0);
    }
};
struct MoeProb2 {
    static constexpr bool SIDE = true;
    const char* A; const char* Bt; const float* bias; volatile LAS unsigned* roff; int KB;
    __device__ __forceinline__ const char* a_base(const pg8::Unit& u) const { return A + ((size_t)roff[u.e] + (size_t)u.pm * 256) * 1024; }
    __device__ __forceinline__ unsigned a_rowoff(const pg8::Unit&, int r, const LAS unsigned char*) const { return (unsigned)r * 1024u; }
    __device__ __forceinline__ const char* b_base(const pg8::Unit& u) const { return Bt + ((size_t)u.e * 1024 + (size_t)u.pn * 256) * 1024; }
    __device__ __forceinline__ void side_issue(const pg8::Unit& u, LAS unsigned char* side, int wid, int lane) const {
        if (wid == 1) __builtin_amdgcn_global_load_lds((const unsigned*)(bias + (size_t)u.e * 1024 + u.pn * 256 + lane * 4), (LAS unsigned*)(side + 1024), 16, 0, 0);
    }
};

template <int NB>
__device__ __forceinline__ void gemv_item(Frame& F, const float* vec, int vstride, const float* W, int K, int N, int n0, const float* bias, float* out, int ostride) {
    LAS float* red = (LAS float*)F.lds;
    const int col = n0 + F.lane, ks = K / NWAVES;
    float acc[NB];
#pragma unroll
    for (int b = 0; b < NB; ++b) acc[b] = 0.f;
    for (int k0 = F.wave * ks; k0 < (F.wave + 1) * ks; k0 += 32) {
        float wv[32];
#pragma unroll
        for (int j = 0; j < 32; ++j) wv[j] = __builtin_nontemporal_load(W + (size_t)(k0 + j) * N + col);
#pragma unroll
        for (int j = 0; j < 32; ++j)
#pragma unroll
            for (int b = 0; b < NB; ++b) acc[b] += vec[b * vstride + k0 + j] * wv[j]; }
#pragma unroll
    for (int b = 0; b < NB; ++b) red[(F.wave * NB + b) * 64 + F.lane] = acc[b];
    __syncthreads();
    if (F.wave == 0) {
#pragma unroll
        for (int b = 0; b < NB; ++b) { float s = bias ? bias[col] : 0.f;
            for (int w = 0; w < NWAVES; ++w) s += red[(w * NB + b) * 64 + F.lane];
            out[b * ostride + col] = s; }
    }
    __syncthreads();
}
template <int MAP>
__device__ __forceinline__ int t_rowmap(int n) {
    if (MAP == 0) return n;
    const int ac = n >> 1, bj = n & 1; return (ac >> 7) * 256 + bj * 128 + (ac & 127);
}
template <int MAP>
__device__ __forceinline__ void transpose_item(const float* W, int K, int Nsrc, int nblk, bf16_t* WT, LAS float* scr, int item, int lane) {
    const int kb = item / nblk, nb = item % nblk, k0 = 64 * kb, n0 = 32 * nb;
    const int nc = n0 + (lane & 31);
    float tv[32];
    if (nc < Nsrc) {
#pragma unroll
        for (int i = 0; i < 32; ++i) tv[i] = __builtin_nontemporal_load(W + (size_t)(k0 + 2 * i + (lane >> 5)) * Nsrc + nc);
    } else {
#pragma unroll
        for (int i = 0; i < 32; ++i) tv[i] = 0.f;
    }
#pragma unroll
    for (int i = 0; i < 32; ++i) scr[(2 * i + (lane >> 5)) * 33 + (lane & 31)] = tv[i];
    WAVE_SYNC(); FENCE();
    const int c = lane & 7;
#pragma unroll
    for (int j = 0; j < 4; ++j) { const int n = (lane >> 3) + 8 * j; const LAS float* s = scr + (8 * c) * 33 + n;
        u32x4 o; o.x = pk2(s[0 * 33], s[1 * 33]); o.y = pk2(s[2 * 33], s[3 * 33]); o.z = pk2(s[4 * 33], s[5 * 33]); o.w = pk2(s[6 * 33], s[7 * 33]);
        *(u32x4*)(WT + (size_t)t_rowmap<MAP>(n0 + n) * K + k0 + 8 * c) = o; }
    WAVE_SYNC(); FENCE();
}
template <int MAP>
__device__ __forceinline__ void transpose_item_f8(const float* W, int K, int Nsrc, int nblk, unsigned char* WT, LAS float* scr, int item, int lane, float scale) {
    const int kb = item / nblk, nb = item % nblk, k0 = 64 * kb, n0 = 32 * nb;
    const int nc = n0 + (lane & 31);
    (void)nc;
    f32x4 tv[8];
#pragma unroll
    for (int i = 0; i < 8; ++i) tv[i] = __builtin_nontemporal_load((const f32x4*)(W + (size_t)(k0 + 8 * i + (lane >> 3)) * Nsrc + n0 + 4 * (lane & 7)));
#pragma unroll
    for (int i = 0; i < 8; ++i) { LAS float* d = scr + (8 * i + (lane >> 3)) * 33 + 4 * (lane & 7);
        d[0] = tv[i][0] * scale; d[1] = tv[i][1] * scale; d[2] = tv[i][2] * scale; d[3] = tv[i][3] * scale; }
    WAVE_SYNC(); FENCE();
    const int c = lane & 7;
#pragma unroll
    for (int j = 0; j < 4; ++j) { const int n = (lane >> 3) + 8 * j; const LAS float* sp = scr + (8 * c) * 33 + n;
        u32x2 o; o.x = pk4_fp8(sp[0 * 33], sp[1 * 33], sp[2 * 33], sp[3 * 33]); o.y = pk4_fp8(sp[4 * 33], sp[5 * 33], sp[6 * 33], sp[7 * 33]);
        *(u32x2*)(WT + (size_t)t_rowmap<MAP>(n0 + n) * K + k0 + 8 * c) = o; }
    WAVE_SYNC(); FENCE();
}
constexpr int P0_I_IN = (DM / 64) * (ZP / 32), P0_I_OUT = (DM / 64) * (DM / 32), P0_I_W1 = (2048 / 64) * (256 / 32), P0_I_W2 = (256 / 64) * (64 / 32);
constexpr int P0_I_GU1 = (DM / 64) * (2048 / 32), P0_I_DN1 = (DFF / 64) * (DM / 32);
constexpr int P0_NITEMS = P0_I_IN + P0_I_OUT + 2 * P0_I_W1 + 2 * P0_I_W2 + NE * P0_I_GU1 + NE * P0_I_DN1;
constexpr int P2_FILL_PER_CU = 44;
__device__ __forceinline__ int p2_fill_items(const Frame& F) { return (F.G == 256 && (T / 256) * (ZP / 256) == 640) ? 128 * P2_FILL_PER_CU : 0; }
#ifndef P7_FILL_ITEMS
#define P7_FILL_ITEMS 5632
#endif
__device__ __forceinline__ int p7_fill_items(const Frame& F) { return (F.G >= 8) ? P7_FILL_ITEMS : 0; }
__device__ __forceinline__ void p0_item(Frame& F, LAS float* scr, int it) {
    int r = it;
    if (r < P0_I_IN) { transpose_item<0>(F.in[I_WIN], DM, INC, ZP / 32, (bf16_t*)(F.ws + WS_WINT), scr, r, F.lane); return; } r -= P0_I_IN;
    if (r < P0_I_OUT) { transpose_item<0>(F.in[I_WOUT], DM, DM, DM / 32, (bf16_t*)(F.ws + WS_WOUTT), scr, r, F.lane); return; } r -= P0_I_OUT;
    if (r < P0_I_W1) { transpose_item<0>(F.in[I_W1K], 2048, 256, 8, (bf16_t*)(F.ws + WS_W1KT), scr, r, F.lane); return; } r -= P0_I_W1;
    if (r < P0_I_W1) { transpose_item<0>(F.in[I_W1V], 2048, 256, 8, (bf16_t*)(F.ws + WS_W1VT), scr, r, F.lane); return; } r -= P0_I_W1;
    if (r < P0_I_W2) { transpose_item<0>(F.in[I_W2K], 256, 64, 2, (bf16_t*)(F.ws + WS_W2KT), scr, r, F.lane); return; } r -= P0_I_W2;
    if (r < P0_I_W2) { transpose_item<0>(F.in[I_W2V], 256, 64, 2, (bf16_t*)(F.ws + WS_W2VT), scr, r, F.lane); return; } r -= P0_I_W2;
    if (r < NE * P0_I_GU1) { const int e = r / P0_I_GU1; transpose_item_f8<1>(F.in[I_WGU] + (size_t)e * DM * 2048, DM, 2048, 64, (unsigned char*)(F.ws + WS_WGUT) + (size_t)e * 2048 * DM, scr, r % P0_I_GU1, F.lane, F8_W_SCALE); return; } r -= NE * P0_I_GU1;
    { const int e = r / P0_I_DN1; transpose_item_f8<0>(F.in[I_WDN] + (size_t)e * DFF * DM, DFF, DM, 32, (unsigned char*)(F.ws + WS_WDNT) + (size_t)e * DM * DFF, scr, r % P0_I_DN1, F.lane, F8_W_SCALE); }
}
__device__ __forceinline__ void p0_prologue(Frame& F) {
    for (int it = F.vcu; it < 96 + 8; it += F.G) {
        if (it < 96) gemv_item<BATCH>(F, F.in[I_C], DM, F.in[I_WADA], DM, 6 * DM, 64 * it, F.in[I_BADA], (float*)(F.ws + WS_MOD), 6 * DM);
        else { const int j = it - 96, kv = j >> 2, n0 = (j & 3) * 64;
            gemv_item<1>(F, F.in[kv ? I_PEV : I_PEK], 0, F.in[kv ? I_W1V : I_W1K], 2048, 256, n0, nullptr, (float*)(F.ws + WS_BPE) + kv * 256, 0); }
    }
    { const float* src = F.in[I_GMWS]; bf16_t* dst = (bf16_t*)(F.ws + WS_WSBF);
      for (int idx = F.vcu * NTHREADS + F.tid; idx < GMG * GMC * GMC; idx += F.G * NTHREADS) { const int i = (idx >> 7) & 127, j = idx & 127; dst[idx] = (bf16_t)f2bf(j <= i ? src[idx] : 0.f); } }
    LAS float* scr = (LAS float*)(F.lds + 8192 + F.wave * 16384);
    const int gw = F.vcu * NWAVES + F.wave, NGW = F.G * NWAVES;
    const int nit = P0_NITEMS - p2_fill_items(F) - p7_fill_items(F);
    constexpr int NGEMV = 96 + 8;
    const int shift = (F.G > 2 * NGEMV) ? 2 * NGEMV * NWAVES : 0, n1 = nit - shift;
    for (int it = gw; it < n1; it += NGW) p0_item(F, scr, it);
    if (shift && F.vcu >= NGEMV) for (int it = n1 + (F.vcu - NGEMV) * NWAVES + F.wave; it < nit; it += (F.G - NGEMV) * NWAVES) p0_item(F, scr, it);
}

__device__ __forceinline__ void norm_rows(Frame& F, const float* xin, const float* g, int mod_shift, int mod_scale, bf16_t* outb) {
    const int gw = F.vcu * NWAVES + F.wave, NGW = F.G * NWAVES;
    const float* mod = (const float*)(F.ws + WS_MOD);
    for (int m0 = gw; m0 < T / 2; m0 += NGW) {
        f32x4 v[2][4]; float s[2] = {0.f, 0.f};
#pragma unroll
        for (int q = 0; q < 2; ++q) { const f32x4* xr = (const f32x4*)(xin + (size_t)(m0 + q * (T / 2)) * DM) + F.lane;
#pragma unroll
            for (int j = 0; j < 4; ++j) v[q][j] = __builtin_nontemporal_load(xr + 64 * j); }
#pragma unroll
        for (int q = 0; q < 2; ++q)
#pragma unroll
            for (int j = 0; j < 4; ++j) s[q] += (v[q][j][0] * v[q][j][0] + v[q][j][1] * v[q][j][1]) + (v[q][j][2] * v[q][j][2] + v[q][j][3] * v[q][j][3]);
#pragma unroll
        for (int o = 1; o < 64; o <<= 1) { s[0] += __shfl_xor(s[0], o); s[1] += __shfl_xor(s[1], o); }
#pragma unroll
        for (int q = 0; q < 2; ++q) { const int m = m0 + q * (T / 2), b = m / SEQ;
            const float rinv = __builtin_amdgcn_rsqf(s[q] * (1.0f / DM) + EPS);
            u32x2* o8 = (u32x2*)(outb + (size_t)m * DM) + F.lane;
#pragma unroll
            for (int j = 0; j < 4; ++j) { const int c = 4 * F.lane + 256 * j;
                const f32x4 gg = *(const f32x4*)(g + c), sc = *(const f32x4*)(mod + (size_t)b * 6144 + mod_scale * 1024 + c), sh = *(const f32x4*)(mod + (size_t)b * 6144 + mod_shift * 1024 + c);
                const f32x4 h = v[q][j] * rinv * gg * (sc + 1.0f) + sh;
                u32x2 w; w.x = pk2(h[0], h[1]); w.y = pk2(h[2], h[3]); o8[64 * j] = w; } }
    }
}

struct GmRegs { u32x4 v[2], u[2]; };
__device__ __forceinline__ void gmlp_load(Frame& F, int tile, GmRegs& R) {
    const int g = tile % GMG, ch = (tile / GMG) % (SEQ / GMC), b = tile / (GMG * (SEQ / GMC));
    const size_t row0 = (size_t)b * SEQ + (size_t)ch * GMC;
    const bf16_t* ZB = (const bf16_t*)(F.ws + WS_ZB);
#pragma unroll
    for (int it = 0; it < 2; ++it) { const int idx = F.tid + it * NTHREADS, row = idx >> 3, c8 = idx & 7;
        R.v[it] = *(const u32x4*)(ZB + (row0 + row) * ZP + ZC_V + g * 64 + c8 * 8);
        R.u[it] = *(const u32x4*)(ZB + (row0 + row) * ZP + ZC_U + g * 64 + c8 * 8); }
}
__device__ __forceinline__ void gmlp_compute(Frame& F, int tile, const GmRegs& R) {
    const int g = tile % GMG, ch = (tile / GMG) % (SEQ / GMC), b = tile / (GMG * (SEQ / GMC));
    const size_t row0 = (size_t)b * SEQ + (size_t)ch * GMC;
    LAS bf16_t* Vt = (LAS bf16_t*)F.lds;
    constexpr int VP = 136, UP = 68;
    LAS float* Us = (LAS float*)(F.lds + 64 * VP * 2);
    const float* gn = F.in[I_GMNG] + g * 64;
    const int fr = F.lane & 15, fq = F.lane >> 4, w = F.wave;
    const bf16_t* Wg = (const bf16_t*)(F.ws + WS_WSBF) + (size_t)g * GMC * GMC;
    bf16x8 af[4];
#pragma unroll
    for (int ks = 0; ks < 4; ++ks) af[ks] = *(const bf16x8*)(Wg + (size_t)(16 * w + fr) * GMC + 32 * ks + 8 * fq);
#pragma unroll
    for (int it = 0; it < 2; ++it) {
        const int idx = F.tid + it * NTHREADS, row = idx >> 3, c8 = idx & 7;
        const u32x4 raw = R.v[it];
        float v[8]; v[0] = bflo(raw.x); v[1] = bfhi(raw.x); v[2] = bflo(raw.y); v[3] = bfhi(raw.y); v[4] = bflo(raw.z); v[5] = bfhi(raw.z); v[6] = bflo(raw.w); v[7] = bfhi(raw.w);
        float ss = 0.f;
#pragma unroll
        for (int e = 0; e < 8; ++e) { v[e] = gelu_tanh(v[e]); ss += v[e] * v[e]; }
        ss += __shfl_xor(ss, 1); ss += __shfl_xor(ss, 2); ss += __shfl_xor(ss, 4);
        const float rinv = __builtin_amdgcn_rsqf(ss * (1.0f / 64.0f) + EPS);
#pragma unroll
        for (int e = 0; e < 8; ++e) Vt[(c8 * 8 + e) * VP + row] = (bf16_t)f2bf(v[e] * rinv * gn[c8 * 8 + e]);
        const u32x4 ur = R.u[it];
        f32x4 u0 = {gelu_tanh(bflo(ur.x)), gelu_tanh(bfhi(ur.x)), gelu_tanh(bflo(ur.y)), gelu_tanh(bfhi(ur.y))}, u1 = {gelu_tanh(bflo(ur.z)), gelu_tanh(bfhi(ur.z)), gelu_tanh(bflo(ur.w)), gelu_tanh(bfhi(ur.w))};
        *(LAS f32x4*)(Us + row * UP + c8 * 8) = u0; *(LAS f32x4*)(Us + row * UP + c8 * 8 + 4) = u1;
    }
    __syncthreads();
    f32x4 acc[4];
#pragma unroll
    for (int n = 0; n < 4; ++n) acc[n] = (f32x4){0.f, 0.f, 0.f, 0.f};
#pragma unroll
    for (int ks = 0; ks < 4; ++ks) {
        if (32 * ks <= 16 * w + 15) {
#pragma unroll
            for (int n = 0; n < 4; ++n) { const bf16x8 bb = *(const LAS bf16x8*)(Vt + (16 * n + fr) * VP + 32 * ks + 8 * fq);
                acc[n] = __builtin_amdgcn_mfma_f32_16x16x32_bf16(af[ks], bb, acc[n], 0, 0, 0); }
        }
    }
    bf16_t* Y = (bf16_t*)(F.ws + WS_YMIX);
    const float* bs = F.in[I_GMBS] + g * GMC;
#pragma unroll
    for (int n = 0; n < 4; ++n)
#pragma unroll
        for (int r = 0; r < 4; ++r) { const int i = 16 * w + 4 * fq + r, d = 16 * n + fr;
            Y[(row0 + i) * DM + g * 64 + d] = (bf16_t)f2bf(Us[i * UP + d] * (acc[n][r] + bs[i])); }
    __syncthreads();
}
__device__ __forceinline__ void gmlp_run(Frame& F, int base, int stride, int n) {
    if (n <= 0) return;
    GmRegs A, B;
    gmlp_load(F, base, A);
    for (int k = 0; k < n; k += 2) {
        if (k + 1 < n) gmlp_load(F, base + (k + 1) * stride, B);
        gmlp_compute(F, base + k * stride, A);
        if (k + 1 < n) { if (k + 2 < n) gmlp_load(F, base + (k + 2) * stride, A); gmlp_compute(F, base + (k + 1) * stride, B); }
    }
}

__device__ __forceinline__ void cmp_tile(Frame& F, int tile) {
    constexpr int NT = NCP / 32;
    const int nt = tile % NT, g = (tile / NT) % NG, b = (tile / (NT * NG)) % BATCH, kv = tile / (NT * NG * BATCH);
    const int n0 = 32 * nt, p0 = 16 * n0;
    const bf16_t* ZB = (const bf16_t*)(F.ws + WS_ZB);
    constexpr int RP = 72;
    LAS bf16_t* Rs = (LAS bf16_t*)F.lds;
    LAS bf16_t* Hs = (LAS bf16_t*)(F.lds + 528 * RP * 2);
    constexpr int HP = 264;
    const int zc = (kv ? ZC_VC : ZC_KC) + g * 64;
    {
        u32x4 sv[9];
#pragma unroll
        for (int it = 0; it < 9; ++it) { const int idx = F.tid + it * NTHREADS, row = idx >> 3, c8 = idx & 7; const int p = p0 + row;
            sv[it] = (u32x4){0u, 0u, 0u, 0u};
            if (idx < 528 * 8 && p < SEQ) sv[it] = *(const u32x4*)(ZB + ((size_t)b * SEQ + p) * ZP + zc + c8 * 8); }
#pragma unroll
        for (int it = 0; it < 9; ++it) { const int idx = F.tid + it * NTHREADS, row = idx >> 3, c8 = idx & 7;
            if (idx < 528 * 8) *(LAS u32x4*)(Rs + row * RP + c8 * 8) = sv[it]; }
    }
    __syncthreads();
    const int i = F.lane & 31, hi = F.lane >> 5, w = F.wave;
    const bf16_t* W1T = (const bf16_t*)(F.ws + (kv ? WS_W1VT : WS_W1KT)) + (size_t)(32 * w + i) * 2048;
    f32x16 acc;
#pragma unroll
    for (int r = 0; r < 16; ++r) acc[r] = 0.f;
    bf16x8 bq[16];
#pragma unroll
    for (int j = 0; j < 16; ++j) bq[j] = *(const bf16x8*)(W1T + 16 * j + 8 * hi);
    for (int kb = 0; kb < 8; ++kb) {
        bf16x8 bn[16];
        const int kn = (kb < 7) ? (kb + 1) * 16 : kb * 16;
#pragma unroll
        for (int j = 0; j < 16; ++j) bn[j] = *(const bf16x8*)(W1T + 16 * (kn + j) + 8 * hi);
#pragma unroll
        for (int j = 0; j < 16; ++j) { const int kk = kb * 16 + j; const int l = kk >> 2, d = (16 * j + 8 * hi) & 63;
            const bf16x8 a = *(const LAS bf16x8*)(Rs + (16 * i + l) * RP + d);
            acc = __builtin_amdgcn_mfma_f32_32x32x16_bf16(a, bq[j], acc, 0, 0, 0); }
#pragma unroll
        for (int j = 0; j < 16; ++j) bq[j] = bn[j];
    }
    const float bpe = ((const float*)(F.ws + WS_BPE))[kv * 256 + 32 * w + i];
#pragma unroll
    for (int r = 0; r < 16; ++r) Hs[crow(r, hi) * HP + 32 * w + i] = (bf16_t)f2bf(gelu_tanh(acc[r] + bpe));
    __syncthreads();
    if (w < 2) {
        const bf16_t* W2T = (const bf16_t*)(F.ws + (kv ? WS_W2VT : WS_W2KT)) + (size_t)(32 * w + i) * 256;
        f32x16 o;
#pragma unroll
        for (int r = 0; r < 16; ++r) o[r] = 0.f;
        for (int kk = 0; kk < 16; ++kk) {
            const bf16x8 a = *(const LAS bf16x8*)(Hs + i * HP + 16 * kk + 8 * hi);
            const bf16x8 bb = *(const bf16x8*)(W2T + 16 * kk + 8 * hi);
            o = __builtin_amdgcn_mfma_f32_32x32x16_bf16(a, bb, o, 0, 0, 0);
        }
        bf16_t* KC = (bf16_t*)(F.ws + (kv ? WS_VC : WS_KC)) + ((size_t)(b * NG + g) * NCP) * 64;
#pragma unroll
        for (int r = 0; r < 16; ++r) { const int n = n0 + crow(r, hi); KC[(size_t)n * 64 + 32 * w + i] = (n < NCMP) ? (bf16_t)f2bf(o[r]) : (bf16_t)0; }
    }
    __syncthreads();
}

constexpr int KPB = 128;
constexpr int NB_K = 64 * KPB;
constexpr int V_H1 = 4096;
constexpr int NB_BUF = NB_K + 8192;
constexpr int A_IMP = 3 * NB_BUF, A_SEL = A_IMP + 64 * 128 * 4, A_UNI = A_SEL + 64 * 8 * 2, A_WSF = A_UNI + 256, A_QF = A_WSF + 8 * 32 * 4, A_Y = A_QF + 8 * 4096, A_GATE = A_Y + 8 * 4096, A_END = A_GATE + 8 * 32 * 3 * 4;
static_assert(A_END <= MISC_OFF, "NSA LDS map");
#ifndef NSA_THR_VAL
#define NSA_THR_VAL 20.0f
#endif
constexpr float NSA_THR = NSA_THR_VAL, NEG_BIG = -1e30f;

#ifdef EMU
__device__ __forceinline__ int opaque_lane(int l) { return l; }
#else
__device__ __forceinline__ int opaque_lane(int) { int x; asm volatile("v_mbcnt_lo_u32_b32 %0, -1, 0\n\tv_mbcnt_hi_u32_b32 %0, -1, %0" : "=v"(x)); return x; }
#endif
#ifdef EMU
__device__ __forceinline__ int red8_add(int v) { v += __shfl_xor(v, 1); v += __shfl_xor(v, 2); v += __shfl_xor(v, 4); return v; }
__device__ __forceinline__ float quad_sum(float v) { v += __shfl_xor(v, 1); v += __shfl_xor(v, 2); return v; }
__device__ __forceinline__ float xor32f(float v) { return __shfl_xor(v, 32); }
#else
__device__ __forceinline__ int red8_add(int v) {
    v += __builtin_amdgcn_update_dpp(0, v, 0xB1, 0xF, 0xF, true);
    v += __builtin_amdgcn_update_dpp(0, v, 0x4E, 0xF, 0xF, true);
    v += __builtin_amdgcn_update_dpp(0, v, 0x141, 0xF, 0xF, true);
    return v;
}
__device__ __forceinline__ float quad_sum(float v) {
    v += __builtin_bit_cast(float, __builtin_amdgcn_update_dpp(0, __builtin_bit_cast(int, v), 0xB1, 0xF, 0xF, true));
    v += __builtin_bit_cast(float, __builtin_amdgcn_update_dpp(0, __builtin_bit_cast(int, v), 0x4E, 0xF, 0xF, true));
    return v;
}
__device__ __forceinline__ float xor32f(float v) {
    const unsigned u = __builtin_bit_cast(unsigned, v); auto rr = __builtin_amdgcn_permlane32_swap(u, u, false, false);
    return __builtin_bit_cast(float, (threadIdx.x & 32) ? rr[0] : rr[1]);
}
#endif

template <bool WITHV>
__device__ __forceinline__ void stage_dma(LAS unsigned char* buf, const bf16_t* Kg, const bf16_t* Vg, size_t pitch, long rbase, int wave, int lane) {
    const int krow = 8 * wave + (lane >> 3), kc = (lane & 7) ^ ((lane >> 3) & 7);
    __builtin_amdgcn_global_load_lds((const unsigned*)(Kg + (size_t)(rbase + krow) * pitch + kc * 8), (LAS unsigned*)(buf + wave * 1024), 16, 0, 0);
    if (WITHV) { const int vrow = 16 * (wave & 3) + (lane >> 2), vc = (wave >> 2) * 4 + (lane & 3);
        __builtin_amdgcn_global_load_lds((const unsigned*)(Vg + (size_t)(rbase + vrow) * pitch + vc * 8), (LAS unsigned*)(buf + NB_K + wave * 1024), 16, 0, 0); }
}
struct BrState { float mref, l; int has; unsigned qxm; f32x16 o0, o1; };
__device__ __forceinline__ unsigned ref_words(float m, float& meff) { const unsigned mh = f2bf(m); const float fh = bf2f((unsigned short)mh); const unsigned ml = f2bf(m - fh); meff = fh + bf2f((unsigned short)ml); return mh | (ml << 16); }

#ifdef EMU
#define VTR(p) __builtin_amdgcn_ds_read_tr16_b64_v4i16(p)
#else
typedef short v4i16_t __attribute__((ext_vector_type(4)));
#define VTR(p) __builtin_bit_cast(s16x4, __builtin_amdgcn_ds_read_tr16_b64_v4i16((LAS v4i16_t*)(p)))
#endif

__device__ __forceinline__ void nsa_qk(const LAS unsigned char* buf, const LAS unsigned char* qfl, unsigned qxs, unsigned qxm_t, unsigned klw0, unsigned klw1, unsigned tbw, unsigned neg1w,
                                       f32x16& p0, f32x16& p1, int lane) {
    const int i = lane & 31, hi = lane >> 5;
    const bf16x8 qx = __builtin_bit_cast(bf16x8, ((u32x4){qxs, qxs, qxm_t, 0u}));
    const bf16x8 kx0 = __builtin_bit_cast(bf16x8, ((u32x4){klw0, tbw, neg1w, 0u})), kx1 = __builtin_bit_cast(bf16x8, ((u32x4){klw1, tbw, neg1w, 0u}));
    const LAS unsigned char* kp = buf + i * KPB;
    {
        const f32x16 zero16 = {0.f, 0.f, 0.f, 0.f, 0.f, 0.f, 0.f, 0.f, 0.f, 0.f, 0.f, 0.f, 0.f, 0.f, 0.f, 0.f};
        p0 = __builtin_amdgcn_mfma_f32_32x32x16_bf16(kx0, qx, zero16, 0, 0, 0);
        p1 = __builtin_amdgcn_mfma_f32_32x32x16_bf16(kx1, qx, zero16, 0, 0, 0);
    }
#pragma unroll
    for (int d0 = 0; d0 < 4; ++d0) {
        const int ko = ((2 * d0 + hi) ^ (i & 7)) << 4;
        const bf16x8 k0 = *(const LAS bf16x8*)(kp + ko), k1 = *(const LAS bf16x8*)(kp + 32 * KPB + ko);
        const bf16x8 qd = *(const LAS bf16x8*)(qfl + d0 * 1024);
        p0 = __builtin_amdgcn_mfma_f32_32x32x16_bf16(k0, qd, p0, 0, 0, 0);
        p1 = __builtin_amdgcn_mfma_f32_32x32x16_bf16(k1, qd, p1, 0, 0, 0);
    }
}
template <bool PV, bool TRACK>
__device__ __forceinline__ void nsa_prep(int mode, int lim, BrState& st, f32x16& p0, f32x16& p1, int lane, LAS float* wsf) {
#ifndef EMU
    asm volatile("" : "+v"(lim));
#endif
    const int i = lane & 31, hi = lane >> 5;
    if (__builtin_amdgcn_readfirstlane(mode) != 0) {
        NOSPEC();
        const int lim2 = lim - 4 * hi; const bool inv = (mode == 2);
#pragma unroll
        for (int r = 0; r < 16; ++r) { const int c0 = (r & 3) + 8 * (r >> 2);
            const bool v0 = (c0 <= lim2) != inv, v1 = (c0 + 32 <= lim2) != inv;
            p0[r] = v0 ? p0[r] : -INFINITY; p1[r] = v1 ? p1[r] : -INFINITY; }
    }
    if (TRACK) {
        float mxa = fmaxf(p0[0], p1[0]), mxb = fmaxf(p0[1], p1[1]);
#pragma unroll
        for (int r = 2; r < 16; r += 2) { mxa = fmaxf(fmaxf(mxa, p0[r]), p1[r]); mxb = fmaxf(fmaxf(mxb, p0[r + 1]), p1[r + 1]); }
        float mx = fmaxf(mxa, mxb);
        mx = fmaxf(mx, xor32f(mx));
        const bool upd = (mx > (st.has ? NSA_THR : NEG_BIG)) && (mx > NEG_BIG);
        if (__any(upd)) {
            NOSPEC();
            float meff; const unsigned w = ref_words(st.mref + mx, meff);
            const float de = upd ? (meff - st.mref) : 0.f;
            const float f = (upd && st.has) ? fexp2(-de) : 1.0f;
#pragma unroll
            for (int r = 0; r < 16; ++r) { p0[r] -= de; p1[r] -= de; }
            st.l *= f;
            if (PV) {
                wsf[i] = f; WAVE_SYNC(); FENCE();
                const LAS float* wr_ = wsf + 4 * hi;
#pragma unroll
                for (int r = 0; r < 16; ++r) { const float a = wr_[(r & 3) + 8 * (r >> 2)]; st.o0[r] *= a; st.o1[r] *= a; }
                WAVE_SYNC(); FENCE();
            }
            if (upd) { st.mref = meff; st.qxm = hi ? 0u : w; st.has = 1; }
        }
    }
}
template <bool PV>
__device__ __forceinline__ void nsa_softmax_pv(const LAS unsigned char* buf, BrState& st, f32x16& p0, f32x16& p1, int lane) {
    const int hi = lane >> 5;
    float rs = 0.f;
#pragma unroll
    for (int r = 0; r < 16; ++r) { p0[r] = fexp2(p0[r]); p1[r] = fexp2(p1[r]); rs += p0[r] + p1[r]; }
    st.l += rs;
    if (PV) {
        const LAS unsigned char* vb = buf + NB_K + (4 * hi + ((lane & 15) >> 2)) * 64 + 32 * ((lane >> 4) & 1) + 8 * (lane & 3);
#pragma unroll
        for (int ks = 0; ks < 4; ++ks) {
            const f32x16& p = (ks < 2) ? p0 : p1; const int s = ks & 1;
            u32x4 pw; pw.x = pk2(p[8 * s + 0], p[8 * s + 1]); pw.y = pk2(p[8 * s + 2], p[8 * s + 3]); pw.z = pk2(p[8 * s + 4], p[8 * s + 5]); pw.w = pk2(p[8 * s + 6], p[8 * s + 7]);
            const bf16x8 pa = __builtin_bit_cast(bf16x8, pw);
#pragma unroll
            for (int d0 = 0; d0 < 2; ++d0) {
                const s16x4 lo = VTR(vb + d0 * V_H1 + ks * 1024), hh = VTR(vb + d0 * V_H1 + ks * 1024 + 512);
                const bf16x8 vf = (bf16x8){lo[0], lo[1], lo[2], lo[3], hh[0], hh[1], hh[2], hh[3]};
                if (d0 == 0) st.o0 = __builtin_amdgcn_mfma_f32_32x32x16_bf16(pa, vf, st.o0, 0, 0, 0);
                else         st.o1 = __builtin_amdgcn_mfma_f32_32x32x16_bf16(pa, vf, st.o1, 0, 0, 0);
            }
        }
    }
}

struct ImpSums { float G0[4], S0[4], G1[4], S1[4]; };
template <bool PRODUCE, bool IMP>
__device__ __forceinline__ void nsa_exp_qk(const LAS unsigned char* nbuf, const LAS unsigned char* qfl, unsigned qxs, unsigned qxm_t, unsigned klw0, unsigned klw1, unsigned tbw, unsigned neg1w,
                                           f32x16& n0, f32x16& n1, BrState& st, f32x16& p0, f32x16& p1, u32x4 (&pw)[4], ImpSums& im, int lane) {
    const int i = lane & 31, hi = lane >> 5;
    const LAS unsigned char* kp = nbuf + i * KPB;
    if (PRODUCE) {
        const bf16x8 qx = __builtin_bit_cast(bf16x8, ((u32x4){qxs, qxs, qxm_t, 0u}));
        const bf16x8 kx0 = __builtin_bit_cast(bf16x8, ((u32x4){klw0, tbw, neg1w, 0u})), kx1 = __builtin_bit_cast(bf16x8, ((u32x4){klw1, tbw, neg1w, 0u}));
        const f32x16 zero16 = {0.f, 0.f, 0.f, 0.f, 0.f, 0.f, 0.f, 0.f, 0.f, 0.f, 0.f, 0.f, 0.f, 0.f, 0.f, 0.f};
        n0 = __builtin_amdgcn_mfma_f32_32x32x16_bf16(kx0, qx, zero16, 0, 0, 0);
        n1 = __builtin_amdgcn_mfma_f32_32x32x16_bf16(kx1, qx, zero16, 0, 0, 0);
    }
    float rs = 0.f;
#pragma unroll
    for (int d0 = 0; d0 < 4; ++d0) {
        if (PRODUCE) {
            const int ko = ((2 * d0 + hi) ^ (i & 7)) << 4;
            const bf16x8 k0 = *(const LAS bf16x8*)(kp + ko), k1 = *(const LAS bf16x8*)(kp + 32 * KPB + ko);
            const bf16x8 qd = *(const LAS bf16x8*)(qfl + d0 * 1024);
            n0 = __builtin_amdgcn_mfma_f32_32x32x16_bf16(k0, qd, n0, 0, 0, 0);
            n1 = __builtin_amdgcn_mfma_f32_32x32x16_bf16(k1, qd, n1, 0, 0, 0);
        }
        const float a0 = fexp2(p0[4 * d0]), a1 = fexp2(p0[4 * d0 + 1]), a2 = fexp2(p0[4 * d0 + 2]), a3 = fexp2(p0[4 * d0 + 3]);
        const float b0 = fexp2(p1[4 * d0]), b1 = fexp2(p1[4 * d0 + 1]), b2 = fexp2(p1[4 * d0 + 2]), b3 = fexp2(p1[4 * d0 + 3]);
        const float ga = (a0 + a1) + (a2 + a3), gb = (b0 + b1) + (b2 + b3);
        rs += ga + gb;
        if (IMP) { im.G0[d0] = ga; im.S0[d0] = a3; im.G1[d0] = gb; im.S1[d0] = b3; }
        const unsigned w0 = pk2(a0, a1), w1 = pk2(a2, a3), v0 = pk2(b0, b1), v1 = pk2(b2, b3);
        if ((d0 & 1) == 0) { pw[d0 >> 1].x = w0; pw[d0 >> 1].y = w1; pw[2 + (d0 >> 1)].x = v0; pw[2 + (d0 >> 1)].y = v1; }
        else               { pw[d0 >> 1].z = w0; pw[d0 >> 1].w = w1; pw[2 + (d0 >> 1)].z = v0; pw[2 + (d0 >> 1)].w = v1; }
        __builtin_amdgcn_sched_barrier(0);
    }
    st.l += rs;
}
template <bool PV>
__device__ __forceinline__ void nsa_pv(const LAS unsigned char* buf, BrState& st, const u32x4 (&pw)[4], int lane) {
    if (!PV) return;
    const int hi = lane >> 5;
    const LAS unsigned char* vb = buf + NB_K + (4 * hi + ((lane & 15) >> 2)) * 64 + 32 * ((lane >> 4) & 1) + 8 * (lane & 3);
#pragma unroll
    for (int ks = 0; ks < 4; ++ks) {
        const bf16x8 pa = __builtin_bit_cast(bf16x8, pw[ks]);
#pragma unroll
        for (int d0 = 0; d0 < 2; ++d0) {
            const s16x4 lo = VTR(vb + d0 * V_H1 + ks * 1024), hh = VTR(vb + d0 * V_H1 + ks * 1024 + 512);
            const bf16x8 vf = (bf16x8){lo[0], lo[1], lo[2], lo[3], hh[0], hh[1], hh[2], hh[3]};
            if (d0 == 0) st.o0 = __builtin_amdgcn_mfma_f32_32x32x16_bf16(pa, vf, st.o0, 0, 0, 0);
            else         st.o1 = __builtin_amdgcn_mfma_f32_32x32x16_bf16(pa, vf, st.o1, 0, 0, 0);
        }
        __builtin_amdgcn_sched_barrier(0);
    }
}

__device__ __forceinline__ int bit128(const LAS unsigned* m, int j) { return (int)((m[j >> 5] >> (j & 31)) & 1u); }
__device__ __forceinline__ int next_below(const LAS unsigned* m, int j) { for (int k = j - 1; k >= 0; --k) if ((m[k >> 5] >> (k & 31)) & 1u) return k; return -1; }

struct NsaCtx {
    int qt, g, t, tloc, qloc, head, w, lane; const bf16_t* Zb;
    LAS unsigned char* lds; LAS float* imp; LAS float* wsf;
};
__device__ __forceinline__ void nsa_importance(const NsaCtx& C, const ImpSums& im, int cur) {
    const int i = C.lane & 31, hi = C.lane >> 5;
    float G0[4], G1[4], S0[4], S1[4];
#pragma unroll
    for (int k = 0; k < 4; ++k) { G0[k] = quad_sum(im.G0[k]); G1[k] = quad_sum(im.G1[k]); S0[k] = quad_sum(im.S0[k]); S1[k] = quad_sum(im.S1[k]); }
    float P0[4], P1[4];
#pragma unroll
    for (int k = 0; k < 4; ++k) { P0[k] = xor32f(S0[k]); P1[k] = xor32f(S1[k]); }
    if ((i & 3) == 0) {
        LAS float* row = C.imp + C.qloc * 128 + 16 * cur + hi;
#pragma unroll
        for (int k = 0; k < 4; ++k) {
            const float prev0 = hi ? P0[k] : (k == 0 ? 0.f : P0[k - 1]);
            const float prev1 = hi ? P1[k] : (k == 0 ? P0[3] : P1[k - 1]);
            row[2 * k] = G0[k] + prev0;
            row[8 + 2 * k] = G1[k] + prev1;
        }
        if (hi == 1 && 16 * (cur + 1) < 128) row[15] += S1[3];
    }
}
template <int KIND, int PRE>
__device__ __forceinline__ void nsa_branch(Frame& F, const NsaCtx& C, const LAS unsigned char* qf, const bf16_t* Kg, const bf16_t* Vg, size_t pitch,
                                           int first, int lo, const LAS unsigned* um, const LAS unsigned* wm, const LAS unsigned* qm, int cfull, int climit, BrState& st) {
    constexpr bool PV = (KIND != 1), TRACK = (KIND != 2), CMP = (KIND == 1 || KIND == 2);
    const int lane = C.lane, w = C.w, qt = C.qt;
    const int ln_ = opaque_lane(lane), hi_ = ln_ >> 5, i_ = ln_ & 31;
    unsigned qxs; { const float s2_ = fexp2(-(float)(4 * C.g + (i_ & 3) + 1)) * LOG2E; const unsigned sh_ = f2bf(s2_); const unsigned sl_ = f2bf(s2_ - bf2f((unsigned short)sh_)); qxs = hi_ ? 0u : (sh_ | (sl_ << 16)); }
    const unsigned neg1w = hi_ ? 0u : 0xBF80BF80u; const unsigned maskw = hi_ ? 0u : 0x00007E96u;
    const unsigned klw0 = hi_ ? 0u : (f2bf((float)(CMP ? 16 * i_ : i_)) * 0x10001u), klw1 = hi_ ? 0u : (f2bf((float)(CMP ? 16 * (i_ + 32) : (i_ + 32))) * 0x10001u);
#define SEQ_NEXT(c) ((c) < 0 ? -1 : (KIND == 3 ? next_below(um, (c)) : (((c) - 1 >= lo) ? (c) - 1 : -1)))
#define TILE_NEED(c) (KIND == 3 ? bit128(wm, (c)) : 1)
#define TILE_MODE(c) (KIND == 0 ? (((c) == qt) ? 1 : (((c) == qt - 8) ? 2 : 0)) : (CMP ? ((64 * (c) + 63 <= cfull) ? 0 : 1) : (((c) == qt) ? 1 : 0)))
#define TILE_LIM(c) (CMP ? (climit - 64 * (c)) : C.tloc)
#define TILE_TBW(c) (hi_ ? 0u : (f2bf((float)((CMP ? 1024 : 64) * (c))) * 0x10001u))
#define TILE_QXM(c) ((KIND == 3) ? (bit128(qm, (c)) ? st.qxm : maskw) : st.qxm)
#define SLOT(s) (C.lds + (s) * NB_BUF)
    f32x16 pA0, pA1, pB0, pB1;
    int c0 = first, c1 = SEQ_NEXT(c0), c2 = SEQ_NEXT(c1), s0 = 0;
    if (PRE == 0) { __syncthreads();
        stage_dma<PV>(SLOT(0), Kg, Vg, pitch, 64L * c0, w, lane); }
    if (PRE < 2 && c1 >= 0) stage_dma<PV>(SLOT(1), Kg, Vg, pitch, 64L * c1, w, lane);
    __syncthreads();
    if (TILE_NEED(c0)) nsa_qk(SLOT(0), qf, qxs, TILE_QXM(c0), klw0, klw1, TILE_TBW(c0), neg1w, pA0, pA1, lane);
#define NSA_STEP(P0, P1, N0, N1) do { \
        const int s1_ = (s0 == 2) ? 0 : s0 + 1, s2_ = (s1_ == 2) ? 0 : s1_ + 1; \
        if (c2 >= 0) stage_dma<PV>(SLOT(s2_), Kg, Vg, pitch, 64L * c2, w, lane); \
        const bool need0_ = TILE_NEED(c0) != 0; const int cn_ = (c1 >= 0) ? c1 : c0;     \
        if (need0_) { \
            u32x4 pw_[4]; ImpSums im_; \
            nsa_prep<PV, TRACK>(TILE_MODE(c0), TILE_LIM(c0), st, P0, P1, lane, C.wsf); \
            __builtin_amdgcn_sched_barrier(0); \
            nsa_exp_qk<true, KIND == 2>(SLOT(s1_), qf, qxs, TILE_QXM(cn_), klw0, klw1, TILE_TBW(cn_), neg1w, N0, N1, st, P0, P1, pw_, im_, lane); \
            nsa_pv<PV>(SLOT(s0), st, pw_, lane); \
            if (KIND == 2) nsa_importance(C, im_, c0); \
        } else nsa_qk(SLOT(s1_), qf, qxs, TILE_QXM(cn_), klw0, klw1, TILE_TBW(cn_), neg1w, N0, N1, lane); \
        __syncthreads(); \
        c0 = c1; c1 = c2; c2 = SEQ_NEXT(c2); s0 = s1_; } while (0)
    for (;;) {
        NSA_STEP(pA0, pA1, pB0, pB1); if (c0 < 0) break;
        NSA_STEP(pB0, pB1, pA0, pA1); if (c0 < 0) break;
    }
#undef NSA_STEP
#undef SEQ_NEXT
#undef TILE_NEED
#undef TILE_MODE
#undef TILE_LIM
#undef TILE_TBW
#undef TILE_QXM
#undef SLOT
}
#if !defined(EMU)
#define SUBT_BEGIN() unsigned long long st_t0_ = 0; if (PROBE_K >= 20 && blockIdx.x == 0 && F.tid == 0) st_t0_ = __builtin_amdgcn_s_memrealtime()
#define SUBT_END(i) do { if (PROBE_K >= 20 && blockIdx.x == 0 && F.tid == 0) { const unsigned long long t1_ = __builtin_amdgcn_s_memrealtime(); F.MISC[300 + (i)] += (unsigned)(t1_ - st_t0_); st_t0_ = t1_; } } while (0)
#else
#define SUBT_BEGIN() ((void)0)
#define SUBT_END(i) ((void)0)
#endif
__device__ __forceinline__ void nsa_task(Frame& F, int task) {
    constexpr int NQT = SEQ / 64;
    const int qt = task % NQT, g = (task / NQT) % NG, b = task / (NQT * NG);
    const int t0 = 64 * qt, w = F.wave;
    const bf16_t* Zb = (const bf16_t*)(F.ws + WS_ZB) + (size_t)b * SEQ * ZP;
    LAS float* imp = (LAS float*)(F.lds + A_IMP);
    LAS unsigned short* selm = (LAS unsigned short*)(F.lds + A_SEL);
    LAS unsigned* uniw = (LAS unsigned*)(F.lds + A_UNI);
#define SECTION_LANE() const int lane = opaque_lane(F.lane), i = lane & 31, hi = lane >> 5, ql = i >> 2, qloc = 8 * w + ql, t = t0 + qloc, head = 4 * g + (i & 3); \
        LAS float* wsf = (LAS float*)(F.lds + A_WSF) + w * 32; LAS unsigned char* qf = F.lds + A_QF + w * 4096 + lane * 16; \
        NsaCtx C; C.qt = qt; C.g = g; C.t = t; C.tloc = qloc; C.qloc = qloc; C.head = head; C.w = w; C.lane = lane; C.Zb = Zb; C.lds = F.lds; C.imp = imp; C.wsf = wsf; \
        LAS unsigned* ya = (LAS unsigned*)(F.lds + A_Y) + w * 1024 + hi * 128 + i; (void)ya; (void)head; (void)t
    const LAS unsigned* zz = (const LAS unsigned*)(F.lds + A_UNI);
#define INIT_ST(st) do { st.mref = 0.f; st.l = 0.f; st.has = 0; st.qxm = 0u; _Pragma("unroll") for (int r = 0; r < 16; ++r) { st.o0[r] = 0.f; st.o1[r] = 0.f; } } while (0)
#define ACC_PREP(st, gidx) float f_ = st.l + xor32f(st.l); { const float gate_ = ((const LAS float*)(F.lds + A_GATE))[w * 96 + i * 3 + gidx]; f_ = (f_ > 0.f) ? gate_ * __builtin_amdgcn_rcpf(f_) : 0.f; }     \
        wsf[i] = f_; WAVE_SYNC(); FENCE(); const LAS float* wr_ = wsf + 4 * hi;
    const bf16_t* KCg = (const bf16_t*)(F.ws + WS_KC) + (size_t)(b * NG + g) * NCP * 64;
    const bf16_t* VCg = (const bf16_t*)(F.ws + WS_VC) + (size_t)(b * NG + g) * NCP * 64;
    const int nct = (t0 + 63 >= 31) ? (((t0 + 63 - 31) >> 4) / 64 + 1) : 0;
#define NSA_PRELOAD_CMP(WV) do { if (nct > 0) { stage_dma<WV>(F.lds, KCg, VCg, 64, 64L * (nct - 1), w, lane); if (nct > 1) stage_dma<WV>(F.lds + NB_BUF, KCg, VCg, 64, 64L * (nct - 2), w, lane); } } while (0)
    bool sel_pre = false;
    SUBT_BEGIN();
    {
        SECTION_LANE();
        __syncthreads();
        stage_dma<true>(F.lds, Zb + ZC_KW + g * 64, Zb + ZC_VW + g * 64, ZP, 64L * qt, w, lane);
        if (qt - 1 >= ((qt - 8 > 0) ? qt - 8 : 0)) stage_dma<true>(F.lds + NB_BUF, Zb + ZC_KW + g * 64, Zb + ZC_VW + g * 64, ZP, 64L * (qt - 1), w, lane);
        for (int idx = F.tid; idx < 64 * 128; idx += NTHREADS) imp[idx] = 0.f;
#pragma unroll
        for (int d0 = 0; d0 < 4; ++d0) { const u32x4 raw = *(const u32x4*)(Zb + (size_t)t * ZP + ZC_Q + head * 64 + 16 * d0 + 8 * hi);
            const float sc = 0.125f * LOG2E; u32x4 o;
            o.x = pk2(bflo(raw.x) * sc, bfhi(raw.x) * sc); o.y = pk2(bflo(raw.y) * sc, bfhi(raw.y) * sc); o.z = pk2(bflo(raw.z) * sc, bfhi(raw.z) * sc); o.w = pk2(bflo(raw.w) * sc, bfhi(raw.w) * sc);
            *(LAS u32x4*)(qf + d0 * 1024) = o; }
        if (hi == 0) {
#pragma unroll
            for (int k = 0; k < 3; ++k) ((LAS float*)(F.lds + A_GATE))[w * 96 + i * 3 + k] = sigmoidf_(bf2f(Zb[(size_t)t * ZP + ZC_GL + head * 3 + k]));
        }
    }
    {
        SECTION_LANE();
        BrState st; INIT_ST(st);
        nsa_branch<0, 2>(F, C, qf, Zb + ZC_KW + g * 64, Zb + ZC_VW + g * 64, ZP, qt, (qt - 8 > 0) ? qt - 8 : 0, zz, zz, zz, 0, 0, st);
        NSA_PRELOAD_CMP(false);
        ACC_PREP(st, 2)
#pragma unroll
        for (int r = 0; r < 16; ++r) { const int c_ = (r & 3) + 8 * (r >> 2); const float a_ = wr_[c_]; ya[c_ * 32] = pk2(a_ * st.o0[r], a_ * st.o1[r]); }
        WAVE_SYNC(); FENCE();
    }
    SUBT_END(1);
    {
        SECTION_LANE();
        const bf16_t* Kg = KCg; const bf16_t* Vg = VCg;
        const int cfull = (t0 >= 31) ? ((t0 - 31) >> 4) : -1;
        const int climit = (t >= 31) ? ((t - 31) >> 4) : -1;
        if (nct > 0) {
            BrState st; INIT_ST(st);
            nsa_branch<1, 2>(F, C, qf, Kg, Vg, 64, nct - 1, 0, zz, zz, zz, cfull, climit, st);
            NSA_PRELOAD_CMP(true);
            SUBT_END(2);
            const float ltot = st.l + xor32f(st.l);
            float meff; const unsigned wfin = ref_words(st.mref + ((ltot > 0.f) ? __builtin_log2f(ltot) : 0.f), meff);
            BrState s2; INIT_ST(s2); s2.qxm = hi ? 0u : wfin;
            nsa_branch<2, 2>(F, C, qf, Kg, Vg, 64, nct - 1, 0, zz, zz, zz, cfull, climit, s2);
            stage_dma<true>(F.lds, Zb + ZC_KS + g * 64, Zb + ZC_VS + g * 64, ZP, 64L * qt, w, lane);
            sel_pre = true;
            s2.l = 0.5f;
            ACC_PREP(s2, 0)
#pragma unroll
            for (int r = 0; r < 16; ++r) { const int c_ = (r & 3) + 8 * (r >> 2); const float a_ = wr_[c_]; const unsigned y_ = ya[c_ * 32]; ya[c_ * 32] = pk2(bflo(y_) + a_ * s2.o0[r], bfhi(y_) + a_ * s2.o1[r]); }
            WAVE_SYNC(); FENCE();
        }
    }
    if (!sel_pre) stage_dma<true>(F.lds, Zb + ZC_KS + g * 64, Zb + ZC_VS + g * 64, ZP, 64L * qt, w, F.lane);
    __syncthreads();
    SUBT_END(3);
    {
        const int lane = opaque_lane(F.lane);
        const int q8 = lane >> 3, sub = lane & 7, qq = 8 * w + q8;
        unsigned key[16];
#pragma unroll
        for (int e = 0; e < 16; ++e) { const int j = 16 * sub + e; const bool valid = (j <= qt) && (j < NBLK);
            unsigned kk = valid ? (__builtin_bit_cast(unsigned, imp[qq * 128 + j]) + 1u) : 0u;
            if (valid && (j == 0 || j == qt || j == qt - 1)) kk = 0x7F000000u;
            key[e] = kk; }
        unsigned thr = 0u;
        for (int bit = 30; bit >= 0; --bit) { const unsigned cand = thr | (1u << bit); int c = 0;
#pragma unroll
            for (int e = 0; e < 16; ++e) c += (key[e] >= cand) ? 1 : 0;
            c = red8_add(c);
            if (c >= NSEL) thr = cand; }
        int ngt = 0, tl = 0;
#pragma unroll
        for (int e = 0; e < 16; ++e) { ngt += (key[e] > thr) ? 1 : 0; tl += (key[e] == thr) ? 1 : 0; }
        ngt = red8_add(ngt);
        int sc = tl;
#pragma unroll
        for (int d = 1; d < 8; d <<= 1) { const int o = __shfl(sc, (lane - d) & 63); if (sub >= d) sc += o; }
        int before = sc - tl; const int need = (thr == 0u) ? 0 : (NSEL - ngt);
        unsigned m16 = 0u;
#pragma unroll
        for (int e = 0; e < 16; ++e) { if (key[e] > thr) m16 |= 1u << e; else if (key[e] == thr) { if (before < need) m16 |= 1u << e; ++before; } }
        selm[qq * 8 + sub] = (unsigned short)m16;
        unsigned um = m16; um |= __shfl_xor(um, 8); um |= __shfl_xor(um, 16); um |= __shfl_xor(um, 32);
        if (q8 == 0) ((LAS unsigned short*)uniw)[w * 8 + sub] = (unsigned short)um;
    }
    __syncthreads();
    SUBT_END(4);
    {
        SECTION_LANE();
        BrState st; INIT_ST(st);
        if (F.tid < 4) { unsigned u = 0u; for (int ww = 0; ww < 8; ++ww) u |= uniw[ww * 4 + F.tid]; uniw[32 + F.tid] = u; }
        __syncthreads();
        const LAS unsigned* um = uniw + 32; const LAS unsigned* wm = uniw + w * 4; const LAS unsigned* qm = (const LAS unsigned*)selm + qloc * 4;
        nsa_branch<3, 1>(F, C, qf, Zb + ZC_KS + g * 64, Zb + ZC_VS + g * 64, ZP, qt, 0, um, wm, qm, 0, 0, st);
        ACC_PREP(st, 1)
        bf16_t* ym = (bf16_t*)(F.ws + WS_YMIX) + ((size_t)b * SEQ + t0 + 8 * w + hi) * DM + 512 + 4 * g * 64 + i;
#pragma unroll
        for (int r = 0; r < 16; ++r) { const int c_ = (r & 3) + 8 * (r >> 2); const float a_ = wr_[c_]; const unsigned y_ = ya[c_ * 32]; bf16_t* op = ym + (c_ >> 2) * DM + (c_ & 3) * 64;
            const unsigned o_ = pk2(bflo(y_) + a_ * st.o0[r], bfhi(y_) + a_ * st.o1[r]); op[0] = (bf16_t)(o_ & 0xffffu); op[32] = (bf16_t)(o_ >> 16); }
        WAVE_SYNC(); FENCE();
    }
    SUBT_END(5);
#undef ACC_PREP
#undef INIT_ST
#undef SECTION_LANE
#undef NSA_PRELOAD_CMP
}

__device__ __forceinline__ void argmax16(float& v, int& idx) {
#ifdef EMU
    for (int o = 1; o < 16; o <<= 1) { const float ov = __shfl_xor(v, o); const int oi = __shfl_xor(idx, o); if (ov > v || (ov == v && oi < idx)) { v = ov; idx = oi; } }
#else
#define AM_STEP(ctrl) do { const float ov = __builtin_bit_cast(float, __builtin_amdgcn_update_dpp(0, __builtin_bit_cast(int, v), ctrl, 0xF, 0xF, true)); \
        const int oi = __builtin_amdgcn_update_dpp(0, idx, ctrl, 0xF, 0xF, true); if (ov > v || (ov == v && oi < idx)) { v = ov; idx = oi; } } while (0)
    AM_STEP(0xB1); AM_STEP(0x4E); AM_STEP(0x141); AM_STEP(0x140);
#undef AM_STEP
#endif
}
template <bool SHADOW>
__device__ __forceinline__ void router_task(Frame& F, int task) {
    const int row0 = 32 * task;
    LAS float* Hs = (LAS float*)F.lds;
    const float* mod = (const float*)(F.ws + WS_MOD);
    const float* X0 = F.in[I_X]; const bf16_t* MIX = (const bf16_t*)(F.ws + WS_MIX);
    unsigned char* H2 = (unsigned char*)(F.ws + WS_H2);
    const float* g = F.in[I_GFFN];
    {
        const int b = row0 / SEQ;
        const float* mb = mod + (size_t)b * 6144;
#pragma unroll
        for (int rb = 0; rb < 2; ++rb) {
            f32x4 v[2][4]; u32x2 mw[2][4];
#pragma unroll
            for (int rr = 0; rr < 2; ++rr) { const size_t ro = (size_t)(row0 + 4 * F.wave + 2 * rb + rr) * DM; const f32x4* xr = (const f32x4*)(X0 + ro) + F.lane; const u32x2* mr = (const u32x2*)(MIX + ro) + F.lane;
#pragma unroll
                for (int j = 0; j < 4; ++j) { v[rr][j] = xr[64 * j]; mw[rr][j] = mr[64 * j]; } }
#pragma unroll
            for (int rr = 0; rr < 2; ++rr)
#pragma unroll
                for (int j = 0; j < 4; ++j) v[rr][j] += *(const f32x4*)(mb + 2 * 1024 + 4 * F.lane + 256 * j) * (f32x4){bflo(mw[rr][j].x), bfhi(mw[rr][j].x), bflo(mw[rr][j].y), bfhi(mw[rr][j].y)};
#pragma unroll
            for (int rr = 0; rr < 2; ++rr) {
                const int lr = 4 * F.wave + 2 * rb + rr, m = row0 + lr;
                float s = 0.f;
#pragma unroll
                for (int j = 0; j < 4; ++j) s += (v[rr][j][0] * v[rr][j][0] + v[rr][j][1] * v[rr][j][1]) + (v[rr][j][2] * v[rr][j][2] + v[rr][j][3] * v[rr][j][3]);
                const float rinv = __builtin_amdgcn_rsqf(wave_sum(s) * (1.0f / DM) + EPS);
                unsigned* o4 = (unsigned*)(H2 + (size_t)m * DM) + F.lane;
#pragma unroll
                for (int j = 0; j < 4; ++j) { const int c = 4 * F.lane + 256 * j;
                    const f32x4 h = v[rr][j] * rinv * (*(const f32x4*)(g + c) * (*(const f32x4*)(mb + 4 * 1024 + c) + 1.0f)) + *(const f32x4*)(mb + 3 * 1024 + c);
                    o4[64 * j] = pk4_fp8(h[0] * F8_ACT_SCALE, h[1] * F8_ACT_SCALE, h[2] * F8_ACT_SCALE, h[3] * F8_ACT_SCALE);
#pragma unroll
                    for (int e = 0; e < 4; ++e) Hs[(c + e) * 33 + lr] = h[e]; }
                __builtin_amdgcn_sched_barrier(0);
            }
        }
    }
    const int i = F.lane & 31, hi = F.lane >> 5;
    const float* WR = F.in[I_WR];
    __builtin_amdgcn_sched_barrier(0);
    float wr[32];
#pragma unroll
    for (int ks = 0; ks < 32; ++ks) wr[ks] = WR[(128 * F.wave + 2 * ks + hi) * 32 + i];
    __syncthreads();
    f32x16 acc;
#pragma unroll
    for (int r = 0; r < 16; ++r) acc[r] = 0.f;
    float wr2[32];
#pragma unroll
    for (int ks = 0; ks < 32; ++ks) wr2[ks] = WR[(128 * F.wave + 2 * (ks + 32) + hi) * 32 + i];
    __builtin_amdgcn_sched_barrier(0);
#pragma unroll
    for (int q4 = 0; q4 < 4; ++q4) {
#pragma unroll
        for (int ks = 8 * q4; ks < 8 * q4 + 8; ++ks) acc = __builtin_amdgcn_mfma_f32_32x32x2f32(Hs[(128 * F.wave + 2 * ks + hi) * 33 + i], wr[ks], acc, 0, 0, 0);
        __builtin_amdgcn_sched_barrier(0);
    }
#pragma unroll
    for (int q4 = 0; q4 < 4; ++q4) {
#pragma unroll
        for (int ks = 8 * q4; ks < 8 * q4 + 8; ++ks) acc = __builtin_amdgcn_mfma_f32_32x32x2f32(Hs[(128 * F.wave + 2 * (ks + 32) + hi) * 33 + i], wr2[ks], acc, 0, 0, 0);
        __builtin_amdgcn_sched_barrier(0);
    }
    __syncthreads();
    LAS float* Ls = (LAS float*)F.lds;
    LAS float* Lg = Ls + 8 * 1024;
    LAS unsigned* hist = (LAS unsigned*)(Lg + 32 * 33);
#pragma unroll
    for (int r = 0; r < 16; ++r) Ls[F.wave * 1024 + crow(r, hi) * 32 + i] = acc[r];
    if (F.tid < 64) hist[F.tid] = 0u;
    __syncthreads();
    const int tk = F.tid >> 4, sub = F.tid & 15;
    float l0 = F.in[I_BR][sub], l1 = F.in[I_BR][sub + 16];
#pragma unroll
    for (int w = 0; w < 8; ++w) { l0 += Ls[w * 1024 + tk * 32 + sub]; l1 += Ls[w * 1024 + tk * 32 + sub + 16]; }
    int be[4]; float bv[4];
#pragma unroll
    for (int k = 0; k < 4; ++k) { float v; int id;
        if (l0 >= l1) { v = l0; id = sub; } else { v = l1; id = sub + 16; }
        argmax16(v, id);
        be[k] = id; bv[k] = v;
        if (id == sub) l0 = -INFINITY;
        if (id == sub + 16) l1 = -INFINITY; }
    unsigned rank[4] = {0u, 0u, 0u, 0u};
    {
        float sum = 0.f; const float mx0 = bv[0];
#pragma unroll
        for (int k = 0; k < 4; ++k) { bv[k] = fexp2((bv[k] - mx0) * LOG2E); sum += bv[k]; }
        const float rs = 1.0f / sum;
#pragma unroll
        for (int k = 0; k < 4; ++k) bv[k] *= rs;
    }
    if (sub == 0) {
#pragma unroll
        for (int k = 0; k < 4; ++k) rank[k] = atomicAdd((unsigned*)&hist[be[k]], 1u);
    }
    __syncthreads();
    if (F.tid < 32) { const unsigned c = hist[F.tid]; hist[32 + F.tid] = c ? atomicAdd(F.ctl + (SHADOW ? CW_CNT2 : CW_CNT) + 64 * F.tid, c) : 0u; }
    __syncthreads();
    if (sub == 0) {
        const int tok = row0 + tk;
        const size_t sh_ = SHADOW ? WS_SHADOW : 0;
        int* lists = (int*)(F.ws + sh_ + WS_LISTS); int* tope = (int*)(F.ws + sh_ + WS_TOPE); float* topw = (float*)(F.ws + sh_ + WS_TOPW); int* topp = (int*)(F.ws + sh_ + WS_TOPP);
#pragma unroll
        for (int k = 0; k < 4; ++k) { const int pos = (int)(hist[32 + be[k]] + rank[k]);
            lists[(size_t)be[k] * T + pos] = tok; tope[tok * 4 + k] = be[k]; topw[tok * 4 + k] = bv[k]; topp[tok * 4 + k] = pos; }
    }
    __syncthreads();
}

__device__ __forceinline__ void moe_tables(Frame& F) {
    if (F.tid < 64) {
        const int e = F.lane & 31;
        const unsigned c = __hip_atomic_load(F.ctl + CW_CNT + 64 * e, __ATOMIC_RELAXED, __HIP_MEMORY_SCOPE_AGENT);
        const unsigned tl = (c + 255u) / 256u;
        unsigned incl = tl;
#pragma unroll
        for (int d = 1; d < 32; d <<= 1) { const unsigned o = __shfl(incl, (F.lane - d) & 63); if (e >= d) incl += o; }
        if (F.lane < 32) { F.MISC[MW_CNT + e] = c; F.MISC[MW_TPFX + e] = incl - tl; F.MISC[MW_ROFF + e] = (incl - tl) * 256u;
            if (e == 31) { F.MISC[MW_TPFX + NE] = incl; F.MISC[MW_ROFF + NE] = incl * 256u; } }
    }
    __syncthreads();
}

__device__ __forceinline__ void final_rows(Frame& F) {
    const int gw = F.vcu * NWAVES + F.wave, NGW = F.G * NWAVES;
    const float* mod = (const float*)(F.ws + WS_MOD);
    const float* X0 = F.in[I_X]; const bf16_t* MIX = (const bf16_t*)(F.ws + WS_MIX);
    const bf16_t* YD = (const bf16_t*)(F.ws + WS_YD);
    const int* tope = (const int*)(F.ws + WS_TOPE); const float* topw = (const float*)(F.ws + WS_TOPW); const int* topp = (const int*)(F.ws + WS_TOPP);
    const float* gf = F.in[I_GFIN];
    int m = gw;
    u32x4 ne = (u32x4){0u, 0u, 0u, 0u}, np = ne; f32x4 nw = (f32x4){0.f, 0.f, 0.f, 0.f}; f32x4 nx[4]; u32x2 nm[4];
    if (m < T) { ne = *(const u32x4*)(tope + m * 4); np = *(const u32x4*)(topp + m * 4); nw = *(const f32x4*)(topw + m * 4);
#pragma unroll
        for (int j = 0; j < 4; ++j) { nx[j] = ((const f32x4*)(X0 + (size_t)m * DM) + F.lane)[64 * j]; nm[j] = ((const u32x2*)(MIX + (size_t)m * DM) + F.lane)[64 * j]; } }
    for (; m < T; m += NGW) {
        const int b = m / SEQ;
        const u32x4 ce = ne, cp = np; const f32x4 cw = nw; f32x4 cx[4];
#pragma unroll
        for (int j = 0; j < 4; ++j) { const f32x4 g1 = *(const f32x4*)(mod + (size_t)b * 6144 + 2 * 1024 + 4 * F.lane + 256 * j);
            cx[j] = nx[j] + g1 * (f32x4){bflo(nm[j].x), bfhi(nm[j].x), bflo(nm[j].y), bfhi(nm[j].y)}; }
        size_t yrow[4];
#pragma unroll
        for (int k = 0; k < 4; ++k) yrow[k] = (size_t)(F.MISC[MW_ROFF + ce[k]] + cp[k]) * DM;
        u32x2 yw[4][4];
#pragma unroll
        for (int j = 0; j < 4; ++j)
#pragma unroll
            for (int k = 0; k < 4; ++k) yw[j][k] = *(const u32x2*)(YD + yrow[k] + 4 * F.lane + 256 * j);
        const int mn = m + NGW;
        if (mn < T) { ne = *(const u32x4*)(tope + mn * 4); np = *(const u32x4*)(topp + mn * 4); nw = *(const f32x4*)(topw + mn * 4);
#pragma unroll
            for (int j = 0; j < 4; ++j) { nx[j] = ((const f32x4*)(X0 + (size_t)mn * DM) + F.lane)[64 * j]; nm[j] = ((const u32x2*)(MIX + (size_t)mn * DM) + F.lane)[64 * j]; } }
        f32x4 v[4]; float s = 0.f;
#pragma unroll
        for (int j = 0; j < 4; ++j) { const int c = 4 * F.lane + 256 * j;
            f32x4 mo = (f32x4){0.f, 0.f, 0.f, 0.f};
#pragma unroll
            for (int k = 0; k < 4; ++k) mo += cw[k] * (f32x4){bflo(yw[j][k].x), bfhi(yw[j][k].x), bflo(yw[j][k].y), bfhi(yw[j][k].y)};
            const f32x4 gt = *(const f32x4*)(mod + (size_t)b * 6144 + 5 * 1024 + c);
            v[j] = cx[j] + gt * mo;
            s += (v[j][0] * v[j][0] + v[j][1] * v[j][1]) + (v[j][2] * v[j][2] + v[j][3] * v[j][3]); }
        const float rinv = __builtin_amdgcn_rsqf(wave_sum(s) * (1.0f / DM) + EPS);
        f32x4* orow = (f32x4*)(F.out + (size_t)m * DM) + F.lane;
#pragma unroll
        for (int j = 0; j < 4; ++j) orow[64 * j] = v[j] * rinv * *(const f32x4*)(gf + 4 * F.lane + 256 * j);
    }
}

constexpr int N_PHASES = 10;
#define REP0 1
#define REPB 1
#define REP1 1
#define REP6 1
#define REP2 1
#define REP3 1
#define REP4 1
#define REP5 1
#define REP7 1
#define REP8 1
#define REP9 1
__global__ void __launch_bounds__(NTHREADS, 2) mk_fwd(Args args) {
#ifdef EMU
    unsigned char* lds = emu_blk->lds;
#else
    extern __shared__ __attribute__((aligned(16))) unsigned char lds[];
#endif
    Frame F;
    F.lds = (LAS unsigned char*)lds;
    F.MISC = (volatile LAS unsigned*)(F.lds + MISC_OFF);
    F.tid = threadIdx.x; F.lane = F.tid & 63; F.wave = __builtin_amdgcn_readfirstlane(F.tid >> 6);
    F.G = gridDim.x; { const int bx = blockIdx.x; F.vcu = (F.G % 8 == 0) ? (bx % 8) * (F.G / 8) + bx / 8 : bx; }
    F.ws = args.ws; F.ctl = (unsigned*)(args.ws + WS_CTL); F.out = args.out;
#pragma unroll
    for (int k = 0; k < 24; ++k) F.in[k] = args.in[k];
    for (int u = F.tid; u < (LDS_BYTES - MISC_OFF) / 4; u += NTHREADS) F.MISC[u] = 0u;
    __syncthreads();
    XcdBarrier bar = xcd_barrier_post(F.ctl + CW_BAR, F.MISC + 8);
    const int lo = args.ph_lo, hi = args.ph_hi;
#ifndef EMU
#define STAMP(k) do { if (PROBE_K >= 0 && blockIdx.x == 0 && F.tid == 0) { const unsigned long long t_ = __builtin_amdgcn_s_memrealtime(); F.MISC[((k) >= 20 ? 360 : 256) + 2 * (k)] = (unsigned)t_; F.MISC[((k) >= 20 ? 361 : 257) + 2 * (k)] = (unsigned)(t_ >> 32); } } while (0)
#else
#define STAMP(k) ((void)0)
#endif
    STAMP(0);
#ifndef PH_MASK
#define PH_MASK 0xffff
#endif
#define IN(k) (((PH_MASK >> (k)) & 1) && lo <= (k) && (k) < hi)
#define SEAM(k) do { if (IN(k) && IN((k) + 1)) { xcd_barrier(bar); if (REPB > 1) xcd_barrier(bar); } } while (0)

    if (IN(0)) { p0_prologue(F); if (REP0 > 1) p0_prologue(F); }
    STAMP(20); SEAM(0); STAMP(1);
#ifndef EMU
    if (IN(0) && IN(1)) {
        if (F.tid == 0) { unsigned ok = 1u; for (int j = 0; j < 8; ++j) ok &= (xb_ld(F.ctl + CW_BAR + XB_XCNT(j)) == (unsigned)(F.G / 8)) ? 1u : 0u;
            F.MISC[12] = (ok && bar.x < 8u) ? (bar.x * (unsigned)(F.G / 8) + F.MISC[10]) : (unsigned)F.vcu; }
        __syncthreads();
        F.vcu = (int)F.MISC[12];
    }
#endif
    if (IN(1)) { norm_rows(F, F.in[I_X], F.in[I_GMIX], 0, 1, (bf16_t*)(F.ws + WS_HB)); if (REP1 > 1) norm_rows(F, F.in[I_X], F.in[I_GMIX], 0, 1, (bf16_t*)(F.ws + WS_HB)); }
    STAMP(21); SEAM(1); STAMP(2);
    if (IN(2)) {
        {
        pg8::DenseProb P{(const char*)(F.ws + WS_HB), (const char*)(F.ws + WS_WINT), DM * 2};
        pg8::DenseOrder S; S.init(T, ZP, F.G, (F.G % 8 == 0) ? (F.vcu % (F.G / 8)) * 8 + F.vcu / (F.G / 8) : (int)blockIdx.x);
        EpiZ E{(bf16_t*)(F.ws + WS_ZB)};
        pg8::gemm_phase<false>(F.lds, P, S, E);
        if (p2_fill_items(F) && S.c >= 128) {
            LAS float* scr = (LAS float*)(F.lds + 8192 + F.wave * 16384);
            const int base = P0_NITEMS - p7_fill_items(F) - p2_fill_items(F) + (S.c - 128) * P2_FILL_PER_CU;
            for (int k = F.wave; k < P2_FILL_PER_CU; k += NWAVES) p0_item(F, scr, base + k);
        }
        }
        if (REP2 > 1) {
        pg8::DenseProb P{(const char*)(F.ws + WS_HB), (const char*)(F.ws + WS_WINT), DM * 2};
        pg8::DenseOrder S; S.init(T, ZP, F.G, (F.G % 8 == 0) ? (F.vcu % (F.G / 8)) * 8 + F.vcu / (F.G / 8) : (int)blockIdx.x);
        EpiZ E{(bf16_t*)(F.ws + WS_ZB)};
        pg8::gemm_phase<false>(F.lds, P, S, E);
        }
    }
    STAMP(22); SEAM(2); STAMP(3);
    if (IN(3)) {
        constexpr int NGM = BATCH * (SEQ / GMC) * GMG, NCT = 2 * BATCH * NG * (NCP / 32);
        for (int rep = 0; rep < (REP3 > 1 ? 2 : 1); ++rep) {
            if (F.G == 2 * NCT && NGM == 8 * NCT) {
                if (F.vcu < NCT) { cmp_tile(F, F.vcu); gmlp_run(F, 3 * F.vcu, 1, 3); }
                else gmlp_run(F, 3 * NCT + 5 * (F.vcu - NCT), 1, 5);
            } else { for (int it = F.vcu; it < NCT; it += F.G) cmp_tile(F, it);
                     const int first = ((F.vcu - NCT) % F.G + F.G) % F.G; gmlp_run(F, first, F.G, (NGM - first + F.G - 1) / F.G); }
        }
    }
    STAMP(23); SEAM(3); STAMP(4);
    if (IN(4)) {
        constexpr int NQT_ = SEQ / 64, NPAIR = BATCH * NQT_;
        for (int rep = 0; rep < (REP4 > 1 ? 2 : 1); ++rep)
        for (int pr = F.vcu; pr < NPAIR; pr += F.G) { const int b_ = pr / NQT_, x_ = pr % NQT_;
            for (int k2 = 0; k2 < 2; ++k2) nsa_task(F, k2 ? (b_ * NG + 0) * NQT_ + x_ : (b_ * NG + 1) * NQT_ + (NQT_ - 1 - x_)); }
    }
    STAMP(24); SEAM(4); STAMP(5);
    if (IN(5)) {
        {
        pg8::DenseProb P{(const char*)(F.ws + WS_YMIX), (const char*)(F.ws + WS_WOUTT), DM * 2};
        pg8::DenseOrder S; S.init(T, DM, F.G, (F.G % 8 == 0) ? (F.vcu % (F.G / 8)) * 8 + F.vcu / (F.G / 8) : (int)blockIdx.x);
        EpiMix E{(bf16_t*)(F.ws + WS_MIX)};
        pg8::gemm_phase<false>(F.lds, P, S, E);
        }
        if (REP5 > 1) {
        pg8::DenseProb P{(const char*)(F.ws + WS_YMIX), (const char*)(F.ws + WS_WOUTT), DM * 2};
        pg8::DenseOrder S; S.init(T, DM, F.G, (F.G % 8 == 0) ? (F.vcu % (F.G / 8)) * 8 + F.vcu / (F.G / 8) : (int)blockIdx.x);
        EpiMix E{(bf16_t*)(F.ws + WS_MIX)};
        pg8::gemm_phase<false>(F.lds, P, S, E);
        }
    }
    STAMP(25); SEAM(5); STAMP(6);
    if (IN(6)) { for (int it = F.vcu; it < T / 32; it += F.G) router_task<false>(F, it); if (REP6 > 1) for (int it = F.vcu; it < T / 32; it += F.G) router_task<true>(F, it); }
    STAMP(26); SEAM(6); STAMP(7);
    if (IN(7)) {
        {
        moe_tables(F);
        MoeProb1 P{(const char*)(F.ws + WS_H2), (const char*)(F.ws + WS_WGUT), (const int*)(F.ws + WS_LISTS), F.in[I_BGU], F.MISC + MW_CNT, DM};
        pg8::MoeOrder S{F.MISC + MW_TPFX, 8, F.G, F.vcu, 0};
        EpiAct E{(unsigned char*)(F.ws + WS_ACT), F.in[I_BGU], F.MISC + MW_ROFF};
        pg8::gemm_phase<true>(F.lds, P, S, E);
        if (p7_fill_items(F)) {
            const int rem = ((int)F.MISC[MW_TPFX + NE] * 8) % F.G;
            int nidle = rem ? F.G - rem : 0, j = F.vcu - rem;
            if (nidle < F.G / 4) { nidle = F.G; j = F.vcu; }
            if (j >= 0) {
                __syncthreads();
                LAS float* scr = (LAS float*)(F.lds + F.wave * 8704);
                const int base = P0_NITEMS - p7_fill_items(F);
                for (int k = j * NWAVES + F.wave; k < p7_fill_items(F); k += nidle * NWAVES) p0_item(F, scr, base + k);
            }
        }
        }
        if (REP7 > 1) {
        moe_tables(F);
        MoeProb1 P{(const char*)(F.ws + WS_H2), (const char*)(F.ws + WS_WGUT), (const int*)(F.ws + WS_LISTS), F.in[I_BGU], F.MISC + MW_CNT, DM};
        pg8::MoeOrder S{F.MISC + MW_TPFX, 8, F.G, F.vcu, 0};
        EpiAct E{(unsigned char*)(F.ws + WS_ACT), F.in[I_BGU], F.MISC + MW_ROFF};
        pg8::gemm_phase<true>(F.lds, P, S, E);
        }
    }
    STAMP(27); SEAM(7); STAMP(8);
    if (IN(8)) {
        {
        moe_tables(F);
        MoeProb2 P{(const char*)(F.ws + WS_ACT), (const char*)(F.ws + WS_WDNT), F.in[I_BDN], F.MISC + MW_ROFF, DFF};
        pg8::MoeOrder S{F.MISC + MW_TPFX, 4, F.G, F.vcu, 0};
        EpiYd E{(bf16_t*)(F.ws + WS_YD), F.in[I_BDN], F.MISC + MW_ROFF};
        pg8::gemm_phase<true>(F.lds, P, S, E);
        }
        if (REP8 > 1) {
        moe_tables(F);
        MoeProb2 P{(const char*)(F.ws + WS_ACT), (const char*)(F.ws + WS_WDNT), F.in[I_BDN], F.MISC + MW_ROFF, DFF};
        pg8::MoeOrder S{F.MISC + MW_TPFX, 4, F.G, F.vcu, 0};
        EpiYd E{(bf16_t*)(F.ws + WS_YD), F.in[I_BDN], F.MISC + MW_ROFF};
        pg8::gemm_phase<true>(F.lds, P, S, E);
        }
    }
    STAMP(28); SEAM(8); STAMP(9);
    if (IN(9)) { moe_tables(F); final_rows(F); if (REP9 > 1) final_rows(F); }
#ifndef EMU
    if (PROBE_K >= 0 && blockIdx.x == 0 && F.tid == 0) {
        STAMP(10);
        unsigned long long a_ = 0, b_ = 0;
        if (PROBE_K == 19) { a_ = ((unsigned long long)F.MISC[257] << 32) | F.MISC[256]; b_ = ((unsigned long long)F.MISC[257 + 20] << 32) | F.MISC[256 + 20]; }
        else if (PROBE_K < 20) { a_ = ((unsigned long long)F.MISC[257 + 2 * (PROBE_K % 20)] << 32) | F.MISC[256 + 2 * (PROBE_K % 20)];
                            b_ = ((unsigned long long)F.MISC[259 + 2 * (PROBE_K % 20)] << 32) | F.MISC[258 + 2 * (PROBE_K % 20)]; }
        else if (PROBE_K >= 30 && PROBE_K < 40) { a_ = ((unsigned long long)F.MISC[361 + 2 * (20 + PROBE_K - 30)] << 32) | F.MISC[360 + 2 * (20 + PROBE_K - 30)]; b_ = ((unsigned long long)F.MISC[257 + 2 * (PROBE_K - 30 + 1)] << 32) | F.MISC[256 + 2 * (PROBE_K - 30 + 1)]; }
        else if (PROBE_K >= 50) b_ = F.MISC[300 + 6 + (PROBE_K % 10)];
        else b_ = F.MISC[300 + (PROBE_K - 20)];
        const unsigned long long t0_ = __builtin_amdgcn_s_memrealtime();
        while (__builtin_amdgcn_s_memrealtime() - t0_ < (b_ - a_)) __builtin_amdgcn_s_sleep(8);
    }
#endif
#undef IN
#undef SEAM
}

#ifdef EMU
struct EmuDump { const char* name; size_t off; size_t bytes; };
EmuDump emu_dumps[] = {
    {"mod", WS_MOD, (size_t)BATCH * 6144 * 4}, {"bpe", WS_BPE, 512 * 4}, {"wint", WS_WINT, (size_t)ZP * DM * 2}, {"hb", WS_HB, (size_t)T * DM * 2},
    {"zb", WS_ZB, (size_t)T * ZP * 2}, {"kc", WS_KC, (size_t)BATCH * NG * NCP * 64 * 2}, {"vc", WS_VC, (size_t)BATCH * NG * NCP * 64 * 2},
    {"ymix", WS_YMIX, (size_t)T * DM * 2}, {"mix", WS_MIX, (size_t)T * DM * 2}, {"h2", WS_H2, (size_t)T * DM * 2},
    {"tope", WS_TOPE, (size_t)T * 16}, {"topw", WS_TOPW, (size_t)T * 16}, {"topp", WS_TOPP, (size_t)T * 16}, {"ctl", WS_CTL, CTL_ZERO_BYTES},
};
int emu_ndumps = sizeof(emu_dumps) / sizeof(emu_dumps[0]);
size_t emu_ws_bytes = WS_END;
int emu_out_elems = T * DM;
#endif

extern "C" void kernel_launch(void* const* d_in, const int* in_sizes, int n_in, void* d_out, int out_size, void* d_ws, size_t ws_size, hipStream_t stream) {
    (void)in_sizes; (void)out_size; (void)ws_size;
    Args a{};
    for (int i = 0; i < 24 && i < n_in; ++i) a.in[i] = (const float*)d_in[i];
    a.out = (float*)d_out; a.ws = (unsigned char*)d_ws;
#ifndef EMU
    (void)hipMemsetAsync((char*)d_ws + WS_CTL, 0, CTL_ZERO_BYTES, stream);
#endif
#ifdef EMU
    int plo = 0, phi = N_PHASES;
    if (const char* e = getenv("EMU_PH_LO")) plo = atoi(e);
    if (const char* e = getenv("EMU_PH_HI")) phi = atoi(e);
    if (plo == 0) (void)hipMemsetAsync((char*)d_ws + WS_CTL, 0, CTL_ZERO_BYTES, stream);
    const int grid = emu_num_cus();
    for (int ph = plo; ph < phi; ++ph) { a.ph_lo = ph; a.ph_hi = ph + 1; Args ac = a; fprintf(stderr, "EMU phase %d\n", ph);
        emu_launch(grid, NTHREADS, LDS_BYTES, [ac]() { mk_fwd(ac); }); }
#else
    static int grid = 0;
    if (grid == 0) {
        int dev = 0, cus = 0, per_cu = 0;
        (void)hipGetDevice(&dev);
        (void)hipDeviceGetAttribute(&cus, hipDeviceAttributeMultiprocessorCount, dev);
        (void)hipFuncSetAttribute((const void*)mk_fwd, hipFuncAttributeMaxDynamicSharedMemorySize, LDS_BYTES);
        (void)hipOccupancyMaxActiveBlocksPerMultiprocessor(&per_cu, (const void*)mk_fwd, NTHREADS, LDS_BYTES);
        if (per_cu < 1) fprintf(stderr, "kernel_launch: occupancy query reports %d blocks/CU\n", per_cu);
        grid = cus;
        (void)hipGetLastError();
    }
    a.ph_lo = 0; a.ph_hi = N_PHASES;
    void* kargs[] = {&a};
    hipError_t e = hipLaunchCooperativeKernel((const void*)mk_fwd, dim3(grid), dim3(NTHREADS), kargs, LDS_BYTES, stream);
    if (e != hipSuccess) fprintf(stderr, "cooperative launch failed: %s (grid %d)\n", hipGetErrorString(e), grid);
#endif
}
```

```cpp
#ifndef EMU
#include <hip/hip_runtime.h>
#endif
#include <cstdio>
#include <cstdint>

#ifndef CFG_BATCH
#define CFG_BATCH 2
#endif
#ifndef CFG_SEQ
#define CFG_SEQ 8192
#endif

#define PROBE_K -1
#ifdef EMU
#define NOSPEC() ((void)0)
#define LAS
#define ASM_VMCNT(n) ((void)0)
#define ASM_LGKMCNT(n) ((void)0)
#define WAVE_SYNC() emu_wave_sync()
#define FENCE() ((void)0)
#else
#define NOSPEC() asm volatile("; rare path" ::: "memory")
#define LAS __attribute__((address_space(3)))
#define ASM_VMCNT(n) asm volatile("s_waitcnt vmcnt(" #n ")" ::: "memory")
#define ASM_LGKMCNT(n) asm volatile("s_waitcnt lgkmcnt(" #n ")" ::: "memory")
#define WAVE_SYNC() asm volatile("s_waitcnt lgkmcnt(0)" ::: "memory")
#define FENCE() asm volatile("" ::: "memory")
#endif

typedef unsigned short bf16_t;
typedef short bf16x8 __attribute__((ext_vector_type(8)));
typedef short s16x4 __attribute__((ext_vector_type(4)));
typedef float f32x4 __attribute__((ext_vector_type(4)));
typedef float f32x16 __attribute__((ext_vector_type(16)));
typedef unsigned u32x4 __attribute__((ext_vector_type(4)));
typedef unsigned u32x2 __attribute__((ext_vector_type(2)));

constexpr int NWAVES = 8, NTHREADS = 512;
constexpr int BATCH = CFG_BATCH, SEQ = CFG_SEQ, DM = 1024, T = BATCH * SEQ;
constexpr int GMW = 512, GMG = 8, GMC = 128;
constexpr int NH = 8, NG = 2, NR = 4, HD = 64;
constexpr int INC = 2328, ZP = 2560;
constexpr int ZC_U = 0, ZC_V = 512, ZC_Q = 1024, ZC_KC = 1536, ZC_VC = 1664, ZC_KS = 1792, ZC_VS = 1920, ZC_KW = 2048, ZC_VW = 2176, ZC_GL = 2304;
constexpr int NCMP = SEQ / 16 - 1, NCP = SEQ / 16;
constexpr int NBLK = SEQ / 64;
constexpr int NSEL = NBLK < 16 ? NBLK : 16;
constexpr int NE = 32, TOPK = 4, DFF = 1024;
constexpr int TK = T * TOPK;
constexpr int ACT_ROWS = TK + NE * 256;
constexpr float EPS = 1e-6f;
constexpr float LOG2E = 1.4426950408889634f;
constexpr float F8_ACT_SCALE = 8.0f, F8_W_SCALE = 64.0f, F8_ACC_SCALE = 1.0f / 512.0f;

constexpr size_t MiB = 1u << 20;
constexpr size_t WS_CTL = 0, CTL_ZERO_BYTES = 192 * 1024;
constexpr size_t WS_MOD = 1 * MiB;
constexpr size_t WS_BPE = 1 * MiB + 512 * 1024;
constexpr size_t WS_LISTS = 2 * MiB;
constexpr size_t WS_TOPE = 4 * MiB;
constexpr size_t WS_TOPW = 4 * MiB + 512 * 1024;
constexpr size_t WS_TOPP = 5 * MiB;
constexpr size_t WS_WSBF = 6 * MiB;
constexpr size_t WS_W2KT = 6 * MiB + 512 * 1024;
constexpr size_t WS_W2VT = WS_W2KT + 64 * 1024;
constexpr size_t WS_W1KT = 7 * MiB;
constexpr size_t WS_W1VT = 8 * MiB;
constexpr size_t WS_WOUTT = 9 * MiB;
constexpr size_t WS_WINT = 11 * MiB;
constexpr size_t WS_KC = 16 * MiB;
constexpr size_t WS_VC = 16 * MiB + 512 * 1024;
constexpr size_t WS_WGUT = 32 * MiB;
constexpr size_t WS_WDNT = 160 * MiB;
constexpr size_t WS_HB = 224 * MiB;
constexpr size_t WS_H2 = 256 * MiB;
constexpr size_t WS_ZB = 288 * MiB;
constexpr size_t WS_YMIX = 368 * MiB;
constexpr size_t WS_MIX = 400 * MiB;
constexpr size_t WS_ACT = 464 * MiB;
constexpr size_t WS_YD = 608 * MiB;
constexpr size_t WS_YACC = 768 * MiB;
constexpr size_t WS_END = 804 * MiB;
constexpr int CW_BAR = 4096;
constexpr int CW_CNT = 16384;
constexpr int CW_CNT2 = 32768;
constexpr size_t WS_SHADOW = 752 * MiB;

constexpr int RING_BYTES = 131072;
constexpr int MISC_OFF = 155648;
constexpr int LDS_BYTES = 159744;
constexpr int MW_CNT = 16, MW_TPFX = 64, MW_ROFF = 128;

__device__ __forceinline__ unsigned f2bf(float f) { unsigned u = __builtin_bit_cast(unsigned, f); return (u + 0x7fffu + ((u >> 16) & 1u)) >> 16; }
#ifdef EMU
__device__ __forceinline__ unsigned pk2(float lo, float hi) { return f2bf(lo) | (f2bf(hi) << 16); }
#else
typedef float f32x2_t __attribute__((ext_vector_type(2))); typedef __bf16 bf16x2_t __attribute__((ext_vector_type(2)));
__device__ __forceinline__ unsigned pk2(float lo, float hi) { f32x2_t v = {lo, hi}; bf16x2_t bb = __builtin_convertvector(v, bf16x2_t); return __builtin_bit_cast(unsigned, bb); }
#endif
__device__ __forceinline__ unsigned pk4_fp8(float a, float b, float c, float d) {
    a = fminf(fmaxf(a, -448.f), 448.f); b = fminf(fmaxf(b, -448.f), 448.f); c = fminf(fmaxf(c, -448.f), 448.f); d = fminf(fmaxf(d, -448.f), 448.f);
    int w = 0; w = __builtin_amdgcn_cvt_pk_fp8_f32(a, b, w, false); w = __builtin_amdgcn_cvt_pk_fp8_f32(c, d, w, true); return (unsigned)w;
}
__device__ __forceinline__ unsigned pk4_fp8_nc(float a, float b, float c, float d) {
    int w = 0; w = __builtin_amdgcn_cvt_pk_fp8_f32(a, b, w, false); w = __builtin_amdgcn_cvt_pk_fp8_f32(c, d, w, true); return (unsigned)w;
}
typedef int v8i_t __attribute__((ext_vector_type(8)));
typedef int v4i_t __attribute__((ext_vector_type(4)));
__device__ __forceinline__ float bf2f(unsigned short h) { return __builtin_bit_cast(float, (unsigned)h << 16); }
__device__ __forceinline__ float bflo(unsigned w) { return __builtin_bit_cast(float, w << 16); }
__device__ __forceinline__ float bfhi(unsigned w) { return __builtin_bit_cast(float, w & 0xffff0000u); }
__device__ __forceinline__ float fexp2(float x) { return __builtin_amdgcn_exp2f(x); }
__device__ __forceinline__ float gelu_tanh(float x) {
    const float y2 = 1.5957691216057308f * (x + 0.044715f * x * x * x);
    return x * __builtin_amdgcn_rcpf(1.0f + fexp2(-y2 * LOG2E));
}
__device__ __forceinline__ float sigmoidf_(float x) { return __builtin_amdgcn_rcpf(1.0f + fexp2(-x * LOG2E)); }
__device__ __forceinline__ float wave_sum(float v) {
#pragma unroll
    for (int o = 1; o < 64; o <<= 1) v += __shfl_xor(v, o);
    return v;
}
__device__ __forceinline__ int crow(int r, int hi) { return (r & 3) + 8 * (r >> 2) + 4 * hi; }

#define XB_TMO      128
#define XB_XCNT(j)  (256  + 64 * (j))
#define XB_XSUB(j)  (1280 + 64 * (j))
#define XB_XGEN(j)  (2304 + 64 * (j))
#define XB_TOP      3328
#define XB_TOPGEN   3392
#define XCD_BAR_WORDS 3456
#define XB_SPIN_CAP (1u << 18)
struct XcdBarrier { unsigned* bar; unsigned x; volatile LAS unsigned* st; };
#ifndef EMU
__device__ __forceinline__ unsigned xb_ld(unsigned* p)              { return __hip_atomic_load(p, __ATOMIC_RELAXED, __HIP_MEMORY_SCOPE_AGENT); }
__device__ __forceinline__ unsigned xb_add(unsigned* p, unsigned v) { return __hip_atomic_fetch_add(p, v, __ATOMIC_RELAXED, __HIP_MEMORY_SCOPE_AGENT); }
__device__ __forceinline__ unsigned xb_xcc_id() { return (unsigned)__builtin_amdgcn_s_getreg((3 << 11) | 20) & 0xFu; }
#define XB_SPIN(cond, bar) do { unsigned _sp = 0; while (cond) { __builtin_amdgcn_s_sleep(1); \
    if ((++_sp & 255u) == 0u) { if (xb_ld(&(bar)[XB_TMO])) break; if (_sp > XB_SPIN_CAP) { atomicAdd(&(bar)[XB_TMO], 1u); break; } } } } while (0)
__device__ __forceinline__ XcdBarrier xcd_barrier_post(unsigned* bar, volatile LAS unsigned* st) {
    XcdBarrier b; b.bar = bar; b.x = xb_xcc_id(); b.st = st;
    if (threadIdx.x == 0) st[2] = xb_add(&bar[XB_XCNT(b.x)], 1u);
    return b;
}
__device__ __forceinline__ void xcd_barrier_complete(unsigned* bar, unsigned x, unsigned& nloc, unsigned& nx) {
    const unsigned G = gridDim.x * gridDim.y * gridDim.z;
    unsigned sum, cnt, mine, sp = 0u;
    for (;;) {
        sum = 0u; cnt = 0u; mine = 0u;
#pragma unroll
        for (unsigned j = 0; j < 16; ++j) { const unsigned c = xb_ld(&bar[XB_XCNT(j)]); sum += c; cnt += (c > 0u) ? 1u : 0u; mine = (j == x) ? c : mine; }
        if (sum == G) break;
        __builtin_amdgcn_s_sleep(1);
        if ((++sp & 255u) == 0u) { if (xb_ld(&bar[XB_TMO])) break; if (sp > XB_SPIN_CAP) { atomicAdd(&bar[XB_TMO], 1u); break; } }
    }
    nloc = mine > 0u ? mine : 1u; nx = cnt > 0u ? cnt : 1u;
}
__device__ __forceinline__ void xcd_barrier(const XcdBarrier& b) {
    asm volatile("s_waitcnt vmcnt(0)" ::: "memory");
    __syncthreads();
    if (threadIdx.x == 0) {
        unsigned* bar = b.bar;
        __builtin_amdgcn_s_waitcnt(0);
        unsigned nloc = b.st[0], nx = b.st[1];
        if (nloc == 0u) { xcd_barrier_complete(bar, b.x, nloc, nx); b.st[0] = nloc; b.st[1] = nx; }
        const unsigned old = xb_add(&bar[XB_XSUB(b.x)], 1u);
        const unsigned gen = old / nloc;
        if (old + 1u == (gen + 1u) * nloc) {
            __builtin_amdgcn_fence(__ATOMIC_RELEASE, "agent");
            asm volatile("s_waitcnt vmcnt(0)" ::: "memory");
            const unsigned og = xb_add(&bar[XB_TOP], 1u);
            const unsigned tg = og / nx;
            if (og + 1u == (tg + 1u) * nx) xb_add(&bar[XB_TOPGEN], 1u);
            else XB_SPIN(xb_ld(&bar[XB_TOPGEN]) == tg, bar);
            __builtin_amdgcn_fence(__ATOMIC_ACQUIRE, "agent");
            xb_add(&bar[XB_XGEN(b.x)], 1u);
            asm volatile("s_waitcnt vmcnt(0)" ::: "memory");
        } else {
            XB_SPIN(xb_ld(&bar[XB_XGEN(b.x)]) == gen, bar);
            __builtin_amdgcn_fence(__ATOMIC_ACQUIRE, "agent");
            asm volatile("s_waitcnt vmcnt(0)" ::: "memory");
        }
    }
    __syncthreads();
}
#else
__device__ __forceinline__ XcdBarrier xcd_barrier_post(unsigned* bar, volatile unsigned* st) { XcdBarrier b; b.bar = bar; b.x = 0; b.st = st; return b; }
__device__ __forceinline__ void xcd_barrier(const XcdBarrier&) { fprintf(stderr, "EMU: grid barrier inside a launch\n"); abort(); }
#endif

struct Args { const float* in[24]; float* out; unsigned char* ws; int ph_lo, ph_hi; };
enum { I_X = 0, I_C, I_WADA, I_BADA, I_GMIX, I_WIN, I_GMWS, I_GMBS, I_GMNG, I_PEK, I_W1K, I_W2K, I_PEV, I_W1V, I_W2V, I_WOUT, I_GFFN, I_WR, I_BR, I_WGU, I_BGU, I_WDN, I_BDN, I_GFIN };

struct Frame {
    LAS unsigned char* lds;
    volatile LAS unsigned* MISC;
    unsigned* ctl;
    unsigned char* ws;
    const float* in[24];
    float* out;
    int tid, lane, wave, vcu, G;
};

namespace pg8 {
constexpr int BM = 256, BK = 64, HALF = 128, HTB = HALF * BK * 2, STAGE_BYTES = 8 * HTB;
__device__ __forceinline__ int lds_byte(int r, int c) { const int st = (r >> 4) * 2 + (c >> 5), rr = r & 15, cc = c & 31, ob = rr * 64 + cc * 2; return st * 1024 + (ob ^ (((ob >> 9) & 1) << 5)); }
__device__ __forceinline__ void stage_rc(int b, int& R, int& C) { const int st = b / 1024, sb = b % 1024, swz = sb ^ (((sb >> 9) & 1) << 5); R = (st >> 1) * 16 + swz / 64; C = (st & 1) * 32 + (swz % 64) / 2; }
__device__ __forceinline__ int perm32(int rho) { const int n = rho >> 4, i = rho & 15; return 8 * (i >> 2) + 4 * n + (i & 3); }
struct Unit { int pm, pn, e; };

template <bool FP8, class Prob, class Sched, class Epi>
__device__ __forceinline__ void gemm_phase(LAS unsigned char* lds, const Prob& P, const Sched& S, const Epi& E) {
    const int tid = threadIdx.x, wid = __builtin_amdgcn_readfirstlane(tid >> 6), lane = tid & 63, wr = wid >> 2, wc = wid & 3, fr = lane & 15, fq = lane >> 4;
    const int KB = P.KB, nt = KB / 128;
    int Rr[2], Cc[2]; unsigned voffB[2];
#pragma unroll
    for (int i = 0; i < 2; ++i) { int R, C; stage_rc(tid * 16 + i * 8192, R, C); Rr[i] = R; Cc[i] = C; const int Rb = Epi::PERM ? ((R & ~31) + perm32(R & 31)) : R; voffB[i] = (unsigned)(Rb * KB + C * 2); }
    const size_t kstep = (size_t)(BK * 2);
    const size_t hstepB = (size_t)HALF * KB;
    const unsigned ldsw = (unsigned)wid * 1024u;
    const int aoff = lds_byte(wr * 64 + fr, fq * 8), boff = lds_byte(wc * 32 + fr, fq * 8);
#define PG8_SA(b, h) (((b) * 2 + (h)) * HTB)
#define PG8_SB(b, h) ((4 + (b) * 2 + (h)) * HTB)
#define PG8_STAGE(bufoff, gbase, voff) do { _Pragma("unroll") for (int _i = 0; _i < 2; ++_i) \
        __builtin_amdgcn_global_load_lds((const unsigned*)((const char*)(gbase) + (voff)[_i]), (LAS unsigned*)(lds + (bufoff) + ldsw + _i * 8192), 16, 0, 0); } while (0)
#define PG8_LD8(p) __builtin_shufflevector(*(const LAS v4i_t*)(p), *(const LAS v4i_t*)((p) + 1024), 0, 1, 2, 3, 4, 5, 6, 7)
#define PG8_LDA(dst, b, h) do { _Pragma("unroll") for (int m = 0; m < 4; ++m) dst[m] = PG8_LD8(lds + PG8_SA(b, h) + aoff + m * 2048); } while (0)
#define PG8_LDB(dst, b, h) do { _Pragma("unroll") for (int n = 0; n < 2; ++n) dst[n] = PG8_LD8(lds + PG8_SB(b, h) + boff + n * 2048); } while (0)
#define PG8_LO(x) __builtin_bit_cast(bf16x8, __builtin_shufflevector(x, x, 0, 1, 2, 3))
#define PG8_HI(x) __builtin_bit_cast(bf16x8, __builtin_shufflevector(x, x, 4, 5, 6, 7))
#ifdef EMU
#define PG8_MFMA_F8(c_, b_, a_) c_ = __builtin_amdgcn_mfma_scale_f32_16x16x128_f8f6f4(b_, a_, c_, 0, 0, 0, 0x7F7F7F7F, 0, 0x7F7F7F7F)
#else
#define PG8_MFMA_F8(c_, b_, a_) asm volatile("v_mfma_scale_f32_16x16x128_f8f6f4 %0, %1, %2, %0, %3, %3 op_sel_hi:[0,0,0]" : "+v"(c_) : "v"(b_), "v"(a_), "v"(f8one))
#endif
#define PG8_MMA(ai, bj, At, Bt) do { __builtin_amdgcn_s_setprio(1); \
        if (FP8) { _Pragma("unroll") for (int m = 0; m < 4; ++m) _Pragma("unroll") for (int n = 0; n < 2; ++n) PG8_MFMA_F8(acc[ai][bj][m][n], Bt[n], At[m]); } \
        else { _Pragma("unroll") for (int m = 0; m < 4; ++m) _Pragma("unroll") for (int n = 0; n < 2; ++n) { \
            acc[ai][bj][m][n] = __builtin_amdgcn_mfma_f32_16x16x32_bf16(PG8_LO(Bt[n]), PG8_LO(At[m]), acc[ai][bj][m][n], 0, 0, 0); \
            acc[ai][bj][m][n] = __builtin_amdgcn_mfma_f32_16x16x32_bf16(PG8_HI(Bt[n]), PG8_HI(At[m]), acc[ai][bj][m][n], 0, 0, 0); } } \
        __builtin_amdgcn_s_setprio(0); } while (0)
#define PG8_WAIT_V(n) ASM_VMCNT(n)
#define PG8_WAIT_L(n) ASM_LGKMCNT(n)
#define PG8_BAR __builtin_amdgcn_s_barrier()
#define PG8_SCHED __builtin_amdgcn_sched_barrier(0)
#ifndef EMU
    unsigned long long ge0_ = 0; const bool gprobe0_ = (PROBE_K / 10 == Epi::PID) && blockIdx.x == 0 && tid == 0;
    if (gprobe0_) ge0_ = __builtin_amdgcn_s_memrealtime();
#endif
    Unit cur, nxt; int ui = 0;
    if (!S.next(0, cur)) return;
    f32x4 acc[2][2][4][2];
#pragma unroll
    for (int a = 0; a < 2; ++a)
#pragma unroll
        for (int b = 0; b < 2; ++b)
#pragma unroll
            for (int m = 0; m < 4; ++m)
#pragma unroll
                for (int n = 0; n < 2; ++n) acc[a][b][m][n] = (f32x4){0.f, 0.f, 0.f, 0.f};
    v8i_t At[4], B0[2], B1[2];
    int f8one = 0x7F7F7F7F;
#ifndef EMU
    asm volatile("" : "+v"(f8one));
#endif
    (void)f8one;
    unsigned vA0[2], vA1[2], nA0[2], nA1[2];
#define PG8_SIDE(k) (lds + STAGE_BYTES + ((k) % 3) * 2048)
    if (Prob::SIDE) { P.side_issue(cur, PG8_SIDE(0), wid, lane); PG8_WAIT_V(0); PG8_BAR; }
#pragma unroll
    for (int i = 0; i < 2; ++i) { vA0[i] = P.a_rowoff(cur, Rr[i], PG8_SIDE(0)) + (unsigned)Cc[i] * 2u; vA1[i] = P.a_rowoff(cur, HALF + Rr[i], PG8_SIDE(0)) + (unsigned)Cc[i] * 2u; }
    const char* cA = P.a_base(cur); const char* cB = P.b_base(cur);
    PG8_STAGE(PG8_SB(0, 0), cB, voffB); PG8_STAGE(PG8_SB(0, 1), cB + hstepB, voffB); PG8_STAGE(PG8_SA(0, 0), cA, vA0); PG8_STAGE(PG8_SA(0, 1), cA, vA1);
    if (wr == 1) PG8_BAR;
    PG8_WAIT_V(2); PG8_BAR;
    PG8_STAGE(PG8_SB(1, 0), cB + kstep, voffB); PG8_STAGE(PG8_SA(1, 0), cA + kstep, vA0); PG8_STAGE(PG8_SB(1, 1), cB + hstepB + kstep, voffB);
    PG8_WAIT_V(6); PG8_BAR;
    for (;;) {
        const bool has_next = S.next(ui + 1, nxt);
        const char* nA = has_next ? P.a_base(nxt) : cA; const char* nB = has_next ? P.b_base(nxt) : cB;
        if (Prob::SIDE && has_next) P.side_issue(nxt, PG8_SIDE(ui + 1), wid, lane);
#pragma unroll
        for (int i = 0; i < 2; ++i) { nA0[i] = vA0[i]; nA1[i] = vA1[i]; }
        if (!Prob::SIDE && has_next) {
#pragma unroll
            for (int i = 0; i < 2; ++i) { nA0[i] = P.a_rowoff(nxt, Rr[i], PG8_SIDE(0)) + (unsigned)Cc[i] * 2u; nA1[i] = P.a_rowoff(nxt, HALF + Rr[i], PG8_SIDE(0)) + (unsigned)Cc[i] * 2u; }
        }
#ifndef EMU
        unsigned long long gt0_ = 0; const bool gprobe_ = (PROBE_K / 10 == Epi::PID) && blockIdx.x == 0 && tid == 0;
        if (gprobe_) { gt0_ = __builtin_amdgcn_s_memrealtime(); if (ui == 0) ((volatile LAS unsigned*)(lds + MISC_OFF))[300 + 8] += (unsigned)(gt0_ - ge0_); }
#endif
        for (int t = 0; t < nt; t += 2) {
            const bool last = (t == nt - 2);
            if (Prob::SIDE && has_next && t == nt - 4) {
#pragma unroll
                for (int i = 0; i < 2; ++i) { nA0[i] = P.a_rowoff(nxt, Rr[i], PG8_SIDE(ui + 1)) + (unsigned)Cc[i] * 2u; nA1[i] = P.a_rowoff(nxt, HALF + Rr[i], PG8_SIDE(ui + 1)) + (unsigned)Cc[i] * 2u; }
            }
            const char* a1 = cA + (size_t)(t + 1) * kstep;
            const char* a2 = last ? nA : cA + (size_t)(t + 2) * kstep; const char* b2 = last ? nB : cB + (size_t)(t + 2) * kstep;
            const char* a3 = a2 + kstep; const char* b3 = b2 + kstep;
            unsigned s0[2], s1[2];
#pragma unroll
            for (int i = 0; i < 2; ++i) { s0[i] = last ? nA0[i] : vA0[i]; s1[i] = last ? nA1[i] : vA1[i]; }
            PG8_LDB(B0, 0, 0); PG8_LDB(B1, 0, 1); PG8_SCHED; PG8_LDA(At, 0, 0); PG8_STAGE(PG8_SA(1, 1), a1, vA1);
            PG8_WAIT_V(8); PG8_WAIT_L(0); PG8_BAR; PG8_MMA(0, 0, At, B0); PG8_MMA(0, 1, At, B1); PG8_BAR; PG8_SCHED;
            PG8_LDA(At, 0, 1); PG8_STAGE(PG8_SB(0, 0), b2, voffB); PG8_STAGE(PG8_SB(0, 1), b2 + hstepB, voffB); PG8_STAGE(PG8_SA(0, 0), a2, s0);
            PG8_WAIT_V(8); PG8_WAIT_L(0); PG8_BAR; PG8_MMA(1, 0, At, B0); PG8_MMA(1, 1, At, B1); PG8_BAR; PG8_SCHED;
            PG8_LDB(B0, 1, 0); PG8_LDB(B1, 1, 1); PG8_SCHED; PG8_LDA(At, 1, 0); PG8_STAGE(PG8_SA(0, 1), a2, s1);
            PG8_WAIT_V(8); PG8_WAIT_L(0); PG8_BAR; PG8_MMA(0, 0, At, B0); PG8_MMA(0, 1, At, B1); PG8_BAR; PG8_SCHED;
            PG8_LDA(At, 1, 1); PG8_STAGE(PG8_SB(1, 0), b3, voffB); PG8_STAGE(PG8_SB(1, 1), b3 + hstepB, voffB); PG8_STAGE(PG8_SA(1, 0), a3, s0);
            PG8_WAIT_V(8); PG8_WAIT_L(0); PG8_BAR; PG8_MMA(1, 0, At, B0); PG8_MMA(1, 1, At, B1); PG8_BAR; PG8_SCHED;
        }
#ifndef EMU
        if (gprobe_) { const unsigned long long t1_ = __builtin_amdgcn_s_memrealtime(); ((volatile LAS unsigned*)(lds + MISC_OFF))[300 + 6] += (unsigned)(t1_ - gt0_); gt0_ = t1_; }
#endif
        if (wr == 0) PG8_BAR;
#ifndef EMU
        if (FP8) asm volatile("s_nop 15\n\ts_nop 15" ::: "memory");
#endif
        E(acc, cur, wr, wc, fr, fq, (const LAS float*)(PG8_SIDE(ui) + 1024));
        if (!has_next) break;
#pragma unroll
        for (int a = 0; a < 2; ++a)
#pragma unroll
            for (int b = 0; b < 2; ++b)
#pragma unroll
                for (int m = 0; m < 4; ++m)
#pragma unroll
                    for (int n = 0; n < 2; ++n) acc[a][b][m][n] = (f32x4){0.f, 0.f, 0.f, 0.f};
#ifndef EMU
        if (gprobe_) { const unsigned long long t1_ = __builtin_amdgcn_s_memrealtime(); ((volatile LAS unsigned*)(lds + MISC_OFF))[300 + 7] += (unsigned)(t1_ - gt0_); }
#endif
        cur = nxt; cA = nA; cB = nB; ++ui;
#pragma unroll
        for (int i = 0; i < 2; ++i) { vA0[i] = nA0[i]; vA1[i] = nA1[i]; }
        if (wr == 1) PG8_BAR;
    }
#ifndef EMU
    if (gprobe0_) ge0_ = __builtin_amdgcn_s_memrealtime();
#endif
    PG8_WAIT_V(0);
    PG8_BAR;
#ifndef EMU
    if (gprobe0_) ((volatile LAS unsigned*)(lds + MISC_OFF))[300 + 9] += (unsigned)(__builtin_amdgcn_s_memrealtime() - ge0_);
#endif
#undef PG8_SIDE
#undef PG8_SA
#undef PG8_SB
#undef PG8_STAGE
#undef PG8_LDA
#undef PG8_LDB
#undef PG8_MMA
#undef PG8_MFMA_F8
#undef PG8_LD8
#undef PG8_LO
#undef PG8_HI
#undef PG8_WAIT_V
#undef PG8_WAIT_L
#undef PG8_BAR
#undef PG8_SCHED
}

struct DenseOrder {
    int nM, nN, nwg, G, c;
    __device__ __forceinline__ void init(int M, int N, int G_, int c_) { nM = M / BM; nN = N / BM; nwg = nM * nN; G = G_; c = c_; }
    __device__ __forceinline__ bool next(int i, Unit& u) const {
        const long L = (long)i * G + c; if (L >= nwg) return false;
        int wgid = (int)L; { const int q = nwg / 8, r = nwg % 8, xcd = wgid % 8, off = wgid / 8; wgid = (xcd < r ? xcd * (q + 1) : r * (q + 1) + (xcd - r) * q) + off; }
        const int nig = 8 * nN, gid = wgid / nig, fm = gid * 8, gsz = (nM - fm) < 8 ? (nM - fm) : 8;
        u.pm = fm + ((wgid % nig) % gsz); u.pn = (wgid % nig) / gsz; u.e = 0; return true;
    }
};
struct DenseProb {
    static constexpr bool SIDE = false;
    const char* A; const char* Bt; int KB;
    __device__ __forceinline__ const char* a_base(const Unit& u) const { return A + (size_t)u.pm * BM * KB; }
    __device__ __forceinline__ unsigned a_rowoff(const Unit&, int r, const LAS unsigned char*) const { return (unsigned)(r * KB); }
    __device__ __forceinline__ const char* b_base(const Unit& u) const { return Bt + (size_t)u.pn * BM * KB; }
    __device__ __forceinline__ void side_issue(const Unit&, LAS unsigned char*, int, int) const {}
};
struct MoeOrder {
    volatile LAS unsigned* tpfx; int nN, G, c;
    mutable int ecur;
    __device__ __forceinline__ bool next(int i, Unit& u) const {
        const int L = i * G + c; const int total = (int)tpfx[NE] * nN; if (L >= total) return false;
        int e = ecur;
        if (L < (int)tpfx[e] * nN) e = 0;
        while (L >= (int)tpfx[e + 1] * nN) ++e;
        ecur = e;
        const int rem = L - (int)tpfx[e] * nN, tm = (int)tpfx[e + 1] - (int)tpfx[e];
        u.e = e; u.pm = rem % tm; u.pn = rem / tm; return true;
    }
};
}

struct EpiZ {
    static constexpr bool PERM = true; static constexpr int PID = 2;
    bf16_t* O;
    __device__ __forceinline__ void operator()(const f32x4 (&acc)[2][2][4][2], const pg8::Unit& u, int wr, int wc, int fr, int fq, const LAS float*) const {
        const int row0 = u.pm * 256 + wr * 64 + fr, col0 = u.pn * 256 + wc * 32 + 8 * fq;
#pragma unroll
        for (int ai = 0; ai < 2; ++ai)
#pragma unroll
            for (int m = 0; m < 4; ++m) { bf16_t* rowp = O + (size_t)(row0 + ai * 128 + m * 16) * ZP + col0;
#pragma unroll
                for (int bj = 0; bj < 2; ++bj) { const f32x4 v0 = acc[ai][bj][m][0], v1 = acc[ai][bj][m][1];
                    u32x4 w; w.x = pk2(v0[0], v0[1]); w.y = pk2(v0[2], v0[3]); w.z = pk2(v1[0], v1[1]); w.w = pk2(v1[2], v1[3]);
                    *(u32x4*)(rowp + bj * 128) = w; } }
    }
};
struct EpiMix {
    static constexpr bool PERM = true; static constexpr int PID = 5;
    bf16_t* O;
    __device__ __forceinline__ void operator()(const f32x4 (&acc)[2][2][4][2], const pg8::Unit& u, int wr, int wc, int fr, int fq, const LAS float*) const {
        const int row0 = u.pm * 256 + wr * 64 + fr, col0 = u.pn * 256 + wc * 32 + 8 * fq;
#pragma unroll
        for (int ai = 0; ai < 2; ++ai)
#pragma unroll
            for (int m = 0; m < 4; ++m) { bf16_t* rowp = O + (size_t)(row0 + ai * 128 + m * 16) * DM + col0;
#pragma unroll
                for (int bj = 0; bj < 2; ++bj) { const f32x4 v0 = acc[ai][bj][m][0], v1 = acc[ai][bj][m][1];
                    u32x4 w; w.x = pk2(v0[0], v0[1]); w.y = pk2(v0[2], v0[3]); w.z = pk2(v1[0], v1[1]); w.w = pk2(v1[2], v1[3]);
                    *(u32x4*)(rowp + bj * 128) = w; } }
    }
};
struct EpiAct {
    static constexpr bool PERM = true; static constexpr int PID = 7;
    unsigned char* O; const float* bgu; volatile LAS unsigned* roff;
    __device__ __forceinline__ void operator()(const f32x4 (&acc)[2][2][4][2], const pg8::Unit& u, int wr, int wc, int fr, int fq, const LAS float* sb) const {
        const int row0 = (int)roff[u.e] + u.pm * 256 + wr * 64 + fr, col0 = u.pn * 128 + wc * 32 + 8 * fq;
        const LAS float* bp = sb + 2 * (wc * 32 + 8 * fq);
        f32x4 bb[4];
#pragma unroll
        for (int j = 0; j < 4; ++j) bb[j] = *(const LAS f32x4*)(bp + 4 * j);
#pragma unroll
        for (int ai = 0; ai < 2; ++ai)
#pragma unroll
            for (int m = 0; m < 4; ++m) { float a8[8];
#pragma unroll
                for (int n = 0; n < 2; ++n)
#pragma unroll
                    for (int j = 0; j < 4; ++j) { const int cc = 4 * n + j;
                        float g = acc[ai][0][m][n][j] * F8_ACC_SCALE + bb[cc >> 1][(cc & 1) * 2], l = acc[ai][1][m][n][j] * F8_ACC_SCALE + bb[cc >> 1][(cc & 1) * 2 + 1];
                        g = fminf(g, 7.0f); l = fminf(fmaxf(l, -7.0f), 7.0f);
                        a8[cc] = (g * F8_ACT_SCALE) * __builtin_amdgcn_rcpf(1.0f + fexp2(g * (-1.702f * LOG2E))) * (l + 1.0f); }
                u32x2 w; w.x = pk4_fp8_nc(a8[0], a8[1], a8[2], a8[3]); w.y = pk4_fp8_nc(a8[4], a8[5], a8[6], a8[7]);
                *(u32x2*)(O + (size_t)(row0 + ai * 128 + m * 16) * DFF + col0) = w; }
    }
};
struct EpiYd {
    static constexpr bool PERM = true; static constexpr int PID = 8;
    bf16_t* O; const float* bdn; volatile LAS unsigned* roff;
    __device__ __forceinline__ void operator()(const f32x4 (&acc)[2][2][4][2], const pg8::Unit& u, int wr, int wc, int fr, int fq, const LAS float* sb) const {
        const int row0 = (int)roff[u.e] + u.pm * 256 + wr * 64 + fr, col0 = u.pn * 256 + wc * 32 + 8 * fq;
        f32x4 bv[2][2];
#pragma unroll
        for (int bj = 0; bj < 2; ++bj)
#pragma unroll
            for (int n = 0; n < 2; ++n) bv[bj][n] = *(const LAS f32x4*)(sb + wc * 32 + 8 * fq + bj * 128 + 4 * n);
#pragma unroll
        for (int ai = 0; ai < 2; ++ai)
#pragma unroll
            for (int m = 0; m < 4; ++m) { bf16_t* rowp = O + (size_t)(row0 + ai * 128 + m * 16) * DM + col0;
#pragma unroll
                for (int bj = 0; bj < 2; ++bj) { const f32x4 v0 = acc[ai][bj][m][0] * F8_ACC_SCALE + bv[bj][0], v1 = acc[ai][bj][m][1] * F8_ACC_SCALE + bv[bj][1];
                    u32x4 w; w.x = pk2(v0[0], v0[1]); w.y = pk2(v0[2], v0[3]); w.z = pk2(v1[0], v1[1]); w.w = pk2(v1[2], v1[3]);
                    *(u32x4*)(rowp + bj * 128) = w; } }
    }
};
struct MoeProb1 {
    static constexpr bool SIDE = true;
    const char* H2; const char* Bt; const int* lists; const float* bias; volatile LAS unsigned* cnt; int KB;
    __device__ __forceinline__ const char* a_base(const pg8::Unit&) const { return H2; }
    __device__ __forceinline__ unsigned a_rowoff(const pg8::Unit& u, int r, const LAS unsigned char* side) const { const int i = u.pm * 256 + r; const int tok = (i < (int)cnt[u.e]) ? ((const LAS int*)side)[r] : 0; return (unsigned)tok * 1024u; }
    __device__ __forceinline__ const char* b_base(const pg8::Unit& u) const { return Bt + ((size_t)u.e * 2048 + (size_t)u.pn * 256) * 1024; }
    __device__ __forceinline__ void side_issue(const pg8::Unit& u, LAS unsigned char* side, int wid, int lane) const {
        if (wid == 0) __builtin_amdgcn_global_load_lds((const unsigned*)(lists + (size_t)u.e * T + u.pm * 256 + lane * 4), (LAS unsigned*)side, 16, 0, 0);
        if (wid == 1) __builtin_amdgcn_global_load_lds((const unsigned*)(bias + (size_t)u.e * 2048 + u.pn * 256 + lane * 4), (LAS unsigned*)(side + 1024), 16, 0, 0);
    }
};
struct MoeProb2 {
    static constexpr bool SIDE = true;
    const char* A; const char* Bt; const float* bias; volatile LAS unsigned* roff; int KB;
    __device__ __forceinline__ const char* a_base(const pg8::Unit& u) const { return A + ((size_t)roff[u.e] + (size_t)u.pm * 256) * 1024; }
    __device__ __forceinline__ unsigned a_rowoff(const pg8::Unit&, int r, const LAS unsigned char*) const { return (unsigned)r * 1024u; }
    __device__ __forceinline__ const char* b_base(const pg8::Unit& u) const { return Bt + ((size_t)u.e * 1024 + (size_t)u.pn * 256) * 1024; }
    __device__ __forceinline__ void side_issue(const pg8::Unit& u, LAS unsigned char* side, int wid, int lane) const {
        if (wid == 1) __builtin_amdgcn_global_load_lds((const unsigned*)(bias + (size_t)u.e * 1024 + u.pn * 256 + lane * 4), (LAS unsigned*)(side + 1024), 16, 0, 0);
    }
};

template <int NB>
__device__ __forceinline__ void gemv_item(Frame& F, const float* vec, int vstride, const float* W, int K, int N, int n0, const float* bias, float* out, int ostride) {
    LAS float* red = (LAS float*)F.lds;
    const int col = n0 + F.lane, ks = K / NWAVES;
    float acc[NB];
#pragma unroll
    for (int b = 0; b < NB; ++b) acc[b] = 0.f;
    for (int k0 = F.wave * ks; k0 < (F.wave + 1) * ks; k0 += 32) {
        float wv[32];
#pragma unroll
        for (int j = 0; j < 32; ++j) wv[j] = __builtin_nontemporal_load(W + (size_t)(k0 + j) * N + col);
#pragma unroll
        for (int j = 0; j < 32; ++j)
#pragma unroll
            for (int b = 0; b < NB; ++b) acc[b] += vec[b * vstride + k0 + j] * wv[j]; }
#pragma unroll
    for (int b = 0; b < NB; ++b) red[(F.wave * NB + b) * 64 + F.lane] = acc[b];
    __syncthreads();
    if (F.wave == 0) {
#pragma unroll
        for (int b = 0; b < NB; ++b) { float s = bias ? bias[col] : 0.f;
            for (int w = 0; w < NWAVES; ++w) s += red[(w * NB + b) * 64 + F.lane];
            out[b * ostride + col] = s; }
    }
    __syncthreads();
}
template <int MAP>
__device__ __forceinline__ int t_rowmap(int n) {
    if (MAP == 0) return n;
    const int ac = n >> 1, bj = n & 1; return (ac >> 7) * 256 + bj * 128 + (ac & 127);
}
template <int MAP>
__device__ __forceinline__ void transpose_item(const float* W, int K, int Nsrc, int nblk, bf16_t* WT, LAS float* scr, int item, int lane) {
    const int kb = item / nblk, nb = item % nblk, k0 = 64 * kb, n0 = 32 * nb;
    const int nc = n0 + (lane & 31);
    float tv[32];
    if (nc < Nsrc) {
#pragma unroll
        for (int i = 0; i < 32; ++i) tv[i] = __builtin_nontemporal_load(W + (size_t)(k0 + 2 * i + (lane >> 5)) * Nsrc + nc);
    } else {
#pragma unroll
        for (int i = 0; i < 32; ++i) tv[i] = 0.f;
    }
#pragma unroll
    for (int i = 0; i < 32; ++i) scr[(2 * i + (lane >> 5)) * 33 + (lane & 31)] = tv[i];
    WAVE_SYNC(); FENCE();
    const int c = lane & 7;
#pragma unroll
    for (int j = 0; j < 4; ++j) { const int n = (lane >> 3) + 8 * j; const LAS float* s = scr + (8 * c) * 33 + n;
        u32x4 o; o.x = pk2(s[0 * 33], s[1 * 33]); o.y = pk2(s[2 * 33], s[3 * 33]); o.z = pk2(s[4 * 33], s[5 * 33]); o.w = pk2(s[6 * 33], s[7 * 33]);
        *(u32x4*)(WT + (size_t)t_rowmap<MAP>(n0 + n) * K + k0 + 8 * c) = o; }
    WAVE_SYNC(); FENCE();
}
template <int MAP>
__device__ __forceinline__ void transpose_item_f8(const float* W, int K, int Nsrc, int nblk, unsigned char* WT, LAS float* scr, int item, int lane, float scale) {
    const int kb = item / nblk, nb = item % nblk, k0 = 64 * kb, n0 = 32 * nb;
    const int nc = n0 + (lane & 31);
    (void)nc;
    f32x4 tv[8];
#pragma unroll
    for (int i = 0; i < 8; ++i) tv[i] = __builtin_nontemporal_load((const f32x4*)(W + (size_t)(k0 + 8 * i + (lane >> 3)) * Nsrc + n0 + 4 * (lane & 7)));
#pragma unroll
    for (int i = 0; i < 8; ++i) { LAS float* d = scr + (8 * i + (lane >> 3)) * 33 + 4 * (lane & 7);
        d[0] = tv[i][0] * scale; d[1] = tv[i][1] * scale; d[2] = tv[i][2] * scale; d[3] = tv[i][3] * scale; }
    WAVE_SYNC(); FENCE();
    const int c = lane & 7;
#pragma unroll
    for (int j = 0; j < 4; ++j) { const int n = (lane >> 3) + 8 * j; const LAS float* sp = scr + (8 * c) * 33 + n;
        u32x2 o; o.x = pk4_fp8(sp[0 * 33], sp[1 * 33], sp[2 * 33], sp[3 * 33]); o.y = pk4_fp8(sp[4 * 33], sp[5 * 33], sp[6 * 33], sp[7 * 33]);
        *(u32x2*)(WT + (size_t)t_rowmap<MAP>(n0 + n) * K + k0 + 8 * c) = o; }
    WAVE_SYNC(); FENCE();
}
constexpr int P0_I_IN = (DM / 64) * (ZP / 32), P0_I_OUT = (DM / 64) * (DM / 32), P0_I_W1 = (2048 / 64) * (256 / 32), P0_I_W2 = (256 / 64) * (64 / 32);
constexpr int P0_I_GU1 = (DM / 64) * (2048 / 32), P0_I_DN1 = (DFF / 64) * (DM / 32);
constexpr int P0_NITEMS = P0_I_IN + P0_I_OUT + 2 * P0_I_W1 + 2 * P0_I_W2 + NE * P0_I_GU1 + NE * P0_I_DN1;
constexpr int P2_FILL_PER_CU = 44;
__device__ __forceinline__ int p2_fill_items(const Frame& F) { return (F.G == 256 && (T / 256) * (ZP / 256) == 640) ? 128 * P2_FILL_PER_CU : 0; }
#ifndef P7_FILL_ITEMS
#define P7_FILL_ITEMS 8192
#endif
__device__ __forceinline__ int p7_fill_items(const Frame& F) { return (F.G >= 8) ? P7_FILL_ITEMS : 0; }
__device__ __forceinline__ void p0_item(Frame& F, LAS float* scr, int it) {
    int r = it;
    if (r < P0_I_IN) { transpose_item<0>(F.in[I_WIN], DM, INC, ZP / 32, (bf16_t*)(F.ws + WS_WINT), scr, r, F.lane); return; } r -= P0_I_IN;
    if (r < P0_I_OUT) { transpose_item<0>(F.in[I_WOUT], DM, DM, DM / 32, (bf16_t*)(F.ws + WS_WOUTT), scr, r, F.lane); return; } r -= P0_I_OUT;
    if (r < P0_I_W1) { transpose_item<0>(F.in[I_W1K], 2048, 256, 8, (bf16_t*)(F.ws + WS_W1KT), scr, r, F.lane); return; } r -= P0_I_W1;
    if (r < P0_I_W1) { transpose_item<0>(F.in[I_W1V], 2048, 256, 8, (bf16_t*)(F.ws + WS_W1VT), scr, r, F.lane); return; } r -= P0_I_W1;
    if (r < P0_I_W2) { transpose_item<0>(F.in[I_W2K], 256, 64, 2, (bf16_t*)(F.ws + WS_W2KT), scr, r, F.lane); return; } r -= P0_I_W2;
    if (r < P0_I_W2) { transpose_item<0>(F.in[I_W2V], 256, 64, 2, (bf16_t*)(F.ws + WS_W2VT), scr, r, F.lane); return; } r -= P0_I_W2;
    if (r < NE * P0_I_GU1) { const int e = r / P0_I_GU1; transpose_item_f8<1>(F.in[I_WGU] + (size_t)e * DM * 2048, DM, 2048, 64, (unsigned char*)(F.ws + WS_WGUT) + (size_t)e * 2048 * DM, scr, r % P0_I_GU1, F.lane, F8_W_SCALE); return; } r -= NE * P0_I_GU1;
    { const int e = r / P0_I_DN1; transpose_item_f8<0>(F.in[I_WDN] + (size_t)e * DFF * DM, DFF, DM, 32, (unsigned char*)(F.ws + WS_WDNT) + (size_t)e * DM * DFF, scr, r % P0_I_DN1, F.lane, F8_W_SCALE); }
}
__device__ __forceinline__ void p0_prologue(Frame& F) {
    for (int it = F.vcu; it < 96 + 8; it += F.G) {
        if (it < 96) gemv_item<BATCH>(F, F.in[I_C], DM, F.in[I_WADA], DM, 6 * DM, 64 * it, F.in[I_BADA], (float*)(F.ws + WS_MOD), 6 * DM);
        else { const int j = it - 96, kv = j >> 2, n0 = (j & 3) * 64;
            gemv_item<1>(F, F.in[kv ? I_PEV : I_PEK], 0, F.in[kv ? I_W1V : I_W1K], 2048, 256, n0, nullptr, (float*)(F.ws + WS_BPE) + kv * 256, 0); }
    }
    { const float* src = F.in[I_GMWS]; bf16_t* dst = (bf16_t*)(F.ws + WS_WSBF);
      for (int idx = F.vcu * NTHREADS + F.tid; idx < GMG * GMC * GMC; idx += F.G * NTHREADS) { const int i = (idx >> 7) & 127, j = idx & 127; dst[idx] = (bf16_t)f2bf(j <= i ? src[idx] : 0.f); } }
    LAS float* scr = (LAS float*)(F.lds + 8192 + F.wave * 16384);
    const int gw = F.vcu * NWAVES + F.wave, NGW = F.G * NWAVES;
    const int nit = P0_NITEMS - p2_fill_items(F) - p7_fill_items(F);
    constexpr int NGEMV = 96 + 8;
    const int shift = (F.G > 2 * NGEMV) ? 2 * NGEMV * NWAVES : 0, n1 = nit - shift;
    for (int it = gw; it < n1; it += NGW) p0_item(F, scr, it);
    if (shift && F.vcu >= NGEMV) for (int it = n1 + (F.vcu - NGEMV) * NWAVES + F.wave; it < nit; it += (F.G - NGEMV) * NWAVES) p0_item(F, scr, it);
}

__device__ __forceinline__ void norm_rows(Frame& F, const float* xin, const float* g, int mod_shift, int mod_scale, bf16_t* outb) {
    const int gw = F.vcu * NWAVES + F.wave, NGW = F.G * NWAVES;
    const float* mod = (const float*)(F.ws + WS_MOD);
    for (int m0 = gw; m0 < T / 2; m0 += NGW) {
        f32x4 v[2][4]; float s[2] = {0.f, 0.f};
#pragma unroll
        for (int q = 0; q < 2; ++q) { const f32x4* xr = (const f32x4*)(xin + (size_t)(m0 + q * (T / 2)) * DM) + F.lane;
#pragma unroll
            for (int j = 0; j < 4; ++j) v[q][j] = __builtin_nontemporal_load(xr + 64 * j); }
#pragma unroll
        for (int q = 0; q < 2; ++q)
#pragma unroll
            for (int j = 0; j < 4; ++j) s[q] += (v[q][j][0] * v[q][j][0] + v[q][j][1] * v[q][j][1]) + (v[q][j][2] * v[q][j][2] + v[q][j][3] * v[q][j][3]);
#pragma unroll
        for (int o = 1; o < 64; o <<= 1) { s[0] += __shfl_xor(s[0], o); s[1] += __shfl_xor(s[1], o); }
#pragma unroll
        for (int q = 0; q < 2; ++q) { const int m = m0 + q * (T / 2), b = m / SEQ;
            const float rinv = __builtin_amdgcn_rsqf(s[q] * (1.0f / DM) + EPS);
            u32x2* o8 = (u32x2*)(outb + (size_t)m * DM) + F.lane;
#pragma unroll
            for (int j = 0; j < 4; ++j) { const int c = 4 * F.lane + 256 * j;
                const f32x4 gg = *(const f32x4*)(g + c), sc = *(const f32x4*)(mod + (size_t)b * 6144 + mod_scale * 1024 + c), sh = *(const f32x4*)(mod + (size_t)b * 6144 + mod_shift * 1024 + c);
                const f32x4 h = v[q][j] * rinv * gg * (sc + 1.0f) + sh;
                u32x2 w; w.x = pk2(h[0], h[1]); w.y = pk2(h[2], h[3]); o8[64 * j] = w; } }
    }
}

struct GmRegs { u32x4 v[2], u[2]; };
__device__ __forceinline__ void gmlp_load(Frame& F, int tile, GmRegs& R) {
    const int g = tile % GMG, ch = (tile / GMG) % (SEQ / GMC), b = tile / (GMG * (SEQ / GMC));
    const size_t row0 = (size_t)b * SEQ + (size_t)ch * GMC;
    const bf16_t* ZB = (const bf16_t*)(F.ws + WS_ZB);
#pragma unroll
    for (int it = 0; it < 2; ++it) { const int idx = F.tid + it * NTHREADS, row = idx >> 3, c8 = idx & 7;
        R.v[it] = *(const u32x4*)(ZB + (row0 + row) * ZP + ZC_V + g * 64 + c8 * 8);
        R.u[it] = *(const u32x4*)(ZB + (row0 + row) * ZP + ZC_U + g * 64 + c8 * 8); }
}
__device__ __forceinline__ void gmlp_compute(Frame& F, int tile, const GmRegs& R) {
    const int g = tile % GMG, ch = (tile / GMG) % (SEQ / GMC), b = tile / (GMG * (SEQ / GMC));
    const size_t row0 = (size_t)b * SEQ + (size_t)ch * GMC;
    LAS bf16_t* Vt = (LAS bf16_t*)F.lds;
    constexpr int VP = 136, UP = 68;
    LAS float* Us = (LAS float*)(F.lds + 64 * VP * 2);
    const float* gn = F.in[I_GMNG] + g * 64;
    const int fr = F.lane & 15, fq = F.lane >> 4, w = F.wave;
    const bf16_t* Wg = (const bf16_t*)(F.ws + WS_WSBF) + (size_t)g * GMC * GMC;
    bf16x8 af[4];
#pragma unroll
    for (int ks = 0; ks < 4; ++ks) af[ks] = *(const bf16x8*)(Wg + (size_t)(16 * w + fr) * GMC + 32 * ks + 8 * fq);
#pragma unroll
    for (int it = 0; it < 2; ++it) {
        const int idx = F.tid + it * NTHREADS, row = idx >> 3, c8 = idx & 7;
        const u32x4 raw = R.v[it];
        float v[8]; v[0] = bflo(raw.x); v[1] = bfhi(raw.x); v[2] = bflo(raw.y); v[3] = bfhi(raw.y); v[4] = bflo(raw.z); v[5] = bfhi(raw.z); v[6] = bflo(raw.w); v[7] = bfhi(raw.w);
        float ss = 0.f;
#pragma unroll
        for (int e = 0; e < 8; ++e) { v[e] = gelu_tanh(v[e]); ss += v[e] * v[e]; }
        ss += __shfl_xor(ss, 1); ss += __shfl_xor(ss, 2); ss += __shfl_xor(ss, 4);
        const float rinv = __builtin_amdgcn_rsqf(ss * (1.0f / 64.0f) + EPS);
#pragma unroll
        for (int e = 0; e < 8; ++e) Vt[(c8 * 8 + e) * VP + row] = (bf16_t)f2bf(v[e] * rinv * gn[c8 * 8 + e]);
        const u32x4 ur = R.u[it];
        f32x4 u0 = {gelu_tanh(bflo(ur.x)), gelu_tanh(bfhi(ur.x)), gelu_tanh(bflo(ur.y)), gelu_tanh(bfhi(ur.y))}, u1 = {gelu_tanh(bflo(ur.z)), gelu_tanh(bfhi(ur.z)), gelu_tanh(bflo(ur.w)), gelu_tanh(bfhi(ur.w))};
        *(LAS f32x4*)(Us + row * UP + c8 * 8) = u0; *(LAS f32x4*)(Us + row * UP + c8 * 8 + 4) = u1;
    }
    __syncthreads();
    f32x4 acc[4];
#pragma unroll
    for (int n = 0; n < 4; ++n) acc[n] = (f32x4){0.f, 0.f, 0.f, 0.f};
#pragma unroll
    for (int ks = 0; ks < 4; ++ks) {
        if (32 * ks <= 16 * w + 15) {
#pragma unroll
            for (int n = 0; n < 4; ++n) { const bf16x8 bb = *(const LAS bf16x8*)(Vt + (16 * n + fr) * VP + 32 * ks + 8 * fq);
                acc[n] = __builtin_amdgcn_mfma_f32_16x16x32_bf16(af[ks], bb, acc[n], 0, 0, 0); }
        }
    }
    bf16_t* Y = (bf16_t*)(F.ws + WS_YMIX);
    const float* bs = F.in[I_GMBS] + g * GMC;
#pragma unroll
    for (int n = 0; n < 4; ++n)
#pragma unroll
        for (int r = 0; r < 4; ++r) { const int i = 16 * w + 4 * fq + r, d = 16 * n + fr;
            Y[(row0 + i) * DM + g * 64 + d] = (bf16_t)f2bf(Us[i * UP + d] * (acc[n][r] + bs[i])); }
    __syncthreads();
}
__device__ __forceinline__ void gmlp_run(Frame& F, int base, int stride, int n) {
    if (n <= 0) return;
    GmRegs A, B;
    gmlp_load(F, base, A);
    for (int k = 0; k < n; k += 2) {
        if (k + 1 < n) gmlp_load(F, base + (k + 1) * stride, B);
        gmlp_compute(F, base + k * stride, A);
        if (k + 1 < n) { if (k + 2 < n) gmlp_load(F, base + (k + 2) * stride, A); gmlp_compute(F, base + (k + 1) * stride, B); }
    }
}

__device__ __forceinline__ void cmp_tile(Frame& F, int tile) {
    constexpr int NT = NCP / 32;
    const int nt = tile % NT, g = (tile / NT) % NG, b = (tile / (NT * NG)) % BATCH, kv = tile / (NT * NG * BATCH);
    const int n0 = 32 * nt, p0 = 16 * n0;
    const bf16_t* ZB = (const bf16_t*)(F.ws + WS_ZB);
    constexpr int RP = 72;
    LAS bf16_t* Rs = (LAS bf16_t*)F.lds;
    LAS bf16_t* Hs = (LAS bf16_t*)(F.lds + 528 * RP * 2);
    constexpr int HP = 264;
    const int zc = (kv ? ZC_VC : ZC_KC) + g * 64;
    {
        u32x4 sv[9];
#pragma unroll
        for (int it = 0; it < 9; ++it) { const int idx = F.tid + it * NTHREADS, row = idx >> 3, c8 = idx & 7; const int p = p0 + row;
            sv[it] = (u32x4){0u, 0u, 0u, 0u};
            if (idx < 528 * 8 && p < SEQ) sv[it] = *(const u32x4*)(ZB + ((size_t)b * SEQ + p) * ZP + zc + c8 * 8); }
#pragma unroll
        for (int it = 0; it < 9; ++it) { const int idx = F.tid + it * NTHREADS, row = idx >> 3, c8 = idx & 7;
            if (idx < 528 * 8) *(LAS u32x4*)(Rs + row * RP + c8 * 8) = sv[it]; }
    }
    __syncthreads();
    const int i = F.lane & 31, hi = F.lane >> 5, w = F.wave;
    const bf16_t* W1T = (const bf16_t*)(F.ws + (kv ? WS_W1VT : WS_W1KT)) + (size_t)(32 * w + i) * 2048;
    f32x16 acc;
#pragma unroll
    for (int r = 0; r < 16; ++r) acc[r] = 0.f;
    bf16x8 bq[16];
#pragma unroll
    for (int j = 0; j < 16; ++j) bq[j] = *(const bf16x8*)(W1T + 16 * j + 8 * hi);
    for (int kb = 0; kb < 8; ++kb) {
        bf16x8 bn[16];
        const int kn = (kb < 7) ? (kb + 1) * 16 : kb * 16;
#pragma unroll
        for (int j = 0; j < 16; ++j) bn[j] = *(const bf16x8*)(W1T + 16 * (kn + j) + 8 * hi);
#pragma unroll
        for (int j = 0; j < 16; ++j) { const int kk = kb * 16 + j; const int l = kk >> 2, d = (16 * j + 8 * hi) & 63;
            const bf16x8 a = *(const LAS bf16x8*)(Rs + (16 * i + l) * RP + d);
            acc = __builtin_amdgcn_mfma_f32_32x32x16_bf16(a, bq[j], acc, 0, 0, 0); }
#pragma unroll
        for (int j = 0; j < 16; ++j) bq[j] = bn[j];
    }
    const float bpe = ((const float*)(F.ws + WS_BPE))[kv * 256 + 32 * w + i];
#pragma unroll
    for (int r = 0; r < 16; ++r) Hs[crow(r, hi) * HP + 32 * w + i] = (bf16_t)f2bf(gelu_tanh(acc[r] + bpe));
    __syncthreads();
    if (w < 2) {
        const bf16_t* W2T = (const bf16_t*)(F.ws + (kv ? WS_W2VT : WS_W2KT)) + (size_t)(32 * w + i) * 256;
        f32x16 o;
#pragma unroll
        for (int r = 0; r < 16; ++r) o[r] = 0.f;
        for (int kk = 0; kk < 16; ++kk) {
            const bf16x8 a = *(const LAS bf16x8*)(Hs + i * HP + 16 * kk + 8 * hi);
            const bf16x8 bb = *(const bf16x8*)(W2T + 16 * kk + 8 * hi);
            o = __builtin_amdgcn_mfma_f32_32x32x16_bf16(a, bb, o, 0, 0, 0);
        }
        bf16_t* KC = (bf16_t*)(F.ws + (kv ? WS_VC : WS_KC)) + ((size_t)(b * NG + g) * NCP) * 64;
#pragma unroll
        for (int r = 0; r < 16; ++r) { const int n = n0 + crow(r, hi); KC[(size_t)n * 64 + 32 * w + i] = (n < NCMP) ? (bf16_t)f2bf(o[r]) : (bf16_t)0; }
    }
    __syncthreads();
}

constexpr int KPB = 128;
constexpr int NB_K = 64 * KPB;
constexpr int V_H1 = 4096;
constexpr int NB_BUF = NB_K + 8192;
constexpr int A_IMP = 3 * NB_BUF, A_SEL = A_IMP + 64 * 128 * 4, A_UNI = A_SEL + 64 * 8 * 2, A_WSF = A_UNI + 256, A_QF = A_WSF + 8 * 32 * 4, A_Y = A_QF + 8 * 4096, A_GATE = A_Y + 8 * 4096, A_END = A_GATE + 8 * 32 * 3 * 4;
static_assert(A_END <= MISC_OFF, "NSA LDS map");
#ifndef NSA_THR_VAL
#define NSA_THR_VAL 20.0f
#endif
constexpr float NSA_THR = NSA_THR_VAL, NEG_BIG = -1e30f;

#ifdef EMU
__device__ __forceinline__ int opaque_lane(int l) { return l; }
#else
__device__ __forceinline__ int opaque_lane(int) { int x; asm volatile("v_mbcnt_lo_u32_b32 %0, -1, 0\n\tv_mbcnt_hi_u32_b32 %0, -1, %0" : "=v"(x)); return x; }
#endif
#ifdef EMU
__device__ __forceinline__ int red8_add(int v) { v += __shfl_xor(v, 1); v += __shfl_xor(v, 2); v += __shfl_xor(v, 4); return v; }
__device__ __forceinline__ float quad_sum(float v) { v += __shfl_xor(v, 1); v += __shfl_xor(v, 2); return v; }
__device__ __forceinline__ float xor32f(float v) { return __shfl_xor(v, 32); }
#else
__device__ __forceinline__ int red8_add(int v) {
    v += __builtin_amdgcn_update_dpp(0, v, 0xB1, 0xF, 0xF, true);
    v += __builtin_amdgcn_update_dpp(0, v, 0x4E, 0xF, 0xF, true);
    v += __builtin_amdgcn_update_dpp(0, v, 0x141, 0xF, 0xF, true);
    return v;
}
__device__ __forceinline__ float quad_sum(float v) {
    v += __builtin_bit_cast(float, __builtin_amdgcn_update_dpp(0, __builtin_bit_cast(int, v), 0xB1, 0xF, 0xF, true));
    v += __builtin_bit_cast(float, __builtin_amdgcn_update_dpp(0, __builtin_bit_cast(int, v), 0x4E, 0xF, 0xF, true));
    return v;
}
__device__ __forceinline__ float xor32f(float v) {
    const unsigned u = __builtin_bit_cast(unsigned, v); auto rr = __builtin_amdgcn_permlane32_swap(u, u, false, false);
    return __builtin_bit_cast(float, (threadIdx.x & 32) ? rr[0] : rr[1]);
}
#endif

template <bool WITHV>
__device__ __forceinline__ void stage_dma(LAS unsigned char* buf, const bf16_t* Kg, const bf16_t* Vg, size_t pitch, long rbase, int wave, int lane) {
    const int krow = 8 * wave + (lane >> 3), kc = (lane & 7) ^ ((lane >> 3) & 7);
    __builtin_amdgcn_global_load_lds((const unsigned*)(Kg + (size_t)(rbase + krow) * pitch + kc * 8), (LAS unsigned*)(buf + wave * 1024), 16, 0, 0);
    if (WITHV) { const int vrow = 16 * (wave & 3) + (lane >> 2), vc = (wave >> 2) * 4 + (lane & 3);
        __builtin_amdgcn_global_load_lds((const unsigned*)(Vg + (size_t)(rbase + vrow) * pitch + vc * 8), (LAS unsigned*)(buf + NB_K + wave * 1024), 16, 0, 0); }
}
struct BrState { float mref, l; int has; unsigned qxm; f32x16 o0, o1; };
__device__ __forceinline__ unsigned ref_words(float m, float& meff) { const unsigned mh = f2bf(m); const float fh = bf2f((unsigned short)mh); const unsigned ml = f2bf(m - fh); meff = fh + bf2f((unsigned short)ml); return mh | (ml << 16); }

#ifdef EMU
#define VTR(p) __builtin_amdgcn_ds_read_tr16_b64_v4i16(p)
#else
typedef short v4i16_t __attribute__((ext_vector_type(4)));
#define VTR(p) __builtin_bit_cast(s16x4, __builtin_amdgcn_ds_read_tr16_b64_v4i16((LAS v4i16_t*)(p)))
#endif

__device__ __forceinline__ void nsa_qk(const LAS unsigned char* buf, const LAS unsigned char* qfl, unsigned qxs, unsigned qxm_t, unsigned klw0, unsigned klw1, unsigned tbw, unsigned neg1w,
                                       f32x16& p0, f32x16& p1, int lane) {
    const int i = lane & 31, hi = lane >> 5;
    const bf16x8 qx = __builtin_bit_cast(bf16x8, ((u32x4){qxs, qxs, qxm_t, 0u}));
    const bf16x8 kx0 = __builtin_bit_cast(bf16x8, ((u32x4){klw0, tbw, neg1w, 0u})), kx1 = __builtin_bit_cast(bf16x8, ((u32x4){klw1, tbw, neg1w, 0u}));
    const LAS unsigned char* kp = buf + i * KPB;
    {
        const f32x16 zero16 = {0.f, 0.f, 0.f, 0.f, 0.f, 0.f, 0.f, 0.f, 0.f, 0.f, 0.f, 0.f, 0.f, 0.f, 0.f, 0.f};
        p0 = __builtin_amdgcn_mfma_f32_32x32x16_bf16(kx0, qx, zero16, 0, 0, 0);
        p1 = __builtin_amdgcn_mfma_f32_32x32x16_bf16(kx1, qx, zero16, 0, 0, 0);
    }
#pragma unroll
    for (int d0 = 0; d0 < 4; ++d0) {
        const int ko = ((2 * d0 + hi) ^ (i & 7)) << 4;
        const bf16x8 k0 = *(const LAS bf16x8*)(kp + ko), k1 = *(const LAS bf16x8*)(kp + 32 * KPB + ko);
        const bf16x8 qd = *(const LAS bf16x8*)(qfl + d0 * 1024);
        p0 = __builtin_amdgcn_mfma_f32_32x32x16_bf16(k0, qd, p0, 0, 0, 0);
        p1 = __builtin_amdgcn_mfma_f32_32x32x16_bf16(k1, qd, p1, 0, 0, 0);
    }
}
template <bool PV, bool TRACK>
__device__ __forceinline__ void nsa_prep(int mode, int lim, BrState& st, f32x16& p0, f32x16& p1, int lane, LAS float* wsf) {
#ifndef EMU
    asm volatile("" : "+v"(lim));
#endif
    const int i = lane & 31, hi = lane >> 5;
    if (__builtin_amdgcn_readfirstlane(mode) != 0) {
        NOSPEC();
        const int lim2 = lim - 4 * hi; const bool inv = (mode == 2);
#pragma unroll
        for (int r = 0; r < 16; ++r) { const int c0 = (r & 3) + 8 * (r >> 2);
            const bool v0 = (c0 <= lim2) != inv, v1 = (c0 + 32 <= lim2) != inv;
            p0[r] = v0 ? p0[r] : -INFINITY; p1[r] = v1 ? p1[r] : -INFINITY; }
    }
    if (TRACK) {
        float mxa = fmaxf(p0[0], p1[0]), mxb = fmaxf(p0[1], p1[1]);
#pragma unroll
        for (int r = 2; r < 16; r += 2) { mxa = fmaxf(fmaxf(mxa, p0[r]), p1[r]); mxb = fmaxf(fmaxf(mxb, p0[r + 1]), p1[r + 1]); }
        float mx = fmaxf(mxa, mxb);
        mx = fmaxf(mx, xor32f(mx));
        const bool upd = (mx > (st.has ? NSA_THR : NEG_BIG)) && (mx > NEG_BIG);
        if (__any(upd)) {
            NOSPEC();
            float meff; const unsigned w = ref_words(st.mref + mx, meff);
            const float de = upd ? (meff - st.mref) : 0.f;
            const float f = (upd && st.has) ? fexp2(-de) : 1.0f;
#pragma unroll
            for (int r = 0; r < 16; ++r) { p0[r] -= de; p1[r] -= de; }
            st.l *= f;
            if (PV) {
                wsf[i] = f; WAVE_SYNC(); FENCE();
                const LAS float* wr_ = wsf + 4 * hi;
#pragma unroll
                for (int r = 0; r < 16; ++r) { const float a = wr_[(r & 3) + 8 * (r >> 2)]; st.o0[r] *= a; st.o1[r] *= a; }
                WAVE_SYNC(); FENCE();
            }
            if (upd) { st.mref = meff; st.qxm = hi ? 0u : w; st.has = 1; }
        }
    }
}
template <bool PV>
__device__ __forceinline__ void nsa_softmax_pv(const LAS unsigned char* buf, BrState& st, f32x16& p0, f32x16& p1, int lane) {
    const int hi = lane >> 5;
    float rs = 0.f;
#pragma unroll
    for (int r = 0; r < 16; ++r) { p0[r] = fexp2(p0[r]); p1[r] = fexp2(p1[r]); rs += p0[r] + p1[r]; }
    st.l += rs;
    if (PV) {
        const LAS unsigned char* vb = buf + NB_K + (4 * hi + ((lane & 15) >> 2)) * 64 + 32 * ((lane >> 4) & 1) + 8 * (lane & 3);
#pragma unroll
        for (int ks = 0; ks < 4; ++ks) {
            const f32x16& p = (ks < 2) ? p0 : p1; const int s = ks & 1;
            u32x4 pw; pw.x = pk2(p[8 * s + 0], p[8 * s + 1]); pw.y = pk2(p[8 * s + 2], p[8 * s + 3]); pw.z = pk2(p[8 * s + 4], p[8 * s + 5]); pw.w = pk2(p[8 * s + 6], p[8 * s + 7]);
            const bf16x8 pa = __builtin_bit_cast(bf16x8, pw);
#pragma unroll
            for (int d0 = 0; d0 < 2; ++d0) {
                const s16x4 lo = VTR(vb + d0 * V_H1 + ks * 1024), hh = VTR(vb + d0 * V_H1 + ks * 1024 + 512);
                const bf16x8 vf = (bf16x8){lo[0], lo[1], lo[2], lo[3], hh[0], hh[1], hh[2], hh[3]};
                if (d0 == 0) st.o0 = __builtin_amdgcn_mfma_f32_32x32x16_bf16(pa, vf, st.o0, 0, 0, 0);
                else         st.o1 = __builtin_amdgcn_mfma_f32_32x32x16_bf16(pa, vf, st.o1, 0, 0, 0);
            }
        }
    }
}

struct ImpSums { float G0[4], S0[4], G1[4], S1[4]; };
template <bool PRODUCE, bool IMP>
__device__ __forceinline__ void nsa_exp_qk(const LAS unsigned char* nbuf, const LAS unsigned char* qfl, unsigned qxs, unsigned qxm_t, unsigned klw0, unsigned klw1, unsigned tbw, unsigned neg1w,
                                           f32x16& n0, f32x16& n1, BrState& st, f32x16& p0, f32x16& p1, u32x4 (&pw)[4], ImpSums& im, int lane) {
    const int i = lane & 31, hi = lane >> 5;
    const LAS unsigned char* kp = nbuf + i * KPB;
    if (PRODUCE) {
        const bf16x8 qx = __builtin_bit_cast(bf16x8, ((u32x4){qxs, qxs, qxm_t, 0u}));
        const bf16x8 kx0 = __builtin_bit_cast(bf16x8, ((u32x4){klw0, tbw, neg1w, 0u})), kx1 = __builtin_bit_cast(bf16x8, ((u32x4){klw1, tbw, neg1w, 0u}));
        const f32x16 zero16 = {0.f, 0.f, 0.f, 0.f, 0.f, 0.f, 0.f, 0.f, 0.f, 0.f, 0.f, 0.f, 0.f, 0.f, 0.f, 0.f};
        n0 = __builtin_amdgcn_mfma_f32_32x32x16_bf16(kx0, qx, zero16, 0, 0, 0);
        n1 = __builtin_amdgcn_mfma_f32_32x32x16_bf16(kx1, qx, zero16, 0, 0, 0);
    }
    float rs = 0.f;
#pragma unroll
    for (int d0 = 0; d0 < 4; ++d0) {
        if (PRODUCE) {
            const int ko = ((2 * d0 + hi) ^ (i & 7)) << 4;
            const bf16x8 k0 = *(const LAS bf16x8*)(kp + ko), k1 = *(const LAS bf16x8*)(kp + 32 * KPB + ko);
            const bf16x8 qd = *(const LAS bf16x8*)(qfl + d0 * 1024);
            n0 = __builtin_amdgcn_mfma_f32_32x32x16_bf16(k0, qd, n0, 0, 0, 0);
            n1 = __builtin_amdgcn_mfma_f32_32x32x16_bf16(k1, qd, n1, 0, 0, 0);
        }
        const float a0 = fexp2(p0[4 * d0]), a1 = fexp2(p0[4 * d0 + 1]), a2 = fexp2(p0[4 * d0 + 2]), a3 = fexp2(p0[4 * d0 + 3]);
        const float b0 = fexp2(p1[4 * d0]), b1 = fexp2(p1[4 * d0 + 1]), b2 = fexp2(p1[4 * d0 + 2]), b3 = fexp2(p1[4 * d0 + 3]);
        const float ga = (a0 + a1) + (a2 + a3), gb = (b0 + b1) + (b2 + b3);
        rs += ga + gb;
        if (IMP) { im.G0[d0] = ga; im.S0[d0] = a3; im.G1[d0] = gb; im.S1[d0] = b3; }
        const unsigned w0 = pk2(a0, a1), w1 = pk2(a2, a3), v0 = pk2(b0, b1), v1 = pk2(b2, b3);
        if ((d0 & 1) == 0) { pw[d0 >> 1].x = w0; pw[d0 >> 1].y = w1; pw[2 + (d0 >> 1)].x = v0; pw[2 + (d0 >> 1)].y = v1; }
        else               { pw[d0 >> 1].z = w0; pw[d0 >> 1].w = w1; pw[2 + (d0 >> 1)].z = v0; pw[2 + (d0 >> 1)].w = v1; }
        __builtin_amdgcn_sched_barrier(0);
    }
    st.l += rs;
}
template <bool PV>
__device__ __forceinline__ void nsa_pv(const LAS unsigned char* buf, BrState& st, const u32x4 (&pw)[4], int lane) {
    if (!PV) return;
    const int hi = lane >> 5;
    const LAS unsigned char* vb = buf + NB_K + (4 * hi + ((lane & 15) >> 2)) * 64 + 32 * ((lane >> 4) & 1) + 8 * (lane & 3);
#pragma unroll
    for (int ks = 0; ks < 4; ++ks) {
        const bf16x8 pa = __builtin_bit_cast(bf16x8, pw[ks]);
#pragma unroll
        for (int d0 = 0; d0 < 2; ++d0) {
            const s16x4 lo = VTR(vb + d0 * V_H1 + ks * 1024), hh = VTR(vb + d0 * V_H1 + ks * 1024 + 512);
            const bf16x8 vf = (bf16x8){lo[0], lo[1], lo[2], lo[3], hh[0], hh[1], hh[2], hh[3]};
            if (d0 == 0) st.o0 = __builtin_amdgcn_mfma_f32_32x32x16_bf16(pa, vf, st.o0, 0, 0, 0);
            else         st.o1 = __builtin_amdgcn_mfma_f32_32x32x16_bf16(pa, vf, st.o1, 0, 0, 0);
        }
        __builtin_amdgcn_sched_barrier(0);
    }
}

__device__ __forceinline__ int bit128(const LAS unsigned* m, int j) { return (int)((m[j >> 5] >> (j & 31)) & 1u); }
__device__ __forceinline__ int next_below(const LAS unsigned* m, int j) { for (int k = j - 1; k >= 0; --k) if ((m[k >> 5] >> (k & 31)) & 1u) return k; return -1; }

struct NsaCtx {
    int qt, g, t, tloc, qloc, head, w, lane; const bf16_t* Zb;
    LAS unsigned char* lds; LAS float* imp; LAS float* wsf;
};
__device__ __forceinline__ void nsa_importance(const NsaCtx& C, const ImpSums& im, int cur) {
    const int i = C.lane & 31, hi = C.lane >> 5;
    float G0[4], G1[4], S0[4], S1[4];
#pragma unroll
    for (int k = 0; k < 4; ++k) { G0[k] = quad_sum(im.G0[k]); G1[k] = quad_sum(im.G1[k]); S0[k] = quad_sum(im.S0[k]); S1[k] = quad_sum(im.S1[k]); }
    float P0[4], P1[4];
#pragma unroll
    for (int k = 0; k < 4; ++k) { P0[k] = xor32f(S0[k]); P1[k] = xor32f(S1[k]); }
    if ((i & 3) == 0) {
        LAS float* row = C.imp + C.qloc * 128 + 16 * cur + hi;
#pragma unroll
        for (int k = 0; k < 4; ++k) {
            const float prev0 = hi ? P0[k] : (k == 0 ? 0.f : P0[k - 1]);
            const float prev1 = hi ? P1[k] : (k == 0 ? P0[3] : P1[k - 1]);
            row[2 * k] = G0[k] + prev0;
            row[8 + 2 * k] = G1[k] + prev1;
        }
        if (hi == 1 && 16 * (cur + 1) < 128) row[15] += S1[3];
    }
}
template <int KIND, int PRE>
__device__ __forceinline__ void nsa_branch(Frame& F, const NsaCtx& C, const LAS unsigned char* qf, const bf16_t* Kg, const bf16_t* Vg, size_t pitch,
                                           int first, int lo, const LAS unsigned* um, const LAS unsigned* wm, const LAS unsigned* qm, int cfull, int climit, BrState& st) {
    constexpr bool PV = (KIND != 1), TRACK = (KIND != 2), CMP = (KIND == 1 || KIND == 2);
    const int lane = C.lane, w = C.w, qt = C.qt;
    const int ln_ = opaque_lane(lane), hi_ = ln_ >> 5, i_ = ln_ & 31;
    unsigned qxs; { const float s2_ = fexp2(-(float)(4 * C.g + (i_ & 3) + 1)) * LOG2E; const unsigned sh_ = f2bf(s2_); const unsigned sl_ = f2bf(s2_ - bf2f((unsigned short)sh_)); qxs = hi_ ? 0u : (sh_ | (sl_ << 16)); }
    const unsigned neg1w = hi_ ? 0u : 0xBF80BF80u; const unsigned maskw = hi_ ? 0u : 0x00007E96u;
    const unsigned klw0 = hi_ ? 0u : (f2bf((float)(CMP ? 16 * i_ : i_)) * 0x10001u), klw1 = hi_ ? 0u : (f2bf((float)(CMP ? 16 * (i_ + 32) : (i_ + 32))) * 0x10001u);
#define SEQ_NEXT(c) ((c) < 0 ? -1 : (KIND == 3 ? next_below(um, (c)) : (((c) - 1 >= lo) ? (c) - 1 : -1)))
#define TILE_NEED(c) (KIND == 3 ? bit128(wm, (c)) : 1)
#define TILE_MODE(c) (KIND == 0 ? (((c) == qt) ? 1 : (((c) == qt - 8) ? 2 : 0)) : (CMP ? ((64 * (c) + 63 <= cfull) ? 0 : 1) : (((c) == qt) ? 1 : 0)))
#define TILE_LIM(c) (CMP ? (climit - 64 * (c)) : C.tloc)
#define TILE_TBW(c) (hi_ ? 0u : (f2bf((float)((CMP ? 1024 : 64) * (c))) * 0x10001u))
#define TILE_QXM(c) ((KIND == 3) ? (bit128(qm, (c)) ? st.qxm : maskw) : st.qxm)
#define SLOT(s) (C.lds + (s) * NB_BUF)
    f32x16 pA0, pA1, pB0, pB1;
    int c0 = first, c1 = SEQ_NEXT(c0), c2 = SEQ_NEXT(c1), s0 = 0;
    if (PRE == 0) { __syncthreads();
        stage_dma<PV>(SLOT(0), Kg, Vg, pitch, 64L * c0, w, lane); }
    if (PRE < 2 && c1 >= 0) stage_dma<PV>(SLOT(1), Kg, Vg, pitch, 64L * c1, w, lane);
    __syncthreads();
    if (TILE_NEED(c0)) nsa_qk(SLOT(0), qf, qxs, TILE_QXM(c0), klw0, klw1, TILE_TBW(c0), neg1w, pA0, pA1, lane);
#define NSA_STEP(P0, P1, N0, N1) do { \
        const int s1_ = (s0 == 2) ? 0 : s0 + 1, s2_ = (s1_ == 2) ? 0 : s1_ + 1; \
        if (c2 >= 0) stage_dma<PV>(SLOT(s2_), Kg, Vg, pitch, 64L * c2, w, lane); \
        const bool need0_ = TILE_NEED(c0) != 0; const int cn_ = (c1 >= 0) ? c1 : c0;     \
        if (need0_) { \
            u32x4 pw_[4]; ImpSums im_; \
            nsa_prep<PV, TRACK>(TILE_MODE(c0), TILE_LIM(c0), st, P0, P1, lane, C.wsf); \
            __builtin_amdgcn_sched_barrier(0); \
            nsa_exp_qk<true, KIND == 2>(SLOT(s1_), qf, qxs, TILE_QXM(cn_), klw0, klw1, TILE_TBW(cn_), neg1w, N0, N1, st, P0, P1, pw_, im_, lane); \
            nsa_pv<PV>(SLOT(s0), st, pw_, lane); \
            if (KIND == 2) nsa_importance(C, im_, c0); \
        } else nsa_qk(SLOT(s1_), qf, qxs, TILE_QXM(cn_), klw0, klw1, TILE_TBW(cn_), neg1w, N0, N1, lane); \
        __syncthreads(); \
        c0 = c1; c1 = c2; c2 = SEQ_NEXT(c2); s0 = s1_; } while (0)
    for (;;) {
        NSA_STEP(pA0, pA1, pB0, pB1); if (c0 < 0) break;
        NSA_STEP(pB0, pB1, pA0, pA1); if (c0 < 0) break;
    }
#undef NSA_STEP
#undef SEQ_NEXT
#undef TILE_NEED
#undef TILE_MODE
#undef TILE_LIM
#undef TILE_TBW
#undef TILE_QXM
#undef SLOT
}
#if !defined(EMU)
#define SUBT_BEGIN() unsigned long long st_t0_ = 0; if (PROBE_K >= 20 && blockIdx.x == 0 && F.tid == 0) st_t0_ = __builtin_amdgcn_s_memrealtime()
#define SUBT_END(i) do { if (PROBE_K >= 20 && blockIdx.x == 0 && F.tid == 0) { const unsigned long long t1_ = __builtin_amdgcn_s_memrealtime(); F.MISC[300 + (i)] += (unsigned)(t1_ - st_t0_); st_t0_ = t1_; } } while (0)
#else
#define SUBT_BEGIN() ((void)0)
#define SUBT_END(i) ((void)0)
#endif
__device__ __forceinline__ void nsa_task(Frame& F, int task) {
    constexpr int NQT = SEQ / 64;
    const int qt = task % NQT, g = (task / NQT) % NG, b = task / (NQT * NG);
    const int t0 = 64 * qt, w = F.wave;
    const bf16_t* Zb = (const bf16_t*)(F.ws + WS_ZB) + (size_t)b * SEQ * ZP;
    LAS float* imp = (LAS float*)(F.lds + A_IMP);
    LAS unsigned short* selm = (LAS unsigned short*)(F.lds + A_SEL);
    LAS unsigned* uniw = (LAS unsigned*)(F.lds + A_UNI);
#define SECTION_LANE() const int lane = opaque_lane(F.lane), i = lane & 31, hi = lane >> 5, ql = i >> 2, qloc = 8 * w + ql, t = t0 + qloc, head = 4 * g + (i & 3); \
        LAS float* wsf = (LAS float*)(F.lds + A_WSF) + w * 32; LAS unsigned char* qf = F.lds + A_QF + w * 4096 + lane * 16; \
        NsaCtx C; C.qt = qt; C.g = g; C.t = t; C.tloc = qloc; C.qloc = qloc; C.head = head; C.w = w; C.lane = lane; C.Zb = Zb; C.lds = F.lds; C.imp = imp; C.wsf = wsf; \
        LAS unsigned* ya = (LAS unsigned*)(F.lds + A_Y) + w * 1024 + hi * 128 + i; (void)ya; (void)head; (void)t
    const LAS unsigned* zz = (const LAS unsigned*)(F.lds + A_UNI);
#define INIT_ST(st) do { st.mref = 0.f; st.l = 0.f; st.has = 0; st.qxm = 0u; _Pragma("unroll") for (int r = 0; r < 16; ++r) { st.o0[r] = 0.f; st.o1[r] = 0.f; } } while (0)
#define ACC_PREP(st, gidx) float f_ = st.l + xor32f(st.l); { const float gate_ = ((const LAS float*)(F.lds + A_GATE))[w * 96 + i * 3 + gidx]; f_ = (f_ > 0.f) ? gate_ * __builtin_amdgcn_rcpf(f_) : 0.f; }     \
        wsf[i] = f_; WAVE_SYNC(); FENCE(); const LAS float* wr_ = wsf + 4 * hi;
    const bf16_t* KCg = (const bf16_t*)(F.ws + WS_KC) + (size_t)(b * NG + g) * NCP * 64;
    const bf16_t* VCg = (const bf16_t*)(F.ws + WS_VC) + (size_t)(b * NG + g) * NCP * 64;
    const int nct = (t0 + 63 >= 31) ? (((t0 + 63 - 31) >> 4) / 64 + 1) : 0;
#define NSA_PRELOAD_CMP(WV) do { if (nct > 0) { stage_dma<WV>(F.lds, KCg, VCg, 64, 64L * (nct - 1), w, lane); if (nct > 1) stage_dma<WV>(F.lds + NB_BUF, KCg, VCg, 64, 64L * (nct - 2), w, lane); } } while (0)
    bool sel_pre = false;
    SUBT_BEGIN();
    {
        SECTION_LANE();
        __syncthreads();
        stage_dma<true>(F.lds, Zb + ZC_KW + g * 64, Zb + ZC_VW + g * 64, ZP, 64L * qt, w, lane);
        if (qt - 1 >= ((qt - 8 > 0) ? qt - 8 : 0)) stage_dma<true>(F.lds + NB_BUF, Zb + ZC_KW + g * 64, Zb + ZC_VW + g * 64, ZP, 64L * (qt - 1), w, lane);
        for (int idx = F.tid; idx < 64 * 128; idx += NTHREADS) imp[idx] = 0.f;
#pragma unroll
        for (int d0 = 0; d0 < 4; ++d0) { const u32x4 raw = *(const u32x4*)(Zb + (size_t)t * ZP + ZC_Q + head * 64 + 16 * d0 + 8 * hi);
            const float sc = 0.125f * LOG2E; u32x4 o;
            o.x = pk2(bflo(raw.x) * sc, bfhi(raw.x) * sc); o.y = pk2(bflo(raw.y) * sc, bfhi(raw.y) * sc); o.z = pk2(bflo(raw.z) * sc, bfhi(raw.z) * sc); o.w = pk2(bflo(raw.w) * sc, bfhi(raw.w) * sc);
            *(LAS u32x4*)(qf + d0 * 1024) = o; }
        if (hi == 0) {
#pragma unroll
            for (int k = 0; k < 3; ++k) ((LAS float*)(F.lds + A_GATE))[w * 96 + i * 3 + k] = sigmoidf_(bf2f(Zb[(size_t)t * ZP + ZC_GL + head * 3 + k]));
        }
    }
    {
        SECTION_LANE();
        BrState st; INIT_ST(st);
        nsa_branch<0, 2>(F, C, qf, Zb + ZC_KW + g * 64, Zb + ZC_VW + g * 64, ZP, qt, (qt - 8 > 0) ? qt - 8 : 0, zz, zz, zz, 0, 0, st);
        NSA_PRELOAD_CMP(false);
        ACC_PREP(st, 2)
#pragma unroll
        for (int r = 0; r < 16; ++r) { const int c_ = (r & 3) + 8 * (r >> 2); const float a_ = wr_[c_]; ya[c_ * 32] = pk2(a_ * st.o0[r], a_ * st.o1[r]); }
        WAVE_SYNC(); FENCE();
    }
    SUBT_END(1);
    {
        SECTION_LANE();
        const bf16_t* Kg = KCg; const bf16_t* Vg = VCg;
        const int cfull = (t0 >= 31) ? ((t0 - 31) >> 4) : -1;
        const int climit = (t >= 31) ? ((t - 31) >> 4) : -1;
        if (nct > 0) {
            BrState st; INIT_ST(st);
            nsa_branch<1, 2>(F, C, qf, Kg, Vg, 64, nct - 1, 0, zz, zz, zz, cfull, climit, st);
            NSA_PRELOAD_CMP(true);
            SUBT_END(2);
            const float ltot = st.l + xor32f(st.l);
            float meff; const unsigned wfin = ref_words(st.mref + ((ltot > 0.f) ? __builtin_log2f(ltot) : 0.f), meff);
            BrState s2; INIT_ST(s2); s2.qxm = hi ? 0u : wfin;
            nsa_branch<2, 2>(F, C, qf, Kg, Vg, 64, nct - 1, 0, zz, zz, zz, cfull, climit, s2);
            stage_dma<true>(F.lds, Zb + ZC_KS + g * 64, Zb + ZC_VS + g * 64, ZP, 64L * qt, w, lane);
            sel_pre = true;
            s2.l = 0.5f;
            ACC_PREP(s2, 0)
#pragma unroll
            for (int r = 0; r < 16; ++r) { const int c_ = (r & 3) + 8 * (r >> 2); const float a_ = wr_[c_]; const unsigned y_ = ya[c_ * 32]; ya[c_ * 32] = pk2(bflo(y_) + a_ * s2.o0[r], bfhi(y_) + a_ * s2.o1[r]); }
            WAVE_SYNC(); FENCE();
        }
    }
    if (!sel_pre) stage_dma<true>(F.lds, Zb + ZC_KS + g * 64, Zb + ZC_VS + g * 64, ZP, 64L * qt, w, F.lane);
    __syncthreads();
    SUBT_END(3);
    {
        const int lane = opaque_lane(F.lane);
        const int q8 = lane >> 3, sub = lane & 7, qq = 8 * w + q8;
        unsigned key[16];
#pragma unroll
        for (int e = 0; e < 16; ++e) { const int j = 16 * sub + e; const bool valid = (j <= qt) && (j < NBLK);
            unsigned kk = valid ? (__builtin_bit_cast(unsigned, imp[qq * 128 + j]) + 1u) : 0u;
            if (valid && (j == 0 || j == qt || j == qt - 1)) kk = 0x7F000000u;
            key[e] = kk; }
        unsigned thr = 0u;
        for (int bit = 30; bit >= 0; --bit) { const unsigned cand = thr | (1u << bit); int c = 0;
#pragma unroll
            for (int e = 0; e < 16; ++e) c += (key[e] >= cand) ? 1 : 0;
            c = red8_add(c);
            if (c >= NSEL) thr = cand; }
        int ngt = 0, tl = 0;
#pragma unroll
        for (int e = 0; e < 16; ++e) { ngt += (key[e] > thr) ? 1 : 0; tl += (key[e] == thr) ? 1 : 0; }
        ngt = red8_add(ngt);
        int sc = tl;
#pragma unroll
        for (int d = 1; d < 8; d <<= 1) { const int o = __shfl(sc, (lane - d) & 63); if (sub >= d) sc += o; }
        int before = sc - tl; const int need = (thr == 0u) ? 0 : (NSEL - ngt);
        unsigned m16 = 0u;
#pragma unroll
        for (int e = 0; e < 16; ++e) { if (key[e] > thr) m16 |= 1u << e; else if (key[e] == thr) { if (before < need) m16 |= 1u << e; ++before; } }
        selm[qq * 8 + sub] = (unsigned short)m16;
        unsigned um = m16; um |= __shfl_xor(um, 8); um |= __shfl_xor(um, 16); um |= __shfl_xor(um, 32);
        if (q8 == 0) ((LAS unsigned short*)uniw)[w * 8 + sub] = (unsigned short)um;
    }
    __syncthreads();
    SUBT_END(4);
    {
        SECTION_LANE();
        BrState st; INIT_ST(st);
        if (F.tid < 4) { unsigned u = 0u; for (int ww = 0; ww < 8; ++ww) u |= uniw[ww * 4 + F.tid]; uniw[32 + F.tid] = u; }
        __syncthreads();
        const LAS unsigned* um = uniw + 32; const LAS unsigned* wm = uniw + w * 4; const LAS unsigned* qm = (const LAS unsigned*)selm + qloc * 4;
        nsa_branch<3, 1>(F, C, qf, Zb + ZC_KS + g * 64, Zb + ZC_VS + g * 64, ZP, qt, 0, um, wm, qm, 0, 0, st);
        ACC_PREP(st, 1)
        bf16_t* ym = (bf16_t*)(F.ws + WS_YMIX) + ((size_t)b * SEQ + t0 + 8 * w + hi) * DM + 512 + 4 * g * 64 + i;
#pragma unroll
        for (int r = 0; r < 16; ++r) { const int c_ = (r & 3) + 8 * (r >> 2); const float a_ = wr_[c_]; const unsigned y_ = ya[c_ * 32]; bf16_t* op = ym + (c_ >> 2) * DM + (c_ & 3) * 64;
            const unsigned o_ = pk2(bflo(y_) + a_ * st.o0[r], bfhi(y_) + a_ * st.o1[r]); op[0] = (bf16_t)(o_ & 0xffffu); op[32] = (bf16_t)(o_ >> 16); }
        WAVE_SYNC(); FENCE();
    }
    SUBT_END(5);
#undef ACC_PREP
#undef INIT_ST
#undef SECTION_LANE
#undef NSA_PRELOAD_CMP
}

__device__ __forceinline__ void argmax16(float& v, int& idx) {
#ifdef EMU
    for (int o = 1; o < 16; o <<= 1) { const float ov = __shfl_xor(v, o); const int oi = __shfl_xor(idx, o); if (ov > v || (ov == v && oi < idx)) { v = ov; idx = oi; } }
#else
#define AM_STEP(ctrl) do { const float ov = __builtin_bit_cast(float, __builtin_amdgcn_update_dpp(0, __builtin_bit_cast(int, v), ctrl, 0xF, 0xF, true)); \
        const int oi = __builtin_amdgcn_update_dpp(0, idx, ctrl, 0xF, 0xF, true); if (ov > v || (ov == v && oi < idx)) { v = ov; idx = oi; } } while (0)
    AM_STEP(0xB1); AM_STEP(0x4E); AM_STEP(0x141); AM_STEP(0x140);
#undef AM_STEP
#endif
}
template <bool SHADOW>
__device__ __forceinline__ void router_task(Frame& F, int task) {
    const int row0 = 32 * task;
    LAS float* Hs = (LAS float*)F.lds;
    const float* mod = (const float*)(F.ws + WS_MOD);
    const float* X0 = F.in[I_X]; const bf16_t* MIX = (const bf16_t*)(F.ws + WS_MIX);
    unsigned char* H2 = (unsigned char*)(F.ws + WS_H2);
    const float* g = F.in[I_GFFN];
    {
        const int b = row0 / SEQ;
        const float* mb = mod + (size_t)b * 6144;
#pragma unroll
        for (int rb = 0; rb < 2; ++rb) {
            f32x4 v[2][4]; u32x2 mw[2][4];
#pragma unroll
            for (int rr = 0; rr < 2; ++rr) { const size_t ro = (size_t)(row0 + 4 * F.wave + 2 * rb + rr) * DM; const f32x4* xr = (const f32x4*)(X0 + ro) + F.lane; const u32x2* mr = (const u32x2*)(MIX + ro) + F.lane;
#pragma unroll
                for (int j = 0; j < 4; ++j) { v[rr][j] = xr[64 * j]; mw[rr][j] = mr[64 * j]; } }
#pragma unroll
            for (int rr = 0; rr < 2; ++rr)
#pragma unroll
                for (int j = 0; j < 4; ++j) v[rr][j] += *(const f32x4*)(mb + 2 * 1024 + 4 * F.lane + 256 * j) * (f32x4){bflo(mw[rr][j].x), bfhi(mw[rr][j].x), bflo(mw[rr][j].y), bfhi(mw[rr][j].y)};
#pragma unroll
            for (int rr = 0; rr < 2; ++rr) {
                const int lr = 4 * F.wave + 2 * rb + rr, m = row0 + lr;
                float s = 0.f;
#pragma unroll
                for (int j = 0; j < 4; ++j) s += (v[rr][j][0] * v[rr][j][0] + v[rr][j][1] * v[rr][j][1]) + (v[rr][j][2] * v[rr][j][2] + v[rr][j][3] * v[rr][j][3]);
                const float rinv = __builtin_amdgcn_rsqf(wave_sum(s) * (1.0f / DM) + EPS);
                unsigned* o4 = (unsigned*)(H2 + (size_t)m * DM) + F.lane;
#pragma unroll
                for (int j = 0; j < 4; ++j) { const int c = 4 * F.lane + 256 * j;
                    const f32x4 h = v[rr][j] * rinv * (*(const f32x4*)(g + c) * (*(const f32x4*)(mb + 4 * 1024 + c) + 1.0f)) + *(const f32x4*)(mb + 3 * 1024 + c);
                    o4[64 * j] = pk4_fp8(h[0] * F8_ACT_SCALE, h[1] * F8_ACT_SCALE, h[2] * F8_ACT_SCALE, h[3] * F8_ACT_SCALE);
#pragma unroll
                    for (int e = 0; e < 4; ++e) Hs[(c + e) * 33 + lr] = h[e]; }
                __builtin_amdgcn_sched_barrier(0);
            }
        }
    }
    const int i = F.lane & 31, hi = F.lane >> 5;
    const float* WR = F.in[I_WR];
    __builtin_amdgcn_sched_barrier(0);
    float wr[32];
#pragma unroll
    for (int ks = 0; ks < 32; ++ks) wr[ks] = WR[(128 * F.wave + 2 * ks + hi) * 32 + i];
    __syncthreads();
    f32x16 acc;
#pragma unroll
    for (int r = 0; r < 16; ++r) acc[r] = 0.f;
    float wr2[32];
#pragma unroll
    for (int ks = 0; ks < 32; ++ks) wr2[ks] = WR[(128 * F.wave + 2 * (ks + 32) + hi) * 32 + i];
    __builtin_amdgcn_sched_barrier(0);
#pragma unroll
    for (int q4 = 0; q4 < 4; ++q4) {
#pragma unroll
        for (int ks = 8 * q4; ks < 8 * q4 + 8; ++ks) acc = __builtin_amdgcn_mfma_f32_32x32x2f32(Hs[(128 * F.wave + 2 * ks + hi) * 33 + i], wr[ks], acc, 0, 0, 0);
        __builtin_amdgcn_sched_barrier(0);
    }
#pragma unroll
    for (int q4 = 0; q4 < 4; ++q4) {
#pragma unroll
        for (int ks = 8 * q4; ks < 8 * q4 + 8; ++ks) acc = __builtin_amdgcn_mfma_f32_32x32x2f32(Hs[(128 * F.wave + 2 * (ks + 32) + hi) * 33 + i], wr2[ks], acc, 0, 0, 0);
        __builtin_amdgcn_sched_barrier(0);
    }
    __syncthreads();
    LAS float* Ls = (LAS float*)F.lds;
    LAS float* Lg = Ls + 8 * 1024;
    LAS unsigned* hist = (LAS unsigned*)(Lg + 32 * 33);
#pragma unroll
    for (int r = 0; r < 16; ++r) Ls[F.wave * 1024 + crow(r, hi) * 32 + i] = acc[r];
    if (F.tid < 64) hist[F.tid] = 0u;
    __syncthreads();
    const int tk = F.tid >> 4, sub = F.tid & 15;
    float l0 = F.in[I_BR][sub], l1 = F.in[I_BR][sub + 16];
#pragma unroll
    for (int w = 0; w < 8; ++w) { l0 += Ls[w * 1024 + tk * 32 + sub]; l1 += Ls[w * 1024 + tk * 32 + sub + 16]; }
    int be[4]; float bv[4];
#pragma unroll
    for (int k = 0; k < 4; ++k) { float v; int id;
        if (l0 >= l1) { v = l0; id = sub; } else { v = l1; id = sub + 16; }
        argmax16(v, id);
        be[k] = id; bv[k] = v;
        if (id == sub) l0 = -INFINITY;
        if (id == sub + 16) l1 = -INFINITY; }
    unsigned rank[4] = {0u, 0u, 0u, 0u};
    {
        float sum = 0.f; const float mx0 = bv[0];
#pragma unroll
        for (int k = 0; k < 4; ++k) { bv[k] = fexp2((bv[k] - mx0) * LOG2E); sum += bv[k]; }
        const float rs = 1.0f / sum;
#pragma unroll
        for (int k = 0; k < 4; ++k) bv[k] *= rs;
    }
    if (sub == 0) {
#pragma unroll
        for (int k = 0; k < 4; ++k) rank[k] = atomicAdd((unsigned*)&hist[be[k]], 1u);
    }
    __syncthreads();
    if (F.tid < 32) { const unsigned c = hist[F.tid]; hist[32 + F.tid] = c ? atomicAdd(F.ctl + (SHADOW ? CW_CNT2 : CW_CNT) + 64 * F.tid, c) : 0u; }
    __syncthreads();
    if (sub == 0) {
        const int tok = row0 + tk;
        const size_t sh_ = SHADOW ? WS_SHADOW : 0;
        int* lists = (int*)(F.ws + sh_ + WS_LISTS); int* tope = (int*)(F.ws + sh_ + WS_TOPE); float* topw = (float*)(F.ws + sh_ + WS_TOPW); int* topp = (int*)(F.ws + sh_ + WS_TOPP);
#pragma unroll
        for (int k = 0; k < 4; ++k) { const int pos = (int)(hist[32 + be[k]] + rank[k]);
            lists[(size_t)be[k] * T + pos] = tok; tope[tok * 4 + k] = be[k]; topw[tok * 4 + k] = bv[k]; topp[tok * 4 + k] = pos; }
    }
    __syncthreads();
}

__device__ __forceinline__ void moe_tables(Frame& F) {
    if (F.tid < 64) {
        const int e = F.lane & 31;
        const unsigned c = __hip_atomic_load(F.ctl + CW_CNT + 64 * e, __ATOMIC_RELAXED, __HIP_MEMORY_SCOPE_AGENT);
        const unsigned tl = (c + 255u) / 256u;
        unsigned incl = tl;
#pragma unroll
        for (int d = 1; d < 32; d <<= 1) { const unsigned o = __shfl(incl, (F.lane - d) & 63); if (e >= d) incl += o; }
        if (F.lane < 32) { F.MISC[MW_CNT + e] = c; F.MISC[MW_TPFX + e] = incl - tl; F.MISC[MW_ROFF + e] = (incl - tl) * 256u;
            if (e == 31) { F.MISC[MW_TPFX + NE] = incl; F.MISC[MW_ROFF + NE] = incl * 256u; } }
    }
    __syncthreads();
}

__device__ __forceinline__ void final_rows(Frame& F) {
    const int gw = F.vcu * NWAVES + F.wave, NGW = F.G * NWAVES;
    const float* mod = (const float*)(F.ws + WS_MOD);
    const float* X0 = F.in[I_X]; const bf16_t* MIX = (const bf16_t*)(F.ws + WS_MIX);
    const bf16_t* YD = (const bf16_t*)(F.ws + WS_YD);
    const int* tope = (const int*)(F.ws + WS_TOPE); const float* topw = (const float*)(F.ws + WS_TOPW); const int* topp = (const int*)(F.ws + WS_TOPP);
    const float* gf = F.in[I_GFIN];
    int m = gw;
    u32x4 ne = (u32x4){0u, 0u, 0u, 0u}, np = ne; f32x4 nw = (f32x4){0.f, 0.f, 0.f, 0.f}; f32x4 nx[4]; u32x2 nm[4];
    if (m < T) { ne = *(const u32x4*)(tope + m * 4); np = *(const u32x4*)(topp + m * 4); nw = *(const f32x4*)(topw + m * 4);
#pragma unroll
        for (int j = 0; j < 4; ++j) { nx[j] = ((const f32x4*)(X0 + (size_t)m * DM) + F.lane)[64 * j]; nm[j] = ((const u32x2*)(MIX + (size_t)m * DM) + F.lane)[64 * j]; } }
    for (; m < T; m += NGW) {
        const int b = m / SEQ;
        const u32x4 ce = ne, cp = np; const f32x4 cw = nw; f32x4 cx[4];
#pragma unroll
        for (int j = 0; j < 4; ++j) { const f32x4 g1 = *(const f32x4*)(mod + (size_t)b * 6144 + 2 * 1024 + 4 * F.lane + 256 * j);
            cx[j] = nx[j] + g1 * (f32x4){bflo(nm[j].x), bfhi(nm[j].x), bflo(nm[j].y), bfhi(nm[j].y)}; }
        size_t yrow[4];
#pragma unroll
        for (int k = 0; k < 4; ++k) yrow[k] = (size_t)(F.MISC[MW_ROFF + ce[k]] + cp[k]) * DM;
        u32x2 yw[4][4];
#pragma unroll
        for (int j = 0; j < 4; ++j)
#pragma unroll
            for (int k = 0; k < 4; ++k) yw[j][k] = *(const u32x2*)(YD + yrow[k] + 4 * F.lane + 256 * j);
        const int mn = m + NGW;
        if (mn < T) { ne = *(const u32x4*)(tope + mn * 4); np = *(const u32x4*)(topp + mn * 4); nw = *(const f32x4*)(topw + mn * 4);
#pragma unroll
            for (int j = 0; j < 4; ++j) { nx[j] = ((const f32x4*)(X0 + (size_t)mn * DM) + F.lane)[64 * j]; nm[j] = ((const u32x2*)(MIX + (size_t)mn * DM) + F.lane)[64 * j]; } }
        f32x4 v[4]; float s = 0.f;
#pragma unroll
        for (int j = 0; j < 4; ++j) { const int c = 4 * F.lane + 256 * j;
            f32x4 mo = (f32x4){0.f, 0.f, 0.f, 0.f};
#pragma unroll
            for (int k = 0; k < 4; ++k) mo += cw[k] * (f32x4){bflo(yw[j][k].x), bfhi(yw[j][k].x), bflo(yw[j][k].y), bfhi(yw[j][k].y)};
            const f32x4 gt = *(const f32x4*)(mod + (size_t)b * 6144 + 5 * 1024 + c);
            v[j] = cx[j] + gt * mo;
            s += (v[j][0] * v[j][0] + v[j][1] * v[j][1]) + (v[j][2] * v[j][2] + v[j][3] * v[j][3]); }
        const float rinv = __builtin_amdgcn_rsqf(wave_sum(s) * (1.0f / DM) + EPS);
        f32x4* orow = (f32x4*)(F.out + (size_t)m * DM) + F.lane;
#pragma unroll
        for (int j = 0; j < 4; ++j) orow[64 * j] = v[j] * rinv * *(const f32x4*)(gf + 4 * F.lane + 256 * j);
    }
}

constexpr int N_PHASES = 10;
#define REP0 1
#define REPB 1
#define REP1 1
#define REP6 1
#define REP2 1
#define REP3 1
#define REP4 1
#define REP5 1
#define REP7 1
#define REP8 1
#define REP9 1
__global__ void __launch_bounds__(NTHREADS, 2) mk_fwd(Args args) {
#ifdef EMU
    unsigned char* lds = emu_blk->lds;
#else
    extern __shared__ __attribute__((aligned(16))) unsigned char lds[];
#endif
    Frame F;
    F.lds = (LAS unsigned char*)lds;
    F.MISC = (volatile LAS unsigned*)(F.lds + MISC_OFF);
    F.tid = threadIdx.x; F.lane = F.tid & 63; F.wave = __builtin_amdgcn_readfirstlane(F.tid >> 6);
    F.G = gridDim.x; { const int bx = blockIdx.x; F.vcu = (F.G % 8 == 0) ? (bx % 8) * (F.G / 8) + bx / 8 : bx; }
    F.ws = args.ws; F.ctl = (unsigned*)(args.ws + WS_CTL); F.out = args.out;
#pragma unroll
    for (int k = 0; k < 24; ++k) F.in[k] = args.in[k];
    for (int u = F.tid; u < (LDS_BYTES - MISC_OFF) / 4; u += NTHREADS) F.MISC[u] = 0u;
    __syncthreads();
    XcdBarrier bar = xcd_barrier_post(F.ctl + CW_BAR, F.MISC + 8);
    const int lo = args.ph_lo, hi = args.ph_hi;
#ifndef EMU
#define STAMP(k) do { if (PROBE_K >= 0 && blockIdx.x == 0 && F.tid == 0) { const unsigned long long t_ = __builtin_amdgcn_s_memrealtime(); F.MISC[((k) >= 20 ? 360 : 256) + 2 * (k)] = (unsigned)t_; F.MISC[((k) >= 20 ? 361 : 257) + 2 * (k)] = (unsigned)(t_ >> 32); } } while (0)
#else
#define STAMP(k) ((void)0)
#endif
    STAMP(0);
#ifndef PH_MASK
#define PH_MASK 0xffff
#endif
#define IN(k) (((PH_MASK >> (k)) & 1) && lo <= (k) && (k) < hi)
#define SEAM(k) do { if (IN(k) && IN((k) + 1)) { xcd_barrier(bar); if (REPB > 1) xcd_barrier(bar); } } while (0)

    if (IN(0)) { p0_prologue(F); if (REP0 > 1) p0_prologue(F); }
    STAMP(20); SEAM(0); STAMP(1);
#ifndef EMU
    if (IN(0) && IN(1)) {
        if (F.tid == 0) { unsigned ok = 1u; for (int j = 0; j < 8; ++j) ok &= (xb_ld(F.ctl + CW_BAR + XB_XCNT(j)) == (unsigned)(F.G / 8)) ? 1u : 0u;
            F.MISC[12] = (ok && bar.x < 8u) ? (bar.x * (unsigned)(F.G / 8) + F.MISC[10]) : (unsigned)F.vcu; }
        __syncthreads();
        F.vcu = (int)F.MISC[12];
    }
#endif
    if (IN(1)) { norm_rows(F, F.in[I_X], F.in[I_GMIX], 0, 1, (bf16_t*)(F.ws + WS_HB)); if (REP1 > 1) norm_rows(F, F.in[I_X], F.in[I_GMIX], 0, 1, (bf16_t*)(F.ws + WS_HB)); }
    STAMP(21); SEAM(1); STAMP(2);
    if (IN(2)) {
        {
        pg8::DenseProb P{(const char*)(F.ws + WS_HB), (const char*)(F.ws + WS_WINT), DM * 2};
        pg8::DenseOrder S; S.init(T, ZP, F.G, (F.G % 8 == 0) ? (F.vcu % (F.G / 8)) * 8 + F.vcu / (F.G / 8) : (int)blockIdx.x);
        EpiZ E{(bf16_t*)(F.ws + WS_ZB)};
        pg8::gemm_phase<false>(F.lds, P, S, E);
        if (p2_fill_items(F) && S.c >= 128) {
            LAS float* scr = (LAS float*)(F.lds + 8192 + F.wave * 16384);
            const int base = P0_NITEMS - p7_fill_items(F) - p2_fill_items(F) + (S.c - 128) * P2_FILL_PER_CU;
            for (int k = F.wave; k < P2_FILL_PER_CU; k += NWAVES) p0_item(F, scr, base + k);
        }
        }
        if (REP2 > 1) {
        pg8::DenseProb P{(const char*)(F.ws + WS_HB), (const char*)(F.ws + WS_WINT), DM * 2};
        pg8::DenseOrder S; S.init(T, ZP, F.G, (F.G % 8 == 0) ? (F.vcu % (F.G / 8)) * 8 + F.vcu / (F.G / 8) : (int)blockIdx.x);
        EpiZ E{(bf16_t*)(F.ws + WS_ZB)};
        pg8::gemm_phase<false>(F.lds, P, S, E);
        }
    }
    STAMP(22); SEAM(2); STAMP(3);
    if (IN(3)) {
        constexpr int NGM = BATCH * (SEQ / GMC) * GMG, NCT = 2 * BATCH * NG * (NCP / 32);
        for (int rep = 0; rep < (REP3 > 1 ? 2 : 1); ++rep) {
            if (F.G == 2 * NCT && NGM == 8 * NCT) {
                if (F.vcu < NCT) { cmp_tile(F, F.vcu); gmlp_run(F, 3 * F.vcu, 1, 3); }
                else gmlp_run(F, 3 * NCT + 5 * (F.vcu - NCT), 1, 5);
            } else { for (int it = F.vcu; it < NCT; it += F.G) cmp_tile(F, it);
                     const int first = ((F.vcu - NCT) % F.G + F.G) % F.G; gmlp_run(F, first, F.G, (NGM - first + F.G - 1) / F.G); }
        }
    }
    STAMP(23); SEAM(3); STAMP(4);
    if (IN(4)) {
        constexpr int NQT_ = SEQ / 64, NPAIR = BATCH * NQT_;
        for (int rep = 0; rep < (REP4 > 1 ? 2 : 1); ++rep)
        for (int pr = F.vcu; pr < NPAIR; pr += F.G) { const int b_ = pr / NQT_, x_ = pr % NQT_;
            for (int k2 = 0; k2 < 2; ++k2) nsa_task(F, k2 ? (b_ * NG + 0) * NQT_ + x_ : (b_ * NG + 1) * NQT_ + (NQT_ - 1 - x_)); }
    }
    STAMP(24); SEAM(4); STAMP(5);
    if (IN(5)) {
        {
        pg8::DenseProb P{(const char*)(F.ws + WS_YMIX), (const char*)(F.ws + WS_WOUTT), DM * 2};
        pg8::DenseOrder S; S.init(T, DM, F.G, (F.G % 8 == 0) ? (F.vcu % (F.G / 8)) * 8 + F.vcu / (F.G / 8) : (int)blockIdx.x);
        EpiMix E{(bf16_t*)(F.ws + WS_MIX)};
        pg8::gemm_phase<false>(F.lds, P, S, E);
        }
        if (REP5 > 1) {
        pg8::DenseProb P{(const char*)(F.ws + WS_YMIX), (const char*)(F.ws + WS_WOUTT), DM * 2};
        pg8::DenseOrder S; S.init(T, DM, F.G, (F.G % 8 == 0) ? (F.vcu % (F.G / 8)) * 8 + F.vcu / (F.G / 8) : (int)blockIdx.x);
        EpiMix E{(bf16_t*)(F.ws + WS_MIX)};
        pg8::gemm_phase<false>(F.lds, P, S, E);
        }
    }
    STAMP(25); SEAM(5); STAMP(6);
    if (IN(6)) { for (int it = F.vcu; it < T / 32; it += F.G) router_task<false>(F, it); if (REP6 > 1) for (int it = F.vcu; it < T / 32; it += F.G) router_task<true>(F, it); }
    STAMP(26); SEAM(6); STAMP(7);
    if (IN(7)) {
        {
        moe_tables(F);
        MoeProb1 P{(const char*)(F.ws + WS_H2), (const char*)(F.ws + WS_WGUT), (const int*)(F.ws + WS_LISTS), F.in[I_BGU], F.MISC + MW_CNT, DM};
        pg8::MoeOrder S{F.MISC + MW_TPFX, 8, F.G, F.vcu, 0};
        EpiAct E{(unsigned char*)(F.ws + WS_ACT), F.in[I_BGU], F.MISC + MW_ROFF};
        pg8::gemm_phase<true>(F.lds, P, S, E);
        if (p7_fill_items(F)) {
            const int rem = ((int)F.MISC[MW_TPFX + NE] * 8) % F.G;
            int nidle = rem ? F.G - rem : 0, j = F.vcu - rem;
            if (nidle < F.G / 4) { nidle = F.G; j = F.vcu; }
            if (j >= 0) {
                __syncthreads();
                LAS float* scr = (LAS float*)(F.lds + F.wave * 8704);
                const int base = P0_NITEMS - p7_fill_items(F);
                for (int k = j * NWAVES + F.wave; k < p7_fill_items(F); k += nidle * NWAVES) p0_item(F, scr, base + k);
            }
        }
        }
        if (REP7 > 1) {
        moe_tables(F);
        MoeProb1 P{(const char*)(F.ws + WS_H2), (const char*)(F.ws + WS_WGUT), (const int*)(F.ws + WS_LISTS), F.in[I_BGU], F.MISC + MW_CNT, DM};
        pg8::MoeOrder S{F.MISC + MW_TPFX, 8, F.G, F.vcu, 0};
        EpiAct E{(unsigned char*)(F.ws + WS_ACT), F.in[I_BGU], F.MISC + MW_ROFF};
        pg8::gemm_phase<true>(F.lds, P, S, E);
        }
    }
    STAMP(27); SEAM(7); STAMP(8);
    if (IN(8)) {
        {
        moe_tables(F);
        MoeProb2 P{(const char*)(F.ws + WS_ACT), (const char*)(F.ws + WS_WDNT), F.in[I_BDN], F.MISC + MW_ROFF, DFF};
        pg8::MoeOrder S{F.MISC + MW_TPFX, 4, F.G, F.vcu, 0};
        EpiYd E{(bf16_t*)(F.ws + WS_YD), F.in[I_BDN], F.MISC + MW_ROFF};
        pg8::gemm_phase<true>(F.lds, P, S, E);
        }
        if (REP8 > 1) {
        moe_tables(F);
        MoeProb2 P{(const char*)(F.ws + WS_ACT), (const char*)(F.ws + WS_WDNT), F.in[I_BDN], F.MISC + MW_ROFF, DFF};
        pg8::MoeOrder S{F.MISC + MW_TPFX, 4, F.G, F.vcu, 0};
        EpiYd E{(bf16_t*)(F.ws + WS_YD), F.in[I_BDN], F.MISC + MW_ROFF};
        pg8::gemm_phase<true>(F.lds, P, S, E);
        }
    }
    STAMP(28); SEAM(8); STAMP(9);
    if (IN(9)) { moe_tables(F); final_rows(F); if (REP9 > 1) final_rows(F); }
#ifndef EMU
    if (PROBE_K >= 0 && blockIdx.x == 0 && F.tid == 0) {
        STAMP(10);
        unsigned long long a_ = 0, b_ = 0;
        if (PROBE_K == 19) { a_ = ((unsigned long long)F.MISC[257] << 32) | F.MISC[256]; b_ = ((unsigned long long)F.MISC[257 + 20] << 32) | F.MISC[256 + 20]; }
        else if (PROBE_K < 20) { a_ = ((unsigned long long)F.MISC[257 + 2 * (PROBE_K % 20)] << 32) | F.MISC[256 + 2 * (PROBE_K % 20)];
                            b_ = ((unsigned long long)F.MISC[259 + 2 * (PROBE_K % 20)] << 32) | F.MISC[258 + 2 * (PROBE_K % 20)]; }
        else if (PROBE_K >= 30 && PROBE_K < 40) { a_ = ((unsigned long long)F.MISC[361 + 2 * (20 + PROBE_K - 30)] << 32) | F.MISC[360 + 2 * (20 + PROBE_K - 30)]; b_ = ((unsigned long long)F.MISC[257 + 2 * (PROBE_K - 30 + 1)] << 32) | F.MISC[256 + 2 * (PROBE_K - 30 + 1)]; }
        else if (PROBE_K >= 50) b_ = F.MISC[300 + 6 + (PROBE_K % 10)];
        else b_ = F.MISC[300 + (PROBE_K - 20)];
        const unsigned long long t0_ = __builtin_amdgcn_s_memrealtime();
        while (__builtin_amdgcn_s_memrealtime() - t0_ < (b_ - a_)) __builtin_amdgcn_s_sleep(8);
    }
#endif
#undef IN
#undef SEAM
}

#ifdef EMU
struct EmuDump { const char* name; size_t off; size_t bytes; };
EmuDump emu_dumps[] = {
    {"mod", WS_MOD, (size_t)BATCH * 6144 * 4}, {"bpe", WS_BPE, 512 * 4}, {"wint", WS_WINT, (size_t)ZP * DM * 2}, {"hb", WS_HB, (size_t)T * DM * 2},
    {"zb", WS_ZB, (size_t)T * ZP * 2}, {"kc", WS_KC, (size_t)BATCH * NG * NCP * 64 * 2}, {"vc", WS_VC, (size_t)BATCH * NG * NCP * 64 * 2},
    {"ymix", WS_YMIX, (size_t)T * DM * 2}, {"mix", WS_MIX, (size_t)T * DM * 2}, {"h2", WS_H2, (size_t)T * DM * 2},
    {"tope", WS_TOPE, (size_t)T * 16}, {"topw", WS_TOPW, (size_t)T * 16}, {"topp", WS_TOPP, (size_t)T * 16}, {"ctl", WS_CTL, CTL_ZERO_BYTES},
};
int emu_ndumps = sizeof(emu_dumps) / sizeof(emu_dumps[0]);
size_t emu_ws_bytes = WS_END;
int emu_out_elems = T * DM;
#endif

extern "C" void kernel_launch(void* const* d_in, const int* in_sizes, int n_in, void* d_out, int out_size, void* d_ws, size_t ws_size, hipStream_t stream) {
    (void)in_sizes; (void)out_size; (void)ws_size;
    Args a{};
    for (int i = 0; i < 24 && i < n_in; ++i) a.in[i] = (const float*)d_in[i];
    a.out = (float*)d_out; a.ws = (unsigned char*)d_ws;
#ifndef EMU
    (void)hipMemsetAsync((char*)d_ws + WS_CTL, 0, CTL_ZERO_BYTES, stream);
#endif
#ifdef EMU
    int plo = 0, phi = N_PHASES;
    if (const char* e = getenv("EMU_PH_LO")) plo = atoi(e);
    if (const char* e = getenv("EMU_PH_HI")) phi = atoi(e);
    if (plo == 0) (void)hipMemsetAsync((char*)d_ws + WS_CTL, 0, CTL_ZERO_BYTES, stream);
    const int grid = emu_num_cus();
    for (int ph = plo; ph < phi; ++ph) { a.ph_lo = ph; a.ph_hi = ph + 1; Args ac = a; fprintf(stderr, "EMU phase %d\n", ph);
        emu_launch(grid, NTHREADS, LDS_BYTES, [ac]() { mk_fwd(ac); }); }
#else
    static int grid = 0;
    if (grid == 0) {
        int dev = 0, cus = 0, per_cu = 0;
        (void)hipGetDevice(&dev);
        (void)hipDeviceGetAttribute(&cus, hipDeviceAttributeMultiprocessorCount, dev);
        (void)hipFuncSetAttribute((const void*)mk_fwd, hipFuncAttributeMaxDynamicSharedMemorySize, LDS_BYTES);
        (void)hipOccupancyMaxActiveBlocksPerMultiprocessor(&per_cu, (const void*)mk_fwd, NTHREADS, LDS_BYTES);
        if (per_cu < 1) fprintf(stderr, "kernel_launch: occupancy query reports %d blocks/CU\n", per_cu);
        grid = cus;
        (void)hipGetLastError();
    }
    a.ph_lo = 0; a.ph_hi = N_PHASES;
    void* kargs[] = {&a};
    hipError_t e = hipLaunchCooperativeKernel((const void*)mk_fwd, dim3(grid), dim3(NTHREADS), kargs, LDS_BYTES, stream);
    if (e != hipSuccess) fprintf(stderr, "cooperative launch failed: %s (grid %d)\n", hipGetErrorString(e), grid);
#endif
}
```

```cpp
#ifndef EMU
#include <hip/hip_runtime.h>
#endif
#include <cstdio>
#include <cstdint>

#ifndef CFG_BATCH
#define CFG_BATCH 2
#endif
#ifndef CFG_SEQ
#define CFG_SEQ 8192
#endif

#define PROBE_K -1
#ifdef EMU
#define NOSPEC() ((void)0)
#define LAS
#define ASM_VMCNT(n) ((void)0)
#define ASM_LGKMCNT(n) ((void)0)
#define WAVE_SYNC() emu_wave_sync()
#define FENCE() ((void)0)
#else
#define NOSPEC() asm volatile("; rare path" ::: "memory")
#define LAS __attribute__((address_space(3)))
#define ASM_VMCNT(n) asm volatile("s_waitcnt vmcnt(" #n ")" ::: "memory")
#define ASM_LGKMCNT(n) asm volatile("s_waitcnt lgkmcnt(" #n ")" ::: "memory")
#define WAVE_SYNC() asm volatile("s_waitcnt lgkmcnt(0)" ::: "memory")
#define FENCE() asm volatile("" ::: "memory")
#endif

typedef unsigned short bf16_t;
typedef short bf16x8 __attribute__((ext_vector_type(8)));
typedef short s16x4 __attribute__((ext_vector_type(4)));
typedef float f32x4 __attribute__((ext_vector_type(4)));
typedef float f32x16 __attribute__((ext_vector_type(16)));
typedef unsigned u32x4 __attribute__((ext_vector_type(4)));
typedef unsigned u32x2 __attribute__((ext_vector_type(2)));

constexpr int NWAVES = 8, NTHREADS = 512;
constexpr int BATCH = CFG_BATCH, SEQ = CFG_SEQ, DM = 1024, T = BATCH * SEQ;
constexpr int GMW = 512, GMG = 8, GMC = 128;
constexpr int NH = 8, NG = 2, NR = 4, HD = 64;
constexpr int INC = 2328, ZP = 2560;
constexpr int ZC_U = 0, ZC_V = 512, ZC_Q = 1024, ZC_KC = 1536, ZC_VC = 1664, ZC_KS = 1792, ZC_VS = 1920, ZC_KW = 2048, ZC_VW = 2176, ZC_GL = 2304;
constexpr int NCMP = SEQ / 16 - 1, NCP = SEQ / 16;
constexpr int NBLK = SEQ / 64;
constexpr int NSEL = NBLK < 16 ? NBLK : 16;
constexpr int NE = 32, TOPK = 4, DFF = 1024;
constexpr int TK = T * TOPK;
constexpr int ACT_ROWS = TK + NE * 256;
constexpr float EPS = 1e-6f;
constexpr float LOG2E = 1.4426950408889634f;
constexpr float F8_ACT_SCALE = 8.0f, F8_W_SCALE = 64.0f, F8_ACC_SCALE = 1.0f / 512.0f;
constexpr float F8_YD_SCALE = 16.0f;

constexpr size_t MiB = 1u << 20;
constexpr size_t WS_CTL = 0, CTL_ZERO_BYTES = 192 * 1024;
constexpr size_t WS_MOD = 1 * MiB;
constexpr size_t WS_BPE = 1 * MiB + 512 * 1024;
constexpr size_t WS_WRT = 1 * MiB + 768 * 1024;
constexpr size_t WS_LISTS = 2 * MiB;
constexpr size_t WS_TOPE = 4 * MiB;
constexpr size_t WS_TOPW = 4 * MiB + 512 * 1024;
constexpr size_t WS_TOPP = 5 * MiB;
constexpr size_t WS_WSBF = 6 * MiB;
constexpr size_t WS_W2KT = 6 * MiB + 512 * 1024;
constexpr size_t WS_W2VT = WS_W2KT + 64 * 1024;
constexpr size_t WS_W1KT = 7 * MiB;
constexpr size_t WS_W1VT = 8 * MiB;
constexpr size_t WS_WOUTT = 9 * MiB;
constexpr size_t WS_WINT = 11 * MiB;
constexpr size_t WS_KC = 16 * MiB;
constexpr size_t WS_VC = 16 * MiB + 512 * 1024;
constexpr size_t WS_WGUT = 32 * MiB;
constexpr size_t WS_WDNT = 160 * MiB;
constexpr size_t WS_HB = 224 * MiB;
constexpr size_t WS_H2 = 256 * MiB;
constexpr size_t WS_ZB = 288 * MiB;
constexpr size_t WS_YMIX = 368 * MiB;
constexpr size_t WS_MIX = 400 * MiB;
constexpr size_t WS_ACT = 464 * MiB;
constexpr size_t WS_YD = 608 * MiB;
constexpr size_t WS_YACC = 768 * MiB;
constexpr size_t WS_END = 804 * MiB;
constexpr int CW_BAR = 4096;
constexpr int CW_CNT = 16384;
constexpr int CW_CNT2 = 32768;
constexpr size_t WS_SHADOW = 752 * MiB;

constexpr int RING_BYTES = 131072;
constexpr int MISC_OFF = 155648;
constexpr int LDS_BYTES = 159744;
constexpr int MW_CNT = 16, MW_TPFX = 64, MW_ROFF = 128;

__device__ __forceinline__ unsigned f2bf(float f) { unsigned u = __builtin_bit_cast(unsigned, f); return (u + 0x7fffu + ((u >> 16) & 1u)) >> 16; }
#ifdef EMU
__device__ __forceinline__ unsigned pk2(float lo, float hi) { return f2bf(lo) | (f2bf(hi) << 16); }
#else
typedef float f32x2_t __attribute__((ext_vector_type(2))); typedef __bf16 bf16x2_t __attribute__((ext_vector_type(2)));
__device__ __forceinline__ unsigned pk2(float lo, float hi) { f32x2_t v = {lo, hi}; bf16x2_t bb = __builtin_convertvector(v, bf16x2_t); return __builtin_bit_cast(unsigned, bb); }
#endif
__device__ __forceinline__ unsigned pk4_fp8(float a, float b, float c, float d) {
    a = fminf(fmaxf(a, -448.f), 448.f); b = fminf(fmaxf(b, -448.f), 448.f); c = fminf(fmaxf(c, -448.f), 448.f); d = fminf(fmaxf(d, -448.f), 448.f);
    int w = 0; w = __builtin_amdgcn_cvt_pk_fp8_f32(a, b, w, false); w = __builtin_amdgcn_cvt_pk_fp8_f32(c, d, w, true); return (unsigned)w;
}
#ifdef EMU
__device__ __forceinline__ f32x4 unpk4_fp8(unsigned w) { return (f32x4){emu_fp8_dec((unsigned char)(w & 0xff)), emu_fp8_dec((unsigned char)((w >> 8) & 0xff)), emu_fp8_dec((unsigned char)((w >> 16) & 0xff)), emu_fp8_dec((unsigned char)(w >> 24))}; }
#else
__device__ __forceinline__ f32x4 unpk4_fp8(unsigned w) { return (f32x4){__builtin_amdgcn_cvt_f32_fp8((int)w, 0), __builtin_amdgcn_cvt_f32_fp8((int)w, 1), __builtin_amdgcn_cvt_f32_fp8((int)w, 2), __builtin_amdgcn_cvt_f32_fp8((int)w, 3)}; }
#endif
__device__ __forceinline__ unsigned pk4_fp8_nc(float a, float b, float c, float d) {
    int w = 0; w = __builtin_amdgcn_cvt_pk_fp8_f32(a, b, w, false); w = __builtin_amdgcn_cvt_pk_fp8_f32(c, d, w, true); return (unsigned)w;
}
typedef int v8i_t __attribute__((ext_vector_type(8)));
typedef int v4i_t __attribute__((ext_vector_type(4)));
__device__ __forceinline__ float bf2f(unsigned short h) { return __builtin_bit_cast(float, (unsigned)h << 16); }
__device__ __forceinline__ float bflo(unsigned w) { return __builtin_bit_cast(float, w << 16); }
__device__ __forceinline__ float bfhi(unsigned w) { return __builtin_bit_cast(float, w & 0xffff0000u); }
__device__ __forceinline__ float fexp2(float x) { return __builtin_amdgcn_exp2f(x); }
__device__ __forceinline__ float gelu_tanh(float x) {
    const float y2 = 1.5957691216057308f * (x + 0.044715f * x * x * x);
    return x * __builtin_amdgcn_rcpf(1.0f + fexp2(-y2 * LOG2E));
}
__device__ __forceinline__ float sigmoidf_(float x) { return __builtin_amdgcn_rcpf(1.0f + fexp2(-x * LOG2E)); }
__device__ __forceinline__ float wave_sum(float v) {
#pragma unroll
    for (int o = 1; o < 64; o <<= 1) v += __shfl_xor(v, o);
    return v;
}
__device__ __forceinline__ int crow(int r, int hi) { return (r & 3) + 8 * (r >> 2) + 4 * hi; }

#define XB_TMO      128
#define XB_XCNT(j)  (256  + 64 * (j))
#define XB_XSUB(j)  (1280 + 64 * (j))
#define XB_XGEN(j)  (2304 + 64 * (j))
#define XB_TOP      3328
#define XB_TOPGEN   3392
#define XCD_BAR_WORDS 3456
#define XB_SPIN_CAP (1u << 18)
struct XcdBarrier { unsigned* bar; unsigned x; volatile LAS unsigned* st; };
#ifndef EMU
__device__ __forceinline__ unsigned xb_ld(unsigned* p)              { return __hip_atomic_load(p, __ATOMIC_RELAXED, __HIP_MEMORY_SCOPE_AGENT); }
__device__ __forceinline__ unsigned xb_add(unsigned* p, unsigned v) { return __hip_atomic_fetch_add(p, v, __ATOMIC_RELAXED, __HIP_MEMORY_SCOPE_AGENT); }
__device__ __forceinline__ unsigned xb_xcc_id() { return (unsigned)__builtin_amdgcn_s_getreg((3 << 11) | 20) & 0xFu; }
#define XB_SPIN(cond, bar) do { unsigned _sp = 0; while (cond) { __builtin_amdgcn_s_sleep(1); \
    if ((++_sp & 255u) == 0u) { if (xb_ld(&(bar)[XB_TMO])) break; if (_sp > XB_SPIN_CAP) { atomicAdd(&(bar)[XB_TMO], 1u); break; } } } } while (0)
__device__ __forceinline__ XcdBarrier xcd_barrier_post(unsigned* bar, volatile LAS unsigned* st) {
    XcdBarrier b; b.bar = bar; b.x = xb_xcc_id(); b.st = st;
    if (threadIdx.x == 0) st[2] = xb_add(&bar[XB_XCNT(b.x)], 1u);
    return b;
}
__device__ __forceinline__ void xcd_barrier_complete(unsigned* bar, unsigned x, unsigned& nloc, unsigned& nx) {
    const unsigned G = gridDim.x * gridDim.y * gridDim.z;
    unsigned sum, cnt, mine, sp = 0u;
    for (;;) {
        sum = 0u; cnt = 0u; mine = 0u;
#pragma unroll
        for (unsigned j = 0; j < 16; ++j) { const unsigned c = xb_ld(&bar[XB_XCNT(j)]); sum += c; cnt += (c > 0u) ? 1u : 0u; mine = (j == x) ? c : mine; }
        if (sum == G) break;
        __builtin_amdgcn_s_sleep(1);
        if ((++sp & 255u) == 0u) { if (xb_ld(&bar[XB_TMO])) break; if (sp > XB_SPIN_CAP) { atomicAdd(&bar[XB_TMO], 1u); break; } }
    }
    nloc = mine > 0u ? mine : 1u; nx = cnt > 0u ? cnt : 1u;
}
__device__ __forceinline__ void xcd_barrier(const XcdBarrier& b) {
    asm volatile("s_waitcnt vmcnt(0)" ::: "memory");
    __syncthreads();
    if (threadIdx.x == 0) {
        unsigned* bar = b.bar;
        __builtin_amdgcn_s_waitcnt(0);
        unsigned nloc = b.st[0], nx = b.st[1];
        if (nloc == 0u) { xcd_barrier_complete(bar, b.x, nloc, nx); b.st[0] = nloc; b.st[1] = nx; }
        const unsigned old = xb_add(&bar[XB_XSUB(b.x)], 1u);
        const unsigned gen = old / nloc;
        if (old + 1u == (gen + 1u) * nloc) {
            __builtin_amdgcn_fence(__ATOMIC_RELEASE, "agent");
            asm volatile("s_waitcnt vmcnt(0)" ::: "memory");
            const unsigned og = xb_add(&bar[XB_TOP], 1u);
            const unsigned tg = og / nx;
            if (og + 1u == (tg + 1u) * nx) xb_add(&bar[XB_TOPGEN], 1u);
            else XB_SPIN(xb_ld(&bar[XB_TOPGEN]) == tg, bar);
            __builtin_amdgcn_fence(__ATOMIC_ACQUIRE, "agent");
            xb_add(&bar[XB_XGEN(b.x)], 1u);
            asm volatile("s_waitcnt vmcnt(0)" ::: "memory");
        } else {
            XB_SPIN(xb_ld(&bar[XB_XGEN(b.x)]) == gen, bar);
            __builtin_amdgcn_fence(__ATOMIC_ACQUIRE, "agent");
            asm volatile("s_waitcnt vmcnt(0)" ::: "memory");
        }
    }
    __syncthreads();
}
#else
__device__ __forceinline__ XcdBarrier xcd_barrier_post(unsigned* bar, volatile unsigned* st) { XcdBarrier b; b.bar = bar; b.x = 0; b.st = st; return b; }
__device__ __forceinline__ void xcd_barrier(const XcdBarrier&) { fprintf(stderr, "EMU: grid barrier inside a launch\n"); abort(); }
#endif

struct Args { const float* in[24]; float* out; unsigned char* ws; int ph_lo, ph_hi; };
enum { I_X = 0, I_C, I_WADA, I_BADA, I_GMIX, I_WIN, I_GMWS, I_GMBS, I_GMNG, I_PEK, I_W1K, I_W2K, I_PEV, I_W1V, I_W2V, I_WOUT, I_GFFN, I_WR, I_BR, I_WGU, I_BGU, I_WDN, I_BDN, I_GFIN };

struct Frame {
    LAS unsigned char* lds;
    volatile LAS unsigned* MISC;
    unsigned* ctl;
    unsigned char* ws;
    const float* in[24];
    float* out;
    int tid, lane, wave, vcu, G;
};

namespace pg8 {
constexpr int BM = 256, BK = 64, HALF = 128, HTB = HALF * BK * 2, STAGE_BYTES = 8 * HTB;
__device__ __forceinline__ int lds_byte(int r, int c) { const int st = (r >> 4) * 2 + (c >> 5), rr = r & 15, cc = c & 31, ob = rr * 64 + cc * 2; return st * 1024 + (ob ^ (((ob >> 9) & 1) << 5)); }
__device__ __forceinline__ void stage_rc(int b, int& R, int& C) { const int st = b / 1024, sb = b % 1024, swz = sb ^ (((sb >> 9) & 1) << 5); R = (st >> 1) * 16 + swz / 64; C = (st & 1) * 32 + (swz % 64) / 2; }
__device__ __forceinline__ int perm32(int rho) { const int n = rho >> 4, i = rho & 15; return 8 * (i >> 2) + 4 * n + (i & 3); }
struct Unit { int pm, pn, e; };

template <bool FP8, class Prob, class Sched, class Epi>
__device__ __forceinline__ void gemm_phase(LAS unsigned char* lds, const Prob& P, const Sched& S, const Epi& E) {
    const int tid = threadIdx.x, wid = __builtin_amdgcn_readfirstlane(tid >> 6), lane = tid & 63, wr = wid >> 2, wc = wid & 3, fr = lane & 15, fq = lane >> 4;
    const int KB = P.KB, nt = KB / 128;
    int Rr[2], Cc[2]; unsigned voffB[2];
#pragma unroll
    for (int i = 0; i < 2; ++i) { int R, C; stage_rc(tid * 16 + i * 8192, R, C); Rr[i] = R; Cc[i] = C; const int Rb = Epi::PERM ? ((R & ~31) + perm32(R & 31)) : R; voffB[i] = (unsigned)(Rb * KB + C * 2); }
    const size_t kstep = (size_t)(BK * 2);
    const size_t hstepB = (size_t)HALF * KB;
    const unsigned ldsw = (unsigned)wid * 1024u;
    const int aoff = lds_byte(wr * 64 + fr, fq * 8), boff = lds_byte(wc * 32 + fr, fq * 8);
#define PG8_SA(b, h) (((b) * 2 + (h)) * HTB)
#define PG8_SB(b, h) ((4 + (b) * 2 + (h)) * HTB)
#define PG8_STAGE(bufoff, gbase, voff) do { _Pragma("unroll") for (int _i = 0; _i < 2; ++_i) \
        __builtin_amdgcn_global_load_lds((const unsigned*)((const char*)(gbase) + (voff)[_i]), (LAS unsigned*)(lds + (bufoff) + ldsw + _i * 8192), 16, 0, 0); } while (0)
#define PG8_LD8(p) __builtin_shufflevector(*(const LAS v4i_t*)(p), *(const LAS v4i_t*)((p) + 1024), 0, 1, 2, 3, 4, 5, 6, 7)
#define PG8_LDA(dst, b, h) do { _Pragma("unroll") for (int m = 0; m < 4; ++m) dst[m] = PG8_LD8(lds + PG8_SA(b, h) + aoff + m * 2048); } while (0)
#define PG8_LDB(dst, b, h) do { _Pragma("unroll") for (int n = 0; n < 2; ++n) dst[n] = PG8_LD8(lds + PG8_SB(b, h) + boff + n * 2048); } while (0)
#define PG8_LO(x) __builtin_bit_cast(bf16x8, __builtin_shufflevector(x, x, 0, 1, 2, 3))
#define PG8_HI(x) __builtin_bit_cast(bf16x8, __builtin_shufflevector(x, x, 4, 5, 6, 7))
#ifdef EMU
#define PG8_MFMA_F8(c_, b_, a_) c_ = __builtin_amdgcn_mfma_scale_f32_16x16x128_f8f6f4(b_, a_, c_, 0, 0, 0, 0x7F7F7F7F, 0, 0x7F7F7F7F)
#else
#define PG8_MFMA_F8(c_, b_, a_) asm volatile("v_mfma_scale_f32_16x16x128_f8f6f4 %0, %1, %2, %0, %3, %3 op_sel_hi:[0,0,0]" : "+v"(c_) : "v"(b_), "v"(a_), "v"(f8one))
#endif
#define PG8_MMA(ai, bj, At, Bt) do { __builtin_amdgcn_s_setprio(1); \
        if (FP8) { _Pragma("unroll") for (int m = 0; m < 4; ++m) _Pragma("unroll") for (int n = 0; n < 2; ++n) PG8_MFMA_F8(acc[ai][bj][m][n], Bt[n], At[m]); } \
        else { _Pragma("unroll") for (int m = 0; m < 4; ++m) _Pragma("unroll") for (int n = 0; n < 2; ++n) { \
            acc[ai][bj][m][n] = __builtin_amdgcn_mfma_f32_16x16x32_bf16(PG8_LO(Bt[n]), PG8_LO(At[m]), acc[ai][bj][m][n], 0, 0, 0); \
            acc[ai][bj][m][n] = __builtin_amdgcn_mfma_f32_16x16x32_bf16(PG8_HI(Bt[n]), PG8_HI(At[m]), acc[ai][bj][m][n], 0, 0, 0); } } \
        __builtin_amdgcn_s_setprio(0); } while (0)
#define PG8_WAIT_V(n) ASM_VMCNT(n)
#define PG8_WAIT_L(n) ASM_LGKMCNT(n)
#define PG8_BAR __builtin_amdgcn_s_barrier()
#define PG8_SCHED __builtin_amdgcn_sched_barrier(0)
#ifndef EMU
    unsigned long long ge0_ = 0; const bool gprobe0_ = (PROBE_K / 10 == Epi::PID) && blockIdx.x == 0 && tid == 0;
    if (gprobe0_) ge0_ = __builtin_amdgcn_s_memrealtime();
#endif
    Unit cur, nxt; int ui = 0;
    if (!S.next(0, cur)) return;
    f32x4 acc[2][2][4][2];
#pragma unroll
    for (int a = 0; a < 2; ++a)
#pragma unroll
        for (int b = 0; b < 2; ++b)
#pragma unroll
            for (int m = 0; m < 4; ++m)
#pragma unroll
                for (int n = 0; n < 2; ++n) acc[a][b][m][n] = (f32x4){0.f, 0.f, 0.f, 0.f};
    v8i_t At[4], B0[2], B1[2];
    int f8one = 0x7F7F7F7F;
#ifndef EMU
    asm volatile("" : "+v"(f8one));
#endif
    (void)f8one;
    unsigned vA0[2], vA1[2], nA0[2], nA1[2];
#define PG8_SIDE(k) (lds + STAGE_BYTES + ((k) % 3) * 2048)
    if (Prob::SIDE) { P.side_issue(cur, PG8_SIDE(0), wid, lane); PG8_WAIT_V(0); PG8_BAR; }
#pragma unroll
    for (int i = 0; i < 2; ++i) { vA0[i] = P.a_rowoff(cur, Rr[i], PG8_SIDE(0)) + (unsigned)Cc[i] * 2u; vA1[i] = P.a_rowoff(cur, HALF + Rr[i], PG8_SIDE(0)) + (unsigned)Cc[i] * 2u; }
    const char* cA = P.a_base(cur); const char* cB = P.b_base(cur);
    PG8_STAGE(PG8_SB(0, 0), cB, voffB); PG8_STAGE(PG8_SB(0, 1), cB + hstepB, voffB); PG8_STAGE(PG8_SA(0, 0), cA, vA0); PG8_STAGE(PG8_SA(0, 1), cA, vA1);
    if (wr == 1) PG8_BAR;
    PG8_WAIT_V(2); PG8_BAR;
    PG8_STAGE(PG8_SB(1, 0), cB + kstep, voffB); PG8_STAGE(PG8_SA(1, 0), cA + kstep, vA0); PG8_STAGE(PG8_SB(1, 1), cB + hstepB + kstep, voffB);
    PG8_WAIT_V(6); PG8_BAR;
    for (;;) {
        const bool has_next = S.next(ui + 1, nxt);
        const char* nA = has_next ? P.a_base(nxt) : cA; const char* nB = has_next ? P.b_base(nxt) : cB;
        if (Prob::SIDE && has_next) P.side_issue(nxt, PG8_SIDE(ui + 1), wid, lane);
#pragma unroll
        for (int i = 0; i < 2; ++i) { nA0[i] = vA0[i]; nA1[i] = vA1[i]; }
        if (!Prob::SIDE && has_next) {
#pragma unroll
            for (int i = 0; i < 2; ++i) { nA0[i] = P.a_rowoff(nxt, Rr[i], PG8_SIDE(0)) + (unsigned)Cc[i] * 2u; nA1[i] = P.a_rowoff(nxt, HALF + Rr[i], PG8_SIDE(0)) + (unsigned)Cc[i] * 2u; }
        }
#ifndef EMU
        unsigned long long gt0_ = 0; const bool gprobe_ = (PROBE_K / 10 == Epi::PID) && blockIdx.x == 0 && tid == 0;
        if (gprobe_) { gt0_ = __builtin_amdgcn_s_memrealtime(); if (ui == 0) ((volatile LAS unsigned*)(lds + MISC_OFF))[300 + 8] += (unsigned)(gt0_ - ge0_); }
#endif
        for (int t = 0; t < nt; t += 2) {
            const bool last = (t == nt - 2);
            if (Prob::SIDE && has_next && t == nt - 4) {
#pragma unroll
                for (int i = 0; i < 2; ++i) { nA0[i] = P.a_rowoff(nxt, Rr[i], PG8_SIDE(ui + 1)) + (unsigned)Cc[i] * 2u; nA1[i] = P.a_rowoff(nxt, HALF + Rr[i], PG8_SIDE(ui + 1)) + (unsigned)Cc[i] * 2u; }
            }
            const char* a1 = cA + (size_t)(t + 1) * kstep;
            const char* a2 = last ? nA : cA + (size_t)(t + 2) * kstep; const char* b2 = last ? nB : cB + (size_t)(t + 2) * kstep;
            const char* a3 = a2 + kstep; const char* b3 = b2 + kstep;
            unsigned s0[2], s1[2];
#pragma unroll
            for (int i = 0; i < 2; ++i) { s0[i] = last ? nA0[i] : vA0[i]; s1[i] = last ? nA1[i] : vA1[i]; }
            PG8_LDB(B0, 0, 0); PG8_LDB(B1, 0, 1); PG8_SCHED; PG8_LDA(At, 0, 0); PG8_STAGE(PG8_SA(1, 1), a1, vA1);
            PG8_WAIT_V(8); PG8_WAIT_L(0); PG8_BAR; PG8_MMA(0, 0, At, B0); PG8_MMA(0, 1, At, B1); PG8_BAR; PG8_SCHED;
            PG8_LDA(At, 0, 1); PG8_STAGE(PG8_SB(0, 0), b2, voffB); PG8_STAGE(PG8_SB(0, 1), b2 + hstepB, voffB); PG8_STAGE(PG8_SA(0, 0), a2, s0);
            PG8_WAIT_V(8); PG8_WAIT_L(0); PG8_BAR; PG8_MMA(1, 0, At, B0); PG8_MMA(1, 1, At, B1); PG8_BAR; PG8_SCHED;
            PG8_LDB(B0, 1, 0); PG8_LDB(B1, 1, 1); PG8_SCHED; PG8_LDA(At, 1, 0); PG8_STAGE(PG8_SA(0, 1), a2, s1);
            PG8_WAIT_V(8); PG8_WAIT_L(0); PG8_BAR; PG8_MMA(0, 0, At, B0); PG8_MMA(0, 1, At, B1); PG8_BAR; PG8_SCHED;
            PG8_LDA(At, 1, 1); PG8_STAGE(PG8_SB(1, 0), b3, voffB); PG8_STAGE(PG8_SB(1, 1), b3 + hstepB, voffB); PG8_STAGE(PG8_SA(1, 0), a3, s0);
            PG8_WAIT_V(8); PG8_WAIT_L(0); PG8_BAR; PG8_MMA(1, 0, At, B0); PG8_MMA(1, 1, At, B1); PG8_BAR; PG8_SCHED;
        }
#ifndef EMU
        if (gprobe_) { const unsigned long long t1_ = __builtin_amdgcn_s_memrealtime(); ((volatile LAS unsigned*)(lds + MISC_OFF))[300 + 6] += (unsigned)(t1_ - gt0_); gt0_ = t1_; }
#endif
        if (wr == 0) PG8_BAR;
#ifndef EMU
        if (FP8) asm volatile("s_nop 15\n\ts_nop 15" ::: "memory");
#endif
        E(acc, cur, wr, wc, fr, fq, (const LAS float*)(PG8_SIDE(ui) + 1024));
        if (!has_next) break;
#pragma unroll
        for (int a = 0; a < 2; ++a)
#pragma unroll
            for (int b = 0; b < 2; ++b)
#pragma unroll
                for (int m = 0; m < 4; ++m)
#pragma unroll
                    for (int n = 0; n < 2; ++n) acc[a][b][m][n] = (f32x4){0.f, 0.f, 0.f, 0.f};
#ifndef EMU
        if (gprobe_) { const unsigned long long t1_ = __builtin_amdgcn_s_memrealtime(); ((volatile LAS unsigned*)(lds + MISC_OFF))[300 + 7] += (unsigned)(t1_ - gt0_); }
#endif
        cur = nxt; cA = nA; cB = nB; ++ui;
#pragma unroll
        for (int i = 0; i < 2; ++i) { vA0[i] = nA0[i]; vA1[i] = nA1[i]; }
        if (wr == 1) PG8_BAR;
    }
#ifndef EMU
    if (gprobe0_) ge0_ = __builtin_amdgcn_s_memrealtime();
#endif
    PG8_WAIT_V(0);
    PG8_BAR;
#ifndef EMU
    if (gprobe0_) ((volatile LAS unsigned*)(lds + MISC_OFF))[300 + 9] += (unsigned)(__builtin_amdgcn_s_memrealtime() - ge0_);
#endif
#undef PG8_SIDE
#undef PG8_SA
#undef PG8_SB
#undef PG8_STAGE
#undef PG8_LDA
#undef PG8_LDB
#undef PG8_MMA
#undef PG8_MFMA_F8
#undef PG8_LD8
#undef PG8_LO
#undef PG8_HI
#undef PG8_WAIT_V
#undef PG8_WAIT_L
#undef PG8_BAR
#undef PG8_SCHED
}

struct DenseOrder {
    int nM, nN, nwg, G, c;
    __device__ __forceinline__ void init(int M, int N, int G_, int c_) { nM = M / BM; nN = N / BM; nwg = nM * nN; G = G_; c = c_; }
    __device__ __forceinline__ bool next(int i, Unit& u) const {
        const long L = (long)i * G + c; if (L >= nwg) return false;
        int wgid = (int)L; { const int q = nwg / 8, r = nwg % 8, xcd = wgid % 8, off = wgid / 8; wgid = (xcd < r ? xcd * (q + 1) : r * (q + 1) + (xcd - r) * q) + off; }
        const int nig = 8 * nN, gid = wgid / nig, fm = gid * 8, gsz = (nM - fm) < 8 ? (nM - fm) : 8;
        u.pm = fm + ((wgid % nig) % gsz); u.pn = (wgid % nig) / gsz; u.e = 0; return true;
    }
};
struct DenseProb {
    static constexpr bool SIDE = false;
    const char* A; const char* Bt; int KB;
    __device__ __forceinline__ const char* a_base(const Unit& u) const { return A + (size_t)u.pm * BM * KB; }
    __device__ __forceinline__ unsigned a_rowoff(const Unit&, int r, const LAS unsigned char*) const { return (unsigned)(r * KB); }
    __device__ __forceinline__ const char* b_base(const Unit& u) const { return Bt + (size_t)u.pn * BM * KB; }
    __device__ __forceinline__ void side_issue(const Unit&, LAS unsigned char*, int, int) const {}
};
struct MoeOrder {
    volatile LAS unsigned* tpfx; int nN, G, c;
    mutable int ecur;
    __device__ __forceinline__ bool next(int i, Unit& u) const {
        const int L = i * G + c; const int total = (int)tpfx[NE] * nN; if (L >= total) return false;
        int e = ecur;
        if (L < (int)tpfx[e] * nN) e = 0;
        while (L >= (int)tpfx[e + 1] * nN) ++e;
        ecur = e;
        const int rem = L - (int)tpfx[e] * nN, tm = (int)tpfx[e + 1] - (int)tpfx[e];
        u.e = e; u.pm = rem % tm; u.pn = rem / tm; return true;
    }
};
}

struct EpiZ {
    static constexpr bool PERM = true; static constexpr int PID = 2;
    bf16_t* O;
    __device__ __forceinline__ void operator()(const f32x4 (&acc)[2][2][4][2], const pg8::Unit& u, int wr, int wc, int fr, int fq, const LAS float*) const {
        const int row0 = u.pm * 256 + wr * 64 + fr, col0 = u.pn * 256 + wc * 32 + 8 * fq;
#pragma unroll
        for (int ai = 0; ai < 2; ++ai)
#pragma unroll
            for (int m = 0; m < 4; ++m) { bf16_t* rowp = O + (size_t)(row0 + ai * 128 + m * 16) * ZP + col0;
#pragma unroll
                for (int bj = 0; bj < 2; ++bj) { const f32x4 v0 = acc[ai][bj][m][0], v1 = acc[ai][bj][m][1];
                    u32x4 w; w.x = pk2(v0[0], v0[1]); w.y = pk2(v0[2], v0[3]); w.z = pk2(v1[0], v1[1]); w.w = pk2(v1[2], v1[3]);
                    *(u32x4*)(rowp + bj * 128) = w; } }
    }
};
struct EpiMix {
    static constexpr bool PERM = true; static constexpr int PID = 5;
    bf16_t* O; const float* X; const float* mod;
    __device__ __forceinline__ void operator()(const f32x4 (&acc)[2][2][4][2], const pg8::Unit& u, int wr, int wc, int fr, int fq, const LAS float*) const {
        const int row0 = u.pm * 256 + wr * 64 + fr, col0 = u.pn * 256 + wc * 32 + 8 * fq;
        const float* gp = mod + (size_t)((u.pm * 256) / SEQ) * 6144 + 2 * 1024 + col0;
        f32x4 g1[2][2];
#pragma unroll
        for (int bj = 0; bj < 2; ++bj) { g1[bj][0] = *(const f32x4*)(gp + bj * 128); g1[bj][1] = *(const f32x4*)(gp + bj * 128 + 4); }
#pragma unroll
        for (int ai = 0; ai < 2; ++ai) {
            f32x4 xv[4][2][2];
#pragma unroll
            for (int m = 0; m < 4; ++m) { const float* xr = X + (size_t)(row0 + ai * 128 + m * 16) * DM + col0;
#pragma unroll
                for (int bj = 0; bj < 2; ++bj) { xv[m][bj][0] = __builtin_nontemporal_load((const f32x4*)(xr + bj * 128)); xv[m][bj][1] = __builtin_nontemporal_load((const f32x4*)(xr + bj * 128 + 4)); } }
#pragma unroll
            for (int m = 0; m < 4; ++m) { bf16_t* rowp = O + (size_t)(row0 + ai * 128 + m * 16) * DM + col0;
#pragma unroll
                for (int bj = 0; bj < 2; ++bj) { const f32x4 v0 = xv[m][bj][0] + g1[bj][0] * acc[ai][bj][m][0], v1 = xv[m][bj][1] + g1[bj][1] * acc[ai][bj][m][1];
                    u32x4 w; w.x = pk2(v0[0], v0[1]); w.y = pk2(v0[2], v0[3]); w.z = pk2(v1[0], v1[1]); w.w = pk2(v1[2], v1[3]);
                    *(u32x4*)(rowp + bj * 128) = w; } }
        }
    }
};
struct EpiAct {
    static constexpr bool PERM = true; static constexpr int PID = 7;
    unsigned char* O; const float* bgu; volatile LAS unsigned* roff;
    __device__ __forceinline__ void operator()(const f32x4 (&acc)[2][2][4][2], const pg8::Unit& u, int wr, int wc, int fr, int fq, const LAS float* sb) const {
        const int row0 = (int)roff[u.e] + u.pm * 256 + wr * 64 + fr, col0 = u.pn * 128 + wc * 32 + 8 * fq;
        const LAS float* bp = sb + 2 * (wc * 32 + 8 * fq);
        f32x4 bb[4];
#pragma unroll
        for (int j = 0; j < 4; ++j) bb[j] = *(const LAS f32x4*)(bp + 4 * j);
#pragma unroll
        for (int ai = 0; ai < 2; ++ai)
#pragma unroll
            for (int m = 0; m < 4; ++m) { float a8[8];
#pragma unroll
                for (int n = 0; n < 2; ++n)
#pragma unroll
                    for (int j = 0; j < 4; ++j) { const int cc = 4 * n + j;
                        float g = acc[ai][0][m][n][j] * F8_ACC_SCALE + bb[cc >> 1][(cc & 1) * 2], l = acc[ai][1][m][n][j] * F8_ACC_SCALE + bb[cc >> 1][(cc & 1) * 2 + 1];
                        g = fminf(g, 7.0f); l = fminf(fmaxf(l, -7.0f), 7.0f);
                        a8[cc] = (g * F8_ACT_SCALE) * __builtin_amdgcn_rcpf(1.0f + fexp2(g * (-1.702f * LOG2E))) * (l + 1.0f); }
                u32x2 w; w.x = pk4_fp8_nc(a8[0], a8[1], a8[2], a8[3]); w.y = pk4_fp8_nc(a8[4], a8[5], a8[6], a8[7]);
                *(u32x2*)(O + (size_t)(row0 + ai * 128 + m * 16) * DFF + col0) = w; }
    }
};
struct EpiYd {
    static constexpr bool PERM = true; static constexpr int PID = 8;
    unsigned char* O; const float* bdn; volatile LAS unsigned* roff;
    __device__ __forceinline__ void operator()(const f32x4 (&acc)[2][2][4][2], const pg8::Unit& u, int wr, int wc, int fr, int fq, const LAS float* sb) const {
        const int row0 = (int)roff[u.e] + u.pm * 256 + wr * 64 + fr, col0 = u.pn * 256 + wc * 32 + 8 * fq;
        f32x4 bv[2][2];
#pragma unroll
        for (int bj = 0; bj < 2; ++bj)
#pragma unroll
            for (int n = 0; n < 2; ++n) bv[bj][n] = *(const LAS f32x4*)(sb + wc * 32 + 8 * fq + bj * 128 + 4 * n) * F8_YD_SCALE;
#pragma unroll
        for (int ai = 0; ai < 2; ++ai)
#pragma unroll
            for (int m = 0; m < 4; ++m) { unsigned char* rowp = O + (size_t)(row0 + ai * 128 + m * 16) * DM + col0;
#pragma unroll
                for (int bj = 0; bj < 2; ++bj) { const f32x4 v0 = acc[ai][bj][m][0] * (F8_ACC_SCALE * F8_YD_SCALE) + bv[bj][0], v1 = acc[ai][bj][m][1] * (F8_ACC_SCALE * F8_YD_SCALE) + bv[bj][1];
                    u32x2 w; w.x = pk4_fp8(v0[0], v0[1], v0[2], v0[3]); w.y = pk4_fp8(v1[0], v1[1], v1[2], v1[3]);
                    *(u32x2*)(rowp + bj * 128) = w; } }
    }
};
struct MoeProb1 {
    static constexpr bool SIDE = true;
    const char* H2; const char* Bt; const int* lists; const float* bias; volatile LAS unsigned* cnt; int KB;
    __device__ __forceinline__ const char* a_base(const pg8::Unit&) const { return H2; }
    __device__ __forceinline__ unsigned a_rowoff(const pg8::Unit& u, int r, const LAS unsigned char* side) const { const int i = u.pm * 256 + r; const int tok = (i < (int)cnt[u.e]) ? ((const LAS int*)side)[r] : 0; return (unsigned)tok * 1024u; }
    __device__ __forceinline__ const char* b_base(const pg8::Unit& u) const { return Bt + ((size_t)u.e * 2048 + (size_t)u.pn * 256) * 1024; }
    __device__ __forceinline__ void side_issue(const pg8::Unit& u, LAS unsigned char* side, int wid, int lane) const {
        if (wid == 0) __builtin_amdgcn_global_load_lds((const unsigned*)(lists + (size_t)u.e * T + u.pm * 256 + lane * 4), (LAS unsigned*)side, 16, 0, 0);
        if (wid == 1) __builtin_amdgcn_global_load_lds((const unsigned*)(bias + (size_t)u.e * 2048 + u.pn * 256 + lane * 4), (LAS unsigned*)(side + 1024), 16, 0, 0);
    }
};
struct MoeProb2 {
    static constexpr bool SIDE = true;
    const char* A; const char* Bt; const float* bias; volatile LAS unsigned* roff; int KB;
    __device__ __forceinline__ const char* a_base(const pg8::Unit& u) const { return A + ((size_t)roff[u.e] + (size_t)u.pm * 256) * 1024; }
    __device__ __forceinline__ unsigned a_rowoff(const pg8::Unit&, int r, const LAS unsigned char*) const { return (unsigned)r * 1024u; }
    __device__ __forceinline__ const char* b_base(const pg8::Unit& u) const { return Bt + ((size_t)u.e * 1024 + (size_t)u.pn * 256) * 1024; }
    __device__ __forceinline__ void side_issue(const pg8::Unit& u, LAS unsigned char* side, int wid, int lane) const {
        if (wid == 1) __builtin_amdgcn_global_load_lds((const unsigned*)(bias + (size_t)u.e * 1024 + u.pn * 256 + lane * 4), (LAS unsigned*)(side + 1024), 16, 0, 0);
    }
};

template <int NB>
__device__ __forceinline__ void gemv_item(Frame& F, const float* vec, int vstride, const float* W, int K, int N, int n0, const float* bias, float* out, int ostride) {
    LAS float* red = (LAS float*)F.lds;
    const int col = n0 + F.lane, ks = K / NWAVES;
    float acc[NB];
#pragma unroll
    for (int b = 0; b < NB; ++b) acc[b] = 0.f;
    for (int k0 = F.wave * ks; k0 < (F.wave + 1) * ks; k0 += 32) {
        float wv[32];
#pragma unroll
        for (int j = 0; j < 32; ++j) wv[j] = __builtin_nontemporal_load(W + (size_t)(k0 + j) * N + col);
#pragma unroll
        for (int j = 0; j < 32; ++j)
#pragma unroll
            for (int b = 0; b < NB; ++b) acc[b] += vec[b * vstride + k0 + j] * wv[j]; }
#pragma unroll
    for (int b = 0; b < NB; ++b) red[(F.wave * NB + b) * 64 + F.lane] = acc[b];
    __syncthreads();
    if (F.wave == 0) {
#pragma unroll
        for (int b = 0; b < NB; ++b) { float s = bias ? bias[col] : 0.f;
            for (int w = 0; w < NWAVES; ++w) s += red[(w * NB + b) * 64 + F.lane];
            out[b * ostride + col] = s; }
    }
    __syncthreads();
}
template <int MAP>
__device__ __forceinline__ int t_rowmap(int n) {
    if (MAP == 0) return n;
    const int ac = n >> 1, bj = n & 1; return (ac >> 7) * 256 + bj * 128 + (ac & 127);
}
template <int MAP>
__device__ __forceinline__ void transpose_item(const float* W, int K, int Nsrc, int nblk, bf16_t* WT, LAS float* scr, int item, int lane) {
    const int kb = item / nblk, nb = item % nblk, k0 = 64 * kb, n0 = 32 * nb;
    const int nc = n0 + (lane & 31);
    float tv[32];
    if (nc < Nsrc) {
#pragma unroll
        for (int i = 0; i < 32; ++i) tv[i] = __builtin_nontemporal_load(W + (size_t)(k0 + 2 * i + (lane >> 5)) * Nsrc + nc);
    } else {
#pragma unroll
        for (int i = 0; i < 32; ++i) tv[i] = 0.f;
    }
#pragma unroll
    for (int i = 0; i < 32; ++i) scr[(2 * i + (lane >> 5)) * 33 + (lane & 31)] = tv[i];
    WAVE_SYNC(); FENCE();
    const int c = lane & 7;
#pragma unroll
    for (int j = 0; j < 4; ++j) { const int n = (lane >> 3) + 8 * j; const LAS float* s = scr + (8 * c) * 33 + n;
        u32x4 o; o.x = pk2(s[0 * 33], s[1 * 33]); o.y = pk2(s[2 * 33], s[3 * 33]); o.z = pk2(s[4 * 33], s[5 * 33]); o.w = pk2(s[6 * 33], s[7 * 33]);
        *(u32x4*)(WT + (size_t)t_rowmap<MAP>(n0 + n) * K + k0 + 8 * c) = o; }
    WAVE_SYNC(); FENCE();
}
__device__ __forceinline__ void t8_issue(const float* W, int Nsrc, int nblk, int item, int lane, f32x4 (&tv)[8]) {
    const int kb = item / nblk, nb = item % nblk, k0 = 64 * kb, n0 = 32 * nb;
#pragma unroll
    for (int i = 0; i < 8; ++i) tv[i] = __builtin_nontemporal_load((const f32x4*)(W + (size_t)(k0 + 8 * i + (lane >> 3)) * Nsrc + n0 + 4 * (lane & 7)));
}
template <int MAP>
__device__ __forceinline__ void t8_finish(int K, int nblk, unsigned char* WT, LAS float* scr, int item, int lane, float scale, const f32x4 (&tv)[8]) {
    const int kb = item / nblk, nb = item % nblk, k0 = 64 * kb, n0 = 32 * nb;
#pragma unroll
    for (int i = 0; i < 8; ++i) { LAS float* d = scr + (8 * i + (lane >> 3)) * 33 + 4 * (lane & 7);
        d[0] = tv[i][0] * scale; d[1] = tv[i][1] * scale; d[2] = tv[i][2] * scale; d[3] = tv[i][3] * scale; }
    WAVE_SYNC(); FENCE();
    const int c = lane & 7;
#pragma unroll
    for (int j = 0; j < 4; ++j) { const int n = (lane >> 3) + 8 * j; const LAS float* sp = scr + (8 * c) * 33 + n;
        u32x2 o; o.x = pk4_fp8(sp[0 * 33], sp[1 * 33], sp[2 * 33], sp[3 * 33]); o.y = pk4_fp8(sp[4 * 33], sp[5 * 33], sp[6 * 33], sp[7 * 33]);
        *(u32x2*)(WT + (size_t)t_rowmap<MAP>(n0 + n) * K + k0 + 8 * c) = o; }
    WAVE_SYNC(); FENCE();
}
template <int MAP>
__device__ __forceinline__ void transpose_item_f8(const float* W, int K, int Nsrc, int nblk, unsigned char* WT, LAS float* scr, int item, int lane, float scale) {
    f32x4 tv[8];
    t8_issue(W, Nsrc, nblk, item, lane, tv);
    t8_finish<MAP>(K, nblk, WT, scr, item, lane, scale, tv);
}
constexpr int P0_I_IN = (DM / 64) * (ZP / 32), P0_I_OUT = (DM / 64) * (DM / 32), P0_I_W1 = (2048 / 64) * (256 / 32), P0_I_W2 = (256 / 64) * (64 / 32);
constexpr int P0_I_GU1 = (DM / 64) * (2048 / 32), P0_I_DN1 = (DFF / 64) * (DM / 32);
constexpr int P0_NITEMS = P0_I_IN + P0_I_OUT + 2 * P0_I_W1 + 2 * P0_I_W2 + NE * P0_I_GU1 + NE * P0_I_DN1;
constexpr int P2_FILL_PER_CU = 44;
__device__ __forceinline__ int p2_fill_items(const Frame& F) { return (F.G == 256 && (T / 256) * (ZP / 256) == 640) ? 128 * P2_FILL_PER_CU : 0; }
#ifndef P3_NA
#define P3_NA 0
#endif
#ifndef P7_FILL_ITEMS
#define P7_FILL_ITEMS 8192
#endif
__device__ __forceinline__ int p7_fill_items(const Frame& F) { return (F.G >= 8) ? P7_FILL_ITEMS : 0; }
#ifndef P6_FILL_PER_WAVE
#define P6_FILL_PER_WAVE 1
#endif
constexpr int P6_FILL = (T / 32) * NWAVES * P6_FILL_PER_WAVE;
constexpr int P0_GU_END = P0_I_IN + P0_I_OUT + 2 * P0_I_W1 + 2 * P0_I_W2 + NE * P0_I_GU1;
static_assert(P6_FILL <= NE * P0_I_GU1, "P6 filler");
__device__ __forceinline__ void gu_issue(const Frame& F, int r, f32x4 (&tv)[8]) { const int e = r / P0_I_GU1; t8_issue(F.in[I_WGU] + (size_t)e * DM * 2048, 2048, 64, r % P0_I_GU1, F.lane, tv); }
__device__ __forceinline__ void gu_finish(const Frame& F, LAS float* scr, int r, const f32x4 (&tv)[8]) { const int e = r / P0_I_GU1;
    t8_finish<1>(DM, 64, (unsigned char*)(F.ws + WS_WGUT) + (size_t)e * 2048 * DM, scr, r % P0_I_GU1, F.lane, F8_W_SCALE, tv); }
__device__ __forceinline__ void p0_item(Frame& F, LAS float* scr, int it) {
    int r = it;
    if (r < P0_I_IN) { transpose_item<0>(F.in[I_WIN], DM, INC, ZP / 32, (bf16_t*)(F.ws + WS_WINT), scr, r, F.lane); return; } r -= P0_I_IN;
    if (r < P0_I_OUT) { transpose_item<0>(F.in[I_WOUT], DM, DM, DM / 32, (bf16_t*)(F.ws + WS_WOUTT), scr, r, F.lane); return; } r -= P0_I_OUT;
    if (r < P0_I_W1) { transpose_item<0>(F.in[I_W1K], 2048, 256, 8, (bf16_t*)(F.ws + WS_W1KT), scr, r, F.lane); return; } r -= P0_I_W1;
    if (r < P0_I_W1) { transpose_item<0>(F.in[I_W1V], 2048, 256, 8, (bf16_t*)(F.ws + WS_W1VT), scr, r, F.lane); return; } r -= P0_I_W1;
    if (r < P0_I_W2) { transpose_item<0>(F.in[I_W2K], 256, 64, 2, (bf16_t*)(F.ws + WS_W2KT), scr, r, F.lane); return; } r -= P0_I_W2;
    if (r < P0_I_W2) { transpose_item<0>(F.in[I_W2V], 256, 64, 2, (bf16_t*)(F.ws + WS_W2VT), scr, r, F.lane); return; } r -= P0_I_W2;
    if (r < NE * P0_I_GU1) { const int e = r / P0_I_GU1; transpose_item_f8<1>(F.in[I_WGU] + (size_t)e * DM * 2048, DM, 2048, 64, (unsigned char*)(F.ws + WS_WGUT) + (size_t)e * 2048 * DM, scr, r % P0_I_GU1, F.lane, F8_W_SCALE); return; } r -= NE * P0_I_GU1;
    { const int e = r / P0_I_DN1; transpose_item_f8<0>(F.in[I_WDN] + (size_t)e * DFF * DM, DFF, DM, 32, (unsigned char*)(F.ws + WS_WDNT) + (size_t)e * DM * DFF, scr, r % P0_I_DN1, F.lane, F8_W_SCALE); }
}
__device__ __forceinline__ int p0_hole(int it) { return it < P0_GU_END - P6_FILL ? it : it + P6_FILL; }
__device__ __forceinline__ void p0_prologue(Frame& F) {
    for (int it = F.vcu; it < 96 + 8; it += F.G) {
        if (it < 96) gemv_item<BATCH>(F, F.in[I_C], DM, F.in[I_WADA], DM, 6 * DM, 64 * it, F.in[I_BADA], (float*)(F.ws + WS_MOD), 6 * DM);
        else { const int j = it - 96, kv = j >> 2, n0 = (j & 3) * 64;
            gemv_item<1>(F, F.in[kv ? I_PEV : I_PEK], 0, F.in[kv ? I_W1V : I_W1K], 2048, 256, n0, nullptr, (float*)(F.ws + WS_BPE) + kv * 256, 0); }
    }
    { const float* src = F.in[I_GMWS]; bf16_t* dst = (bf16_t*)(F.ws + WS_WSBF);
      for (int idx = F.vcu * NTHREADS + F.tid; idx < GMG * GMC * GMC; idx += F.G * NTHREADS) { const int i = (idx >> 7) & 127, j = idx & 127; dst[idx] = (bf16_t)f2bf(j <= i ? src[idx] : 0.f); } }
    { const float* src = F.in[I_WR]; float* dst = (float*)(F.ws + WS_WRT);
      for (int idx = F.vcu * NTHREADS + F.tid; idx < DM * NE; idx += F.G * NTHREADS) dst[idx] = src[(idx & (DM - 1)) * NE + (idx >> 10)]; }
    LAS float* scr = (LAS float*)(F.lds + 8192 + F.wave * 16384);
    const int gw = F.vcu * NWAVES + F.wave, NGW = F.G * NWAVES;
    const int nit = P0_NITEMS - p2_fill_items(F) - p7_fill_items(F) - P6_FILL;
    constexpr int NGEMV = 96 + 8;
    const int shift = (F.G > 2 * NGEMV) ? 2 * NGEMV * NWAVES : 0, n1 = nit - shift;
    for (int it = gw; it < n1; it += NGW) p0_item(F, scr, p0_hole(it));
    if (shift && F.vcu >= NGEMV) for (int it = n1 + (F.vcu - NGEMV) * NWAVES + F.wave; it < nit; it += (F.G - NGEMV) * NWAVES) p0_item(F, scr, p0_hole(it));
}

__device__ __forceinline__ void norm_rows(Frame& F, const float* xin, const float* g, int mod_shift, int mod_scale, bf16_t* outb) {
    const int gw = F.vcu * NWAVES + F.wave, NGW = F.G * NWAVES;
    const float* mod = (const float*)(F.ws + WS_MOD);
    for (int m0 = gw; m0 < T / 2; m0 += NGW) {
        f32x4 v[2][4]; float s[2] = {0.f, 0.f};
#pragma unroll
        for (int q = 0; q < 2; ++q) { const f32x4* xr = (const f32x4*)(xin + (size_t)(m0 + q * (T / 2)) * DM) + F.lane;
#pragma unroll
            for (int j = 0; j < 4; ++j) v[q][j] = __builtin_nontemporal_load(xr + 64 * j); }
#pragma unroll
        for (int q = 0; q < 2; ++q)
#pragma unroll
            for (int j = 0; j < 4; ++j) s[q] += (v[q][j][0] * v[q][j][0] + v[q][j][1] * v[q][j][1]) + (v[q][j][2] * v[q][j][2] + v[q][j][3] * v[q][j][3]);
#pragma unroll
        for (int o = 1; o < 64; o <<= 1) { s[0] += __shfl_xor(s[0], o); s[1] += __shfl_xor(s[1], o); }
#pragma unroll
        for (int q = 0; q < 2; ++q) { const int m = m0 + q * (T / 2), b = m / SEQ;
            const float rinv = __builtin_amdgcn_rsqf(s[q] * (1.0f / DM) + EPS);
            u32x2* o8 = (u32x2*)(outb + (size_t)m * DM) + F.lane;
#pragma unroll
            for (int j = 0; j < 4; ++j) { const int c = 4 * F.lane + 256 * j;
                const f32x4 gg = *(const f32x4*)(g + c), sc = *(const f32x4*)(mod + (size_t)b * 6144 + mod_scale * 1024 + c), sh = *(const f32x4*)(mod + (size_t)b * 6144 + mod_shift * 1024 + c);
                const f32x4 h = v[q][j] * rinv * gg * (sc + 1.0f) + sh;
                u32x2 w; w.x = pk2(h[0], h[1]); w.y = pk2(h[2], h[3]); o8[64 * j] = w; } }
    }
}

struct GmRegs { u32x4 v[2], u[2]; };
__device__ __forceinline__ void gmlp_load(Frame& F, int tile, GmRegs& R) {
    const int g = tile % GMG, ch = (tile / GMG) % (SEQ / GMC), b = tile / (GMG * (SEQ / GMC));
    const size_t row0 = (size_t)b * SEQ + (size_t)ch * GMC;
    const bf16_t* ZB = (const bf16_t*)(F.ws + WS_ZB);
#pragma unroll
    for (int it = 0; it < 2; ++it) { const int idx = F.tid + it * NTHREADS, row = idx >> 3, c8 = idx & 7;
        R.v[it] = *(const u32x4*)(ZB + (row0 + row) * ZP + ZC_V + g * 64 + c8 * 8);
        R.u[it] = *(const u32x4*)(ZB + (row0 + row) * ZP + ZC_U + g * 64 + c8 * 8); }
}
__device__ __forceinline__ void gmlp_compute(Frame& F, int tile, const GmRegs& R) {
    const int g = tile % GMG, ch = (tile / GMG) % (SEQ / GMC), b = tile / (GMG * (SEQ / GMC));
    const size_t row0 = (size_t)b * SEQ + (size_t)ch * GMC;
    LAS bf16_t* Vt = (LAS bf16_t*)F.lds;
    constexpr int VP = 136, UP = 68;
    LAS float* Us = (LAS float*)(F.lds + 64 * VP * 2);
    const float* gn = F.in[I_GMNG] + g * 64;
    const int fr = F.lane & 15, fq = F.lane >> 4, w = F.wave;
    const bf16_t* Wg = (const bf16_t*)(F.ws + WS_WSBF) + (size_t)g * GMC * GMC;
    bf16x8 af[4];
#pragma unroll
    for (int ks = 0; ks < 4; ++ks) af[ks] = *(const bf16x8*)(Wg + (size_t)(16 * w + fr) * GMC + 32 * ks + 8 * fq);
#pragma unroll
    for (int it = 0; it < 2; ++it) {
        const int idx = F.tid + it * NTHREADS, row = idx >> 3, c8 = idx & 7;
        const u32x4 raw = R.v[it];
        float v[8]; v[0] = bflo(raw.x); v[1] = bfhi(raw.x); v[2] = bflo(raw.y); v[3] = bfhi(raw.y); v[4] = bflo(raw.z); v[5] = bfhi(raw.z); v[6] = bflo(raw.w); v[7] = bfhi(raw.w);
        float ss = 0.f;
#pragma unroll
        for (int e = 0; e < 8; ++e) { v[e] = gelu_tanh(v[e]); ss += v[e] * v[e]; }
        ss += __shfl_xor(ss, 1); ss += __shfl_xor(ss, 2); ss += __shfl_xor(ss, 4);
        const float rinv = __builtin_amdgcn_rsqf(ss * (1.0f / 64.0f) + EPS);
#pragma unroll
        for (int e = 0; e < 8; ++e) Vt[(c8 * 8 + e) * VP + (row ^ (16 * c8))] = (bf16_t)f2bf(v[e] * rinv * gn[c8 * 8 + e]);
        const u32x4 ur = R.u[it];
        f32x4 u0 = {gelu_tanh(bflo(ur.x)), gelu_tanh(bfhi(ur.x)), gelu_tanh(bflo(ur.y)), gelu_tanh(bfhi(ur.y))}, u1 = {gelu_tanh(bflo(ur.z)), gelu_tanh(bfhi(ur.z)), gelu_tanh(bflo(ur.w)), gelu_tanh(bfhi(ur.w))};
        *(LAS f32x4*)(Us + row * UP + c8 * 8) = u0; *(LAS f32x4*)(Us + row * UP + c8 * 8 + 4) = u1;
    }
    __syncthreads();
    f32x4 acc[4];
#pragma unroll
    for (int n = 0; n < 4; ++n) acc[n] = (f32x4){0.f, 0.f, 0.f, 0.f};
#pragma unroll
    for (int ks = 0; ks < 4; ++ks) {
        if (32 * ks <= 16 * w + 15) {
#pragma unroll
            for (int n = 0; n < 4; ++n) { const bf16x8 bb = *(const LAS bf16x8*)(Vt + (16 * n + fr) * VP + ((32 * ks + 8 * fq) ^ (16 * ((16 * n + fr) >> 3))));
                acc[n] = __builtin_amdgcn_mfma_f32_16x16x32_bf16(af[ks], bb, acc[n], 0, 0, 0); }
        }
    }
    bf16_t* Y = (bf16_t*)(F.ws + WS_YMIX);
    const float* bs = F.in[I_GMBS] + g * GMC;
#pragma unroll
    for (int n = 0; n < 4; ++n)
#pragma unroll
        for (int r = 0; r < 4; ++r) { const int i = 16 * w + 4 * fq + r, d = 16 * n + fr;
            Y[(row0 + i) * DM + g * 64 + d] = (bf16_t)f2bf(Us[i * UP + d] * (acc[n][r] + bs[i])); }
    __syncthreads();
}
__device__ __forceinline__ void gmlp_run(Frame& F, int base, int stride, int n) {
    if (n <= 0) return;
    GmRegs A, B;
    gmlp_load(F, base, A);
    for (int k = 0; k < n; k += 2) {
        if (k + 1 < n) gmlp_load(F, base + (k + 1) * stride, B);
        gmlp_compute(F, base + k * stride, A);
        if (k + 1 < n) { if (k + 2 < n) gmlp_load(F, base + (k + 2) * stride, A); gmlp_compute(F, base + (k + 1) * stride, B); }
    }
}

__device__ __forceinline__ void cmp_tile(Frame& F, int tile) {
    constexpr int NT = NCP / 32;
    const int nt = tile % NT, g = (tile / NT) % NG, b = (tile / (NT * NG)) % BATCH, kv = tile / (NT * NG * BATCH);
    const int n0 = 32 * nt, p0 = 16 * n0;
    const bf16_t* ZB = (const bf16_t*)(F.ws + WS_ZB);
    LAS unsigned char* Rs = F.lds;
    LAS bf16_t* Hs = (LAS bf16_t*)(F.lds + 528 * 128);
    constexpr int HP = 264;
    const int zc = (kv ? ZC_VC : ZC_KC) + g * 64;
    {
        u32x4 sv[9];
#pragma unroll
        for (int it = 0; it < 9; ++it) { const int idx = F.tid + it * NTHREADS, row = idx >> 3, c8 = idx & 7; const int p = p0 + row;
            sv[it] = (u32x4){0u, 0u, 0u, 0u};
            if (idx < 528 * 8 && p < SEQ) sv[it] = *(const u32x4*)(ZB + ((size_t)b * SEQ + p) * ZP + zc + c8 * 8); }
#pragma unroll
        for (int it = 0; it < 9; ++it) { const int idx = F.tid + it * NTHREADS, row = idx >> 3, c8 = idx & 7;
            if (idx < 528 * 8) *(LAS u32x4*)(Rs + ((row ^ ((row >> 7) & 1)) << 7) + ((c8 ^ ((row >> 4) & 7)) << 4)) = sv[it]; }
    }
    __syncthreads();
    const int i = F.lane & 31, hi = F.lane >> 5, w = F.wave;
    const bf16_t* W1T = (const bf16_t*)(F.ws + (kv ? WS_W1VT : WS_W1KT)) + (size_t)(32 * w + i) * 2048;
    f32x16 acc;
#pragma unroll
    for (int r = 0; r < 16; ++r) acc[r] = 0.f;
    bf16x8 bq[16];
#pragma unroll
    for (int j = 0; j < 16; ++j) bq[j] = *(const bf16x8*)(W1T + 16 * j + 8 * hi);
    for (int kb = 0; kb < 8; ++kb) {
        bf16x8 bn[16];
        const int kn = (kb < 7) ? (kb + 1) * 16 : kb * 16;
#pragma unroll
        for (int j = 0; j < 16; ++j) bn[j] = *(const bf16x8*)(W1T + 16 * (kn + j) + 8 * hi);
#pragma unroll
        for (int j = 0; j < 16; ++j) { const int kk = kb * 16 + j; const int l = kk >> 2, r_ = 16 * i + l, c_ = (2 * j + hi) & 7;
            const bf16x8 a = *(const LAS bf16x8*)(Rs + ((r_ ^ ((r_ >> 7) & 1)) << 7) + ((c_ ^ ((r_ >> 4) & 7)) << 4));
            acc = __builtin_amdgcn_mfma_f32_32x32x16_bf16(a, bq[j], acc, 0, 0, 0); }
#pragma unroll
        for (int j = 0; j < 16; ++j) bq[j] = bn[j];
    }
    const float bpe = ((const float*)(F.ws + WS_BPE))[kv * 256 + 32 * w + i];
#pragma unroll
    for (int r = 0; r < 16; ++r) Hs[crow(r, hi) * HP + 32 * w + i] = (bf16_t)f2bf(gelu_tanh(acc[r] + bpe));
    __syncthreads();
    if (w < 2) {
        const bf16_t* W2T = (const bf16_t*)(F.ws + (kv ? WS_W2VT : WS_W2KT)) + (size_t)(32 * w + i) * 256;
        f32x16 o;
#pragma unroll
        for (int r = 0; r < 16; ++r) o[r] = 0.f;
        for (int kk = 0; kk < 16; ++kk) {
            const bf16x8 a = *(const LAS bf16x8*)(Hs + i * HP + 16 * kk + 8 * hi);
            const bf16x8 bb = *(const bf16x8*)(W2T + 16 * kk + 8 * hi);
            o = __builtin_amdgcn_mfma_f32_32x32x16_bf16(a, bb, o, 0, 0, 0);
        }
        bf16_t* KC = (bf16_t*)(F.ws + (kv ? WS_VC : WS_KC)) + ((size_t)(b * NG + g) * NCP) * 64;
#pragma unroll
        for (int r = 0; r < 16; ++r) { const int n = n0 + crow(r, hi); KC[(size_t)n * 64 + 32 * w + i] = (n < NCMP) ? (bf16_t)f2bf(o[r]) : (bf16_t)0; }
    }
    __syncthreads();
}

constexpr int KPB = 128;
constexpr int NB_K = 64 * KPB;
constexpr int V_H1 = 4096;
constexpr int NB_BUF = NB_K + 8192;
constexpr int A_IMP = 3 * NB_BUF, A_SEL = A_IMP + 64 * 128 * 4, A_UNI = A_SEL + 64 * 8 * 2, A_WSF = A_UNI + 256, A_QF = A_WSF + 8 * 32 * 4, A_Y = A_QF + 8 * 4096, A_GATE = A_Y + 8 * 4096, A_END = A_GATE + 8 * 32 * 3 * 4;
static_assert(A_END <= MISC_OFF, "NSA LDS map");
#ifndef NSA_THR_VAL
#define NSA_THR_VAL 20.0f
#endif
constexpr float NSA_THR = NSA_THR_VAL, NEG_BIG = -1e30f;

#ifdef EMU
__device__ __forceinline__ int opaque_lane(int l) { return l; }
#else
__device__ __forceinline__ int opaque_lane(int) { int x; asm volatile("v_mbcnt_lo_u32_b32 %0, -1, 0\n\tv_mbcnt_hi_u32_b32 %0, -1, %0" : "=v"(x)); return x; }
#endif
#ifdef EMU
__device__ __forceinline__ int red8_add(int v) { v += __shfl_xor(v, 1); v += __shfl_xor(v, 2); v += __shfl_xor(v, 4); return v; }
__device__ __forceinline__ float quad_sum(float v) { v += __shfl_xor(v, 1); v += __shfl_xor(v, 2); return v; }
__device__ __forceinline__ float xor32f(float v) { return __shfl_xor(v, 32); }
#else
__device__ __forceinline__ int red8_add(int v) {
    v += __builtin_amdgcn_update_dpp(0, v, 0xB1, 0xF, 0xF, true);
    v += __builtin_amdgcn_update_dpp(0, v, 0x4E, 0xF, 0xF, true);
    v += __builtin_amdgcn_update_dpp(0, v, 0x141, 0xF, 0xF, true);
    return v;
}
__device__ __forceinline__ float quad_sum(float v) {
    v += __builtin_bit_cast(float, __builtin_amdgcn_update_dpp(0, __builtin_bit_cast(int, v), 0xB1, 0xF, 0xF, true));
    v += __builtin_bit_cast(float, __builtin_amdgcn_update_dpp(0, __builtin_bit_cast(int, v), 0x4E, 0xF, 0xF, true));
    return v;
}
__device__ __forceinline__ float xor32f(float v) {
    const unsigned u = __builtin_bit_cast(unsigned, v); auto rr = __builtin_amdgcn_permlane32_swap(u, u, false, false);
    return __builtin_bit_cast(float, (threadIdx.x & 32) ? rr[0] : rr[1]);
}
#endif

template <bool WITHV>
__device__ __forceinline__ void stage_dma(LAS unsigned char* buf, const bf16_t* Kg, const bf16_t* Vg, size_t pitch, long rbase, int wave, int lane) {
    const int krow = 8 * wave + (lane >> 3), kc = (lane & 7) ^ ((lane >> 3) & 7);
    __builtin_amdgcn_global_load_lds((const unsigned*)(Kg + (size_t)(rbase + krow) * pitch + kc * 8), (LAS unsigned*)(buf + wave * 1024), 16, 0, 0);
    if (WITHV) { const int vrow = 16 * (wave & 3) + (lane >> 2), vc = (wave >> 2) * 4 + (lane & 3);
        __builtin_amdgcn_global_load_lds((const unsigned*)(Vg + (size_t)(rbase + vrow) * pitch + vc * 8), (LAS unsigned*)(buf + NB_K + wave * 1024), 16, 0, 0); }
}
struct BrState { float mref, l; int has; unsigned qxm; f32x16 o0, o1; };
__device__ __forceinline__ unsigned ref_words(float m, float& meff) { const unsigned mh = f2bf(m); const float fh = bf2f((unsigned short)mh); const unsigned ml = f2bf(m - fh); meff = fh + bf2f((unsigned short)ml); return mh | (ml << 16); }

#ifdef EMU
#define VTR(p) __builtin_amdgcn_ds_read_tr16_b64_v4i16(p)
#else
typedef short v4i16_t __attribute__((ext_vector_type(4)));
#define VTR(p) __builtin_bit_cast(s16x4, __builtin_amdgcn_ds_read_tr16_b64_v4i16((LAS v4i16_t*)(p)))
#endif

__device__ __forceinline__ void nsa_qk(const LAS unsigned char* buf, const LAS unsigned char* qfl, unsigned qxs, unsigned qxm_t, unsigned klw0, unsigned klw1, unsigned tbw, unsigned neg1w,
                                       f32x16& p0, f32x16& p1, int lane) {
    const int i = lane & 31, hi = lane >> 5;
    const bf16x8 qx = __builtin_bit_cast(bf16x8, ((u32x4){qxs, qxs, qxm_t, 0u}));
    const bf16x8 kx0 = __builtin_bit_cast(bf16x8, ((u32x4){klw0, tbw, neg1w, 0u})), kx1 = __builtin_bit_cast(bf16x8, ((u32x4){klw1, tbw, neg1w, 0u}));
    const LAS unsigned char* kp = buf + i * KPB;
    {
        const f32x16 zero16 = {0.f, 0.f, 0.f, 0.f, 0.f, 0.f, 0.f, 0.f, 0.f, 0.f, 0.f, 0.f, 0.f, 0.f, 0.f, 0.f};
        p0 = __builtin_amdgcn_mfma_f32_32x32x16_bf16(kx0, qx, zero16, 0, 0, 0);
        p1 = __builtin_amdgcn_mfma_f32_32x32x16_bf16(kx1, qx, zero16, 0, 0, 0);
    }
#pragma unroll
    for (int d0 = 0; d0 < 4; ++d0) {
        const int ko = ((2 * d0 + hi) ^ (i & 7)) << 4;
        const bf16x8 k0 = *(const LAS bf16x8*)(kp + ko), k1 = *(const LAS bf16x8*)(kp + 32 * KPB + ko);
        const bf16x8 qd = *(const LAS bf16x8*)(qfl + d0 * 1024);
        p0 = __builtin_amdgcn_mfma_f32_32x32x16_bf16(k0, qd, p0, 0, 0, 0);
        p1 = __builtin_amdgcn_mfma_f32_32x32x16_bf16(k1, qd, p1, 0, 0, 0);
    }
}
template <bool PV, bool TRACK>
__device__ __forceinline__ void nsa_prep(int mode, int lim, BrState& st, f32x16& p0, f32x16& p1, int lane, LAS float* wsf) {
#ifndef EMU
    asm volatile("" : "+v"(lim));
#endif
    const int i = lane & 31, hi = lane >> 5;
    if (__builtin_amdgcn_readfirstlane(mode) != 0) {
        NOSPEC();
        const int lim2 = lim - 4 * hi; const bool inv = (mode == 2);
#pragma unroll
        for (int r = 0; r < 16; ++r) { const int c0 = (r & 3) + 8 * (r >> 2);
            const bool v0 = (c0 <= lim2) != inv, v1 = (c0 + 32 <= lim2) != inv;
            p0[r] = v0 ? p0[r] : -INFINITY; p1[r] = v1 ? p1[r] : -INFINITY; }
    }
    if (TRACK) {
        float mxa = fmaxf(p0[0], p1[0]), mxb = fmaxf(p0[1], p1[1]);
#pragma unroll
        for (int r = 2; r < 16; r += 2) { mxa = fmaxf(fmaxf(mxa, p0[r]), p1[r]); mxb = fmaxf(fmaxf(mxb, p0[r + 1]), p1[r + 1]); }
        float mx = fmaxf(mxa, mxb);
        mx = fmaxf(mx, xor32f(mx));
        const bool upd = (mx > (st.has ? NSA_THR : NEG_BIG)) && (mx > NEG_BIG);
        if (__any(upd)) {
            NOSPEC();
            float meff; const unsigned w = ref_words(st.mref + mx, meff);
            const float de = upd ? (meff - st.mref) : 0.f;
            const float f = (upd && st.has) ? fexp2(-de) : 1.0f;
#pragma unroll
            for (int r = 0; r < 16; ++r) { p0[r] -= de; p1[r] -= de; }
            st.l *= f;
            if (PV) {
                wsf[i] = f; WAVE_SYNC(); FENCE();
                const LAS float* wr_ = wsf + 4 * hi;
#pragma unroll
                for (int r = 0; r < 16; ++r) { const float a = wr_[(r & 3) + 8 * (r >> 2)]; st.o0[r] *= a; st.o1[r] *= a; }
                WAVE_SYNC(); FENCE();
            }
            if (upd) { st.mref = meff; st.qxm = hi ? 0u : w; st.has = 1; }
        }
    }
}
template <bool PV>
__device__ __forceinline__ void nsa_softmax_pv(const LAS unsigned char* buf, BrState& st, f32x16& p0, f32x16& p1, int lane) {
    const int hi = lane >> 5;
    float rs = 0.f;
#pragma unroll
    for (int r = 0; r < 16; ++r) { p0[r] = fexp2(p0[r]); p1[r] = fexp2(p1[r]); rs += p0[r] + p1[r]; }
    st.l += rs;
    if (PV) {
        const LAS unsigned char* vb = buf + NB_K + (4 * hi + ((lane & 15) >> 2)) * 64 + 32 * ((lane >> 4) & 1) + 8 * (lane & 3);
#pragma unroll
        for (int ks = 0; ks < 4; ++ks) {
            const f32x16& p = (ks < 2) ? p0 : p1; const int s = ks & 1;
            u32x4 pw; pw.x = pk2(p[8 * s + 0], p[8 * s + 1]); pw.y = pk2(p[8 * s + 2], p[8 * s + 3]); pw.z = pk2(p[8 * s + 4], p[8 * s + 5]); pw.w = pk2(p[8 * s + 6], p[8 * s + 7]);
            const bf16x8 pa = __builtin_bit_cast(bf16x8, pw);
#pragma unroll
            for (int d0 = 0; d0 < 2; ++d0) {
                const s16x4 lo = VTR(vb + d0 * V_H1 + ks * 1024), hh = VTR(vb + d0 * V_H1 + ks * 1024 + 512);
                const bf16x8 vf = (bf16x8){lo[0], lo[1], lo[2], lo[3], hh[0], hh[1], hh[2], hh[3]};
                if (d0 == 0) st.o0 = __builtin_amdgcn_mfma_f32_32x32x16_bf16(pa, vf, st.o0, 0, 0, 0);
                else         st.o1 = __builtin_amdgcn_mfma_f32_32x32x16_bf16(pa, vf, st.o1, 0, 0, 0);
            }
        }
    }
}

struct ImpSums { float G0[4], S0[4], G1[4], S1[4]; };
template <bool PRODUCE, bool IMP>
__device__ __forceinline__ void nsa_exp_qk(const LAS unsigned char* nbuf, const LAS unsigned char* qfl, unsigned qxs, unsigned qxm_t, unsigned klw0, unsigned klw1, unsigned tbw, unsigned neg1w,
                                           f32x16& n0, f32x16& n1, BrState& st, f32x16& p0, f32x16& p1, u32x4 (&pw)[4], ImpSums& im, int lane) {
    const int i = lane & 31, hi = lane >> 5;
    const LAS unsigned char* kp = nbuf + i * KPB;
    if (PRODUCE) {
        const bf16x8 qx = __builtin_bit_cast(bf16x8, ((u32x4){qxs, qxs, qxm_t, 0u}));
        const bf16x8 kx0 = __builtin_bit_cast(bf16x8, ((u32x4){klw0, tbw, neg1w, 0u})), kx1 = __builtin_bit_cast(bf16x8, ((u32x4){klw1, tbw, neg1w, 0u}));
        const f32x16 zero16 = {0.f, 0.f, 0.f, 0.f, 0.f, 0.f, 0.f, 0.f, 0.f, 0.f, 0.f, 0.f, 0.f, 0.f, 0.f, 0.f};
        n0 = __builtin_amdgcn_mfma_f32_32x32x16_bf16(kx0, qx, zero16, 0, 0, 0);
        n1 = __builtin_amdgcn_mfma_f32_32x32x16_bf16(kx1, qx, zero16, 0, 0, 0);
    }
    float rs = 0.f;
#pragma unroll
    for (int d0 = 0; d0 < 4; ++d0) {
        if (PRODUCE) {
            const int ko = ((2 * d0 + hi) ^ (i & 7)) << 4;
            const bf16x8 k0 = *(const LAS bf16x8*)(kp + ko), k1 = *(const LAS bf16x8*)(kp + 32 * KPB + ko);
            const bf16x8 qd = *(const LAS bf16x8*)(qfl + d0 * 1024);
            n0 = __builtin_amdgcn_mfma_f32_32x32x16_bf16(k0, qd, n0, 0, 0, 0);
            n1 = __builtin_amdgcn_mfma_f32_32x32x16_bf16(k1, qd, n1, 0, 0, 0);
        }
        const float a0 = fexp2(p0[4 * d0]), a1 = fexp2(p0[4 * d0 + 1]), a2 = fexp2(p0[4 * d0 + 2]), a3 = fexp2(p0[4 * d0 + 3]);
        const float b0 = fexp2(p1[4 * d0]), b1 = fexp2(p1[4 * d0 + 1]), b2 = fexp2(p1[4 * d0 + 2]), b3 = fexp2(p1[4 * d0 + 3]);
        const float ga = (a0 + a1) + (a2 + a3), gb = (b0 + b1) + (b2 + b3);
        rs += ga + gb;
        if (IMP) { im.G0[d0] = ga; im.S0[d0] = a3; im.G1[d0] = gb; im.S1[d0] = b3; }
        const unsigned w0 = pk2(a0, a1), w1 = pk2(a2, a3), v0 = pk2(b0, b1), v1 = pk2(b2, b3);
        if ((d0 & 1) == 0) { pw[d0 >> 1].x = w0; pw[d0 >> 1].y = w1; pw[2 + (d0 >> 1)].x = v0; pw[2 + (d0 >> 1)].y = v1; }
        else               { pw[d0 >> 1].z = w0; pw[d0 >> 1].w = w1; pw[2 + (d0 >> 1)].z = v0; pw[2 + (d0 >> 1)].w = v1; }
        __builtin_amdgcn_sched_barrier(0);
    }
    st.l += rs;
}
template <bool PV>
__device__ __forceinline__ void nsa_pv(const LAS unsigned char* buf, BrState& st, const u32x4 (&pw)[4], int lane) {
    if (!PV) return;
    const int hi = lane >> 5;
    const LAS unsigned char* vb = buf + NB_K + (4 * hi + ((lane & 15) >> 2)) * 64 + 32 * ((lane >> 4) & 1) + 8 * (lane & 3);
#pragma unroll
    for (int ks = 0; ks < 4; ++ks) {
        const bf16x8 pa = __builtin_bit_cast(bf16x8, pw[ks]);
#pragma unroll
        for (int d0 = 0; d0 < 2; ++d0) {
            const s16x4 lo = VTR(vb + d0 * V_H1 + ks * 1024), hh = VTR(vb + d0 * V_H1 + ks * 1024 + 512);
            const bf16x8 vf = (bf16x8){lo[0], lo[1], lo[2], lo[3], hh[0], hh[1], hh[2], hh[3]};
            if (d0 == 0) st.o0 = __builtin_amdgcn_mfma_f32_32x32x16_bf16(pa, vf, st.o0, 0, 0, 0);
            else         st.o1 = __builtin_amdgcn_mfma_f32_32x32x16_bf16(pa, vf, st.o1, 0, 0, 0);
        }
        __builtin_amdgcn_sched_barrier(0);
    }
}

__device__ __forceinline__ int bit128(const LAS unsigned* m, int j) { return (int)((m[j >> 5] >> (j & 31)) & 1u); }
__device__ __forceinline__ int next_below(const LAS unsigned* m, int j) { for (int k = j - 1; k >= 0; --k) if ((m[k >> 5] >> (k & 31)) & 1u) return k; return -1; }

struct NsaCtx {
    int qt, g, t, tloc, qloc, head, w, lane; const bf16_t* Zb;
    LAS unsigned char* lds; LAS float* imp; LAS float* wsf;
};
__device__ __forceinline__ void nsa_importance(const NsaCtx& C, const ImpSums& im, int cur) {
    const int i = C.lane & 31, hi = C.lane >> 5;
    float G0[4], G1[4], S0[4], S1[4];
#pragma unroll
    for (int k = 0; k < 4; ++k) { G0[k] = quad_sum(im.G0[k]); G1[k] = quad_sum(im.G1[k]); S0[k] = quad_sum(im.S0[k]); S1[k] = quad_sum(im.S1[k]); }
    float P0[4], P1[4];
#pragma unroll
    for (int k = 0; k < 4; ++k) { P0[k] = xor32f(S0[k]); P1[k] = xor32f(S1[k]); }
    if ((i & 3) == 0) {
        LAS float* row = C.imp + C.qloc * 128 + 16 * cur + hi;
#pragma unroll
        for (int k = 0; k < 4; ++k) {
            const float prev0 = hi ? P0[k] : (k == 0 ? 0.f : P0[k - 1]);
            const float prev1 = hi ? P1[k] : (k == 0 ? P0[3] : P1[k - 1]);
            row[2 * k] = G0[k] + prev0;
            row[8 + 2 * k] = G1[k] + prev1;
        }
        if (hi == 1 && 16 * (cur + 1) < 128) row[15] += S1[3];
    }
}
template <int KIND, int PRE>
__device__ __forceinline__ void nsa_branch(Frame& F, const NsaCtx& C, const LAS unsigned char* qf, const bf16_t* Kg, const bf16_t* Vg, size_t pitch,
                                           int first, int lo, const LAS unsigned* um, const LAS unsigned* wm, const LAS unsigned* qm, int cfull, int climit, BrState& st) {
    constexpr bool PV = (KIND != 1), TRACK = (KIND != 2), CMP = (KIND == 1 || KIND == 2);
    const int lane = C.lane, w = C.w, qt = C.qt;
    const int ln_ = opaque_lane(lane), hi_ = ln_ >> 5, i_ = ln_ & 31;
    unsigned qxs; { const float s2_ = fexp2(-(float)(4 * C.g + (i_ & 3) + 1)) * LOG2E; const unsigned sh_ = f2bf(s2_); const unsigned sl_ = f2bf(s2_ - bf2f((unsigned short)sh_)); qxs = hi_ ? 0u : (sh_ | (sl_ << 16)); }
    const unsigned neg1w = hi_ ? 0u : 0xBF80BF80u; const unsigned maskw = hi_ ? 0u : 0x00007E96u;
    const unsigned klw0 = hi_ ? 0u : (f2bf((float)(CMP ? 16 * i_ : i_)) * 0x10001u), klw1 = hi_ ? 0u : (f2bf((float)(CMP ? 16 * (i_ + 32) : (i_ + 32))) * 0x10001u);
#define SEQ_NEXT(c) ((c) < 0 ? -1 : (KIND == 3 ? next_below(um, (c)) : (((c) - 1 >= lo) ? (c) - 1 : -1)))
#define TILE_NEED(c) (KIND == 3 ? bit128(wm, (c)) : 1)
#define TILE_MODE(c) (KIND == 0 ? (((c) == qt) ? 1 : (((c) == qt - 8) ? 2 : 0)) : (CMP ? ((64 * (c) + 63 <= cfull) ? 0 : 1) : (((c) == qt) ? 1 : 0)))
#define TILE_LIM(c) (CMP ? (climit - 64 * (c)) : C.tloc)
#define TILE_TBW(c) (hi_ ? 0u : (f2bf((float)((CMP ? 1024 : 64) * (c))) * 0x10001u))
#define TILE_QXM(c) ((KIND == 3) ? (bit128(qm, (c)) ? st.qxm : maskw) : st.qxm)
#define SLOT(s) (C.lds + (s) * NB_BUF)
    f32x16 pA0, pA1, pB0, pB1;
    int c0 = first, c1 = SEQ_NEXT(c0), c2 = SEQ_NEXT(c1), s0 = 0;
    if (PRE == 0) { __syncthreads();
        stage_dma<PV>(SLOT(0), Kg, Vg, pitch, 64L * c0, w, lane); }
    if (PRE < 2 && c1 >= 0) stage_dma<PV>(SLOT(1), Kg, Vg, pitch, 64L * c1, w, lane);
    __syncthreads();
    if (TILE_NEED(c0)) nsa_qk(SLOT(0), qf, qxs, TILE_QXM(c0), klw0, klw1, TILE_TBW(c0), neg1w, pA0, pA1, lane);
#define NSA_STEP(P0, P1, N0, N1) do { \
        const int s1_ = (s0 == 2) ? 0 : s0 + 1, s2_ = (s1_ == 2) ? 0 : s1_ + 1; \
        if (c2 >= 0) stage_dma<PV>(SLOT(s2_), Kg, Vg, pitch, 64L * c2, w, lane); \
        const bool need0_ = TILE_NEED(c0) != 0; const int cn_ = (c1 >= 0) ? c1 : c0;     \
        if (need0_) { \
            u32x4 pw_[4]; ImpSums im_; \
            nsa_prep<PV, TRACK>(TILE_MODE(c0), TILE_LIM(c0), st, P0, P1, lane, C.wsf); \
            __builtin_amdgcn_sched_barrier(0); \
            nsa_exp_qk<true, KIND == 2>(SLOT(s1_), qf, qxs, TILE_QXM(cn_), klw0, klw1, TILE_TBW(cn_), neg1w, N0, N1, st, P0, P1, pw_, im_, lane); \
            nsa_pv<PV>(SLOT(s0), st, pw_, lane); \
            if (KIND == 2) nsa_importance(C, im_, c0); \
        } else nsa_qk(SLOT(s1_), qf, qxs, TILE_QXM(cn_), klw0, klw1, TILE_TBW(cn_), neg1w, N0, N1, lane); \
        __syncthreads(); \
        c0 = c1; c1 = c2; c2 = SEQ_NEXT(c2); s0 = s1_; } while (0)
    for (;;) {
        NSA_STEP(pA0, pA1, pB0, pB1); if (c0 < 0) break;
        NSA_STEP(pB0, pB1, pA0, pA1); if (c0 < 0) break;
    }
#undef NSA_STEP
#undef SEQ_NEXT
#undef TILE_NEED
#undef TILE_MODE
#undef TILE_LIM
#undef TILE_TBW
#undef TILE_QXM
#undef SLOT
}
#if !defined(EMU)
#define SUBT_BEGIN() unsigned long long st_t0_ = 0; if (PROBE_K >= 20 && blockIdx.x == 0 && F.tid == 0) st_t0_ = __builtin_amdgcn_s_memrealtime()
#define SUBT_END(i) do { if (PROBE_K >= 20 && blockIdx.x == 0 && F.tid == 0) { const unsigned long long t1_ = __builtin_amdgcn_s_memrealtime(); F.MISC[300 + (i)] += (unsigned)(t1_ - st_t0_); st_t0_ = t1_; } } while (0)
#else
#define SUBT_BEGIN() ((void)0)
#define SUBT_END(i) ((void)0)
#endif
__device__ __forceinline__ void nsa_task(Frame& F, int task) {
    constexpr int NQT = SEQ / 64;
    const int qt = task % NQT, g = (task / NQT) % NG, b = task / (NQT * NG);
    const int t0 = 64 * qt, w = F.wave;
    const bf16_t* Zb = (const bf16_t*)(F.ws + WS_ZB) + (size_t)b * SEQ * ZP;
    LAS float* imp = (LAS float*)(F.lds + A_IMP);
    LAS unsigned short* selm = (LAS unsigned short*)(F.lds + A_SEL);
    LAS unsigned* uniw = (LAS unsigned*)(F.lds + A_UNI);
#define SECTION_LANE() const int lane = opaque_lane(F.lane), i = lane & 31, hi = lane >> 5, ql = i >> 2, qloc = 8 * w + ql, t = t0 + qloc, head = 4 * g + (i & 3); \
        LAS float* wsf = (LAS float*)(F.lds + A_WSF) + w * 32; LAS unsigned char* qf = F.lds + A_QF + w * 4096 + lane * 16; \
        NsaCtx C; C.qt = qt; C.g = g; C.t = t; C.tloc = qloc; C.qloc = qloc; C.head = head; C.w = w; C.lane = lane; C.Zb = Zb; C.lds = F.lds; C.imp = imp; C.wsf = wsf; \
        LAS unsigned* ya = (LAS unsigned*)(F.lds + A_Y) + w * 1024 + hi * 128 + i; (void)ya; (void)head; (void)t
    const LAS unsigned* zz = (const LAS unsigned*)(F.lds + A_UNI);
#define INIT_ST(st) do { st.mref = 0.f; st.l = 0.f; st.has = 0; st.qxm = 0u; _Pragma("unroll") for (int r = 0; r < 16; ++r) { st.o0[r] = 0.f; st.o1[r] = 0.f; } } while (0)
#define ACC_PREP(st, gidx) float f_ = st.l + xor32f(st.l); { const float gate_ = ((const LAS float*)(F.lds + A_GATE))[w * 96 + i * 3 + gidx]; f_ = (f_ > 0.f) ? gate_ * __builtin_amdgcn_rcpf(f_) : 0.f; }     \
        wsf[i] = f_; WAVE_SYNC(); FENCE(); const LAS float* wr_ = wsf + 4 * hi;
    const bf16_t* KCg = (const bf16_t*)(F.ws + WS_KC) + (size_t)(b * NG + g) * NCP * 64;
    const bf16_t* VCg = (const bf16_t*)(F.ws + WS_VC) + (size_t)(b * NG + g) * NCP * 64;
    const int nct = (t0 + 63 >= 31) ? (((t0 + 63 - 31) >> 4) / 64 + 1) : 0;
#define NSA_PRELOAD_CMP(WV) do { if (nct > 0) { stage_dma<WV>(F.lds, KCg, VCg, 64, 64L * (nct - 1), w, lane); if (nct > 1) stage_dma<WV>(F.lds + NB_BUF, KCg, VCg, 64, 64L * (nct - 2), w, lane); } } while (0)
    bool sel_pre = false;
    SUBT_BEGIN();
    {
        SECTION_LANE();
        __syncthreads();
        stage_dma<true>(F.lds, Zb + ZC_KW + g * 64, Zb + ZC_VW + g * 64, ZP, 64L * qt, w, lane);
        if (qt - 1 >= ((qt - 8 > 0) ? qt - 8 : 0)) stage_dma<true>(F.lds + NB_BUF, Zb + ZC_KW + g * 64, Zb + ZC_VW + g * 64, ZP, 64L * (qt - 1), w, lane);
        for (int idx = F.tid; idx < 64 * 128; idx += NTHREADS) imp[idx] = 0.f;
#pragma unroll
        for (int d0 = 0; d0 < 4; ++d0) { const u32x4 raw = *(const u32x4*)(Zb + (size_t)t * ZP + ZC_Q + head * 64 + 16 * d0 + 8 * hi);
            const float sc = 0.125f * LOG2E; u32x4 o;
            o.x = pk2(bflo(raw.x) * sc, bfhi(raw.x) * sc); o.y = pk2(bflo(raw.y) * sc, bfhi(raw.y) * sc); o.z = pk2(bflo(raw.z) * sc, bfhi(raw.z) * sc); o.w = pk2(bflo(raw.w) * sc, bfhi(raw.w) * sc);
            *(LAS u32x4*)(qf + d0 * 1024) = o; }
        if (hi == 0) {
#pragma unroll
            for (int k = 0; k < 3; ++k) ((LAS float*)(F.lds + A_GATE))[w * 96 + i * 3 + k] = sigmoidf_(bf2f(Zb[(size_t)t * ZP + ZC_GL + head * 3 + k]));
        }
    }
    {
        SECTION_LANE();
        BrState st; INIT_ST(st);
        nsa_branch<0, 2>(F, C, qf, Zb + ZC_KW + g * 64, Zb + ZC_VW + g * 64, ZP, qt, (qt - 8 > 0) ? qt - 8 : 0, zz, zz, zz, 0, 0, st);
        NSA_PRELOAD_CMP(false);
        ACC_PREP(st, 2)
#pragma unroll
        for (int r = 0; r < 16; ++r) { const int c_ = (r & 3) + 8 * (r >> 2); const float a_ = wr_[c_]; ya[c_ * 32] = pk2(a_ * st.o0[r], a_ * st.o1[r]); }
        WAVE_SYNC(); FENCE();
    }
    SUBT_END(1);
    {
        SECTION_LANE();
        const bf16_t* Kg = KCg; const bf16_t* Vg = VCg;
        const int cfull = (t0 >= 31) ? ((t0 - 31) >> 4) : -1;
        const int climit = (t >= 31) ? ((t - 31) >> 4) : -1;
        if (nct > 0) {
            BrState st; INIT_ST(st);
            nsa_branch<1, 2>(F, C, qf, Kg, Vg, 64, nct - 1, 0, zz, zz, zz, cfull, climit, st);
            NSA_PRELOAD_CMP(true);
            SUBT_END(2);
            const float ltot = st.l + xor32f(st.l);
            float meff; const unsigned wfin = ref_words(st.mref + ((ltot > 0.f) ? __builtin_log2f(ltot) : 0.f), meff);
            BrState s2; INIT_ST(s2); s2.qxm = hi ? 0u : wfin;
            nsa_branch<2, 2>(F, C, qf, Kg, Vg, 64, nct - 1, 0, zz, zz, zz, cfull, climit, s2);
            stage_dma<true>(F.lds, Zb + ZC_KS + g * 64, Zb + ZC_VS + g * 64, ZP, 64L * qt, w, lane);
            sel_pre = true;
            s2.l = 0.5f;
            ACC_PREP(s2, 0)
#pragma unroll
            for (int r = 0; r < 16; ++r) { const int c_ = (r & 3) + 8 * (r >> 2); const float a_ = wr_[c_]; const unsigned y_ = ya[c_ * 32]; ya[c_ * 32] = pk2(bflo(y_) + a_ * s2.o0[r], bfhi(y_) + a_ * s2.o1[r]); }
            WAVE_SYNC(); FENCE();
        }
    }
    if (!sel_pre) stage_dma<true>(F.lds, Zb + ZC_KS + g * 64, Zb + ZC_VS + g * 64, ZP, 64L * qt, w, F.lane);
    __syncthreads();
    SUBT_END(3);
    {
        const int lane = opaque_lane(F.lane);
        const int q8 = lane >> 3, sub = lane & 7, qq = 8 * w + q8;
        unsigned key[16];
#pragma unroll
        for (int e = 0; e < 16; ++e) { const int j = 16 * sub + e; const bool valid = (j <= qt) && (j < NBLK);
            unsigned kk = valid ? (__builtin_bit_cast(unsigned, imp[qq * 128 + j]) + 1u) : 0u;
            if (valid && (j == 0 || j == qt || j == qt - 1)) kk = 0x7F000000u;
            key[e] = kk; }
        unsigned thr = 0u;
        for (int bit = 30; bit >= 0; --bit) { const unsigned cand = thr | (1u << bit); int c = 0;
#pragma unroll
            for (int e = 0; e < 16; ++e) c += (key[e] >= cand) ? 1 : 0;
            c = red8_add(c);
            if (c >= NSEL) thr = cand; }
        int ngt = 0, tl = 0;
#pragma unroll
        for (int e = 0; e < 16; ++e) { ngt += (key[e] > thr) ? 1 : 0; tl += (key[e] == thr) ? 1 : 0; }
        ngt = red8_add(ngt);
        int sc = tl;
#pragma unroll
        for (int d = 1; d < 8; d <<= 1) { const int o = __shfl(sc, (lane - d) & 63); if (sub >= d) sc += o; }
        int before = sc - tl; const int need = (thr == 0u) ? 0 : (NSEL - ngt);
        unsigned m16 = 0u;
#pragma unroll
        for (int e = 0; e < 16; ++e) { if (key[e] > thr) m16 |= 1u << e; else if (key[e] == thr) { if (before < need) m16 |= 1u << e; ++before; } }
        selm[qq * 8 + sub] = (unsigned short)m16;
        unsigned um = m16; um |= __shfl_xor(um, 8); um |= __shfl_xor(um, 16); um |= __shfl_xor(um, 32);
        if (q8 == 0) ((LAS unsigned short*)uniw)[w * 8 + sub] = (unsigned short)um;
    }
    __syncthreads();
    SUBT_END(4);
    {
        SECTION_LANE();
        BrState st; INIT_ST(st);
        if (F.tid < 4) { unsigned u = 0u; for (int ww = 0; ww < 8; ++ww) u |= uniw[ww * 4 + F.tid]; uniw[32 + F.tid] = u; }
        __syncthreads();
        const LAS unsigned* um = uniw + 32; const LAS unsigned* wm = uniw + w * 4; const LAS unsigned* qm = (const LAS unsigned*)selm + qloc * 4;
        nsa_branch<3, 1>(F, C, qf, Zb + ZC_KS + g * 64, Zb + ZC_VS + g * 64, ZP, qt, 0, um, wm, qm, 0, 0, st);
        ACC_PREP(st, 1)
        bf16_t* ym = (bf16_t*)(F.ws + WS_YMIX) + ((size_t)b * SEQ + t0 + 8 * w + hi) * DM + 512 + 4 * g * 64 + i;
#pragma unroll
        for (int r = 0; r < 16; ++r) { const int c_ = (r & 3) + 8 * (r >> 2); const float a_ = wr_[c_]; const unsigned y_ = ya[c_ * 32]; bf16_t* op = ym + (c_ >> 2) * DM + (c_ & 3) * 64;
            const unsigned o_ = pk2(bflo(y_) + a_ * st.o0[r], bfhi(y_) + a_ * st.o1[r]); op[0] = (bf16_t)(o_ & 0xffffu); op[32] = (bf16_t)(o_ >> 16); }
        WAVE_SYNC(); FENCE();
    }
    SUBT_END(5);
#undef ACC_PREP
#undef INIT_ST
#undef SECTION_LANE
#undef NSA_PRELOAD_CMP
}

__device__ __forceinline__ void argmax16(float& v, int& idx) {
#ifdef EMU
    for (int o = 1; o < 16; o <<= 1) { const float ov = __shfl_xor(v, o); const int oi = __shfl_xor(idx, o); if (ov > v || (ov == v && oi < idx)) { v = ov; idx = oi; } }
#else
#define AM_STEP(ctrl) do { const float ov = __builtin_bit_cast(float, __builtin_amdgcn_update_dpp(0, __builtin_bit_cast(int, v), ctrl, 0xF, 0xF, true)); \
        const int oi = __builtin_amdgcn_update_dpp(0, idx, ctrl, 0xF, 0xF, true); if (ov > v || (ov == v && oi < idx)) { v = ov; idx = oi; } } while (0)
    AM_STEP(0xB1); AM_STEP(0x4E); AM_STEP(0x141); AM_STEP(0x140);
#undef AM_STEP
#endif
}
__device__ __forceinline__ void router_rows_load(const Frame& F, int task, u32x2 (&mw)[4][4]) {
    const bf16_t* X1 = (const bf16_t*)(F.ws + WS_MIX);
    const int lane = opaque_lane(F.lane);
#pragma unroll
    for (int rr = 0; rr < 4; ++rr) { const u32x2* mr = (const u32x2*)(X1 + (size_t)(32 * task + 4 * F.wave + rr) * DM) + lane;
#pragma unroll
        for (int j = 0; j < 4; ++j) mw[rr][j] = mr[64 * j]; }
}
template <bool SHADOW>
__device__ __forceinline__ void router_task(Frame& F, int task, int next_task, u32x2 (&mw)[4][4]) {
    const int row0 = 32 * task;
    const int lane = opaque_lane(F.lane);
    SUBT_BEGIN();
    LAS float* Hs = (LAS float*)F.lds;
    const float* mod = (const float*)(F.ws + WS_MOD);
    unsigned char* H2 = (unsigned char*)(F.ws + WS_H2);
    const float* g = F.in[I_GFFN];
    f32x4 ftv[8];
    {
        const int b = row0 / SEQ;
        const float* mb = mod + (size_t)b * 6144;
        f32x4 gs[4], sh[4];
#pragma unroll
        for (int j = 0; j < 4; ++j) { const int c = 4 * lane + 256 * j; gs[j] = *(const f32x4*)(g + c) * (*(const f32x4*)(mb + 4 * 1024 + c) + 1.0f); sh[j] = *(const f32x4*)(mb + 3 * 1024 + c); }
        f32x4 v[4][4];
        const int q4 = lane >> 4;
#pragma unroll
        for (int rr = 0; rr < 4; ++rr) {
#pragma unroll
            for (int j = 0; j < 4; ++j) v[rr][j] = (f32x4){bflo(mw[rr][j].x), bfhi(mw[rr][j].x), bflo(mw[rr][j].y), bfhi(mw[rr][j].y)};
            const int lr = 4 * F.wave + rr, m = row0 + lr, ls = (lr + q4) & 31;
            float s = 0.f;
#pragma unroll
            for (int j = 0; j < 4; ++j) s += (v[rr][j][0] * v[rr][j][0] + v[rr][j][1] * v[rr][j][1]) + (v[rr][j][2] * v[rr][j][2] + v[rr][j][3] * v[rr][j][3]);
            const float rinv = __builtin_amdgcn_rsqf(wave_sum(s) * (1.0f / DM) + EPS);
            unsigned* o4 = (unsigned*)(H2 + (size_t)m * DM) + lane;
#pragma unroll
            for (int j = 0; j < 4; ++j) { const int c = 4 * lane + 256 * j;
                const f32x4 h = v[rr][j] * rinv * gs[j] + sh[j];
                o4[64 * j] = pk4_fp8(h[0] * F8_ACT_SCALE, h[1] * F8_ACT_SCALE, h[2] * F8_ACT_SCALE, h[3] * F8_ACT_SCALE);
#pragma unroll
                for (int e = 0; e < 4; ++e) Hs[(c + e) * 33 + ls] = h[e]; }
            __builtin_amdgcn_sched_barrier(0);
        }
    }
    const int i = lane & 31, hi = lane >> 5;
    const f32x4* wrp = (const f32x4*)((const float*)(F.ws + WS_WRT) + (size_t)i * DM + 128 * F.wave + 64 * hi);
    __builtin_amdgcn_sched_barrier(0);
    if (P6_FILL_PER_WAVE && !SHADOW) { gu_issue(F, NE * P0_I_GU1 - P6_FILL + (task * NWAVES + F.wave) * P6_FILL_PER_WAVE, ftv); __builtin_amdgcn_sched_barrier(0); }
    f32x4 wq[8];
#pragma unroll
    for (int m = 0; m < 8; ++m) wq[m] = wrp[m];
    SUBT_END(6);
    __syncthreads();
    SUBT_END(7);
    f32x16 acc;
#pragma unroll
    for (int r = 0; r < 16; ++r) acc[r] = 0.f;
    const LAS float* hp = Hs + (128 * F.wave + 64 * hi) * 33 + ((i + ((2 * F.wave + hi) & 3)) & 31);
    f32x4 wq2[8];
#pragma unroll
    for (int m = 0; m < 8; ++m) wq2[m] = wrp[8 + m];
    __builtin_amdgcn_sched_barrier(0);
#pragma unroll
    for (int q8 = 0; q8 < 4; ++q8) {
#pragma unroll
        for (int ks = 8 * q8; ks < 8 * q8 + 8; ++ks) acc = __builtin_amdgcn_mfma_f32_32x32x2f32(hp[ks * 33], wq[ks >> 2][ks & 3], acc, 0, 0, 0);
        __builtin_amdgcn_sched_barrier(0);
    }
    if (next_task >= 0) { router_rows_load(F, next_task, mw); __builtin_amdgcn_sched_barrier(0); }
#pragma unroll
    for (int q8 = 0; q8 < 4; ++q8) {
#pragma unroll
        for (int ks = 8 * q8; ks < 8 * q8 + 8; ++ks) acc = __builtin_amdgcn_mfma_f32_32x32x2f32(hp[(32 + ks) * 33], wq2[ks >> 2][ks & 3], acc, 0, 0, 0);
        __builtin_amdgcn_sched_barrier(0);
    }
    __syncthreads();
    SUBT_END(8);
    LAS float* Ls = (LAS float*)F.lds;
    LAS float* Lg = Ls + 8 * 1024;
    LAS unsigned* hist = (LAS unsigned*)(Lg + 32 * 33);
#pragma unroll
    for (int r = 0; r < 16; ++r) Ls[F.wave * 1024 + crow(r, hi) * 32 + i] = acc[r];
    if (F.tid < 64) hist[F.tid] = 0u;
    if (P6_FILL_PER_WAVE && !SHADOW) gu_finish(F, (LAS float*)(F.lds + 40960 + F.wave * 8704), NE * P0_I_GU1 - P6_FILL + (task * NWAVES + F.wave) * P6_FILL_PER_WAVE, ftv);
    __syncthreads();
    const int tk = F.tid >> 4, sub = F.tid & 15;
    float l0 = F.in[I_BR][sub], l1 = F.in[I_BR][sub + 16];
#pragma unroll
    for (int w = 0; w < 8; ++w) { l0 += Ls[w * 1024 + tk * 32 + sub]; l1 += Ls[w * 1024 + tk * 32 + sub + 16]; }
    int be[4]; float bv[4];
#pragma unroll
    for (int k = 0; k < 4; ++k) { float v; int id;
        if (l0 >= l1) { v = l0; id = sub; } else { v = l1; id = sub + 16; }
        argmax16(v, id);
        be[k] = id; bv[k] = v;
        if (id == sub) l0 = -INFINITY;
        if (id == sub + 16) l1 = -INFINITY; }
    unsigned rank[4] = {0u, 0u, 0u, 0u};
    {
        float sum = 0.f; const float mx0 = bv[0];
#pragma unroll
        for (int k = 0; k < 4; ++k) { bv[k] = fexp2((bv[k] - mx0) * LOG2E); sum += bv[k]; }
        const float rs = 1.0f / sum;
#pragma unroll
        for (int k = 0; k < 4; ++k) bv[k] *= rs;
    }
    if (sub == 0) {
#pragma unroll
        for (int k = 0; k < 4; ++k) rank[k] = atomicAdd((unsigned*)&hist[be[k]], 1u);
    }
    __syncthreads();
    if (F.tid < 32) { const unsigned c = hist[F.tid]; hist[32 + F.tid] = c ? atomicAdd(F.ctl + (SHADOW ? CW_CNT2 : CW_CNT) + 64 * F.tid, c) : 0u; }
    __syncthreads();
    if (sub == 0) {
        const int tok = row0 + tk;
        const size_t sh_ = SHADOW ? WS_SHADOW : 0;
        int* lists = (int*)(F.ws + sh_ + WS_LISTS); int* tope = (int*)(F.ws + sh_ + WS_TOPE); float* topw = (float*)(F.ws + sh_ + WS_TOPW); int* topp = (int*)(F.ws + sh_ + WS_TOPP);
#pragma unroll
        for (int k = 0; k < 4; ++k) { const int pos = (int)(hist[32 + be[k]] + rank[k]);
            lists[(size_t)be[k] * T + pos] = tok; tope[tok * 4 + k] = be[k]; topw[tok * 4 + k] = bv[k]; topp[tok * 4 + k] = pos; }
    }
    __syncthreads();
    SUBT_END(9);
}

__device__ __forceinline__ void moe_tables(Frame& F) {
    if (F.tid < 64) {
        const int e = F.lane & 31;
        const unsigned c = __hip_atomic_load(F.ctl + CW_CNT + 64 * e, __ATOMIC_RELAXED, __HIP_MEMORY_SCOPE_AGENT);
        const unsigned tl = (c + 255u) / 256u;
        unsigned incl = tl;
#pragma unroll
        for (int d = 1; d < 32; d <<= 1) { const unsigned o = __shfl(incl, (F.lane - d) & 63); if (e >= d) incl += o; }
        if (F.lane < 32) { F.MISC[MW_CNT + e] = c; F.MISC[MW_TPFX + e] = incl - tl; F.MISC[MW_ROFF + e] = (incl - tl) * 256u;
            if (e == 31) { F.MISC[MW_TPFX + NE] = incl; F.MISC[MW_ROFF + NE] = incl * 256u; } }
    }
    __syncthreads();
}

__device__ __forceinline__ void final_rows(Frame& F) {
    const int gw = F.vcu * NWAVES + F.wave, NGW = F.G * NWAVES;
    const float* mod = (const float*)(F.ws + WS_MOD);
    const bf16_t* X1 = (const bf16_t*)(F.ws + WS_MIX);
    const unsigned char* YD = (const unsigned char*)(F.ws + WS_YD);
    const int* tope = (const int*)(F.ws + WS_TOPE); const float* topw = (const float*)(F.ws + WS_TOPW); const int* topp = (const int*)(F.ws + WS_TOPP);
    const float* gf = F.in[I_GFIN];
    int m = gw;
    u32x4 ne = (u32x4){0u, 0u, 0u, 0u}, np = ne; f32x4 nw = (f32x4){0.f, 0.f, 0.f, 0.f}; u32x2 nx[4];
    if (m < T) { ne = *(const u32x4*)(tope + m * 4); np = *(const u32x4*)(topp + m * 4); nw = *(const f32x4*)(topw + m * 4);
#pragma unroll
        for (int j = 0; j < 4; ++j) nx[j] = ((const u32x2*)(X1 + (size_t)m * DM) + F.lane)[64 * j]; }
    for (; m < T; m += NGW) {
        const int b = m / SEQ;
        const u32x4 ce = ne, cp = np; const f32x4 cw = nw; f32x4 cx[4];
#pragma unroll
        for (int j = 0; j < 4; ++j) cx[j] = (f32x4){bflo(nx[j].x), bfhi(nx[j].x), bflo(nx[j].y), bfhi(nx[j].y)};
        size_t yrow[4];
#pragma unroll
        for (int k = 0; k < 4; ++k) yrow[k] = (size_t)(F.MISC[MW_ROFF + ce[k]] + cp[k]) * DM;
        unsigned yw[4][4];
#pragma unroll
        for (int j = 0; j < 4; ++j)
#pragma unroll
            for (int k = 0; k < 4; ++k) yw[j][k] = *(const unsigned*)(YD + yrow[k] + 4 * F.lane + 256 * j);
        const int mn = m + NGW;
        if (mn < T) { ne = *(const u32x4*)(tope + mn * 4); np = *(const u32x4*)(topp + mn * 4); nw = *(const f32x4*)(topw + mn * 4);
#pragma unroll
            for (int j = 0; j < 4; ++j) nx[j] = ((const u32x2*)(X1 + (size_t)mn * DM) + F.lane)[64 * j]; }
        f32x4 v[4]; float s = 0.f;
#pragma unroll
        for (int j = 0; j < 4; ++j) { const int c = 4 * F.lane + 256 * j;
            f32x4 mo = (f32x4){0.f, 0.f, 0.f, 0.f};
#pragma unroll
            for (int k = 0; k < 4; ++k) mo += (cw[k] * (1.0f / F8_YD_SCALE)) * unpk4_fp8(yw[j][k]);
            const f32x4 gt = *(const f32x4*)(mod + (size_t)b * 6144 + 5 * 1024 + c);
            v[j] = cx[j] + gt * mo;
            s += (v[j][0] * v[j][0] + v[j][1] * v[j][1]) + (v[j][2] * v[j][2] + v[j][3] * v[j][3]); }
        const float rinv = __builtin_amdgcn_rsqf(wave_sum(s) * (1.0f / DM) + EPS);
        f32x4* orow = (f32x4*)(F.out + (size_t)m * DM) + F.lane;
#pragma unroll
        for (int j = 0; j < 4; ++j) __builtin_nontemporal_store(v[j] * rinv * *(const f32x4*)(gf + 4 * F.lane + 256 * j), orow + 64 * j);
    }
}

constexpr int N_PHASES = 10;
#define REP0 1
#define REPB 1
#define REP1 1
#define REP6 1
#define REP2 1
#define REP3 1
#define REP4 1
#define REP5 1
#define REP7 1
#define REP8 1
#define REP9 1
__global__ void __launch_bounds__(NTHREADS, 2) mk_fwd(Args args) {
#ifdef EMU
    unsigned char* lds = emu_blk->lds;
#else
    extern __shared__ __attribute__((aligned(16))) unsigned char lds[];
#endif
    Frame F;
    F.lds = (LAS unsigned char*)lds;
    F.MISC = (volatile LAS unsigned*)(F.lds + MISC_OFF);
    F.tid = threadIdx.x; F.lane = F.tid & 63; F.wave = __builtin_amdgcn_readfirstlane(F.tid >> 6);
    F.G = gridDim.x; { const int bx = blockIdx.x; F.vcu = (F.G % 8 == 0) ? (bx % 8) * (F.G / 8) + bx / 8 : bx; }
    F.ws = args.ws; F.ctl = (unsigned*)(args.ws + WS_CTL); F.out = args.out;
#pragma unroll
    for (int k = 0; k < 24; ++k) F.in[k] = args.in[k];
    for (int u = F.tid; u < (LDS_BYTES - MISC_OFF) / 4; u += NTHREADS) F.MISC[u] = 0u;
    __syncthreads();
    XcdBarrier bar = xcd_barrier_post(F.ctl + CW_BAR, F.MISC + 8);
    const int lo = args.ph_lo, hi = args.ph_hi;
#ifndef EMU
#define STAMP(k) do { if (PROBE_K >= 0 && blockIdx.x == 0 && F.tid == 0) { const unsigned long long t_ = __builtin_amdgcn_s_memrealtime(); F.MISC[((k) >= 20 ? 360 : 256) + 2 * (k)] = (unsigned)t_; F.MISC[((k) >= 20 ? 361 : 257) + 2 * (k)] = (unsigned)(t_ >> 32); } } while (0)
#else
#define STAMP(k) ((void)0)
#endif
    STAMP(0);
#ifndef PH_MASK
#define PH_MASK 0xffff
#endif
#define IN(k) (((PH_MASK >> (k)) & 1) && lo <= (k) && (k) < hi)
#define SEAM(k) do { if (IN(k) && IN((k) + 1)) { xcd_barrier(bar); if (REPB > 1) xcd_barrier(bar); } } while (0)

    if (IN(0)) { p0_prologue(F); if (REP0 > 1) p0_prologue(F); }
    STAMP(20); SEAM(0); STAMP(1);
#ifndef EMU
    if (IN(0) && IN(1)) {
        if (F.tid == 0) { unsigned ok = 1u; for (int j = 0; j < 8; ++j) ok &= (xb_ld(F.ctl + CW_BAR + XB_XCNT(j)) == (unsigned)(F.G / 8)) ? 1u : 0u;
            F.MISC[12] = (ok && bar.x < 8u) ? (bar.x * (unsigned)(F.G / 8) + F.MISC[10]) : (unsigned)F.vcu; }
        __syncthreads();
        F.vcu = (int)F.MISC[12];
    }
#endif
    if (IN(1)) { norm_rows(F, F.in[I_X], F.in[I_GMIX], 0, 1, (bf16_t*)(F.ws + WS_HB)); if (REP1 > 1) norm_rows(F, F.in[I_X], F.in[I_GMIX], 0, 1, (bf16_t*)(F.ws + WS_HB)); }
    STAMP(21); SEAM(1); STAMP(2);
    if (IN(2)) {
        {
        pg8::DenseProb P{(const char*)(F.ws + WS_HB), (const char*)(F.ws + WS_WINT), DM * 2};
        pg8::DenseOrder S; S.init(T, ZP, F.G, (F.G % 8 == 0) ? (F.vcu % (F.G / 8)) * 8 + F.vcu / (F.G / 8) : (int)blockIdx.x);
        EpiZ E{(bf16_t*)(F.ws + WS_ZB)};
        pg8::gemm_phase<false>(F.lds, P, S, E);
        if (p2_fill_items(F) && S.c >= 128) {
            LAS float* scr = (LAS float*)(F.lds + 8192 + F.wave * 16384);
            const int base = P0_NITEMS - p7_fill_items(F) - p2_fill_items(F) + (S.c - 128) * P2_FILL_PER_CU;
            for (int k = F.wave; k < P2_FILL_PER_CU; k += NWAVES) p0_item(F, scr, base + k);
        }
        }
        if (REP2 > 1) {
        pg8::DenseProb P{(const char*)(F.ws + WS_HB), (const char*)(F.ws + WS_WINT), DM * 2};
        pg8::DenseOrder S; S.init(T, ZP, F.G, (F.G % 8 == 0) ? (F.vcu % (F.G / 8)) * 8 + F.vcu / (F.G / 8) : (int)blockIdx.x);
        EpiZ E{(bf16_t*)(F.ws + WS_ZB)};
        pg8::gemm_phase<false>(F.lds, P, S, E);
        }
    }
    STAMP(22); SEAM(2); STAMP(3);
    if (IN(3)) {
        constexpr int NGM = BATCH * (SEQ / GMC) * GMG, NCT = 2 * BATCH * NG * (NCP / 32);
        for (int rep = 0; rep < (REP3 > 1 ? 2 : 1); ++rep) {
            if (F.G == 2 * NCT && NGM == 8 * NCT) {
                constexpr int NA = P3_NA, NB = 8 - P3_NA;
                if (F.vcu < NCT) { cmp_tile(F, F.vcu); gmlp_run(F, NA * F.vcu, 1, NA); }
                else gmlp_run(F, NA * NCT + NB * (F.vcu - NCT), 1, NB);
            } else { for (int it = F.vcu; it < NCT; it += F.G) cmp_tile(F, it);
                     const int first = ((F.vcu - NCT) % F.G + F.G) % F.G; gmlp_run(F, first, F.G, (NGM - first + F.G - 1) / F.G); }
        }
    }
    STAMP(23); SEAM(3); STAMP(4);
    if (IN(4)) {
        constexpr int NQT_ = SEQ / 64, NPAIR = BATCH * NQT_;
        for (int rep = 0; rep < (REP4 > 1 ? 2 : 1); ++rep)
        for (int pr = F.vcu; pr < NPAIR; pr += F.G) { const int b_ = pr / NQT_, x_ = pr % NQT_;
            for (int k2 = 0; k2 < 2; ++k2) nsa_task(F, k2 ? (b_ * NG + 0) * NQT_ + x_ : (b_ * NG + 1) * NQT_ + (NQT_ - 1 - x_)); }
    }
    STAMP(24); SEAM(4); STAMP(5);
    if (IN(5)) {
        {
        pg8::DenseProb P{(const char*)(F.ws + WS_YMIX), (const char*)(F.ws + WS_WOUTT), DM * 2};
        pg8::DenseOrder S; S.init(T, DM, F.G, (F.G % 8 == 0) ? (F.vcu % (F.G / 8)) * 8 + F.vcu / (F.G / 8) : (int)blockIdx.x);
        EpiMix E{(bf16_t*)(F.ws + WS_MIX), F.in[I_X], (const float*)(F.ws + WS_MOD)};
        pg8::gemm_phase<false>(F.lds, P, S, E);
        }
        if (REP5 > 1) {
        pg8::DenseProb P{(const char*)(F.ws + WS_YMIX), (const char*)(F.ws + WS_WOUTT), DM * 2};
        pg8::DenseOrder S; S.init(T, DM, F.G, (F.G % 8 == 0) ? (F.vcu % (F.G / 8)) * 8 + F.vcu / (F.G / 8) : (int)blockIdx.x);
        EpiMix E{(bf16_t*)(F.ws + WS_MIX), F.in[I_X], (const float*)(F.ws + WS_MOD)};
        pg8::gemm_phase<false>(F.lds, P, S, E);
        }
    }
    STAMP(25); SEAM(5); STAMP(6);
    if (IN(6)) {
        if (PROBE_K >= 26 && PROBE_K <= 29 && blockIdx.x == 0 && F.tid == 0) { F.MISC[306] = 0u; F.MISC[307] = 0u; F.MISC[308] = 0u; F.MISC[309] = 0u; }
        u32x2 rm[4][4];
        if (F.vcu < T / 32) router_rows_load(F, F.vcu, rm);
        for (int it = F.vcu; it < T / 32; it += F.G) router_task<false>(F, it, (it + F.G < T / 32) ? it + F.G : -1, rm);
        if (REP6 > 1) { if (F.vcu < T / 32) router_rows_load(F, F.vcu, rm); for (int it = F.vcu; it < T / 32; it += F.G) router_task<true>(F, it, (it + F.G < T / 32) ? it + F.G : -1, rm); }
    }
    STAMP(26); SEAM(6); STAMP(7);
    if (IN(7)) {
        {
        moe_tables(F);
        MoeProb1 P{(const char*)(F.ws + WS_H2), (const char*)(F.ws + WS_WGUT), (const int*)(F.ws + WS_LISTS), F.in[I_BGU], F.MISC + MW_CNT, DM};
        pg8::MoeOrder S{F.MISC + MW_TPFX, 8, F.G, F.vcu, 0};
        EpiAct E{(unsigned char*)(F.ws + WS_ACT), F.in[I_BGU], F.MISC + MW_ROFF};
        pg8::gemm_phase<true>(F.lds, P, S, E);
        if (p7_fill_items(F)) {
            const int rem = ((int)F.MISC[MW_TPFX + NE] * 8) % F.G;
            int nidle = rem ? F.G - rem : 0, j = F.vcu - rem;
            if (nidle < F.G / 4) { nidle = F.G; j = F.vcu; }
            if (j >= 0) {
                __syncthreads();
                LAS float* scr = (LAS float*)(F.lds + F.wave * 8704);
                const int base = P0_NITEMS - p7_fill_items(F);
                for (int k = j * NWAVES + F.wave; k < p7_fill_items(F); k += nidle * NWAVES) p0_item(F, scr, base + k);
            }
        }
        }
        if (REP7 > 1) {
        moe_tables(F);
        MoeProb1 P{(const char*)(F.ws + WS_H2), (const char*)(F.ws + WS_WGUT), (const int*)(F.ws + WS_LISTS), F.in[I_BGU], F.MISC + MW_CNT, DM};
        pg8::MoeOrder S{F.MISC + MW_TPFX, 8, F.G, F.vcu, 0};
        EpiAct E{(unsigned char*)(F.ws + WS_ACT), F.in[I_BGU], F.MISC + MW_ROFF};
        pg8::gemm_phase<true>(F.lds, P, S, E);
        }
    }
    STAMP(27); SEAM(7); STAMP(8);
    if (IN(8)) {
        {
        moe_tables(F);
        MoeProb2 P{(const char*)(F.ws + WS_ACT), (const char*)(F.ws + WS_WDNT), F.in[I_BDN], F.MISC + MW_ROFF, DFF};
        pg8::MoeOrder S{F.MISC + MW_TPFX, 4, F.G, F.vcu, 0};
        EpiYd E{(unsigned char*)(F.ws + WS_YD), F.in[I_BDN], F.MISC + MW_ROFF};
        pg8::gemm_phase<true>(F.lds, P, S, E);
        }
        if (REP8 > 1) {
        moe_tables(F);
        MoeProb2 P{(const char*)(F.ws + WS_ACT), (const char*)(F.ws + WS_WDNT), F.in[I_BDN], F.MISC + MW_ROFF, DFF};
        pg8::MoeOrder S{F.MISC + MW_TPFX, 4, F.G, F.vcu, 0};
        EpiYd E{(unsigned char*)(F.ws + WS_YD), F.in[I_BDN], F.MISC + MW_ROFF};
        pg8::gemm_phase<true>(F.lds, P, S, E);
        }
    }
    STAMP(28); SEAM(8); STAMP(9);
    if (IN(9)) { moe_tables(F); final_rows(F); if (REP9 > 1) final_rows(F); }
#ifndef EMU
    if (PROBE_K >= 0 && blockIdx.x == 0 && F.tid == 0) {
        STAMP(10);
        unsigned long long a_ = 0, b_ = 0;
        if (PROBE_K == 19) { a_ = ((unsigned long long)F.MISC[257] << 32) | F.MISC[256]; b_ = ((unsigned long long)F.MISC[257 + 20] << 32) | F.MISC[256 + 20]; }
        else if (PROBE_K < 20) { a_ = ((unsigned long long)F.MISC[257 + 2 * (PROBE_K % 20)] << 32) | F.MISC[256 + 2 * (PROBE_K % 20)];
                            b_ = ((unsigned long long)F.MISC[259 + 2 * (PROBE_K % 20)] << 32) | F.MISC[258 + 2 * (PROBE_K % 20)]; }
        else if (PROBE_K >= 30 && PROBE_K < 40) { a_ = ((unsigned long long)F.MISC[361 + 2 * (20 + PROBE_K - 30)] << 32) | F.MISC[360 + 2 * (20 + PROBE_K - 30)]; b_ = ((unsigned long long)F.MISC[257 + 2 * (PROBE_K - 30 + 1)] << 32) | F.MISC[256 + 2 * (PROBE_K - 30 + 1)]; }
        else if (PROBE_K == 99) b_ = 5000;
        else if (PROBE_K >= 50) b_ = F.MISC[300 + 6 + (PROBE_K % 10)];
        else b_ = F.MISC[300 + (PROBE_K - 20)];
        const unsigned long long t0_ = __builtin_amdgcn_s_memrealtime();
        while (__builtin_amdgcn_s_memrealtime() - t0_ < (b_ - a_)) __builtin_amdgcn_s_sleep(8);
    }
#endif
#undef IN
#undef SEAM
}

#ifdef EMU
struct EmuDump { const char* name; size_t off; size_t bytes; };
EmuDump emu_dumps[] = {
    {"mod", WS_MOD, (size_t)BATCH * 6144 * 4}, {"bpe", WS_BPE, 512 * 4}, {"wint", WS_WINT, (size_t)ZP * DM * 2}, {"hb", WS_HB, (size_t)T * DM * 2},
    {"zb", WS_ZB, (size_t)T * ZP * 2}, {"kc", WS_KC, (size_t)BATCH * NG * NCP * 64 * 2}, {"vc", WS_VC, (size_t)BATCH * NG * NCP * 64 * 2},
    {"ymix", WS_YMIX, (size_t)T * DM * 2}, {"mix", WS_MIX, (size_t)T * DM * 2}, {"h2", WS_H2, (size_t)T * DM * 2},
    {"tope", WS_TOPE, (size_t)T * 16}, {"topw", WS_TOPW, (size_t)T * 16}, {"topp", WS_TOPP, (size_t)T * 16}, {"ctl", WS_CTL, CTL_ZERO_BYTES},
};
int emu_ndumps = sizeof(emu_dumps) / sizeof(emu_dumps[0]);
size_t emu_ws_bytes = WS_END;
int emu_out_elems = T * DM;
#endif

extern "C" void kernel_launch(void* const* d_in, const int* in_sizes, int n_in, void* d_out, int out_size, void* d_ws, size_t ws_size, hipStream_t stream) {
    (void)in_sizes; (void)out_size; (void)ws_size;
    Args a{};
    for (int i = 0; i < 24 && i < n_in; ++i) a.in[i] = (const float*)d_in[i];
    a.out = (float*)d_out; a.ws = (unsigned char*)d_ws;
#ifndef EMU
    (void)hipMemsetAsync((char*)d_ws + WS_CTL, 0, CTL_ZERO_BYTES, stream);
#endif
#ifdef EMU
    int plo = 0, phi = N_PHASES;
    if (const char* e = getenv("EMU_PH_LO")) plo = atoi(e);
    if (const char* e = getenv("EMU_PH_HI")) phi = atoi(e);
    if (plo == 0) (void)hipMemsetAsync((char*)d_ws + WS_CTL, 0, CTL_ZERO_BYTES, stream);
    const int grid = emu_num_cus();
    for (int ph = plo; ph < phi; ++ph) { a.ph_lo = ph; a.ph_hi = ph + 1; Args ac = a; fprintf(stderr, "EMU phase %d\n", ph);
        emu_launch(grid, NTHREADS, LDS_BYTES, [ac]() { mk_fwd(ac); }); }
#else
    static int grid = 0;
    if (grid == 0) {
        int dev = 0, cus = 0, per_cu = 0;
        (void)hipGetDevice(&dev);
        (void)hipDeviceGetAttribute(&cus, hipDeviceAttributeMultiprocessorCount, dev);
        (void)hipFuncSetAttribute((const void*)mk_fwd, hipFuncAttributeMaxDynamicSharedMemorySize, LDS_BYTES);
        (void)hipOccupancyMaxActiveBlocksPerMultiprocessor(&per_cu, (const void*)mk_fwd, NTHREADS, LDS_BYTES);
        if (per_cu < 1) fprintf(stderr, "kernel_launch: occupancy query reports %d blocks/CU\n", per_cu);
        grid = cus;
        (void)hipGetLastError();
    }
    a.ph_lo = 0; a.ph_hi = N_PHASES;
    void* kargs[] = {&a};
    hipError_t e = hipLaunchCooperativeKernel((const void*)mk_fwd, dim3(grid), dim3(NTHREADS), kargs, LDS_BYTES, stream);
    if (e != hipSuccess) fprintf(stderr, "cooperative launch failed: %s (grid %d)\n", hipGetErrorString(e), grid);
#endif
}
```
